# Optimizing an MI355X kernel written in HIP

```python
import math
import jax
import jax.numpy as jnp
from jax import lax
import numpy as np

D_MODEL = 1024
BATCH = 4
SEQ = 4096
DEPTH = 4
DEC_BATCH = 32
DEC_SEQ = 4
PAST_LEN = 8192
PAGE_SIZE = 128

N_A_LAYERS = DEPTH // 2
N_B_LAYERS = DEPTH - N_A_LAYERS
N_HEADS = 16
KV_HEADS = 4
GROUP = N_HEADS // KV_HEADS
HEAD_DIM = 64
CONV_W = 31
D_FF = -(-8 * D_MODEL // (3 * 256)) * 256
CMP_BLOCK = 32
SEL_BLOCK = 64
N_SEL = 16
WINDOW = 512
PHI_HIDDEN = 128
N_BUCKETS = 32
MAX_DISTANCE = 1024
Q_BLOCK = 128
EPS = 1e-6
NEG = -1e30
FORCE = 1e4

kernel_name = 'yoco_conformer_nsa_decoder_step'


def rmsnorm(x, g):
    x32 = x.astype(jnp.float32)
    y = x32 * lax.rsqrt(jnp.mean(x32 * x32, axis=-1, keepdims=True) + EPS) * g.astype(jnp.float32)
    return y.astype(x.dtype)


def layernorm(x, g, b):
    x32 = x.astype(jnp.float32)
    mu = jnp.mean(x32, axis=-1, keepdims=True)
    var = jnp.mean(jnp.square(x32 - mu), axis=-1, keepdims=True)
    y = (x32 - mu) * lax.rsqrt(var + EPS) * g.astype(jnp.float32) + b.astype(jnp.float32)
    return y.astype(x.dtype)


def ada_modulation(c, w, b):
    m = jax.nn.silu(c) @ w + b
    shift, scale, gate = jnp.split(m, 3, axis=-1)
    return shift[:, None, :], scale[:, None, :], gate[:, None, :]


def swiglu(h, w_gate, w_up, w_down):
    return (jax.nn.silu(h @ w_gate) * (h @ w_up)) @ w_down


def rel_bucket(dist):
    n = jnp.maximum(dist, 0)
    exact = N_BUCKETS // 2
    nf = jnp.maximum(n, 1).astype(jnp.float32)
    large = exact + (jnp.log(nf / exact) / math.log(MAX_DISTANCE / exact) * (N_BUCKETS - exact)).astype(jnp.int32)
    large = jnp.minimum(large, N_BUCKETS - 1)
    return jnp.where(n < exact, n, large)


def rel_bias_2d(table, q_pos, k_pos):
    b = table.astype(jnp.float32)[rel_bucket(q_pos[:, None] - k_pos[None, :])]
    return b.reshape(q_pos.shape[0], k_pos.shape[0], KV_HEADS, GROUP).transpose(2, 3, 0, 1)


def masked_softmax(s, mask, axis):
    s = jnp.where(mask, s, NEG)
    return jax.nn.softmax(s, axis=axis) * mask


def conformer_conv(h, prev, w_pw1, b_pw1, w_dw, b_dw, ln_g, ln_b, w_pw2, b_pw2):
    u = h @ w_pw1 + b_pw1
    a, g = jnp.split(u, 2, axis=-1)
    u = a * jax.nn.sigmoid(g)
    if prev is None:
        prev = jnp.zeros((u.shape[0], CONV_W - 1, u.shape[2]), u.dtype)
    full = jnp.concatenate([prev.astype(u.dtype), u], axis=1)
    y = lax.conv_general_dilated(full, w_dw[:, None, :].astype(u.dtype), (1,), 'VALID',
                                 dimension_numbers=('NWC', 'WIO', 'NWC'),
                                 feature_group_count=u.shape[-1]) + b_dw
    y = jax.nn.silu(layernorm(y, ln_g, ln_b))
    return y @ w_pw2 + b_pw2, full[:, -(CONV_W - 1):]


def shared_kv_rows(x, g_kv, w_kv):
    B, T, _ = x.shape
    return (rmsnorm(x, g_kv) @ w_kv).reshape(B, T, 3, 2, KV_HEADS, HEAD_DIM)


def gather_pages(cache, page_table):
    g = cache[page_table]
    return g.reshape(page_table.shape[0], page_table.shape[1] * PAGE_SIZE, *cache.shape[2:])


def compress(kv_full, w_phi1, b_phi1, w_phi2, b_phi2, pe_cmp):
    B, Tk = kv_full.shape[:2]
    n = Tk // CMP_BLOCK
    blk = kv_full[:, :n * CMP_BLOCK].reshape(B, n, CMP_BLOCK, 2, KV_HEADS, HEAD_DIM)
    blk = blk + pe_cmp.transpose(1, 0, 2)[:, :, None, :]
    blk = blk.transpose(0, 1, 3, 4, 2, 5).reshape(B, n, 2, KV_HEADS, CMP_BLOCK * HEAD_DIM)
    hid = jax.nn.silu(jnp.einsum('bnegf,efh->bnegh', blk, w_phi1) + b_phi1[:, None, :])
    out = jnp.einsum('bnegh,ehd->bnegd', hid, w_phi2) + b_phi2[:, None, :]
    end = jnp.arange(n) * CMP_BLOCK + CMP_BLOCK - 1
    return out[:, :, 0], out[:, :, 1], end


def selection_blocks(kv_full):
    B, Tk = kv_full.shape[:2]
    n_blk = -(-Tk // SEL_BLOCK)
    kv = jnp.pad(kv_full, ((0, 0), (0, n_blk * SEL_BLOCK - Tk), (0, 0), (0, 0), (0, 0)))
    kv = kv.reshape(B, n_blk, SEL_BLOCK, 2, KV_HEADS, HEAD_DIM).transpose(3, 0, 4, 1, 2, 5)
    return kv[0], kv[1]


def nsa_chunk(q, gates, q_pos, cmp_k, cmp_v, cmp_end, blk_k, blk_v, win_k, win_v, win_pos, table):
    B, Q = q.shape[:2]
    s_c = jnp.einsum('bqgrd,bngd->bgrqn', q, cmp_k).astype(jnp.float32) + rel_bias_2d(table, q_pos, cmp_end)
    p_c = masked_softmax(s_c, cmp_end[None, :] <= q_pos[:, None], -1)
    o_c = jnp.einsum('bgrqn,bngd->bqgrd', p_c.astype(cmp_v.dtype), cmp_v)
    n_cmp = cmp_end.shape[0]
    n_blk = blk_k.shape[2]
    ratio = SEL_BLOCK // CMP_BLOCK
    imp = jnp.pad(p_c.sum(axis=2), ((0, 0), (0, 0), (0, 0), (0, n_blk * ratio - n_cmp)))
    imp = imp.reshape(B, KV_HEADS, Q, n_blk, ratio).sum(-1)
    j = jnp.arange(n_blk)[None, :]
    jq = (q_pos // SEL_BLOCK)[:, None]
    forced = (j == 0) | (j == jq) | (j == jq - 1)
    score = jnp.where(j <= jq, jnp.where(forced, FORCE, imp), -1.0)
    top_s, idx = lax.top_k(score, min(N_SEL, n_blk))
    bi = jnp.arange(B)[:, None, None, None]
    gi = jnp.arange(KV_HEADS)[None, :, None, None]
    ks = blk_k[bi, gi, idx]
    vs = blk_v[bi, gi, idx]
    kpos = idx[..., None] * SEL_BLOCK + jnp.arange(SEL_BLOCK)
    qp = q_pos[None, None, :, None, None]
    smask = (top_s >= 0)[..., None] & (kpos <= qp)
    table_g = table.astype(jnp.float32).reshape(N_BUCKETS, KV_HEADS, GROUP).transpose(1, 0, 2)
    bias_s = table_g[jnp.arange(KV_HEADS)[None, :, None, None, None], rel_bucket(qp - kpos)]
    s_s = jnp.einsum('bqgrd,bgqksd->bgqksr', q, ks).astype(jnp.float32) + bias_s
    nk = ks.shape[3] * SEL_BLOCK
    p_s = masked_softmax(s_s.reshape(B, KV_HEADS, Q, nk, GROUP), smask.reshape(B, KV_HEADS, Q, nk)[..., None], 3)
    o_s = jnp.einsum('bgqnr,bgqnd->bqgrd', p_s.astype(vs.dtype), vs.reshape(B, KV_HEADS, Q, nk, HEAD_DIM))
    d = q_pos[:, None] - win_pos[None, :]
    wmask = (d >= 0) & (d < WINDOW) & (win_pos[None, :] >= 0)
    s_w = jnp.einsum('bqgrd,bkgd->bgrqk', q, win_k).astype(jnp.float32) + rel_bias_2d(table, q_pos, win_pos)
    p_w = masked_softmax(s_w, wmask, -1)
    o_w = jnp.einsum('bgrqk,bkgd->bqgrd', p_w.astype(win_v.dtype), win_v)
    return gates[..., 0:1] * o_c + gates[..., 1:2] * o_s + gates[..., 2:3] * o_w


def nsa_mixer(h, w_qg, w_o, table, cmp_k, cmp_v, cmp_end, blk_k, blk_v, win_all, q_pos0, is_prompt):
    B, T, _ = h.shape
    qg = h @ w_qg
    q = qg[..., :N_HEADS * HEAD_DIM].reshape(B, T, KV_HEADS, GROUP, HEAD_DIM) * (HEAD_DIM ** -0.5)
    gates = jax.nn.sigmoid(qg[..., N_HEADS * HEAD_DIM:]).reshape(B, T, KV_HEADS, GROUP, 3)
    if is_prompt:
        nb = T // Q_BLOCK
        wpad = jnp.pad(win_all, ((0, 0), (WINDOW, 0), (0, 0), (0, 0), (0, 0)))

        def body(args):
            qc, gc, i = args
            start = i * Q_BLOCK
            q_pos = start + jnp.arange(Q_BLOCK)
            wkv = lax.dynamic_slice_in_dim(wpad, start, Q_BLOCK + WINDOW, axis=1)
            w_pos = start - WINDOW + jnp.arange(Q_BLOCK + WINDOW)
            return nsa_chunk(qc, gc, q_pos, cmp_k, cmp_v, cmp_end, blk_k, blk_v,
                             wkv[:, :, 0], wkv[:, :, 1], w_pos, table)

        qc = q.reshape(B, nb, Q_BLOCK, KV_HEADS, GROUP, HEAD_DIM).swapaxes(0, 1)
        gc = gates.reshape(B, nb, Q_BLOCK, KV_HEADS, GROUP, 3).swapaxes(0, 1)
        o = lax.map(body, (qc, gc, jnp.arange(nb)))
        o = o.swapaxes(0, 1).reshape(B, T, N_HEADS * HEAD_DIM)
    else:
        q_pos = q_pos0 + jnp.arange(T)
        w_pos = q_pos0 + T - win_all.shape[1] + jnp.arange(win_all.shape[1])
        o = nsa_chunk(q, gates, q_pos, cmp_k, cmp_v, cmp_end, blk_k, blk_v,
                      win_all[:, :, 0], win_all[:, :, 1], w_pos, table)
        o = o.reshape(B, T, N_HEADS * HEAD_DIM)
    return o @ w_o


def trunk(x, c, is_prompt, cache_kv_cmp, cache_kv_sel, cache_kv_win, state_conv, page_table, P):
    B, T, _ = x.shape
    conv_states = []
    for l in range(DEPTH):
        if l == N_A_LAYERS:
            rows = shared_kv_rows(x, P['g_kv'], P['w_kv'])
            if is_prompt:
                q_pos0 = 0
                cmp_full = rows[:, :, 0]
                sel_full = rows[:, :, 1]
                win_all = rows[:, :, 2]
                win_state = win_all[:, -min(WINDOW, T):]
            else:
                q_pos0 = page_table.shape[1] * PAGE_SIZE
                cmp_full = jnp.concatenate([gather_pages(cache_kv_cmp, page_table), rows[:, :, 0]], axis=1)
                sel_full = jnp.concatenate([gather_pages(cache_kv_sel, page_table), rows[:, :, 1]], axis=1)
                win_all = jnp.concatenate([cache_kv_win, rows[:, :, 2]], axis=1)
                win_state = win_all[:, -cache_kv_win.shape[1]:]
            cmp_k, cmp_v, cmp_end = compress(cmp_full, P['w_phi1'], P['b_phi1'], P['w_phi2'], P['b_phi2'], P['pe_cmp'])
            blk_k, blk_v = selection_blocks(sel_full)
        shift, scale, gate = ada_modulation(c, P['w_ada'][l, 0], P['b_ada'][l, 0])
        h = rmsnorm(x, P['norm_g'][l, 0]) * (1 + scale) + shift
        if l < N_A_LAYERS:
            prev = None if is_prompt else state_conv[l]
            out, st = conformer_conv(h, prev, P['w_pw1'][l], P['b_pw1'][l], P['w_dw'][l], P['b_dw'][l],
                                     P['ln_g'][l], P['ln_b'][l], P['w_pw2'][l], P['b_pw2'][l])
            conv_states.append(st)
        else:
            lb = l - N_A_LAYERS
            out = nsa_mixer(h, P['w_qg'][lb], P['w_o'][lb], P['rel_table'], cmp_k, cmp_v, cmp_end,
                            blk_k, blk_v, win_all, q_pos0, is_prompt)
        x = x + gate * out
        shift, scale, gate = ada_modulation(c, P['w_ada'][l, 1], P['b_ada'][l, 1])
        h = rmsnorm(x, P['norm_g'][l, 1]) * (1 + scale) + shift
        x = x + gate * swiglu(h, P['w_gate'][l], P['w_up'][l], P['w_down'][l])
    y = rmsnorm(x, P['final_g'])
    return y, rows[:, :, 0], rows[:, :, 1], win_state, jnp.stack(conv_states)


def setup_inputs(seed: int = 0) -> dict:
    key = jax.random.key(seed)
    ks = jax.random.split(key, 48)
    it = iter(range(48))

    def nrm(shape, scale):
        return jax.random.normal(ks[next(it)], shape, jnp.float32) * scale

    n_pages = PAST_LEN // PAGE_SIZE
    n_pool = (DEC_BATCH * n_pages * 5 + 3) // 4
    win_buf = min(WINDOW, PAST_LEN)
    qg_width = N_HEADS * HEAD_DIM + 3 * N_HEADS
    kv_width = 3 * 2 * KV_HEADS * HEAD_DIM
    perm = jax.random.permutation(ks[next(it)], n_pool)
    page_table = perm[:DEC_BATCH * n_pages].reshape(DEC_BATCH, n_pages).astype(jnp.int32)
    return {
        'x_prompt': nrm((BATCH, SEQ, D_MODEL), 1.0),
        'x_sample': nrm((DEC_BATCH, DEC_SEQ, D_MODEL), 1.0),
        'c_prompt': nrm((BATCH, D_MODEL), 1.0),
        'c_sample': nrm((DEC_BATCH, D_MODEL), 1.0),
        'cache_kv_cmp': nrm((n_pool, PAGE_SIZE, 2, KV_HEADS, HEAD_DIM), 1.0),
        'cache_kv_sel': nrm((n_pool, PAGE_SIZE, 2, KV_HEADS, HEAD_DIM), 1.0),
        'cache_kv_win': nrm((DEC_BATCH, win_buf, 2, KV_HEADS, HEAD_DIM), 1.0),
        'state_conv': nrm((N_A_LAYERS, DEC_BATCH, CONV_W - 1, D_MODEL), 0.5),
        'page_table': page_table,
        'w_ada': nrm((DEPTH, 2, D_MODEL, 3 * D_MODEL), 0.5 * D_MODEL ** -0.5),
        'b_ada': nrm((DEPTH, 2, 3 * D_MODEL), 0.02),
        'norm_g': 1.0 + nrm((DEPTH, 2, D_MODEL), 0.05),
        'w_pw1': nrm((N_A_LAYERS, D_MODEL, 2 * D_MODEL), D_MODEL ** -0.5),
        'b_pw1': nrm((N_A_LAYERS, 2 * D_MODEL), 0.02),
        'w_dw': nrm((N_A_LAYERS, CONV_W, D_MODEL), CONV_W ** -0.5),
        'b_dw': nrm((N_A_LAYERS, D_MODEL), 0.02),
        'ln_g': 1.0 + nrm((N_A_LAYERS, D_MODEL), 0.05),
        'ln_b': nrm((N_A_LAYERS, D_MODEL), 0.02),
        'w_pw2': nrm((N_A_LAYERS, D_MODEL, D_MODEL), D_MODEL ** -0.5),
        'b_pw2': nrm((N_A_LAYERS, D_MODEL), 0.02),
        'g_kv': 1.0 + nrm((D_MODEL,), 0.05),
        'w_kv': nrm((D_MODEL, kv_width), D_MODEL ** -0.5),
        'w_phi1': nrm((2, CMP_BLOCK * HEAD_DIM, PHI_HIDDEN), (CMP_BLOCK * HEAD_DIM) ** -0.5),
        'b_phi1': nrm((2, PHI_HIDDEN), 0.02),
        'w_phi2': nrm((2, PHI_HIDDEN, HEAD_DIM), PHI_HIDDEN ** -0.5),
        'b_phi2': nrm((2, HEAD_DIM), 0.02),
        'pe_cmp': nrm((2, CMP_BLOCK, HEAD_DIM), 0.1),
        'w_qg': nrm((N_B_LAYERS, D_MODEL, qg_width), D_MODEL ** -0.5),
        'w_o': nrm((N_B_LAYERS, N_HEADS * HEAD_DIM, D_MODEL), (N_HEADS * HEAD_DIM) ** -0.5),
        'rel_table': nrm((N_BUCKETS, N_HEADS), 0.5),
        'w_gate': nrm((DEPTH, D_MODEL, D_FF), D_MODEL ** -0.5),
        'w_up': nrm((DEPTH, D_MODEL, D_FF), D_MODEL ** -0.5),
        'w_down': nrm((DEPTH, D_FF, D_MODEL), D_FF ** -0.5),
        'final_g': 1.0 + nrm((D_MODEL,), 0.05),
    }


def reference(x_prompt, x_sample, c_prompt, c_sample, cache_kv_cmp, cache_kv_sel, cache_kv_win, state_conv,
              page_table, w_ada, b_ada, norm_g, w_pw1, b_pw1, w_dw, b_dw, ln_g, ln_b, w_pw2, b_pw2,
              g_kv, w_kv, w_phi1, b_phi1, w_phi2, b_phi2, pe_cmp, w_qg, w_o, rel_table,
              w_gate, w_up, w_down, final_g):
    P = dict(w_ada=w_ada, b_ada=b_ada, norm_g=norm_g, w_pw1=w_pw1, b_pw1=b_pw1, w_dw=w_dw, b_dw=b_dw,
             ln_g=ln_g, ln_b=ln_b, w_pw2=w_pw2, b_pw2=b_pw2, g_kv=g_kv, w_kv=w_kv, w_phi1=w_phi1,
             b_phi1=b_phi1, w_phi2=w_phi2, b_phi2=b_phi2, pe_cmp=pe_cmp, w_qg=w_qg, w_o=w_o,
             rel_table=rel_table, w_gate=w_gate, w_up=w_up, w_down=w_down, final_g=final_g)
    y_prompt, cmp_p, sel_p, win_p, conv_p = trunk(x_prompt, c_prompt, True, None, None, None, None, None, P)
    y_sample, cmp_s, sel_s, win_s, conv_s = trunk(x_sample, c_sample, False, cache_kv_cmp, cache_kv_sel,
                                                  cache_kv_win, state_conv, page_table, P)
    return (y_prompt, y_sample, cmp_p, cmp_s, sel_p, sel_s, win_p, win_s, conv_p, conv_s)
```

```cpp
#define FK_NLAUNCH 1
#include <math.h>
#include <hip/hip_runtime.h>
#include <stdint.h>
#include <stdio.h>

namespace nv {
constexpr int D = 1024, BATCH = 4, SEQ = 4096, DB = 32, DS = 4, PAST = 8192, PAGE = 128, NPAGES = 64;
constexpr int KVH = 4, GROUP = 4, HD = 64, CONVW = 31, DFF = 2816, PHI = 128, QGW = 1072, KVW = 1536;
constexpr int MP = BATCH * SEQ, MS = DB * DS, R = MP + MS, NC = 36;
constexpr float EPS = 1e-6f;

constexpr size_t O_YP = 0, O_YS = O_YP + (size_t)MP * D, O_CMPP = O_YS + (size_t)MS * D, O_CMPS = O_CMPP + (size_t)MP * 512,
                 O_SELP = O_CMPS + (size_t)MS * 512, O_SELS = O_SELP + (size_t)MP * 512, O_WINP = O_SELS + (size_t)MS * 512,
                 O_WINS = O_WINP + (size_t)BATCH * 512 * 512, O_CONVP = O_WINS + (size_t)DB * 512 * 512,
                 O_CONVS = O_CONVP + (size_t)2 * BATCH * 30 * D, O_END = O_CONVS + (size_t)2 * DB * 30 * D;

__device__ __forceinline__ float silu(float x) { return x / (1.f + expf(-x)); }
__device__ __forceinline__ float sigm(float x) { return 1.f / (1.f + expf(-x)); }
__device__ __forceinline__ int cidx_of(int row) { return row < MP ? row / SEQ : 4 + (row - MP) / DS; }
__device__ __forceinline__ int rel_bucket(int n) {
    if (n < 0) n = 0;
    if (n < 16) return n;
    int b = 16;
    b += (n >= 21); b += (n >= 27); b += (n >= 35); b += (n >= 46); b += (n >= 59); b += (n >= 77); b += (n >= 99); b += (n >= 128);
    b += (n >= 166); b += (n >= 216); b += (n >= 280); b += (n >= 363); b += (n >= 470); b += (n >= 609); b += (n >= 790);
    return b;
}

__global__ __launch_bounds__(256) void k_gemm(const float* __restrict__ A, int lda, const float* __restrict__ W, int ldw, const float* __restrict__ bias,
                                              float* __restrict__ C, int ldc, int M, int N, int K) {
    __shared__ float As[16][68];
    __shared__ float Ws[16][68];
    const int tid = threadIdx.x, tx = tid & 15, ty = tid >> 4;
    const int m0 = blockIdx.y * 64, n0 = blockIdx.x * 64;
    float acc[4][4];
#pragma unroll
    for (int i = 0; i < 4; ++i)
#pragma unroll
        for (int j = 0; j < 4; ++j) acc[i][j] = 0.f;
    for (int k0 = 0; k0 < K; k0 += 16) {
#pragma unroll
        for (int it = 0; it < 4; ++it) { const int i = tid + it * 256; const int m = i >> 4, k = i & 15; const int gm = m0 + m; As[k][m] = gm < M ? A[(size_t)gm * lda + k0 + k] : 0.f; }
#pragma unroll
        for (int it = 0; it < 4; ++it) { const int i = tid + it * 256; const int k = i >> 6, n = i & 63; const int gn = n0 + n; Ws[k][n] = gn < N ? W[(size_t)(k0 + k) * ldw + gn] : 0.f; }
        __syncthreads();
#pragma unroll
        for (int k = 0; k < 16; ++k) {
            const float4 a = *(const float4*)&As[k][ty * 4]; const float4 b = *(const float4*)&Ws[k][tx * 4];
            const float av[4] = {a.x, a.y, a.z, a.w}, bv[4] = {b.x, b.y, b.z, b.w};
#pragma unroll
            for (int i = 0; i < 4; ++i)
#pragma unroll
                for (int j = 0; j < 4; ++j) acc[i][j] += av[i] * bv[j];
        }
        __syncthreads();
    }
#pragma unroll
    for (int i = 0; i < 4; ++i) { const int gm = m0 + ty * 4 + i; if (gm >= M) continue;
#pragma unroll
        for (int j = 0; j < 4; ++j) { const int gn = n0 + tx * 4 + j; if (gn < N) C[(size_t)gm * ldc + gn] = acc[i][j] + (bias ? bias[gn] : 0.f); } }
}

__global__ void k_silu_c(const float* cp, const float* cs, float* SC) {
    const int i = blockIdx.x * blockDim.x + threadIdx.x; if (i >= NC * D) return;
    const int r = i / D, k = i % D; const float v = r < 4 ? cp[r * D + k] : cs[(r - 4) * D + k]; SC[i] = silu(v);
}

__device__ __forceinline__ float block_sum256(float v, float* red) {
#pragma unroll
    for (int o = 32; o >= 1; o >>= 1) v += __shfl_xor(v, o);
    __syncthreads();
    if ((threadIdx.x & 63) == 0) red[threadIdx.x >> 6] = v;
    __syncthreads();
    return red[0] + red[1] + red[2] + red[3];
}
__global__ __launch_bounds__(256) void k_modnorm(const float* __restrict__ X, const float* __restrict__ g, const float* __restrict__ mod, float* __restrict__ H) {
    __shared__ float red[4];
    const int row = blockIdx.x, t = threadIdx.x; const float4 x = ((const float4*)(X + (size_t)row * D))[t];
    const float ss = block_sum256(x.x * x.x + x.y * x.y + x.z * x.z + x.w * x.w, red);
    const float rstd = (1.0f / sqrtf(ss * (1.f / D) + EPS));
    const float4 gv = ((const float4*)g)[t]; float4 y = {x.x * rstd * gv.x, x.y * rstd * gv.y, x.z * rstd * gv.z, x.w * rstd * gv.w};
    if (mod) { const float* m = mod + (size_t)cidx_of(row) * 3072; const float4 sh = ((const float4*)m)[t], sc = ((const float4*)(m + D))[t];
        y.x = y.x * (1.f + sc.x) + sh.x; y.y = y.y * (1.f + sc.y) + sh.y; y.z = y.z * (1.f + sc.z) + sh.z; y.w = y.w * (1.f + sc.w) + sh.w; }
    ((float4*)(H + (size_t)row * D))[t] = y;
}
__global__ void k_glu(const float* __restrict__ T1, float* __restrict__ U) {
    const size_t i = (size_t)blockIdx.x * blockDim.x + threadIdx.x; if (i >= (size_t)R * D) return;
    const size_t r = i / D; const int c = (int)(i % D); const float a = T1[r * 2048 + c], gg = T1[r * 2048 + D + c]; U[i] = a * sigm(gg);
}
__global__ void k_conv(const float* __restrict__ U, const float* __restrict__ state  , const float* __restrict__ wdw  , const float* __restrict__ bdw,
                       float* __restrict__ Y) {
    const size_t i = (size_t)blockIdx.x * blockDim.x + threadIdx.x; if (i >= (size_t)R * D) return;
    const int row = (int)(i / D), c = (int)(i % D); float acc = bdw[c];
    if (row < MP) { const int b = row / SEQ, t = row % SEQ;
        for (int k = 0; k < CONVW; ++k) { const int tt = t - 30 + k; if (tt >= 0) acc += wdw[k * D + c] * U[((size_t)b * SEQ + tt) * D + c]; }
    } else { const int rs = row - MP, b = rs / DS, t = rs % DS;
        for (int k = 0; k < CONVW; ++k) { const int j = t + k; const float v = j < 30 ? state[((size_t)b * 30 + j) * D + c] : U[((size_t)MP + b * DS + (j - 30)) * D + c]; acc += wdw[k * D + c] * v; }
    }
    Y[i] = acc;
}
__global__ void k_conv_state_out(const float* __restrict__ U, const float* __restrict__ state, float* __restrict__ outp  , float* __restrict__ outs  ) {
    const int i = blockIdx.x * blockDim.x + threadIdx.x; const int NPo = BATCH * 30 * D, NSo = DB * 30 * D;
    if (i < NPo) { const int b = i / (30 * D), j = (i / D) % 30, c = i % D; outp[i] = U[((size_t)b * SEQ + SEQ - 30 + j) * D + c]; }
    else if (i < NPo + NSo) { const int ii = i - NPo; const int b = ii / (30 * D), j = (ii / D) % 30, c = ii % D;
        outs[ii] = j < 26 ? state[((size_t)b * 30 + j + 4) * D + c] : U[((size_t)MP + b * DS + (j - 26)) * D + c]; }
}
__global__ __launch_bounds__(256) void k_ln_silu(const float* __restrict__ Y, const float* __restrict__ g, const float* __restrict__ bb, float* __restrict__ Cc) {
    __shared__ float red[4];
    const int row = blockIdx.x, t = threadIdx.x; const float4 x = ((const float4*)(Y + (size_t)row * D))[t];
    const float mu = block_sum256(x.x + x.y + x.z + x.w, red) * (1.f / D);
    const float4 d = {x.x - mu, x.y - mu, x.z - mu, x.w - mu};
    const float var = block_sum256(d.x * d.x + d.y * d.y + d.z * d.z + d.w * d.w, red) * (1.f / D);
    const float rstd = (1.0f / sqrtf(var + EPS)); const float4 gv = ((const float4*)g)[t], bv = ((const float4*)bb)[t];
    float4 y = {silu(d.x * rstd * gv.x + bv.x), silu(d.y * rstd * gv.y + bv.y), silu(d.z * rstd * gv.z + bv.z), silu(d.w * rstd * gv.w + bv.w)};
    ((float4*)(Cc + (size_t)row * D))[t] = y;
}
__global__ void k_resid(float* __restrict__ X, const float* __restrict__ T, int ldt, const float* __restrict__ mod) {
    const size_t i = (size_t)blockIdx.x * blockDim.x + threadIdx.x; if (i >= (size_t)R * D) return;
    const int row = (int)(i / D), c = (int)(i % D); X[i] += mod[(size_t)cidx_of(row) * 3072 + 2048 + c] * T[(size_t)row * ldt + c];
}
__global__ void k_swiglu(const float* __restrict__ G, const float* __restrict__ UP, float* __restrict__ ACT) {
    const size_t i = (size_t)blockIdx.x * blockDim.x + threadIdx.x; if (i >= (size_t)R * DFF) return; ACT[i] = silu(G[i]) * UP[i];
}
__global__ void k_kv_out(const float* __restrict__ ROWS, const float* __restrict__ cache_win, float* __restrict__ out) {
    const size_t i = (size_t)blockIdx.x * blockDim.x + threadIdx.x;
    const size_t n1 = (size_t)MP * 512, n2 = (size_t)MS * 512, n3 = (size_t)BATCH * 512 * 512, n4 = (size_t)DB * 512 * 512;
    if (i < n1) { const size_t r = i / 512, c = i % 512; out[O_CMPP + i] = ROWS[r * KVW + c]; out[O_SELP + i] = ROWS[r * KVW + 512 + c]; }
    if (i < n2) { const size_t r = i / 512, c = i % 512; out[O_CMPS + i] = ROWS[(MP + r) * KVW + c]; out[O_SELS + i] = ROWS[(MP + r) * KVW + 512 + c]; }
    if (i < n3) { const size_t b = i / (512 * 512), j = (i / 512) % 512, c = i % 512; out[O_WINP + i] = ROWS[(b * SEQ + SEQ - 512 + j) * KVW + 1024 + c]; }
    if (i < n4) { const size_t b = i / (512 * 512), j = (i / 512) % 512, c = i % 512;
        out[O_WINS + i] = j < 508 ? cache_win[(b * 512 + j + 4) * 512 + c] : ROWS[(MP + b * DS + (j - 508)) * KVW + 1024 + c]; }
}
__global__ __launch_bounds__(256) void k_compress(int is_prompt, const float* __restrict__ ROWS, const float* __restrict__ cache, const int* __restrict__ pt,
                                                   const float* __restrict__ w1, const float* __restrict__ b1, const float* __restrict__ w2, const float* __restrict__ b2,
                                                   const float* __restrict__ pe, float* __restrict__ CMP) {
    __shared__ float blk[32 * 4 * 64];
    __shared__ float hid[4][PHI];
    const int NB = is_prompt ? 128 : 256, BB = is_prompt ? BATCH : DB;
    const int e = blockIdx.x & 1, n = (blockIdx.x >> 1) % NB, b = (blockIdx.x >> 1) / NB, tid = threadIdx.x;
    for (int i = tid; i < 32 * 256; i += 256) { const int t = i >> 8, gd = i & 255; float v;
        if (is_prompt) v = ROWS[((size_t)b * SEQ + n * 32 + t) * KVW + e * 256 + gd];
        else { const int page = pt[b * NPAGES + (n >> 2)]; v = cache[(((size_t)page * PAGE + (n & 3) * 32 + t) * 2 + e) * 256 + gd]; }
        blk[i] = v + pe[(e * 32 + t) * 64 + (gd & 63)]; }
    __syncthreads();
    const int h = tid & 127, gp = tid >> 7; float a0 = 0.f, a1 = 0.f; const float* w = w1 + (size_t)e * 2048 * PHI + h;
    for (int f = 0; f < 2048; ++f) { const int t = f >> 6, d = f & 63; const float wv = w[(size_t)f * PHI]; a0 += blk[(t * 4 + gp * 2) * 64 + d] * wv; a1 += blk[(t * 4 + gp * 2 + 1) * 64 + d] * wv; }
    hid[gp * 2][h] = silu(a0 + b1[e * PHI + h]); hid[gp * 2 + 1][h] = silu(a1 + b1[e * PHI + h]);
    __syncthreads();
    const int g = tid >> 6, d = tid & 63; float o = b2[e * 64 + d];
    for (int hh = 0; hh < PHI; ++hh) o += hid[g][hh] * w2[((size_t)e * PHI + hh) * 64 + d];
    CMP[((((size_t)e * BB + b) * NB + n) * 4 + g) * 64 + d] = o;
}

struct AttnP {
    const float* QG;
    const float* ROWS;
    const float* CMP;
    const float* cache_sel; const float* cache_win; const int* pt; const float* table;
    float* O;
};
__device__ __forceinline__ const float* kv_ptr_sel(const AttnP& P, int is_prompt, int b, int g, int e, int pos) {
    if (is_prompt) return P.ROWS + ((size_t)b * SEQ + pos) * KVW + 512 + e * 256 + g * 64;
    if (pos < PAST) { const int page = P.pt[b * NPAGES + pos / PAGE]; return P.cache_sel + (((size_t)page * PAGE + pos % PAGE) * 2 + e) * 256 + g * 64; }
    return P.ROWS + ((size_t)MP + b * DS + (pos - PAST)) * KVW + 512 + e * 256 + g * 64;
}
__device__ __forceinline__ const float* kv_ptr_win(const AttnP& P, int is_prompt, int b, int g, int e, int pos) {
    if (is_prompt) return P.ROWS + ((size_t)b * SEQ + pos) * KVW + 1024 + e * 256 + g * 64;
    const int i = pos - (PAST + DS - 516);
    if (i < 512) return P.cache_win + (((size_t)b * 512 + i) * 2 + e) * 256 + g * 64;
    return P.ROWS + ((size_t)MP + b * DS + (i - 512)) * KVW + 1024 + e * 256 + g * 64;
}
__device__ __forceinline__ float wave_max(float v) {
#pragma unroll
    for (int o = 32; o >= 1; o >>= 1) v = fmaxf(v, __shfl_xor(v, o)); return v; }
__device__ __forceinline__ float wave_sum(float v) {
#pragma unroll
    for (int o = 32; o >= 1; o >>= 1) v += __shfl_xor(v, o); return v; }

constexpr int SBW = 1088;
__global__ __launch_bounds__(64) void k_attn(AttnP P, int is_prompt) {
    __shared__ float qs[4][64];
    __shared__ float sb[4][SBW];
    __shared__ float impb[192];
    __shared__ float scoreb[192];
    __shared__ int selb[16];
    const int lane = threadIdx.x; const int T = is_prompt ? SEQ : DS;
    const int g = blockIdx.x & 3, q = (blockIdx.x >> 2) % T, b = (blockIdx.x >> 2) / T;
    const int qpos = is_prompt ? q : PAST + q; const int row = is_prompt ? b * SEQ + q : MP + b * DS + q;
    const int NCMP = is_prompt ? 128 : 256, NBLK = is_prompt ? 64 : 129, BB = is_prompt ? BATCH : DB;
    const float NEGM = -3.0e38f;
#pragma unroll
    for (int r = 0; r < 4; ++r) qs[r][lane] = P.QG[(size_t)row * QGW + (g * 4 + r) * 64 + lane] * 0.125f;
    float gate[4][3];
#pragma unroll
    for (int r = 0; r < 4; ++r)
#pragma unroll
        for (int br = 0; br < 3; ++br) gate[r][br] = sigm(P.QG[(size_t)row * QGW + 1024 + (g * 4 + r) * 3 + br]);
    __syncthreads();
    float out[4] = {0.f, 0.f, 0.f, 0.f};
    {
        const float* CK = P.CMP + ((size_t)0 * BB + b) * NCMP * 256; const float* CV = P.CMP + ((size_t)1 * BB + b) * NCMP * 256;
        float mx[4] = {NEGM, NEGM, NEGM, NEGM};
        for (int n = lane; n < NCMP; n += 64) { const int endp = n * 32 + 31; const bool valid = endp <= qpos; const float* k = CK + ((size_t)n * 4 + g) * 64;
            float s[4] = {0.f, 0.f, 0.f, 0.f};
            for (int d = 0; d < 64; ++d) { const float kv = k[d]; s[0] += qs[0][d] * kv; s[1] += qs[1][d] * kv; s[2] += qs[2][d] * kv; s[3] += qs[3][d] * kv; }
            const int bk = rel_bucket(qpos - endp);
#pragma unroll
            for (int r = 0; r < 4; ++r) { const float v = valid ? s[r] + P.table[bk * 16 + g * 4 + r] : NEGM; sb[r][n] = v; mx[r] = fmaxf(mx[r], v); } }
        float sm[4];
#pragma unroll
        for (int r = 0; r < 4; ++r) { mx[r] = wave_max(mx[r]); float a = 0.f;
            for (int n = lane; n < NCMP; n += 64) { const float v = sb[r][n]; const float p = v > -1e38f ? expf(v - mx[r]) : 0.f; sb[r][n] = p; a += p; }
            sm[r] = wave_sum(a); }
        __syncthreads();
#pragma unroll
        for (int r = 0; r < 4; ++r) { const float inv = sm[r] > 0.f ? 1.f / sm[r] : 0.f; for (int n = lane; n < NCMP; n += 64) sb[r][n] *= inv; }
        __syncthreads();
        float oc[4] = {0.f, 0.f, 0.f, 0.f};
        for (int n = 0; n < NCMP; ++n) { const float v = CV[((size_t)n * 4 + g) * 64 + lane]; oc[0] += sb[0][n] * v; oc[1] += sb[1][n] * v; oc[2] += sb[2][n] * v; oc[3] += sb[3][n] * v; }
#pragma unroll
        for (int r = 0; r < 4; ++r) out[r] += gate[r][0] * oc[r];
        for (int j = lane; j < NBLK; j += 64) { float a = 0.f, c = 0.f;
            if (2 * j < NCMP) a = ((sb[0][2 * j] + sb[1][2 * j]) + sb[2][2 * j]) + sb[3][2 * j];
            if (2 * j + 1 < NCMP) c = ((sb[0][2 * j + 1] + sb[1][2 * j + 1]) + sb[2][2 * j + 1]) + sb[3][2 * j + 1];
            float nz = 1.f;
#ifdef IMP_NOISE
            { unsigned hsh = (unsigned)(j * 2654435761u) ^ (unsigned)(blockIdx.x * 40503u + 12345u); hsh ^= hsh >> 15; hsh *= 2246822519u; hsh ^= hsh >> 13; hsh *= 3266489917u; hsh ^= hsh >> 16;
              nz = 1.f + IMP_NOISE * ((float)(hsh & 0xffff) * (2.f / 65535.f) - 1.f); }
#endif
            impb[j] = (a + c) * nz; }
        __syncthreads();
    }
    const int jq = qpos / 64;
    for (int j = lane; j < NBLK; j += 64) { const bool forced = (j == 0) || (j == jq) || (j == jq - 1); scoreb[j] = j <= jq ? (forced ? 1e4f : impb[j]) : -1.f; }
    if (lane < 16) selb[lane] = -1;
    __syncthreads();
    for (int j = lane; j < NBLK; j += 64) { const float sj = scoreb[j]; int rank = 0;
        for (int i = 0; i < NBLK; ++i) { const float si = scoreb[i]; rank += (si > sj || (si == sj && i < j)) ? 1 : 0; }
        if (rank < 16 && sj >= 0.f) selb[rank] = j; }
    __syncthreads();
    {
        float mx[4] = {NEGM, NEGM, NEGM, NEGM};
        for (int sl = 0; sl < 16; ++sl) { const int j = selb[sl]; const int kpos = j * 64 + lane; const bool valid = (j >= 0) && (kpos <= qpos);
            float s[4] = {0.f, 0.f, 0.f, 0.f};
            if (valid) { const float* k = kv_ptr_sel(P, is_prompt, b, g, 0, kpos);
                for (int d = 0; d < 64; ++d) { const float kv = k[d]; s[0] += qs[0][d] * kv; s[1] += qs[1][d] * kv; s[2] += qs[2][d] * kv; s[3] += qs[3][d] * kv; } }
            const int bk = rel_bucket(qpos - kpos);
#pragma unroll
            for (int r = 0; r < 4; ++r) { const float v = valid ? s[r] + P.table[bk * 16 + g * 4 + r] : NEGM; sb[r][sl * 64 + lane] = v; mx[r] = fmaxf(mx[r], v); } }
        float sm[4];
#pragma unroll
        for (int r = 0; r < 4; ++r) { mx[r] = wave_max(mx[r]); float a = 0.f;
            for (int n = lane; n < 1024; n += 64) { const float v = sb[r][n]; const float p = v > -1e38f ? expf(v - mx[r]) : 0.f; sb[r][n] = p; a += p; }
            sm[r] = wave_sum(a); }
        __syncthreads();
        float os[4] = {0.f, 0.f, 0.f, 0.f};
        for (int sl = 0; sl < 16; ++sl) { const int j = selb[sl]; if (j < 0) continue;
            for (int kk = 0; kk < 64; ++kk) { const int kpos = j * 64 + kk; if (kpos > qpos) break;
                const float v = kv_ptr_sel(P, is_prompt, b, g, 1, kpos)[lane]; const int n = sl * 64 + kk;
                os[0] += sb[0][n] * v; os[1] += sb[1][n] * v; os[2] += sb[2][n] * v; os[3] += sb[3][n] * v; } }
#pragma unroll
        for (int r = 0; r < 4; ++r) out[r] += gate[r][1] * (sm[r] > 0.f ? os[r] / sm[r] : 0.f);
        __syncthreads();
    }
    {
        float mx[4] = {NEGM, NEGM, NEGM, NEGM};
        for (int i = lane; i < 512; i += 64) { const int kpos = qpos - 511 + i; const bool valid = kpos >= 0 && (is_prompt || kpos >= PAST + DS - 516);
            float s[4] = {0.f, 0.f, 0.f, 0.f};
            if (valid) { const float* k = kv_ptr_win(P, is_prompt, b, g, 0, kpos);
                for (int d = 0; d < 64; ++d) { const float kv = k[d]; s[0] += qs[0][d] * kv; s[1] += qs[1][d] * kv; s[2] += qs[2][d] * kv; s[3] += qs[3][d] * kv; } }
            const int bk = rel_bucket(qpos - kpos);
#pragma unroll
            for (int r = 0; r < 4; ++r) { const float v = valid ? s[r] + P.table[bk * 16 + g * 4 + r] : NEGM; sb[r][i] = v; mx[r] = fmaxf(mx[r], v); } }
        float sm[4];
#pragma unroll
        for (int r = 0; r < 4; ++r) { mx[r] = wave_max(mx[r]); float a = 0.f;
            for (int n = lane; n < 512; n += 64) { const float v = sb[r][n]; const float p = v > -1e38f ? expf(v - mx[r]) : 0.f; sb[r][n] = p; a += p; }
            sm[r] = wave_sum(a); }
        __syncthreads();
        float ow[4] = {0.f, 0.f, 0.f, 0.f};
        for (int i = 0; i < 512; ++i) { const int kpos = qpos - 511 + i; if (kpos < 0 || (!is_prompt && kpos < PAST + DS - 516)) continue;
            const float v = kv_ptr_win(P, is_prompt, b, g, 1, kpos)[lane];
            ow[0] += sb[0][i] * v; ow[1] += sb[1][i] * v; ow[2] += sb[2][i] * v; ow[3] += sb[3][i] * v; }
#pragma unroll
        for (int r = 0; r < 4; ++r) out[r] += gate[r][2] * (sm[r] > 0.f ? ow[r] / sm[r] : 0.f);
    }
#pragma unroll
    for (int r = 0; r < 4; ++r) P.O[(size_t)row * D + (g * 4 + r) * 64 + lane] = out[r];
}

constexpr size_t W_SC = 0, W_MOD = W_SC + (size_t)NC * D, W_X = W_MOD + (size_t)8 * NC * 3072, W_H = W_X + (size_t)R * D, W_T1 = W_H + (size_t)R * D,
                 W_T2 = W_T1 + (size_t)R * DFF, W_U = W_T2 + (size_t)R * DFF, W_Y = W_U + (size_t)R * D, W_CC = W_Y + (size_t)R * D, W_ACT = W_CC + (size_t)R * D,
                 W_ROWS = W_ACT + (size_t)R * DFF, W_QG = W_ROWS + (size_t)R * KVW, W_O = W_QG + (size_t)R * QGW, W_CMPP = W_O + (size_t)R * D,
                 W_CMPS = W_CMPP + (size_t)2 * BATCH * 128 * 256, W_END = W_CMPS + (size_t)2 * DB * 256 * 256;

static inline void gemm(hipStream_t st, const float* A, int lda, const float* W, int ldw, const float* bias, float* C, int ldc, int M, int N, int K) {
    dim3 grid((N + 63) / 64, (M + 63) / 64); k_gemm<<<grid, 256, 0, st>>>(A, lda, W, ldw, bias, C, ldc, M, N, K);
}
static inline unsigned cdiv(size_t a, size_t b) { return (unsigned)((a + b - 1) / b); }

typedef void (*Hook)(int id, void* ctx);
static void naive_forward(void* const* d_in, float* out, float* ws, hipStream_t st, Hook hook = nullptr, void* hctx = nullptr) {
#define HOOK(id) do { if (hook) hook((id), hctx); } while (0)
    const float* x_prompt = (const float*)d_in[0]; const float* x_sample = (const float*)d_in[1]; const float* c_prompt = (const float*)d_in[2]; const float* c_sample = (const float*)d_in[3];
    const float* cache_cmp = (const float*)d_in[4]; const float* cache_sel = (const float*)d_in[5]; const float* cache_win = (const float*)d_in[6]; const float* state_conv = (const float*)d_in[7];
    const int* pt = (const int*)d_in[8]; const float* w_ada = (const float*)d_in[9]; const float* b_ada = (const float*)d_in[10]; const float* norm_g = (const float*)d_in[11];
    const float* w_pw1 = (const float*)d_in[12]; const float* b_pw1 = (const float*)d_in[13]; const float* w_dw = (const float*)d_in[14]; const float* b_dw = (const float*)d_in[15];
    const float* ln_g = (const float*)d_in[16]; const float* ln_b = (const float*)d_in[17]; const float* w_pw2 = (const float*)d_in[18]; const float* b_pw2 = (const float*)d_in[19];
    const float* g_kv = (const float*)d_in[20]; const float* w_kv = (const float*)d_in[21]; const float* w_phi1 = (const float*)d_in[22]; const float* b_phi1 = (const float*)d_in[23];
    const float* w_phi2 = (const float*)d_in[24]; const float* b_phi2 = (const float*)d_in[25]; const float* pe_cmp = (const float*)d_in[26]; const float* w_qg = (const float*)d_in[27];
    const float* w_o = (const float*)d_in[28]; const float* rel_table = (const float*)d_in[29]; const float* w_gate = (const float*)d_in[30]; const float* w_up = (const float*)d_in[31];
    const float* w_down = (const float*)d_in[32]; const float* final_g = (const float*)d_in[33];
    float *SC = ws + W_SC, *MOD = ws + W_MOD, *X = ws + W_X, *H = ws + W_H, *T1 = ws + W_T1, *T2 = ws + W_T2, *U = ws + W_U, *Y = ws + W_Y, *CC = ws + W_CC, *ACT = ws + W_ACT,
          *ROWS = ws + W_ROWS, *QG = ws + W_QG, *O = ws + W_O, *CMPP = ws + W_CMPP, *CMPS = ws + W_CMPS;
    const size_t RD = (size_t)R * D;
    hipMemcpyAsync(X, x_prompt, (size_t)MP * D * 4, hipMemcpyDeviceToDevice, st);
    hipMemcpyAsync(X + (size_t)MP * D, x_sample, (size_t)MS * D * 4, hipMemcpyDeviceToDevice, st);
    k_silu_c<<<cdiv(NC * D, 256), 256, 0, st>>>(c_prompt, c_sample, SC);
    for (int ls = 0; ls < 8; ++ls) gemm(st, SC, D, w_ada + (size_t)ls * D * 3072, 3072, b_ada + (size_t)ls * 3072, MOD + (size_t)ls * NC * 3072, 3072, NC, 3072, D);
    HOOK(1);
    for (int l = 0; l < 4; ++l) {
        const float* mod0 = MOD + (size_t)(l * 2 + 0) * NC * 3072; const float* mod1 = MOD + (size_t)(l * 2 + 1) * NC * 3072;
        if (l == 2) {
            k_modnorm<<<R, 256, 0, st>>>(X, g_kv, nullptr, H);
            gemm(st, H, D, w_kv, KVW, nullptr, ROWS, KVW, R, KVW, D);
            k_kv_out<<<cdiv((size_t)MP * 512, 256), 256, 0, st>>>(ROWS, cache_win, out);
            k_compress<<<BATCH * 128 * 2, 256, 0, st>>>(1, ROWS, cache_cmp, pt, w_phi1, b_phi1, w_phi2, b_phi2, pe_cmp, CMPP);
            k_compress<<<DB * 256 * 2, 256, 0, st>>>(0, ROWS, cache_cmp, pt, w_phi1, b_phi1, w_phi2, b_phi2, pe_cmp, CMPS);
            HOOK(250);
        }
        k_modnorm<<<R, 256, 0, st>>>(X, norm_g + (size_t)(l * 2) * D, mod0, H);
        HOOK(100 * l + 1);
        if (l < 2) {
            gemm(st, H, D, w_pw1 + (size_t)l * D * 2048, 2048, b_pw1 + (size_t)l * 2048, T1, 2048, R, 2048, D);
            k_glu<<<cdiv(RD, 256), 256, 0, st>>>(T1, U);
            HOOK(100 * l + 2);
            k_conv<<<cdiv(RD, 256), 256, 0, st>>>(U, state_conv + (size_t)l * DB * 30 * D, w_dw + (size_t)l * CONVW * D, b_dw + (size_t)l * D, Y);
            k_conv_state_out<<<cdiv((size_t)(BATCH + DB) * 30 * D, 256), 256, 0, st>>>(U, state_conv + (size_t)l * DB * 30 * D, out + O_CONVP + (size_t)l * BATCH * 30 * D, out + O_CONVS + (size_t)l * DB * 30 * D);
            k_ln_silu<<<R, 256, 0, st>>>(Y, ln_g + (size_t)l * D, ln_b + (size_t)l * D, CC);
            HOOK(100 * l + 3);
            gemm(st, CC, D, w_pw2 + (size_t)l * D * D, D, b_pw2 + (size_t)l * D, T2, D, R, D, D);
        } else {
            const int lb = l - 2;
            gemm(st, H, D, w_qg + (size_t)lb * D * QGW, QGW, nullptr, QG, QGW, R, QGW, D);
            HOOK(100 * l + 2);
            AttnP P{QG, ROWS, CMPP, cache_sel, cache_win, pt, rel_table, O};
            k_attn<<<BATCH * SEQ * 4, 64, 0, st>>>(P, 1);
            P.CMP = CMPS;
            k_attn<<<DB * DS * 4, 64, 0, st>>>(P, 0);
            HOOK(100 * l + 3);
            gemm(st, O, D, w_o + (size_t)lb * D * D, D, nullptr, T2, D, R, D, D);
        }
        k_resid<<<cdiv(RD, 256), 256, 0, st>>>(X, T2, D, mod0);
        HOOK(100 * l + 4);
        k_modnorm<<<R, 256, 0, st>>>(X, norm_g + (size_t)(l * 2 + 1) * D, mod1, H);
        HOOK(100 * l + 5);
        gemm(st, H, D, w_gate + (size_t)l * D * DFF, DFF, nullptr, T1, DFF, R, DFF, D);
        gemm(st, H, D, w_up + (size_t)l * D * DFF, DFF, nullptr, T2, DFF, R, DFF, D);
        k_swiglu<<<cdiv((size_t)R * DFF, 256), 256, 0, st>>>(T1, T2, ACT);
        HOOK(100 * l + 6);
        gemm(st, ACT, DFF, w_down + (size_t)l * DFF * D, D, nullptr, T1, D, R, D, DFF);
        k_resid<<<cdiv(RD, 256), 256, 0, st>>>(X, T1, D, mod1);
        HOOK(100 * l + 7);
    }
    k_modnorm<<<R, 256, 0, st>>>(X, final_g, nullptr, H);
    hipMemcpyAsync(out + O_YP, H, (size_t)MP * D * 4, hipMemcpyDeviceToDevice, st);
    hipMemcpyAsync(out + O_YS, H + (size_t)MP * D, (size_t)MS * D * 4, hipMemcpyDeviceToDevice, st);
    HOOK(900);
#undef HOOK
}
}
namespace pg8 {
__device__ __forceinline__ int opaque_tid() { int t; asm volatile("v_mov_b32 %0, %1" : "=v"(t) : "v"(threadIdx.x)); return t; }
#define PG8_LAS __attribute__((address_space(3)))
typedef unsigned short bf16_t;
typedef short bf16x8 __attribute__((ext_vector_type(8)));
typedef float f32x4 __attribute__((ext_vector_type(4)));
typedef unsigned u32x4 __attribute__((ext_vector_type(4)));
constexpr int BM = 256, BK = 64, HALF = 128, HTB = HALF * BK * 2  , STAGE_BYTES = 8 * HTB, NXCD = 8, WGM = 8;

__host__ __device__ __forceinline__ int lds_byte(int r, int c) { const int st = (r >> 4) * 2 + (c >> 5), rr = r & 15, cc = c & 31, ob = rr * 64 + cc * 2; return st * 1024 + (ob ^ (((ob >> 9) & 1) << 5)); }
__host__ __device__ __forceinline__ void stage_rc(int b, int& R, int& C) { const int st = b / 1024, sb = b % 1024, swz = sb ^ (((sb >> 9) & 1) << 5); R = (st >> 1) * 16 + swz / 64; C = (st & 1) * 32 + (swz % 64) / 2; }
__host__ __device__ __forceinline__ int perm32(int rho) { const int n = rho >> 4, i = rho & 15; return 8 * (i >> 2) + 4 * n + (i & 3); }

struct Unit { int pm, pn; };
struct Gemm { const bf16_t* A; const bf16_t* Bt; int M, N, K; };

struct StaticOrder {
    int nM, nN, nwg, G, c;
    __host__ __device__ void init(int M, int N, int G_, int c_) { nM = M / BM; nN = N / BM; nwg = nM * nN; G = G_; c = c_; }
    __host__ __device__ bool next(int i, Unit& u) const {
        const long L = (long)i * G + c; if (L >= nwg) return false;
        int wgid = (int)L; { const int q = nwg / NXCD, r = nwg % NXCD, xcd = wgid % NXCD, off = wgid / NXCD; wgid = (xcd < r ? xcd * (q + 1) : r * (q + 1) + (xcd - r) * q) + off; }
        const int nig = WGM * nN, gid = wgid / nig, fm = gid * WGM, gsz = (nM - fm) < WGM ? (nM - fm) : WGM;
        u.pm = fm + ((wgid % nig) % gsz); u.pn = (wgid % nig) / gsz; return true;
    }
    __device__ __forceinline__ void a_ready(const Unit&) const {}
    __device__ __forceinline__ void done(const Unit&) const {}
};

template <class Epi, class Sched, bool ALIGN_EPI = false, bool SP2 = false>
__device__ __forceinline__ void gemm_phase(PG8_LAS unsigned char* lds, const Gemm g, const Sched& S, const Epi& E) {
    const int tid = opaque_tid(), wid = __builtin_amdgcn_readfirstlane(tid >> 6), lane = tid & 63, wr = wid >> 2, wc = wid & 3, fr = lane & 15, fq = lane >> 4;
    const int K = g.K, nt = K / BK;
    unsigned voffA[2], voffB[2];
#pragma unroll
    for (int i = 0; i < 2; ++i) { int R, C; stage_rc(tid * 16 + i * 8192, R, C); const int Rb = Epi::PERM ? ((R & ~31) + perm32(R & 31)) : R;
        voffA[i] = (unsigned)(R * K + C) * 2u; voffB[i] = (unsigned)(Rb * K + C) * 2u; }
    const size_t kstep = (size_t)(BK * 2);
    const size_t hstep = (size_t)HALF * K * 2;
    const size_t tstep = 2 * hstep;
    const unsigned ldsw = (unsigned)wid * 1024u;
    const int aoff = lds_byte(wr * 64 + fr, fq * 8), boff = lds_byte(wc * 32 + fr, fq * 8);
#define PG8_SA(b, h) (((b) * 2 + (h)) * HTB)
#define PG8_SB(b, h) ((4 + (b) * 2 + (h)) * HTB)
#define PG8_STAGE(bufoff, gbase, voff) do { _Pragma("unroll") for (int _i = 0; _i < 2; ++_i) \
        __builtin_amdgcn_global_load_lds((const unsigned*)((const char*)(gbase) + (voff)[_i]), (PG8_LAS unsigned*)(lds + (bufoff) + ldsw + _i * 8192), 16, 0, 0); } while (0)
#define PG8_LDA(dst, b, h) do { _Pragma("unroll") for (int m = 0; m < 4; ++m) _Pragma("unroll") for (int k = 0; k < 2; ++k) dst[m][k] = *(const PG8_LAS bf16x8*)(lds + PG8_SA(b, h) + aoff + m * 2048 + k * 1024); } while (0)
#define PG8_LDB(dst, b, h) do { _Pragma("unroll") for (int n = 0; n < 2; ++n) _Pragma("unroll") for (int k = 0; k < 2; ++k) dst[n][k] = *(const PG8_LAS bf16x8*)(lds + PG8_SB(b, h) + boff + n * 2048 + k * 1024); } while (0)
#define PG8_MMA(ai, bj, At, Bt) do { __builtin_amdgcn_s_setprio(1); _Pragma("unroll") for (int m = 0; m < 4; ++m) _Pragma("unroll") for (int n = 0; n < 2; ++n) _Pragma("unroll") for (int k = 0; k < 2; ++k) \
        acc[ai][bj][m][n] = __builtin_amdgcn_mfma_f32_16x16x32_bf16(Bt[n][k], At[m][k], acc[ai][bj][m][n], 0, 0, 0); __builtin_amdgcn_s_setprio(0); } while (0)
#define PG8_WAIT_V(n) asm volatile("s_waitcnt vmcnt(" #n ")" ::: "memory")
#define PG8_WAIT_L(n) asm volatile("s_waitcnt lgkmcnt(" #n ")" ::: "memory")
#define PG8_BAR __builtin_amdgcn_s_barrier()
#define PG8_SCHED __builtin_amdgcn_sched_barrier(0)
    Unit cur, nxt; int ui = 0;
    if (!S.next(0, cur)) return;
    f32x4 acc[2][2][4][2];
#pragma unroll
    for (int a = 0; a < 2; ++a)
#pragma unroll
        for (int b = 0; b < 2; ++b)
#pragma unroll
            for (int m = 0; m < 4; ++m)
#pragma unroll
                for (int n = 0; n < 2; ++n) acc[a][b][m][n] = (f32x4){0.f, 0.f, 0.f, 0.f};
    bf16x8 At[4][2], B0[2][2], B1[2][2];
    const char* cA = (const char*)g.A + (size_t)cur.pm * tstep; const char* cB = (const char*)g.Bt + (size_t)cur.pn * tstep;
    S.a_ready(cur);
    if constexpr (SP2) {
        PG8_STAGE(PG8_SB(0, 0), cB, voffB); PG8_STAGE(PG8_SB(0, 1), cB + hstep, voffB); PG8_STAGE(PG8_SA(0, 0), cA, voffA); PG8_STAGE(PG8_SA(0, 1), cA + hstep, voffA);
        if (wr == 1) PG8_BAR;
        PG8_WAIT_V(2); PG8_BAR;
        PG8_STAGE(PG8_SB(1, 0), cB + kstep, voffB); PG8_STAGE(PG8_SA(1, 0), cA + kstep, voffA); PG8_STAGE(PG8_SB(1, 1), cB + hstep + kstep, voffB);
        PG8_WAIT_V(6); PG8_BAR;
    } else {
        PG8_STAGE(PG8_SB(0, 0), cB, voffB); PG8_STAGE(PG8_SA(0, 0), cA, voffA); PG8_STAGE(PG8_SB(0, 1), cB + hstep, voffB); PG8_STAGE(PG8_SA(0, 1), cA + hstep, voffA);
        if (wr == 1) PG8_BAR;
        PG8_WAIT_V(4); PG8_BAR;
        PG8_STAGE(PG8_SB(1, 0), cB + kstep, voffB); PG8_STAGE(PG8_SA(1, 0), cA + kstep, voffA); PG8_STAGE(PG8_SB(1, 1), cB + hstep + kstep, voffB);
        PG8_WAIT_V(6); PG8_BAR;
    }
    for (;;) {
        const bool has_next = S.next(ui + 1, nxt);
        const char* nA = has_next ? (const char*)g.A + (size_t)nxt.pm * tstep : cA; const char* nB = has_next ? (const char*)g.Bt + (size_t)nxt.pn * tstep : cB;
        for (int t = 0; t < nt; t += 2) {
            const bool last = (t == nt - 2);
            const char* a1 = cA + (size_t)(t + 1) * kstep;
            const char* a2 = last ? nA : cA + (size_t)(t + 2) * kstep; const char* b2 = last ? nB : cB + (size_t)(t + 2) * kstep;
            const char* a3 = a2 + kstep; const char* b3 = b2 + kstep;
            if (last && has_next) S.a_ready(nxt);
            if constexpr (SP2) {
            PG8_LDB(B0, 0, 0); PG8_LDB(B1, 0, 1); PG8_SCHED; PG8_LDA(At, 0, 0); PG8_STAGE(PG8_SA(1, 1), a1 + hstep, voffA);
            PG8_WAIT_V(8); PG8_WAIT_L(0); PG8_BAR; PG8_MMA(0, 0, At, B0); PG8_MMA(0, 1, At, B1); PG8_BAR; PG8_SCHED;
            PG8_LDA(At, 0, 1); PG8_STAGE(PG8_SB(0, 0), b2, voffB); PG8_STAGE(PG8_SB(0, 1), b2 + hstep, voffB); PG8_STAGE(PG8_SA(0, 0), a2, voffA);
            PG8_WAIT_V(8); PG8_WAIT_L(0); PG8_BAR; PG8_MMA(1, 0, At, B0); PG8_MMA(1, 1, At, B1); PG8_BAR; PG8_SCHED;
            PG8_LDB(B0, 1, 0); PG8_LDB(B1, 1, 1); PG8_SCHED; PG8_LDA(At, 1, 0); PG8_STAGE(PG8_SA(0, 1), a2 + hstep, voffA);
            PG8_WAIT_V(8); PG8_WAIT_L(0); PG8_BAR; PG8_MMA(0, 0, At, B0); PG8_MMA(0, 1, At, B1); PG8_BAR; PG8_SCHED;
            PG8_LDA(At, 1, 1); PG8_STAGE(PG8_SB(1, 0), b3, voffB); PG8_STAGE(PG8_SB(1, 1), b3 + hstep, voffB); PG8_STAGE(PG8_SA(1, 0), a3, voffA);
            PG8_WAIT_V(8); PG8_WAIT_L(0); PG8_BAR; PG8_MMA(1, 0, At, B0); PG8_MMA(1, 1, At, B1); PG8_BAR; PG8_SCHED;
            } else {
            PG8_LDB(B0, 0, 0); PG8_SCHED; PG8_LDA(At, 0, 0); PG8_STAGE(PG8_SA(1, 1), a1 + hstep, voffA);
            PG8_WAIT_L(8); PG8_BAR; PG8_WAIT_L(0); PG8_MMA(0, 0, At, B0); PG8_BAR; PG8_SCHED;
            PG8_LDB(B1, 0, 1); PG8_STAGE(PG8_SB(0, 0), b2, voffB);
            PG8_BAR; PG8_WAIT_L(0); PG8_MMA(0, 1, At, B1); PG8_BAR;
            PG8_LDA(At, 0, 1); PG8_STAGE(PG8_SA(0, 0), a2, voffA);
            PG8_BAR; PG8_WAIT_L(0); PG8_MMA(1, 0, At, B0); PG8_BAR; PG8_SCHED;
            PG8_STAGE(PG8_SB(0, 1), b2 + hstep, voffB);
            PG8_WAIT_V(6); PG8_BAR; PG8_MMA(1, 1, At, B1); PG8_BAR;
            PG8_LDB(B0, 1, 0); PG8_SCHED; PG8_LDA(At, 1, 0); PG8_STAGE(PG8_SA(0, 1), a2 + hstep, voffA);
            PG8_WAIT_L(8); PG8_BAR; PG8_WAIT_L(0); PG8_MMA(0, 0, At, B0); PG8_BAR; PG8_SCHED;
            PG8_LDB(B1, 1, 1); PG8_STAGE(PG8_SB(1, 0), b3, voffB);
            PG8_BAR; PG8_WAIT_L(0); PG8_MMA(0, 1, At, B1); PG8_BAR;
            PG8_LDA(At, 1, 1); PG8_STAGE(PG8_SA(1, 0), a3, voffA);
            PG8_BAR; PG8_WAIT_L(0); PG8_MMA(1, 0, At, B0); PG8_BAR; PG8_SCHED;
            PG8_STAGE(PG8_SB(1, 1), b3 + hstep, voffB);
            PG8_WAIT_V(6); PG8_BAR; PG8_MMA(1, 1, At, B1); PG8_BAR;
            }
        }
        if constexpr (ALIGN_EPI) { if (wr == 0) PG8_BAR; }
        if constexpr (!Epi::AFTER_DRAIN) { E(acc, cur, wr, wc, fr, fq); S.done(cur); }
        if (!has_next) break;
#pragma unroll
        for (int a = 0; a < 2; ++a)
#pragma unroll
            for (int b = 0; b < 2; ++b)
#pragma unroll
                for (int m = 0; m < 4; ++m)
#pragma unroll
                    for (int n = 0; n < 2; ++n) acc[a][b][m][n] = (f32x4){0.f, 0.f, 0.f, 0.f};
        cur = nxt; cA = nA; cB = nB; ++ui;
        if constexpr (ALIGN_EPI) { if (wr == 1) PG8_BAR; }
    }
    PG8_WAIT_V(0);
    if constexpr (!ALIGN_EPI) { if (wr == 0) PG8_BAR; }
    PG8_BAR;
    if constexpr (Epi::AFTER_DRAIN) { E.fused(acc, cur, wr, wc, fr, fq, lds, wid, lane); S.done(cur); }
#undef PG8_SA
#undef PG8_SB
#undef PG8_STAGE
#undef PG8_LDA
#undef PG8_LDB
#undef PG8_MMA
#undef PG8_WAIT_V
#undef PG8_WAIT_L
#undef PG8_BAR
#undef PG8_SCHED
}
}
#define XB_TMO      128
#define XB_XCNT(j)  (256  + 64 * (j))
#define XB_XSUB(j)  (1280 + 64 * (j))
#define XB_XGEN(j)  (2304 + 64 * (j))
#define XB_TOP      3328
#define XB_TOPGEN   3392
#define XCD_BAR_WORDS 3456
#define XB_SPIN_CAP (1u << 18)
#define LAS __attribute__((address_space(3)))

__device__ __forceinline__ unsigned xb_ld(unsigned* p)              { return __hip_atomic_load(p, __ATOMIC_RELAXED, __HIP_MEMORY_SCOPE_AGENT); }
__device__ __forceinline__ unsigned xb_add(unsigned* p, unsigned v) { return __hip_atomic_fetch_add(p, v, __ATOMIC_RELAXED, __HIP_MEMORY_SCOPE_AGENT); }
__device__ __forceinline__ unsigned xb_xcc_id() { return (unsigned)__builtin_amdgcn_s_getreg((3 << 11) | 20) & 0xFu; }
#define XB_SPIN(cond, bar) do { unsigned _sp = 0; while (cond) { __builtin_amdgcn_s_sleep(1); \
    if ((++_sp & 255u) == 0u) { if (xb_ld(&(bar)[XB_TMO])) break; if (_sp > XB_SPIN_CAP) { atomicAdd(&(bar)[XB_TMO], 1u); break; } } } } while (0)

struct XcdBarrier {
    unsigned* bar; unsigned x;
    volatile LAS unsigned* st;
};

__device__ __forceinline__ XcdBarrier xcd_barrier_post(unsigned* bar, volatile LAS unsigned* st) {
    XcdBarrier b; b.bar = bar; b.x = xb_xcc_id(); b.st = st;
    if (threadIdx.x == 0) (void)xb_add(&bar[XB_XCNT(b.x)], 1u);
    return b;
}
__device__ __forceinline__ void xcd_barrier_complete(unsigned* bar, unsigned x, unsigned& nloc, unsigned& nx) {
    const unsigned G = gridDim.x * gridDim.y * gridDim.z;
    unsigned sum, cnt, mine, sp = 0u;
    for (;;) {
        sum = 0u; cnt = 0u; mine = 0u;
#pragma unroll
        for (unsigned j = 0; j < 16; ++j) { const unsigned c = xb_ld(&bar[XB_XCNT(j)]); sum += c; cnt += (c > 0u) ? 1u : 0u; mine = (j == x) ? c : mine; }
        if (sum == G) break;
        __builtin_amdgcn_s_sleep(1);
        if ((++sp & 255u) == 0u) { if (xb_ld(&bar[XB_TMO])) break; if (sp > XB_SPIN_CAP) { atomicAdd(&bar[XB_TMO], 1u); break; } }
    }
    nloc = mine > 0u ? mine : 1u; nx = cnt > 0u ? cnt : 1u;
}

__device__ __forceinline__ void xcd_barrier(const XcdBarrier& b) {
    asm volatile("s_waitcnt vmcnt(0)" ::: "memory");
    __syncthreads();
    if (threadIdx.x == 0) {
        unsigned* bar = b.bar;
        __builtin_amdgcn_s_waitcnt(0);
        unsigned nloc = b.st[0], nx = b.st[1];
        if (nloc == 0u) { xcd_barrier_complete(bar, b.x, nloc, nx); b.st[0] = nloc; b.st[1] = nx; }
        const unsigned old = xb_add(&bar[XB_XSUB(b.x)], 1u);
        const unsigned gen = old / nloc;
        if (old + 1u == (gen + 1u) * nloc) {
            __builtin_amdgcn_fence(__ATOMIC_RELEASE, "agent");
            asm volatile("s_waitcnt vmcnt(0)" ::: "memory");
            const unsigned og = xb_add(&bar[XB_TOP], 1u);
            const unsigned tg = og / nx;
            if (og + 1u == (tg + 1u) * nx) xb_add(&bar[XB_TOPGEN], 1u);
            else XB_SPIN(xb_ld(&bar[XB_TOPGEN]) == tg, bar);
            __builtin_amdgcn_fence(__ATOMIC_ACQUIRE, "agent");
            xb_add(&bar[XB_XGEN(b.x)], 1u);
            asm volatile("s_waitcnt vmcnt(0)" ::: "memory");
        } else {
            XB_SPIN(xb_ld(&bar[XB_XGEN(b.x)]) == gen, bar);
            __builtin_amdgcn_fence(__ATOMIC_ACQUIRE, "agent");
            asm volatile("s_waitcnt vmcnt(0)" ::: "memory");
        }
    }
    __syncthreads();
}

namespace fk {
using namespace nv;
typedef unsigned short bf16;
typedef float f32x4 __attribute__((ext_vector_type(4)));
typedef short bf16x8 __attribute__((ext_vector_type(8)));
typedef unsigned u32x2 __attribute__((ext_vector_type(2)));
typedef unsigned u32x4 __attribute__((ext_vector_type(4)));
#define FLAS __attribute__((address_space(3)))
constexpr float LOG2E = 1.4426950408889634f;
constexpr int NTHR = 512, NWAVE = 8;
constexpr int LDS_BYTES = 147456;
constexpr int LDS_MISC = 131072 + 8192;

__device__ __forceinline__ unsigned f2bf(float f) { unsigned u = __builtin_bit_cast(unsigned, f); return (u + 0x7fffu + ((u >> 16) & 1u)) >> 16; }
__device__ __forceinline__ unsigned pk2(float lo, float hi) { return f2bf(lo) | (f2bf(hi) << 16); }
__device__ __forceinline__ float bf2f(unsigned short b) { return __builtin_bit_cast(float, (unsigned)b << 16); }
__device__ __forceinline__ float fsigm(float x) { return 1.f / (1.f + __expf(-x)); }
__device__ __forceinline__ float fsilu(float x) { return x / (1.f + __expf(-x)); }
__device__ __forceinline__ float wsum(float v) {
#pragma unroll
    for (int o = 1; o < 64; o <<= 1) v += __shfl_xor(v, o);
    return v; }
__device__ __forceinline__ int cidx_row(int row) { return row < MP ? (row >> 12) : 4 + ((row - MP) >> 2); }

constexpr size_t al(size_t x) { return (x + 4095) & ~(size_t)4095; }
constexpr size_t F_CTL = 0, F_MOD = 1u << 20, F_WPW1 = F_MOD + al((size_t)8 * NC * 3072 * 4), F_WPW2 = F_WPW1 + (size_t)2 * 2048 * 1024 * 2,
    F_WGU = F_WPW2 + (size_t)2 * 1024 * 1024 * 2, F_WDN = F_WGU + (size_t)4 * 5632 * 1024 * 2, F_WKV = F_WDN + (size_t)4 * 1024 * 2816 * 2,
    F_WQ = F_WKV + (size_t)1536 * 1024 * 2, F_WG = F_WQ + (size_t)2 * 1024 * 1024 * 2, F_WO = F_WG + (size_t)2 * 64 * 1024 * 2, F_WPHI1 = F_WO + (size_t)2 * 1024 * 1024 * 2,
    F_WPHI2 = F_WPHI1 + (size_t)2 * 128 * 2048 * 2, F_BPHI = F_WPHI2 + (size_t)2 * 64 * 128 * 2, F_X = F_BPHI + 4096, F_H = F_X + al((size_t)R * D * 4),
    F_HKV = F_H + al((size_t)R * D * 2), F_U = F_HKV + al((size_t)R * D * 2), F_US = F_U + al((size_t)R * D * 2), F_C = F_US + (size_t)MS * D * 4, F_ACT = F_C + al((size_t)R * D * 2),
    F_RB = F_ACT + al((size_t)R * DFF * 2), F_Q = F_RB + al((size_t)R * KVW * 2), F_GT = F_Q + al((size_t)R * D * 2), F_O = F_GT + al((size_t)R * 64 * 4),
    F_VT = F_O + al((size_t)R * D * 2), F_CMPK = F_VT + (size_t)2 * 16 * 64 * 4096 * 2, F_CMPVT = F_CMPK + (size_t)16 * 128 * 64 * 2, F_CMPS = F_CMPVT + (size_t)16 * 128 * 64 * 2,
    F_END = F_CMPS + (size_t)2 * DB * 256 * 256 * 4;
constexpr size_t CTL_BYTES = 1u << 20;

struct Args { const void* in[34]; float* out; unsigned char* fb; int lo, hi; };

struct Ctx {
    FLAS unsigned char* lds; int tid, lane, wave, G, wg; int gw, ngw;
    const Args* a;
};
#define IN_F(i) ((const float*)A.in[i])
enum TrMode { TR_PLAIN = 0, TR_PW1 = 1, TR_GATE = 2, TR_UP = 3, TR_QG = 4 };
__device__ __forceinline__ void tr_item(const float* __restrict__ W, int K, int N, bf16* __restrict__ WT, bf16* __restrict__ WT2, int mode, FLAS float* scr, int item, int lane) {
    const int nblk = (N + 31) / 32, kb = item / nblk, nb = item % nblk, k0 = 64 * kb, n0 = 32 * nb;
    const int ncol = n0 + (lane & 31); const bool okc = ncol < N;
#pragma unroll 8
    for (int i = 0; i < 32; ++i) { const int kk = 2 * i + (lane >> 5); scr[kk * 33 + (lane & 31)] = okc ? W[(size_t)(k0 + kk) * N + ncol] : 0.f; }
    asm volatile("s_waitcnt lgkmcnt(0)" ::: "memory");
    const int c = lane & 7;
#pragma unroll
    for (int j = 0; j < 4; ++j) { const int nl = (lane >> 3) + 8 * j; const int n = n0 + nl; const FLAS float* s = scr + (8 * c) * 33 + nl;
        u32x4 o; o.x = pk2(s[0 * 33], s[1 * 33]); o.y = pk2(s[2 * 33], s[3 * 33]); o.z = pk2(s[4 * 33], s[5 * 33]); o.w = pk2(s[6 * 33], s[7 * 33]);
        bf16* dst = WT; int nr = n;
        if (mode == TR_PW1) { const int f = n & 1023, isg = n >> 10; nr = 256 * (f >> 7) + 128 * isg + (f & 127); }
        else if (mode == TR_GATE) nr = 256 * (n >> 7) + (n & 127);
        else if (mode == TR_UP) nr = 256 * (n >> 7) + 128 + (n & 127);
        else if (mode == TR_QG) { if (n >= 1024) { dst = WT2; nr = n - 1024; } }
        *(u32x4*)(dst + (size_t)nr * K + k0 + 8 * c) = o; }
    asm volatile("s_waitcnt lgkmcnt(0)" ::: "memory");
}
struct TrJob { const float* W; bf16* WT; bf16* WT2; int K, N, mode, nitems; };

__device__ __forceinline__ void mod_unit(const Ctx& C, const Args& A, int unit) {
    const int ls = unit / 24, cg = unit % 24, tid = C.tid; const int nl = tid & 127, kq = tid >> 7, n = cg * 128 + nl;
    FLAS float* SCs = (FLAS float*)C.lds;
    const float* W = IN_F(9) + (size_t)ls * D * 3072;
    float acc[36];
#pragma unroll
    for (int c = 0; c < 36; ++c) acc[c] = 0.f;
    for (int half = 0; half < 2; ++half) {
        __syncthreads();
        { const int p = tid, kg = (p >> 7) * 256 + half * 128 + (p & 127);
#pragma unroll 4
          for (int c = 0; c < 36; ++c) { const float v = c < 4 ? IN_F(2)[c * D + kg] : IN_F(3)[(c - 4) * D + kg]; SCs[p * 36 + c] = fsilu(v); } }
        __syncthreads();
        const float* wp = W + (size_t)(kq * 256 + half * 128) * 3072 + n;
        const FLAS f32x4* sp = (const FLAS f32x4*)(SCs + (kq * 128) * 36);
#pragma unroll 2
        for (int kk = 0; kk < 128; ++kk) { const float w = wp[(size_t)kk * 3072];
#pragma unroll
            for (int q = 0; q < 9; ++q) { const f32x4 s = sp[kk * 9 + q]; acc[4 * q] += s[0] * w; acc[4 * q + 1] += s[1] * w; acc[4 * q + 2] += s[2] * w; acc[4 * q + 3] += s[3] * w; } }
    }
    __syncthreads();
    FLAS float* part = (FLAS float*)C.lds;
#pragma unroll
    for (int c = 0; c < 36; ++c) part[(kq * 128 + nl) * 37 + c] = acc[c];
    __syncthreads();
    for (int o = tid; o < 36 * 128; o += NTHR) { const int c = o >> 7, nn = o & 127, ng = cg * 128 + nn;
        float v = part[(0 * 128 + nn) * 37 + c] + part[(1 * 128 + nn) * 37 + c] + part[(2 * 128 + nn) * 37 + c] + part[(3 * 128 + nn) * 37 + c] + IN_F(10)[ls * 3072 + ng];
        if (ng >= 1024 && ng < 2048) v = IN_F(11)[ls * D + ng - 1024] * (1.f + v);
        ((float*)(A.fb + F_MOD))[((size_t)ls * NC + c) * 3072 + ng] = v; }
    __syncthreads();
}

__device__ __forceinline__ void phase_prologue(const Ctx& C, const Args& A) {
    unsigned char* fb = A.fb;
    {
        FLAS float* scr = (FLAS float*)(C.lds + C.wave * 8704);
        int it = C.gw;
#define TRJOB(Wp, WTp, WT2p, Kv, Nv, modev) { const int nit = ((Kv) / 64) * (((Nv) + 31) / 32); while (it < nit) { tr_item((Wp), (Kv), (Nv), (WTp), (WT2p), (modev), scr, it, C.lane); it += C.ngw; } it -= nit; }
        for (int l = 0; l < 2; ++l) {
            TRJOB(IN_F(12) + (size_t)l * D * 2048, (bf16*)(fb + F_WPW1) + (size_t)l * 2048 * 1024, nullptr, 1024, 2048, TR_PW1)
            TRJOB(IN_F(18) + (size_t)l * D * D, (bf16*)(fb + F_WPW2) + (size_t)l * 1024 * 1024, nullptr, 1024, 1024, TR_PLAIN)
            TRJOB(IN_F(27) + (size_t)l * D * QGW, (bf16*)(fb + F_WQ) + (size_t)l * 1024 * 1024, (bf16*)(fb + F_WG) + (size_t)l * 64 * 1024, 1024, QGW, TR_QG)
            TRJOB(IN_F(28) + (size_t)l * D * D, (bf16*)(fb + F_WO) + (size_t)l * 1024 * 1024, nullptr, 1024, 1024, TR_PLAIN)
            TRJOB(IN_F(22) + (size_t)l * 2048 * PHI, (bf16*)(fb + F_WPHI1) + (size_t)l * 128 * 2048, nullptr, 2048, 128, TR_PLAIN)
            TRJOB(IN_F(24) + (size_t)l * PHI * 64, (bf16*)(fb + F_WPHI2) + (size_t)l * 64 * 128, nullptr, 128, 64, TR_PLAIN)
        }
        for (int l = 0; l < 4; ++l) {
            TRJOB(IN_F(30) + (size_t)l * D * DFF, (bf16*)(fb + F_WGU) + (size_t)l * 5632 * 1024, nullptr, 1024, DFF, TR_GATE)
            TRJOB(IN_F(31) + (size_t)l * D * DFF, (bf16*)(fb + F_WGU) + (size_t)l * 5632 * 1024, nullptr, 1024, DFF, TR_UP)
            TRJOB(IN_F(32) + (size_t)l * DFF * D, (bf16*)(fb + F_WDN) + (size_t)l * 1024 * 2816, nullptr, 2816, 1024, TR_PLAIN)
        }
        TRJOB(IN_F(21), (bf16*)(fb + F_WKV), nullptr, 1024, KVW, TR_PLAIN)
#undef TRJOB
    }
    {
        const size_t gt = (size_t)C.wg * NTHR + C.tid, nt = (size_t)C.G * NTHR;
        const f32x4* src = (const f32x4*)IN_F(6); f32x4* dst = (f32x4*)(A.out + O_WINS);
        for (size_t i = gt; i < (size_t)DB * 508 * 128; i += nt) { const size_t b = i / (508 * 128), r = i % (508 * 128); dst[b * 512 * 128 + r] = src[b * 512 * 128 + 4 * 128 + r]; }
        const f32x4* s2 = (const f32x4*)IN_F(7); f32x4* d2 = (f32x4*)(A.out + O_CONVS);
        for (size_t i = gt; i < (size_t)2 * DB * 26 * 256; i += nt) { const size_t lb = i / (26 * 256), r = i % (26 * 256); d2[lb * 30 * 256 + r] = s2[lb * 30 * 256 + 4 * 256 + r]; }
    }
    if (C.wg == C.G - 1 && C.tid < 256) { const int e = C.tid >> 7, h = C.tid & 127; float a = IN_F(23)[e * PHI + h]; const float* w = IN_F(22) + (size_t)e * 2048 * PHI + h; const float* pe = IN_F(26) + e * 2048;
        for (int f = 0; f < 2048; ++f) a += pe[f] * w[(size_t)f * PHI];
        ((float*)(fb + F_BPHI))[e * PHI + h] = a; }
    __syncthreads();
    for (int u = C.wg; u < 192; u += C.G) mod_unit(C, A, u);
}

__device__ __forceinline__ void phase_norm(const Ctx& C, const Args& A, int mode, int ls, bool from_input) {
    unsigned char* fb = A.fb; const float* modf = (const float*)(fb + F_MOD) + (size_t)ls * NC * 3072; const float* XF = (const float*)(fb + F_X);
    for (int row = C.gw; row < R; row += C.ngw) {
        const float* xr = from_input ? (row < MP ? IN_F(0) + (size_t)row * D : IN_F(1) + (size_t)(row - MP) * D) : XF + (size_t)row * D;
        f32x4 v[4]; float ss = 0.f;
#pragma unroll
        for (int j = 0; j < 4; ++j) { v[j] = ((const f32x4*)xr)[C.lane + 64 * j]; ss += (v[j][0] * v[j][0] + v[j][1] * v[j][1]) + (v[j][2] * v[j][2] + v[j][3] * v[j][3]); }
        const float rstd = rsqrtf(wsum(ss) * (1.f / D) + EPS);
        if (mode == 2) { float* yo = row < MP ? A.out + O_YP + (size_t)row * D : A.out + O_YS + (size_t)(row - MP) * D;
#pragma unroll
            for (int j = 0; j < 4; ++j) { const f32x4 g = ((const f32x4*)IN_F(33))[C.lane + 64 * j]; ((f32x4*)yo)[C.lane + 64 * j] = v[j] * rstd * g; }
            continue; }
        const float* m = modf + (size_t)cidx_row(row) * 3072;
        u32x2* ho = (u32x2*)((bf16*)(fb + F_H) + (size_t)row * D);
#pragma unroll
        for (int j = 0; j < 4; ++j) { const f32x4 sh = ((const f32x4*)m)[C.lane + 64 * j], aa = ((const f32x4*)(m + D))[C.lane + 64 * j]; const f32x4 h = v[j] * rstd * aa + sh;
            u32x2 o; o.x = pk2(h[0], h[1]); o.y = pk2(h[2], h[3]); ho[C.lane + 64 * j] = o; }
        if (mode == 1) { u32x2* ko = (u32x2*)((bf16*)(fb + F_HKV) + (size_t)row * D);
#pragma unroll
            for (int j = 0; j < 4; ++j) { const f32x4 g = ((const f32x4*)IN_F(20))[C.lane + 64 * j]; const f32x4 h = v[j] * rstd * g; u32x2 o; o.x = pk2(h[0], h[1]); o.y = pk2(h[2], h[3]); ko[C.lane + 64 * j] = o; } }
    }
}

struct EpGLU { static constexpr bool PERM = true, PAIRED = true;
    bf16* U; float* US; const float* b1; float* convp; float* convs;
    __device__ __forceinline__ void st2(int row, int f, f32x4 a, f32x4 g) const {
        const f32x4 ba = *(const f32x4*)(b1 + f), bg = *(const f32x4*)(b1 + 1024 + f); f32x4 u;
#pragma unroll
        for (int j = 0; j < 4; ++j) u[j] = (a[j] + ba[j]) * fsigm(g[j] + bg[j]);
        u32x2 o; o.x = pk2(u[0], u[1]); o.y = pk2(u[2], u[3]); *(u32x2*)(U + (size_t)row * D + f) = o;
        if (row < MP) { const int t = row & 4095; if (t >= 4066) *(f32x4*)(convp + ((size_t)(row >> 12) * 30 + (t - 4066)) * D + f) = u; }
        else { const int rs = row - MP; *(f32x4*)(US + (size_t)rs * D + f) = u; *(f32x4*)(convs + ((size_t)(rs >> 2) * 30 + 26 + (rs & 3)) * D + f) = u; }
    } };
struct EpSwiGLU { static constexpr bool PERM = true, PAIRED = true;
    bf16* ACT;
    __device__ __forceinline__ void st2(int row, int f, f32x4 g, f32x4 u) const {
        f32x4 a;
#pragma unroll
        for (int j = 0; j < 4; ++j) a[j] = fsilu(g[j]) * u[j];
        u32x2 o; o.x = pk2(a[0], a[1]); o.y = pk2(a[2], a[3]); *(u32x2*)(ACT + (size_t)row * DFF + f) = o;
    } };
struct EpResid { static constexpr bool PERM = false, PAIRED = false;
    const float* xp; const float* xs; float* X; const float* mod; const float* bias;
    __device__ __forceinline__ void st(int row, int col, f32x4 v) const {
        const f32x4 gt = *(const f32x4*)(mod + (size_t)cidx_row(row) * 3072 + 2048 + col);
        const f32x4 x = row < MP ? *(const f32x4*)(xp + (size_t)row * D + col) : *(const f32x4*)(xs + (size_t)(row - MP) * D + col);
        f32x4 b = {0.f, 0.f, 0.f, 0.f}; if (bias) b = *(const f32x4*)(bias + col);
        *(f32x4*)(X + (size_t)row * D + col) = x + gt * (v + b);
    } };
struct EpKV { static constexpr bool PERM = false, PAIRED = false;
    float* out; bf16* RB;
    __device__ __forceinline__ void st(int row, int col, f32x4 v) const {
        u32x2 o; o.x = pk2(v[0], v[1]); o.y = pk2(v[2], v[3]); *(u32x2*)(RB + (size_t)row * KVW + col) = o;
        const int br = col >> 9, c = col & 511;
        if (row < MP) {
            if (br == 0) *(f32x4*)(out + O_CMPP + (size_t)row * 512 + c) = v;
            else if (br == 1) *(f32x4*)(out + O_SELP + (size_t)row * 512 + c) = v;
            else { const int t = row & 4095; if (t >= 3584) *(f32x4*)(out + O_WINP + ((size_t)(row >> 12) * 512 + (t - 3584)) * 512 + c) = v; }
        } else { const int rs = row - MP;
            if (br == 0) *(f32x4*)(out + O_CMPS + (size_t)rs * 512 + c) = v;
            else if (br == 1) *(f32x4*)(out + O_SELS + (size_t)rs * 512 + c) = v;
            else *(f32x4*)(out + O_WINS + ((size_t)(rs >> 2) * 512 + 508 + (rs & 3)) * 512 + c) = v; }
    } };
struct EpQ { static constexpr bool PERM = true, PAIRED = false;
    bf16* Q;
    __device__ __forceinline__ void st(int row, int col, f32x4 v) const {
        const float s = 0.125f * LOG2E; u32x2 o; o.x = pk2(v[0] * s, v[1] * s); o.y = pk2(v[2] * s, v[3] * s); *(u32x2*)(Q + (size_t)row * D + col) = o;
    } };
struct EpGates { static constexpr bool PERM = false, PAIRED = false;
    float* GT;
    __device__ __forceinline__ void st(int row, int col, f32x4 v) const {
        f32x4 o; o[0] = fsigm(v[0]); o[1] = fsigm(v[1]); o[2] = fsigm(v[2]); o[3] = fsigm(v[3]); *(f32x4*)(GT + (size_t)row * 64 + col) = o;
    } };
template <class E> struct PgE { static constexpr bool PERM = E::PERM, AFTER_DRAIN = false; E e;
    __device__ __forceinline__ void operator()(const pg8::f32x4 (&acc)[2][2][4][2], const pg8::Unit& u, int wr, int wc, int fr, int fq) const {
#pragma unroll
        for (int ai = 0; ai < 2; ++ai)
#pragma unroll
            for (int m = 0; m < 4; ++m) { const int row = u.pm * 256 + ai * 128 + wr * 64 + m * 16 + fr;
                if constexpr (E::PAIRED) {
#pragma unroll
                    for (int n = 0; n < 2; ++n) { const int f = u.pn * 128 + wc * 32 + (E::PERM ? 8 * fq + 4 * n : 16 * n + 4 * fq); e.st2(row, f, acc[ai][0][m][n], acc[ai][1][m][n]); }
                } else {
#pragma unroll
                    for (int bj = 0; bj < 2; ++bj)
#pragma unroll
                        for (int n = 0; n < 2; ++n) { const int col = u.pn * 256 + bj * 128 + wc * 32 + (E::PERM ? 8 * fq + 4 * n : 16 * n + 4 * fq); e.st(row, col, acc[ai][bj][m][n]); }
                } }
    } };
template <class E> __device__ __forceinline__ void gemm_prompt(const Ctx& C, const bf16* Ap, const bf16* Bt, int N, int K, const E& e) {
    pg8::Gemm g{Ap, Bt, MP, N, K}; pg8::StaticOrder S; S.init(MP, N, C.G, C.wg); PgE<E> pe{e};
    pg8::gemm_phase<PgE<E>, pg8::StaticOrder, true, true>((PG8_LAS unsigned char*)C.lds, g, S, pe);
}
template <class E> __device__ __forceinline__ void gemm_sample(const Ctx& C, const bf16* As  , const bf16* Bt, int N, int K, const E& e) {
    const int nunits = E::PAIRED ? N / 64 : N / 64;
    const int fr = C.lane & 15, fq = C.lane >> 4;
    for (int u = C.G - 1 - C.wg; u < nunits; u += C.G) {
        int brow[4];
#pragma unroll
        for (int t = 0; t < 4; ++t) { if (E::PAIRED) { const int f = u * 32 + 16 * (t & 1); brow[t] = 256 * (f >> 7) + (f & 127) + 128 * (t >> 1); } else brow[t] = u * 64 + 16 * t; }
        f32x4 acc[4];
#pragma unroll
        for (int t = 0; t < 4; ++t) acc[t] = (f32x4){0.f, 0.f, 0.f, 0.f};
        const bf16* ap = As + (size_t)(C.wave * 16 + fr) * K + fq * 8;
#pragma unroll 4
        for (int k = 0; k < K; k += 32) { const bf16x8 a = *(const bf16x8*)(ap + k);
#pragma unroll
            for (int t = 0; t < 4; ++t) { const bf16x8 b = *(const bf16x8*)(Bt + (size_t)(brow[t] + fr) * K + k + fq * 8); acc[t] = __builtin_amdgcn_mfma_f32_16x16x32_bf16(b, a, acc[t], 0, 0, 0); } }
        const int row = MP + C.wave * 16 + fr;
        if constexpr (E::PAIRED) { e.st2(row, u * 32 + 4 * fq, acc[0], acc[2]); e.st2(row, u * 32 + 16 + 4 * fq, acc[1], acc[3]); }
        else {
#pragma unroll
            for (int t = 0; t < 4; ++t) e.st(row, u * 64 + 16 * t + 4 * fq, acc[t]); }
    }
}

__device__ __forceinline__ void phase_conv(const Ctx& C, const Args& A, int l) {
    unsigned char* fb = A.fb; const bf16* U = (const bf16*)(fb + F_U); bf16* Cc = (bf16*)(fb + F_C); const float* US = (const float*)(fb + F_US);
    const int c0 = 2 * C.tid;
    constexpr int TOK = 8, NR = 528;
    const unsigned voff2 = (unsigned)c0 * 2u, voff4 = (unsigned)c0 * 4u;
    float w0[31], w1[31];
    { const char* wb = (const char*)(IN_F(14) + ((size_t)l * CONVW) * D);
#pragma unroll
      for (int k = 0; k < 31; ++k) { const float2 w = *(const float2*)(wb + (size_t)k * (D * 4) + voff4); w0[k] = w.x; w1[k] = w.y; } }
    const float2 bdw = *(const float2*)(IN_F(15) + l * D + c0), lg = *(const float2*)(IN_F(16) + l * D + c0), lb = *(const float2*)(IN_F(17) + l * D + c0);
    FLAS float* red = (FLAS float*)C.lds;
    FLAS float* ybuf = (FLAS float*)(C.lds + 65536);
    const int nPU = MP / TOK, nU = nPU + DB;
    for (int u = C.wg; u < nU; u += C.G) {
        int ntok; size_t orow0;
        __syncthreads();
        if (u < nPU) {
            const int row0 = u * TOK, t0 = row0 & 4095; ntok = TOK; orow0 = row0;
            for (int t = 0; t < TOK; ++t) {
                const char* up = (const char*)(U + (size_t)(row0 + t - 30) * D); float a0 = bdw.x, a1 = bdw.y;
#pragma unroll
                for (int k = 0; k < 31; ++k) { unsigned v = 0u; if (t0 + t - 30 + k >= 0) v = *(const unsigned*)(up + (size_t)k * (D * 2) + voff2);
                    a0 += w0[k] * __builtin_bit_cast(float, v << 16); a1 += w1[k] * __builtin_bit_cast(float, v & 0xffff0000u); }
                ybuf[(t * NTHR + C.tid) * 2] = a0; ybuf[(t * NTHR + C.tid) * 2 + 1] = a1; red[(2 * t) * NR + C.tid] = a0 + a1; red[(2 * t + 1) * NR + C.tid] = a0 * a0 + a1 * a1; }
        } else {
            const int b = u - nPU; ntok = 4; orow0 = (size_t)MP + b * 4;
            const char* sp = (const char*)(IN_F(7) + (((size_t)l * DB + b) * 30) * D); const char* usp = (const char*)(US + ((size_t)b * 4) * D);
            for (int t = 0; t < TOK; ++t) { float a0 = bdw.x, a1 = bdw.y;
                if (t < 4) {
#pragma unroll
                    for (int k = 0; k < 31; ++k) { const int j = t + k; const char* p = j < 30 ? sp + (size_t)j * (D * 4) : usp + (size_t)(j - 30) * (D * 4); const float2 v = *(const float2*)(p + voff4);
                        a0 += w0[k] * v.x; a1 += w1[k] * v.y; } }
                ybuf[(t * NTHR + C.tid) * 2] = a0; ybuf[(t * NTHR + C.tid) * 2 + 1] = a1; red[(2 * t) * NR + C.tid] = a0 + a1; red[(2 * t + 1) * NR + C.tid] = a0 * a0 + a1 * a1; }
        }
        __syncthreads();
        { const int v = C.tid >> 5, part = C.tid & 31; float s = 0.f;
#pragma unroll 8
          for (int i = 0; i < 16; ++i) s += red[v * NR + i * 32 + part];
          s += __shfl_xor(s, 1); s += __shfl_xor(s, 2); s += __shfl_xor(s, 4); s += __shfl_xor(s, 8); s += __shfl_xor(s, 16);
          if (part == 0) red[2 * TOK * NR + v] = s; }
        __syncthreads();
        for (int t = 0; t < ntok; ++t) { const float mu = red[2 * TOK * NR + 2 * t] * (1.f / D); const float var = red[2 * TOK * NR + 2 * t + 1] * (1.f / D) - mu * mu; const float rstd = rsqrtf(fmaxf(var, 0.f) + EPS);
            const float yx = ybuf[(t * NTHR + C.tid) * 2], yy = ybuf[(t * NTHR + C.tid) * 2 + 1];
            const float o0 = fsilu((yx - mu) * rstd * lg.x + lb.x), o1 = fsilu((yy - mu) * rstd * lg.y + lb.y);
            *(unsigned*)(Cc + (orow0 + t) * D + c0) = pk2(o0, o1); }
    }
    __syncthreads();
}
#define FK_HAVE_ATTN 1
typedef float f32x16 __attribute__((ext_vector_type(16)));
template <class E> __device__ __forceinline__ void gemm128(const Ctx& C, const bf16* Arows  , int grow0, const bf16* Bt, int K, const E& e, int u) {
    const int fr = C.lane & 15, fq = C.lane >> 4;
    int brow[4];
#pragma unroll
    for (int t = 0; t < 4; ++t) { if (E::PAIRED) { const int f = u * 32 + 16 * (t & 1); brow[t] = 256 * (f >> 7) + (f & 127) + 128 * (t >> 1); } else brow[t] = u * 64 + 16 * t; }
    f32x4 acc[4];
#pragma unroll
    for (int t = 0; t < 4; ++t) acc[t] = (f32x4){0.f, 0.f, 0.f, 0.f};
    const bf16* ap = Arows + (size_t)(C.wave * 16 + fr) * K + fq * 8;
#pragma unroll 4
    for (int k = 0; k < K; k += 32) { const bf16x8 a = *(const bf16x8*)(ap + k);
#pragma unroll
        for (int t = 0; t < 4; ++t) { const bf16x8 b = *(const bf16x8*)(Bt + (size_t)(brow[t] + fr) * K + k + fq * 8); acc[t] = __builtin_amdgcn_mfma_f32_16x16x32_bf16(b, a, acc[t], 0, 0, 0); } }
    const int row = grow0 + C.wave * 16 + fr;
    if constexpr (E::PAIRED) { e.st2(row, u * 32 + 4 * fq, acc[0], acc[2]); e.st2(row, u * 32 + 16 + 4 * fq, acc[1], acc[3]); }
    else {
#pragma unroll
        for (int t = 0; t < 4; ++t) e.st(row, u * 64 + 16 * t + 4 * fq, acc[t]); }
}

__device__ __forceinline__ void phase_qkv(const Ctx& C, const Args& A, int l) {
    unsigned char* fb = A.fb; const bf16* HF = (const bf16*)(fb + F_H); const bf16* HKV = (const bf16*)(fb + F_HKV);
    if (l == 2) { EpKV e{A.out, (bf16*)(fb + F_RB)}; const bf16* W = (const bf16*)(fb + F_WKV);
        gemm_prompt(C, HKV, W, KVW, 1024, e); gemm_sample(C, HKV + (size_t)MP * D, W, KVW, 1024, e); }
    { EpQ e{(bf16*)(fb + F_Q)}; const bf16* W = (const bf16*)(fb + F_WQ) + (size_t)(l - 2) * 1024 * 1024;
      gemm_prompt(C, HF, W, 1024, 1024, e); gemm_sample(C, HF + (size_t)MP * D, W, 1024, 1024, e); }
    { EpGates e{(float*)(fb + F_GT)}; const bf16* W = (const bf16*)(fb + F_WG) + (size_t)(l - 2) * 64 * 1024;
      for (int rg = (C.wg + 64) % C.G; rg < R / 128; rg += C.G) gemm128(C, HF + (size_t)rg * 128 * D, rg * 128, W, 1024, e, 0); }
}

__device__ __forceinline__ void compress_task(const Ctx& C, const Args& A, int task, bool prompt) {
    unsigned char* fb = A.fb; const int fr = C.lane & 15, fq = C.lane >> 4, nl = fr >> 2, g = fr & 3;
    int e, b, grp; if (prompt) { e = task & 1; grp = (task >> 1) & 31; b = task >> 6; } else { e = task & 1; grp = (task >> 1) & 63; b = task >> 7; }
    const bf16* W1 = (const bf16*)(fb + F_WPHI1) + (size_t)e * 128 * 2048; const bf16* W2 = (const bf16*)(fb + F_WPHI2) + (size_t)e * 64 * 128;
    f32x4 acc[8];
#pragma unroll
    for (int j = 0; j < 8; ++j) acc[j] = (f32x4){0.f, 0.f, 0.f, 0.f};
    const bf16* w1p = W1 + (size_t)fr * 2048 + fq * 8;
    if (prompt) {
        const bf16* ap = (const bf16*)(fb + F_RB) + ((size_t)b * SEQ + (grp * 4 + nl) * 32) * KVW + e * 256 + g * 64 + fq * 8;
#pragma unroll 2
        for (int kk = 0; kk < 64; ++kk) { const bf16x8 a = *(const bf16x8*)(ap + (size_t)(kk >> 1) * KVW + (kk & 1) * 32);
#pragma unroll
            for (int j = 0; j < 8; ++j) { const bf16x8 w = *(const bf16x8*)(w1p + (size_t)j * 16 * 2048 + kk * 32); acc[j] = __builtin_amdgcn_mfma_f32_16x16x32_bf16(w, a, acc[j], 0, 0, 0); } }
    } else {
        const int page = ((const int*)A.in[8])[b * NPAGES + grp];
        const float* ap = IN_F(4) + ((((size_t)page * PAGE + nl * 32) * 2 + e) * 4 + g) * 64 + fq * 8;
#pragma unroll 4
        for (int kk = 0; kk < 64; ++kk) { const float* p = ap + (size_t)(kk >> 1) * 512 + (kk & 1) * 32; const f32x4 x0 = *(const f32x4*)p, x1 = *(const f32x4*)(p + 4);
            u32x4 pa; pa.x = pk2(x0[0], x0[1]); pa.y = pk2(x0[2], x0[3]); pa.z = pk2(x1[0], x1[1]); pa.w = pk2(x1[2], x1[3]); const bf16x8 a = __builtin_bit_cast(bf16x8, pa);
#pragma unroll
            for (int j = 0; j < 8; ++j) { const bf16x8 w = *(const bf16x8*)(w1p + (size_t)j * 16 * 2048 + kk * 32); acc[j] = __builtin_amdgcn_mfma_f32_16x16x32_bf16(w, a, acc[j], 0, 0, 0); } }
    }
    const float* bph = (const float*)(fb + F_BPHI) + e * PHI;
#pragma unroll
    for (int j = 0; j < 8; ++j) { const f32x4 bb = *(const f32x4*)(bph + 16 * j + 4 * fq);
#pragma unroll
        for (int r = 0; r < 4; ++r) acc[j][r] = fsilu(acc[j][r] + bb[r]); }
    f32x4 o2[4];
#pragma unroll
    for (int jj = 0; jj < 4; ++jj) o2[jj] = (f32x4){0.f, 0.f, 0.f, 0.f};
#pragma unroll
    for (int kq = 0; kq < 4; ++kq) {
        u32x4 pa; pa.x = pk2(acc[2 * kq][0], acc[2 * kq][1]); pa.y = pk2(acc[2 * kq][2], acc[2 * kq][3]); pa.z = pk2(acc[2 * kq + 1][0], acc[2 * kq + 1][1]); pa.w = pk2(acc[2 * kq + 1][2], acc[2 * kq + 1][3]);
        const bf16x8 a2 = __builtin_bit_cast(bf16x8, pa);
#pragma unroll
        for (int jj = 0; jj < 4; ++jj) { const bf16* wp = W2 + (size_t)(16 * jj + fr) * 128 + 32 * kq + 4 * fq; const u32x2 lo = *(const u32x2*)wp, hi = *(const u32x2*)(wp + 16);
            u32x4 pw; pw.x = lo.x; pw.y = lo.y; pw.z = hi.x; pw.w = hi.y; o2[jj] = __builtin_amdgcn_mfma_f32_16x16x32_bf16(__builtin_bit_cast(bf16x8, pw), a2, o2[jj], 0, 0, 0); } }
    const float* b2 = IN_F(25) + e * 64; const int n = grp * 4 + nl;
#pragma unroll
    for (int jj = 0; jj < 4; ++jj) { const int od = 16 * jj + 4 * fq; const f32x4 v = o2[jj] + *(const f32x4*)(b2 + od);
        if (prompt) {
            if (e == 0) { u32x2 o; o.x = pk2(v[0], v[1]); o.y = pk2(v[2], v[3]); *(u32x2*)((bf16*)(fb + F_CMPK) + (((size_t)b * 4 + g) * 128 + n) * 64 + od) = o; }
            else { bf16* vt = (bf16*)(fb + F_CMPVT) + (((size_t)b * 4 + g) * 64 + od) * 128 + n;
#pragma unroll
                for (int r = 0; r < 4; ++r) vt[r * 128] = (bf16)f2bf(v[r]); }
        } else *(f32x4*)((float*)(fb + F_CMPS) + ((((size_t)e * DB + b) * 256 + n) * 4 + g) * 64 + od) = v;
    }
}
__device__ __forceinline__ void phase_prep(const Ctx& C, const Args& A) {
    unsigned char* fb = A.fb; const bf16* RB = (const bf16*)(fb + F_RB); bf16* VT = (bf16*)(fb + F_VT);
    FLAS unsigned char* scr = C.lds + C.wave * 9216;
    for (int it = C.gw; it < 2048; it += C.ngw) {
        const int tc = it & 63, g = (it >> 6) & 3, b = (it >> 8) & 3, br = it >> 10; const int t0 = tc * 64, col0 = 512 * (br + 1) + 256 + g * 64;
#pragma unroll
        for (int i = 0; i < 8; ++i) { const int tok = i * 8 + (C.lane >> 3), ch = C.lane & 7; *(FLAS u32x4*)(scr + tok * 144 + ch * 16) = *(const u32x4*)(RB + ((size_t)b * SEQ + t0 + tok) * KVW + col0 + ch * 8); }
        asm volatile("s_waitcnt lgkmcnt(0)" ::: "memory");
        bf16* dst = VT + ((((size_t)br * 4 + b) * 4 + g) * 64 + C.lane) * SEQ + t0;
#pragma unroll
        for (int i = 0; i < 8; ++i) { unsigned w[4];
#pragma unroll
            for (int j = 0; j < 4; ++j) { const unsigned lo = *(const FLAS unsigned short*)(scr + (8 * i + 2 * j) * 144 + C.lane * 2), hi = *(const FLAS unsigned short*)(scr + (8 * i + 2 * j + 1) * 144 + C.lane * 2); w[j] = lo | (hi << 16); }
            u32x4 o; o.x = w[0]; o.y = w[1]; o.z = w[2]; o.w = w[3]; *(u32x4*)(dst + 8 * i) = o; }
        asm volatile("s_waitcnt lgkmcnt(0)" ::: "memory");
    }
    for (int it = C.gw; it < 256; it += C.ngw) compress_task(C, A, it, true);
    for (int it = C.gw; it < 4096; it += C.ngw) compress_task(C, A, it, false);
}

__device__ __forceinline__ float dpp_xor1(float v) { return __builtin_bit_cast(float, __builtin_amdgcn_update_dpp(0, __builtin_bit_cast(int, v), 0xB1, 0xF, 0xF, true)); }
__device__ __forceinline__ float dpp_xor2(float v) { return __builtin_bit_cast(float, __builtin_amdgcn_update_dpp(0, __builtin_bit_cast(int, v), 0x4E, 0xF, 0xF, true)); }
__device__ __forceinline__ int swz23(int m) { return (m & 0x13) | ((m & 4) << 1) | ((m & 8) >> 1); }
constexpr int AL_KB0 = 0, AL_VB0 = 9216, AL_KB1 = 18432, AL_VB1 = 27648, AL_CK = 36864, AL_CV = 55296, AL_LUT = 72704, AL_IMP = 85504, AL_SELM = 101888, AL_SCR = 102400;
constexpr int DMAXB = 790;
__device__ __forceinline__ bf16x8 pack8(const f32x16& p, int s) {
    u32x4 o; o.x = pk2(p[8 * s], p[8 * s + 1]); o.y = pk2(p[8 * s + 2], p[8 * s + 3]); o.z = pk2(p[8 * s + 4], p[8 * s + 5]); o.w = pk2(p[8 * s + 6], p[8 * s + 7]); return __builtin_bit_cast(bf16x8, o); }

__device__ __forceinline__ void attn_prompt_unit(const Ctx& C, const Args& A, int b, int g, int qt, bool load_bg) {
    unsigned char* fb = A.fb; FLAS unsigned char* L = C.lds;
    const bf16* RB = (const bf16*)(fb + F_RB); const bf16* VT = (const bf16*)(fb + F_VT); const bf16* Q = (const bf16*)(fb + F_Q); const float* GT = (const float*)(fb + F_GT);
    const int tid = C.tid, lane = C.lane, w = C.wave, n = lane & 31, h = lane >> 5, ql = n >> 2, r = n & 3;
    const int q0 = qt * 64, qpos = q0 + 8 * w + ql, jq = qt; const size_t qrow = (size_t)b * SEQ + qpos;
    __syncthreads();
    if (load_bg) {
        const bf16* ck = (const bf16*)(fb + F_CMPK) + ((size_t)b * 4 + g) * 128 * 64; const bf16* cv = (const bf16*)(fb + F_CMPVT) + ((size_t)b * 4 + g) * 64 * 128;
        for (int i = tid; i < 1024; i += NTHR) { const int key = i >> 3, ch = i & 7; *(FLAS u32x4*)(L + AL_CK + key * 144 + ch * 16) = *(const u32x4*)(ck + key * 64 + ch * 8); }
        for (int i = tid; i < 1024; i += NTHR) { const int dim = i >> 4, ch = i & 15; *(FLAS u32x4*)(L + AL_CV + dim * 272 + ch * 16) = *(const u32x4*)(cv + dim * 128 + ch * 8); }
        for (int i = tid; i < (DMAXB + 1) * 4; i += NTHR) { const int d = i >> 2, rr = i & 3; ((FLAS float*)(L + AL_LUT))[i] = IN_F(29)[rel_bucket(d) * 16 + g * 4 + rr] * LOG2E; }
    }
    bf16x8 qf[4];
#pragma unroll
    for (int s = 0; s < 4; ++s) qf[s] = *(const bf16x8*)(Q + qrow * D + (g * 4 + r) * 64 + 16 * s + 8 * h);
    const float gt0 = GT[qrow * 64 + (g * 4 + r) * 3 + 0], gt1 = GT[qrow * 64 + (g * 4 + r) * 3 + 1], gt2 = GT[qrow * 64 + (g * 4 + r) * 3 + 2];
    __syncthreads();
    const FLAS float* LUT = (const FLAS float*)(L + AL_LUT);
    f32x16 outa[2];
    const int krow = swz23(n);
    {
        f32x16 S[4]; float mx = -1e30f;
#pragma unroll
        for (int sub = 0; sub < 4; ++sub) { f32x16 acc;
#pragma unroll
            for (int i = 0; i < 16; ++i) acc[i] = 0.f;
#pragma unroll
            for (int ks = 0; ks < 4; ++ks) { const bf16x8 a = *(const FLAS bf16x8*)(L + AL_CK + (32 * sub + krow) * 144 + (16 * ks + 8 * h) * 2); acc = __builtin_amdgcn_mfma_f32_32x32x16_bf16(a, qf[ks], acc, 0, 0, 0); }
#pragma unroll
            for (int i = 0; i < 16; ++i) { const int nb = 32 * sub + (i & 7) + 8 * h + 16 * (i >> 3); const int d = qpos - (32 * nb + 31); const bool valid = d >= 0;
                const float v = valid ? acc[i] + LUT[(d > DMAXB ? DMAXB : (d < 0 ? 0 : d)) * 4 + r] : -INFINITY; acc[i] = v; mx = fmaxf(mx, v); }
            S[sub] = acc; }
        mx = fmaxf(mx, __shfl_xor(mx, 32));
        float sum = 0.f;
#pragma unroll
        for (int sub = 0; sub < 4; ++sub)
#pragma unroll
            for (int i = 0; i < 16; ++i) { const float p = exp2f(S[sub][i] - mx); S[sub][i] = p; sum += p; }
        sum += __shfl_xor(sum, 32);
        const float inv = sum > 0.f ? 1.f / sum : 0.f;
        f32x16 oc[2];
#pragma unroll
        for (int d2 = 0; d2 < 2; ++d2)
#pragma unroll
            for (int i = 0; i < 16; ++i) oc[d2][i] = 0.f;
        FLAS float* IMP = (FLAS float*)(L + AL_IMP) + (w * 8 + ql) * 64;
#pragma unroll
        for (int sub = 0; sub < 4; ++sub) {
#pragma unroll
            for (int i = 0; i < 16; ++i) S[sub][i] *= inv;
#pragma unroll
            for (int i = 0; i < 16; i += 2) { float v = S[sub][i] + S[sub][i + 1]; v += dpp_xor1(v); v += dpp_xor2(v);
                const int j = 16 * sub + ((i & 7) >> 1) + 4 * h + 8 * (i >> 3); if (r == 0) IMP[j] = v; }
#pragma unroll
            for (int s = 0; s < 2; ++s) { const bf16x8 pb = pack8(S[sub], s);
#pragma unroll
                for (int d2 = 0; d2 < 2; ++d2) { const bf16x8 a = *(const FLAS bf16x8*)(L + AL_CV + (32 * d2 + n) * 272 + (32 * sub + 16 * s + 8 * h) * 2); oc[d2] = __builtin_amdgcn_mfma_f32_32x32x16_bf16(a, pb, oc[d2], 0, 0, 0); } }
        }
#pragma unroll
        for (int d2 = 0; d2 < 2; ++d2) outa[d2] = oc[d2] * gt0;
    }
    asm volatile("s_waitcnt lgkmcnt(0)" ::: "memory");
    {
        FLAS float* SCR = (FLAS float*)(L + AL_SCR) + w * 64; FLAS unsigned* SELM = (FLAS unsigned*)(L + AL_SELM) + w * 16;
        for (int qq = 0; qq < 8; ++qq) {
            unsigned long long mask;
            if (jq < 16) mask = (2ull << jq) - 1ull;
            else {
                const int j = lane; const float impj = ((const FLAS float*)(L + AL_IMP))[(w * 8 + qq) * 64 + j];
                const bool forced = (j == 0) || (j == jq) || (j == jq - 1); const float sj = j <= jq ? (forced ? 1e4f : impj) : -1.f;
                SCR[j] = sj; asm volatile("s_waitcnt lgkmcnt(0)" ::: "memory");
                int rank = 0;
#pragma unroll
                for (int i4 = 0; i4 < 16; ++i4) { const f32x4 sv = *(const FLAS f32x4*)(SCR + 4 * i4);
#pragma unroll
                    for (int k = 0; k < 4; ++k) { const int i = 4 * i4 + k; rank += (sv[k] > sj || (sv[k] == sj && i < j)) ? 1 : 0; } }
                mask = __ballot(rank < 16 && sj >= 0.f);
                asm volatile("s_waitcnt lgkmcnt(0)" ::: "memory");
            }
            if (lane == 0) { SELM[2 * qq] = (unsigned)mask; SELM[2 * qq + 1] = (unsigned)(mask >> 32); }
        }
        asm volatile("s_waitcnt lgkmcnt(0)" ::: "memory");
    }
    const unsigned selLo = ((const FLAS unsigned*)(L + AL_SELM))[w * 16 + 2 * ql], selHi = ((const FLAS unsigned*)(L + AL_SELM))[w * 16 + 2 * ql + 1];
    const int jw0 = jq - 8 > 0 ? jq - 8 : 0; const int NTL = (jq + 1) + (jq - jw0 + 1);
    const int skey = tid >> 3, sch = tid & 7;
    const bf16* kbase = RB + ((size_t)b * SEQ + skey) * KVW + g * 64 + sch * 8;
    const bf16* vbase = VT + (((size_t)b * 4 + g) * 64 + skey) * SEQ + sch * 8;
    float m = -1e30f, lsum = 0.f; f32x16 oa[2];
#pragma unroll
    for (int d2 = 0; d2 < 2; ++d2)
#pragma unroll
        for (int i = 0; i < 16; ++i) oa[d2][i] = 0.f;
    u32x4 kreg, vreg;
    { kreg = *(const u32x4*)(kbase + 512); vreg = *(const u32x4*)vbase; }
    *(FLAS u32x4*)(L + AL_KB0 + skey * 144 + sch * 16) = kreg; *(FLAS u32x4*)(L + AL_VB0 + skey * 144 + sch * 16) = vreg;
    __syncthreads();
    const float b31 = LUT[DMAXB * 4 + r];
    for (int ti = 0; ti < NTL; ++ti) {
        const bool isw = ti > jq; const int j = isw ? jw0 + (ti - jq - 1) : ti; const int buf = ti & 1;
        if (ti + 1 < NTL) { const bool nw = (ti + 1) > jq; const int nj = nw ? jw0 + (ti - jq) : ti + 1;
            kreg = *(const u32x4*)(kbase + (size_t)64 * nj * KVW + (nw ? 1024 : 512)); vreg = *(const u32x4*)(vbase + (nw ? (size_t)16 * 64 * SEQ : 0) + 64 * nj); }
        if (ti == jq + 1) {
            const float lt = lsum + __shfl_xor(lsum, 32); const float f = lt > 0.f ? gt1 / lt : 0.f;
#pragma unroll
            for (int d2 = 0; d2 < 2; ++d2) { outa[d2] += oa[d2] * f;
#pragma unroll
                for (int i = 0; i < 16; ++i) oa[d2][i] = 0.f; }
            m = -1e30f; lsum = 0.f; }
        const bool selbit = ((j < 32 ? selLo >> j : selHi >> (j - 32)) & 1u) != 0u;
        const bool active = isw ? true : (__any(selbit) != 0);
        if (active) {
            const FLAS unsigned char* KB = L + (buf ? AL_KB1 : AL_KB0); const FLAS unsigned char* VB = L + (buf ? AL_VB1 : AL_VB0);
            f32x16 S[2];
#pragma unroll
            for (int sub = 0; sub < 2; ++sub) { f32x16 acc;
#pragma unroll
                for (int i = 0; i < 16; ++i) acc[i] = 0.f;
#pragma unroll
                for (int ks = 0; ks < 4; ++ks) { const bf16x8 a = *(const FLAS bf16x8*)(KB + (32 * sub + krow) * 144 + (16 * ks + 8 * h) * 2); acc = __builtin_amdgcn_mfma_f32_32x32x16_bf16(a, qf[ks], acc, 0, 0, 0); }
                S[sub] = acc; }
            const int dbase = qpos - 64 * j;
            float tmax = -INFINITY;
            const bool far = !isw && ((q0 + 8 * w) - (64 * j + 63) >= DMAXB);
            if (far) { const float add = selbit ? b31 : -INFINITY;
#pragma unroll
                for (int sub = 0; sub < 2; ++sub)
#pragma unroll
                    for (int i = 0; i < 16; ++i) { const float v = S[sub][i] + add; S[sub][i] = v; tmax = fmaxf(tmax, v); }
            } else {
#pragma unroll
                for (int sub = 0; sub < 2; ++sub)
#pragma unroll
                    for (int i = 0; i < 16; ++i) { const int d = dbase - (32 * sub + (i & 7) + 8 * h + 16 * (i >> 3)); const bool valid = isw ? (d >= 0 && d < 512) : (selbit && d >= 0);
                        const float v = valid ? S[sub][i] + LUT[(d > DMAXB ? DMAXB : (d < 0 ? 0 : d)) * 4 + r] : -INFINITY; S[sub][i] = v; tmax = fmaxf(tmax, v); }
            }
            tmax = fmaxf(tmax, __shfl_xor(tmax, 32));
            const float mnew = fmaxf(m, tmax); const float sc = exp2f(m - mnew); m = mnew;
            float ps = 0.f;
#pragma unroll
            for (int sub = 0; sub < 2; ++sub)
#pragma unroll
                for (int i = 0; i < 16; ++i) { const float p = exp2f(S[sub][i] - mnew); S[sub][i] = p; ps += p; }
            lsum = lsum * sc + ps;
#pragma unroll
            for (int d2 = 0; d2 < 2; ++d2) oa[d2] *= sc;
#pragma unroll
            for (int sub = 0; sub < 2; ++sub)
#pragma unroll
                for (int s = 0; s < 2; ++s) { const bf16x8 pb = pack8(S[sub], s);
#pragma unroll
                    for (int d2 = 0; d2 < 2; ++d2) { const bf16x8 a = *(const FLAS bf16x8*)(VB + (32 * d2 + n) * 144 + (32 * sub + 16 * s + 8 * h) * 2); oa[d2] = __builtin_amdgcn_mfma_f32_32x32x16_bf16(a, pb, oa[d2], 0, 0, 0); } }
        }
        if (ti + 1 < NTL) { FLAS unsigned char* KBn = L + (buf ? AL_KB0 : AL_KB1); FLAS unsigned char* VBn = L + (buf ? AL_VB0 : AL_VB1);
            *(FLAS u32x4*)(KBn + skey * 144 + sch * 16) = kreg; *(FLAS u32x4*)(VBn + skey * 144 + sch * 16) = vreg; }
        __syncthreads();
    }
    { const float lt = lsum + __shfl_xor(lsum, 32); const float f = lt > 0.f ? gt2 / lt : 0.f;
#pragma unroll
      for (int d2 = 0; d2 < 2; ++d2) outa[d2] += oa[d2] * f; }
    bf16* op = (bf16*)(fb + F_O) + qrow * D + (g * 4 + r) * 64;
#pragma unroll
    for (int d2 = 0; d2 < 2; ++d2)
#pragma unroll
        for (int c = 0; c < 4; ++c) { u32x2 o; o.x = pk2(outa[d2][4 * c], outa[d2][4 * c + 1]); o.y = pk2(outa[d2][4 * c + 2], outa[d2][4 * c + 3]); *(u32x2*)(op + 32 * d2 + 8 * c + 4 * h) = o; }
}

struct SKeySrc { const float* cache_sel; const float* cache_win; const int* pt; const float* out; };
__device__ __forceinline__ const float* s_sel_ptr(const SKeySrc& S, int b, int g, int e, int pos) {
    if (pos < PAST) { const int page = S.pt[b * NPAGES + pos / PAGE]; return S.cache_sel + (((size_t)page * PAGE + pos % PAGE) * 2 + e) * 256 + g * 64; }
    return S.out + O_SELS + ((size_t)b * DS + (pos - PAST)) * 512 + e * 256 + g * 64;
}
__device__ __forceinline__ const float* s_win_ptr(const SKeySrc& S, int b, int g, int e, int pos) {
    const int i = pos - (PAST + DS - 516);
    if (i < 512) return S.cache_win + (((size_t)b * 512 + i) * 2 + e) * 256 + g * 64;
    return S.out + O_WINS + ((size_t)b * 512 + 508 + (i - 512)) * 512 + e * 256 + g * 64;
}
__device__ __forceinline__ float wmaxf(float v) {
#pragma unroll
    for (int o = 1; o < 64; o <<= 1) v = fmaxf(v, __shfl_xor(v, o));
    return v; }
__device__ __forceinline__ void s_block(FLAS float* qs, FLAS float* pb, int lane, bool valid, const float* kp, const float (&bias2)[4], float (&m)[4], float (&l)[4], float (&o)[4], float (&pout)[4]) {
    float s[4] = {0.f, 0.f, 0.f, 0.f};
    if (valid) {
#pragma unroll 4
        for (int d4 = 0; d4 < 16; ++d4) { const f32x4 kv = *(const f32x4*)(kp + 4 * d4);
#pragma unroll
            for (int r = 0; r < 4; ++r) { const f32x4 qv = *(const FLAS f32x4*)(qs + r * 64 + 4 * d4); s[r] += qv[0] * kv[0] + qv[1] * kv[1] + qv[2] * kv[2] + qv[3] * kv[3]; } } }
#pragma unroll
    for (int r = 0; r < 4; ++r) { const float v = valid ? s[r] + bias2[r] : -INFINITY; const float bm = wmaxf(v); const float mn = fmaxf(m[r], bm); const float sc = exp2f(m[r] - mn);
        const float p = exp2f(v - mn); const float ps = wsum(p); l[r] = l[r] * sc + ps; o[r] *= sc; m[r] = mn; pb[r * 64 + lane] = p; pout[r] = p; }
    asm volatile("s_waitcnt lgkmcnt(0)" ::: "memory");
}
__device__ __forceinline__ void attn_sample_wave(const Ctx& C, const Args& A, int idx) {
    unsigned char* fb = A.fb; const int lane = C.lane;
    FLAS float* qs = (FLAS float*)(C.lds + C.wave * 8192); FLAS float* pb = qs + 256; FLAS float* impb = qs + 512; FLAS float* scoreb = qs + 704; FLAS int* selb = (FLAS int*)(qs + 896); FLAS float* scb = qs + 1024;
    const int g = idx & 3, q = (idx >> 2) & 3, b = idx >> 4; const int qpos = PAST + q; const size_t row = (size_t)MP + b * DS + q;
    const bf16* Q = (const bf16*)(fb + F_Q); const float* GT = (const float*)(fb + F_GT); const float* table = IN_F(29);
    SKeySrc S{IN_F(5), IN_F(6), (const int*)A.in[8], A.out};
#pragma unroll
    for (int r = 0; r < 4; ++r) qs[r * 64 + lane] = bf2f(Q[row * D + (g * 4 + r) * 64 + lane]);
    float gate[4][3];
#pragma unroll
    for (int r = 0; r < 4; ++r)
#pragma unroll
        for (int br = 0; br < 3; ++br) gate[r][br] = GT[row * 64 + (g * 4 + r) * 3 + br];
    asm volatile("s_waitcnt lgkmcnt(0)" ::: "memory");
    float out[4] = {0.f, 0.f, 0.f, 0.f};
    {
        const float* CK = (const float*)(fb + F_CMPS) + ((size_t)0 * DB + b) * 256 * 256; const float* CV = (const float*)(fb + F_CMPS) + ((size_t)1 * DB + b) * 256 * 256;
        float mx[4] = {-1e30f, -1e30f, -1e30f, -1e30f};
#pragma unroll 1
        for (int blk = 0; blk < 4; ++blk) { const int nn = blk * 64 + lane; const float* kp = CK + ((size_t)nn * 4 + g) * 64; float s[4] = {0.f, 0.f, 0.f, 0.f};
#pragma unroll 4
            for (int d4 = 0; d4 < 16; ++d4) { const f32x4 kv = *(const f32x4*)(kp + 4 * d4);
#pragma unroll
                for (int r = 0; r < 4; ++r) { const f32x4 qv = *(const FLAS f32x4*)(qs + r * 64 + 4 * d4); s[r] += qv[0] * kv[0] + qv[1] * kv[1] + qv[2] * kv[2] + qv[3] * kv[3]; } }
            const int bk = rel_bucket(qpos - (nn * 32 + 31));
#pragma unroll
            for (int r = 0; r < 4; ++r) { const float v = s[r] + table[bk * 16 + g * 4 + r] * LOG2E; scb[r * 256 + nn] = v; mx[r] = fmaxf(mx[r], v); } }
        asm volatile("s_waitcnt lgkmcnt(0)" ::: "memory");
#pragma unroll
        for (int r = 0; r < 4; ++r) { mx[r] = wmaxf(mx[r]); float a = 0.f;
#pragma unroll
            for (int blk = 0; blk < 4; ++blk) { const float p = exp2f(scb[r * 256 + blk * 64 + lane] - mx[r]); scb[r * 256 + blk * 64 + lane] = p; a += p; }
            const float inv = 1.f / wsum(a);
#pragma unroll
            for (int blk = 0; blk < 4; ++blk) scb[r * 256 + blk * 64 + lane] *= inv; }
        asm volatile("s_waitcnt lgkmcnt(0)" ::: "memory");
        for (int j = lane; j < 128; j += 64) { const float a = ((scb[2 * j] + scb[256 + 2 * j]) + scb[512 + 2 * j]) + scb[768 + 2 * j];
            const float c = ((scb[2 * j + 1] + scb[256 + 2 * j + 1]) + scb[512 + 2 * j + 1]) + scb[768 + 2 * j + 1]; impb[j] = a + c; }
        if (lane == 0) impb[128] = 0.f;
        float oc[4] = {0.f, 0.f, 0.f, 0.f};
#pragma unroll 4
        for (int kk = 0; kk < 256; ++kk) { const float v = CV[((size_t)kk * 4 + g) * 64 + lane];
#pragma unroll
            for (int r = 0; r < 4; ++r) oc[r] += scb[r * 256 + kk] * v; }
#pragma unroll
        for (int r = 0; r < 4; ++r) out[r] += gate[r][0] * oc[r];
        asm volatile("s_waitcnt lgkmcnt(0)" ::: "memory");
    }
    const int jq = qpos / 64;
    for (int j = lane; j < 129; j += 64) { const bool forced = (j == 0) || (j == jq) || (j == jq - 1); scoreb[j] = j <= jq ? (forced ? 1e4f : impb[j]) : -1.f; }
    if (lane < 16) selb[lane] = -1;
    asm volatile("s_waitcnt lgkmcnt(0)" ::: "memory");
    for (int j = lane; j < 129; j += 64) { const float sj = scoreb[j]; int rank = 0;
        for (int i = 0; i < 129; ++i) { const float si = scoreb[i]; rank += (si > sj || (si == sj && i < j)) ? 1 : 0; }
        if (rank < 16 && sj >= 0.f) selb[rank] = j; }
    asm volatile("s_waitcnt lgkmcnt(0)" ::: "memory");
    {
        float m[4] = {-1e30f, -1e30f, -1e30f, -1e30f}, l[4] = {0.f, 0.f, 0.f, 0.f}, o[4] = {0.f, 0.f, 0.f, 0.f};
#pragma unroll 1
        for (int sl = 0; sl < 16; ++sl) { const int j = selb[sl]; if (j < 0) continue;
            const int kpos = j * 64 + lane; const bool valid = kpos <= qpos; const float* kp = valid ? s_sel_ptr(S, b, g, 0, kpos) : nullptr;
            const int bk = rel_bucket(qpos - kpos); float bias2[4], pp[4];
#pragma unroll
            for (int r = 0; r < 4; ++r) bias2[r] = table[bk * 16 + g * 4 + r] * LOG2E;
            s_block(qs, pb, lane, valid, kp, bias2, m, l, o, pp);
            const int nk = qpos - j * 64 + 1 < 64 ? qpos - j * 64 + 1 : 64;
            for (int kk = 0; kk < nk; ++kk) { const float v = s_sel_ptr(S, b, g, 1, j * 64 + kk)[lane];
#pragma unroll
                for (int r = 0; r < 4; ++r) o[r] += pb[r * 64 + kk] * v; }
            asm volatile("s_waitcnt lgkmcnt(0)" ::: "memory");
        }
#pragma unroll
        for (int r = 0; r < 4; ++r) out[r] += gate[r][1] * (l[r] > 0.f ? o[r] / l[r] : 0.f);
    }
    {
        float m[4] = {-1e30f, -1e30f, -1e30f, -1e30f}, l[4] = {0.f, 0.f, 0.f, 0.f}, o[4] = {0.f, 0.f, 0.f, 0.f};
#pragma unroll 1
        for (int blk = 0; blk < 8; ++blk) { const int kpos = qpos - 511 + blk * 64 + lane; const float* kp = s_win_ptr(S, b, g, 0, kpos);
            const int bk = rel_bucket(qpos - kpos); float bias2[4], pp[4];
#pragma unroll
            for (int r = 0; r < 4; ++r) bias2[r] = table[bk * 16 + g * 4 + r] * LOG2E;
            s_block(qs, pb, lane, true, kp, bias2, m, l, o, pp);
            for (int kk = 0; kk < 64; ++kk) { const float v = s_win_ptr(S, b, g, 1, qpos - 511 + blk * 64 + kk)[lane];
#pragma unroll
                for (int r = 0; r < 4; ++r) o[r] += pb[r * 64 + kk] * v; }
            asm volatile("s_waitcnt lgkmcnt(0)" ::: "memory");
        }
#pragma unroll
        for (int r = 0; r < 4; ++r) out[r] += gate[r][2] * (l[r] > 0.f ? o[r] / l[r] : 0.f);
    }
    bf16* O = (bf16*)(fb + F_O);
#pragma unroll
    for (int r = 0; r < 4; ++r) O[row * D + (g * 4 + r) * 64 + lane] = (bf16)f2bf(out[r]);
}

__device__ __forceinline__ void phase_attn(const Ctx& C, const Args& A, int l) {
    int prev_bg = -1;
    for (int u = C.wg; u < 1024; u += C.G) { const int i = u >> 8, wv = u & 255, bg = wv & 15, k = wv >> 4; const int qt = i == 0 ? 63 - k : (i == 1 ? 32 + k : (i == 2 ? 31 - k : k));
        attn_prompt_unit(C, A, bg >> 2, bg & 3, qt, bg != prev_bg); prev_bg = bg; }
    __syncthreads();
    for (int u = C.gw; u < DB * DS * 4; u += C.ngw) attn_sample_wave(C, A, u);
    __syncthreads();
}
constexpr int NPHASE = 31;
__global__ void __launch_bounds__(NTHR, 2) mega(Args A) {
    extern __shared__ __attribute__((aligned(16))) unsigned char lds_raw[];
    Ctx C; C.lds = (FLAS unsigned char*)lds_raw; C.tid = threadIdx.x; C.lane = C.tid & 63; C.wave = __builtin_amdgcn_readfirstlane(C.tid >> 6); C.G = gridDim.x; C.wg = blockIdx.x;
    C.gw = C.wg * NWAVE + C.wave; C.ngw = C.G * NWAVE; C.a = &A;
    unsigned char* fb = A.fb;
    volatile FLAS unsigned* misc = (volatile FLAS unsigned*)(C.lds + LDS_MISC);
    if (C.tid < 8) misc[C.tid] = 0u;
    __syncthreads();
    const int lo = A.lo, hi = A.hi;
    const bool use_bar = (hi - lo) > 1;
    XcdBarrier bar; bar.bar = (unsigned*)(fb + F_CTL) + 1024; bar.x = 0; bar.st = nullptr;
    if (use_bar) bar = xcd_barrier_post((unsigned*)(fb + F_CTL) + 1024, misc);
    int pidx = 0;
#define PH_BEGIN if (lo <= pidx && pidx < hi) { C.tid = pg8::opaque_tid(); C.lane = C.tid & 63;
#define PH_END   if (pidx + 1 < hi) xcd_barrier(bar); } ++pidx;
    float* XF = (float*)(fb + F_X); bf16* HF = (bf16*)(fb + F_H); const float* MODF = (const float*)(fb + F_MOD);

    PH_BEGIN phase_prologue(C, A); PH_END

    for (int l = 0; l < 4; ++l) {
        const float* mod0 = MODF + (size_t)(2 * l) * NC * 3072; const float* mod1 = MODF + (size_t)(2 * l + 1) * NC * 3072;
        PH_BEGIN phase_norm(C, A, l == 2 ? 1 : 0, 2 * l, l == 0); PH_END
        if (l < 2) {
            PH_BEGIN {
                EpGLU e{(bf16*)(fb + F_U), (float*)(fb + F_US), IN_F(13) + (size_t)l * 2048, A.out + O_CONVP + (size_t)l * BATCH * 30 * D, A.out + O_CONVS + (size_t)l * DB * 30 * D};
                const bf16* W = (const bf16*)(fb + F_WPW1) + (size_t)l * 2048 * 1024;
                gemm_prompt(C, HF, W, 2048, 1024, e);
                gemm_sample(C, HF + (size_t)MP * D, W, 2048, 1024, e);
            } PH_END
            PH_BEGIN phase_conv(C, A, l); PH_END
            PH_BEGIN {
                EpResid e{l == 0 ? IN_F(0) : XF, l == 0 ? IN_F(1) : XF + (size_t)MP * D, XF, mod0, IN_F(19) + (size_t)l * D};
                const bf16* W = (const bf16*)(fb + F_WPW2) + (size_t)l * 1024 * 1024; const bf16* Ain = (const bf16*)(fb + F_C);
                gemm_prompt(C, Ain, W, 1024, 1024, e);
                gemm_sample(C, Ain + (size_t)MP * D, W, 1024, 1024, e);
            } PH_END
        } else {
#ifdef FK_HAVE_ATTN
            PH_BEGIN phase_qkv(C, A, l); PH_END
            if (l == 2) { PH_BEGIN phase_prep(C, A); PH_END }
            PH_BEGIN phase_attn(C, A, l); PH_END
            PH_BEGIN {
                EpResid e{XF, XF + (size_t)MP * D, XF, mod0, nullptr};
                const bf16* W = (const bf16*)(fb + F_WO) + (size_t)(l - 2) * 1024 * 1024; const bf16* Ain = (const bf16*)(fb + F_O);
                gemm_prompt(C, Ain, W, 1024, 1024, e);
                gemm_sample(C, Ain + (size_t)MP * D, W, 1024, 1024, e);
            } PH_END
#endif
        }
        PH_BEGIN phase_norm(C, A, 0, 2 * l + 1, false); PH_END
        PH_BEGIN {
            EpSwiGLU e{(bf16*)(fb + F_ACT)};
            const bf16* W = (const bf16*)(fb + F_WGU) + (size_t)l * 5632 * 1024;
            gemm_prompt(C, HF, W, 5632, 1024, e);
            gemm_sample(C, HF + (size_t)MP * D, W, 5632, 1024, e);
        } PH_END
        PH_BEGIN {
            EpResid e{XF, XF + (size_t)MP * D, XF, mod1, nullptr};
            const bf16* W = (const bf16*)(fb + F_WDN) + (size_t)l * 1024 * 2816; const bf16* Ain = (const bf16*)(fb + F_ACT);
            gemm_prompt(C, Ain, W, 1024, 2816, e);
            gemm_sample(C, Ain + (size_t)MP * DFF, W, 1024, 2816, e);
        } PH_END
    }
    PH_BEGIN phase_norm(C, A, 2, 0, false); PH_END
#undef PH_BEGIN
#undef PH_END
}

static int g_grid = 0;
static bool fast_setup() {
    if (g_grid) return g_grid > 0;
    int dev = 0, cus = 0;
    if (hipGetDevice(&dev) != hipSuccess || hipDeviceGetAttribute(&cus, hipDeviceAttributeMultiprocessorCount, dev) != hipSuccess) { g_grid = -1; return false; }
    if (hipFuncSetAttribute((const void*)mega, hipFuncAttributeMaxDynamicSharedMemorySize, LDS_BYTES) != hipSuccess) { g_grid = -1; return false; }
    int per_cu = 0; (void)hipOccupancyMaxActiveBlocksPerMultiprocessor(&per_cu, (const void*)mega, NTHR, LDS_BYTES); (void)hipGetLastError();
    if (per_cu < 1) fprintf(stderr, "fast_setup: occupancy query says %d blocks/CU\n", per_cu);
    g_grid = cus;
    return true;
}
static void fast_launch(void* const* d_in, float* out, unsigned char* fb, int lo, int hi, hipStream_t st) {
    if (!fast_setup()) return;
    Args a{}; for (int i = 0; i < 34; ++i) a.in[i] = d_in[i]; a.out = out; a.fb = fb; a.lo = lo; a.hi = hi;
    hipLaunchKernelGGL(mega, dim3(g_grid), dim3(NTHR), LDS_BYTES, st, a);
}
}
extern "C" void kernel_launch(void* const* d_in, const int* in_sizes, int n_in, void* d_out, int out_size, void* d_ws, size_t ws_size, hipStream_t stream) {
    if (ws_size < fk::F_END) { fprintf(stderr, "ws too small: %zu < %zu\n", ws_size, (size_t)fk::F_END); return; }
    unsigned char* fb = (unsigned char*)d_ws;
    (void)hipMemsetAsync(fb + fk::F_CTL, 0, fk::CTL_BYTES, stream);
#if FK_NLAUNCH == 1
    fk::fast_launch(d_in, (float*)d_out, fb, 0, fk::NPHASE, stream);
#else
    for (int p = 0; p < fk::NPHASE; ++p) fk::fast_launch(d_in, (float*)d_out, fb, p, p + 1, stream);
#endif
}
```

```cpp
#define FK_NLAUNCH 1
#include <math.h>
#include <hip/hip_runtime.h>
#include <stdint.h>
#include <stdio.h>

namespace nv {
constexpr int D = 1024, BATCH = 4, SEQ = 4096, DB = 32, DS = 4, PAST = 8192, PAGE = 128, NPAGES = 64;
constexpr int KVH = 4, GROUP = 4, HD = 64, CONVW = 31, DFF = 2816, PHI = 128, QGW = 1072, KVW = 1536;
constexpr int MP = BATCH * SEQ, MS = DB * DS, R = MP + MS, NC = 36;
constexpr float EPS = 1e-6f;

constexpr size_t O_YP = 0, O_YS = O_YP + (size_t)MP * D, O_CMPP = O_YS + (size_t)MS * D, O_CMPS = O_CMPP + (size_t)MP * 512,
                 O_SELP = O_CMPS + (size_t)MS * 512, O_SELS = O_SELP + (size_t)MP * 512, O_WINP = O_SELS + (size_t)MS * 512,
                 O_WINS = O_WINP + (size_t)BATCH * 512 * 512, O_CONVP = O_WINS + (size_t)DB * 512 * 512,
                 O_CONVS = O_CONVP + (size_t)2 * BATCH * 30 * D, O_END = O_CONVS + (size_t)2 * DB * 30 * D;

__device__ __forceinline__ float silu(float x) { return x / (1.f + expf(-x)); }
__device__ __forceinline__ float sigm(float x) { return 1.f / (1.f + expf(-x)); }
__device__ __forceinline__ int cidx_of(int row) { return row < MP ? row / SEQ : 4 + (row - MP) / DS; }
__device__ __forceinline__ int rel_bucket(int n) {
    if (n < 0) n = 0;
    if (n < 16) return n;
    int b = 16;
    b += (n >= 21); b += (n >= 27); b += (n >= 35); b += (n >= 46); b += (n >= 59); b += (n >= 77); b += (n >= 99); b += (n >= 128);
    b += (n >= 166); b += (n >= 216); b += (n >= 280); b += (n >= 363); b += (n >= 470); b += (n >= 609); b += (n >= 790);
    return b;
}

__global__ __launch_bounds__(256) void k_gemm(const float* __restrict__ A, int lda, const float* __restrict__ W, int ldw, const float* __restrict__ bias,
                                              float* __restrict__ C, int ldc, int M, int N, int K) {
    __shared__ float As[16][68];
    __shared__ float Ws[16][68];
    const int tid = threadIdx.x, tx = tid & 15, ty = tid >> 4;
    const int m0 = blockIdx.y * 64, n0 = blockIdx.x * 64;
    float acc[4][4];
#pragma unroll
    for (int i = 0; i < 4; ++i)
#pragma unroll
        for (int j = 0; j < 4; ++j) acc[i][j] = 0.f;
    for (int k0 = 0; k0 < K; k0 += 16) {
#pragma unroll
        for (int it = 0; it < 4; ++it) { const int i = tid + it * 256; const int m = i >> 4, k = i & 15; const int gm = m0 + m; As[k][m] = gm < M ? A[(size_t)gm * lda + k0 + k] : 0.f; }
#pragma unroll
        for (int it = 0; it < 4; ++it) { const int i = tid + it * 256; const int k = i >> 6, n = i & 63; const int gn = n0 + n; Ws[k][n] = gn < N ? W[(size_t)(k0 + k) * ldw + gn] : 0.f; }
        __syncthreads();
#pragma unroll
        for (int k = 0; k < 16; ++k) {
            const float4 a = *(const float4*)&As[k][ty * 4]; const float4 b = *(const float4*)&Ws[k][tx * 4];
            const float av[4] = {a.x, a.y, a.z, a.w}, bv[4] = {b.x, b.y, b.z, b.w};
#pragma unroll
            for (int i = 0; i < 4; ++i)
#pragma unroll
                for (int j = 0; j < 4; ++j) acc[i][j] += av[i] * bv[j];
        }
        __syncthreads();
    }
#pragma unroll
    for (int i = 0; i < 4; ++i) { const int gm = m0 + ty * 4 + i; if (gm >= M) continue;
#pragma unroll
        for (int j = 0; j < 4; ++j) { const int gn = n0 + tx * 4 + j; if (gn < N) C[(size_t)gm * ldc + gn] = acc[i][j] + (bias ? bias[gn] : 0.f); } }
}

__global__ void k_silu_c(const float* cp, const float* cs, float* SC) {
    const int i = blockIdx.x * blockDim.x + threadIdx.x; if (i >= NC * D) return;
    const int r = i / D, k = i % D; const float v = r < 4 ? cp[r * D + k] : cs[(r - 4) * D + k]; SC[i] = silu(v);
}

__device__ __forceinline__ float block_sum256(float v, float* red) {
#pragma unroll
    for (int o = 32; o >= 1; o >>= 1) v += __shfl_xor(v, o);
    __syncthreads();
    if ((threadIdx.x & 63) == 0) red[threadIdx.x >> 6] = v;
    __syncthreads();
    return red[0] + red[1] + red[2] + red[3];
}
__global__ __launch_bounds__(256) void k_modnorm(const float* __restrict__ X, const float* __restrict__ g, const float* __restrict__ mod, float* __restrict__ H) {
    __shared__ float red[4];
    const int row = blockIdx.x, t = threadIdx.x; const float4 x = ((const float4*)(X + (size_t)row * D))[t];
    const float ss = block_sum256(x.x * x.x + x.y * x.y + x.z * x.z + x.w * x.w, red);
    const float rstd = (1.0f / sqrtf(ss * (1.f / D) + EPS));
    const float4 gv = ((const float4*)g)[t]; float4 y = {x.x * rstd * gv.x, x.y * rstd * gv.y, x.z * rstd * gv.z, x.w * rstd * gv.w};
    if (mod) { const float* m = mod + (size_t)cidx_of(row) * 3072; const float4 sh = ((const float4*)m)[t], sc = ((const float4*)(m + D))[t];
        y.x = y.x * (1.f + sc.x) + sh.x; y.y = y.y * (1.f + sc.y) + sh.y; y.z = y.z * (1.f + sc.z) + sh.z; y.w = y.w * (1.f + sc.w) + sh.w; }
    ((float4*)(H + (size_t)row * D))[t] = y;
}
__global__ void k_glu(const float* __restrict__ T1, float* __restrict__ U) {
    const size_t i = (size_t)blockIdx.x * blockDim.x + threadIdx.x; if (i >= (size_t)R * D) return;
    const size_t r = i / D; const int c = (int)(i % D); const float a = T1[r * 2048 + c], gg = T1[r * 2048 + D + c]; U[i] = a * sigm(gg);
}
__global__ void k_conv(const float* __restrict__ U, const float* __restrict__ state  , const float* __restrict__ wdw  , const float* __restrict__ bdw,
                       float* __restrict__ Y) {
    const size_t i = (size_t)blockIdx.x * blockDim.x + threadIdx.x; if (i >= (size_t)R * D) return;
    const int row = (int)(i / D), c = (int)(i % D); float acc = bdw[c];
    if (row < MP) { const int b = row / SEQ, t = row % SEQ;
        for (int k = 0; k < CONVW; ++k) { const int tt = t - 30 + k; if (tt >= 0) acc += wdw[k * D + c] * U[((size_t)b * SEQ + tt) * D + c]; }
    } else { const int rs = row - MP, b = rs / DS, t = rs % DS;
        for (int k = 0; k < CONVW; ++k) { const int j = t + k; const float v = j < 30 ? state[((size_t)b * 30 + j) * D + c] : U[((size_t)MP + b * DS + (j - 30)) * D + c]; acc += wdw[k * D + c] * v; }
    }
    Y[i] = acc;
}
__global__ void k_conv_state_out(const float* __restrict__ U, const float* __restrict__ state, float* __restrict__ outp  , float* __restrict__ outs  ) {
    const int i = blockIdx.x * blockDim.x + threadIdx.x; const int NPo = BATCH * 30 * D, NSo = DB * 30 * D;
    if (i < NPo) { const int b = i / (30 * D), j = (i / D) % 30, c = i % D; outp[i] = U[((size_t)b * SEQ + SEQ - 30 + j) * D + c]; }
    else if (i < NPo + NSo) { const int ii = i - NPo; const int b = ii / (30 * D), j = (ii / D) % 30, c = ii % D;
        outs[ii] = j < 26 ? state[((size_t)b * 30 + j + 4) * D + c] : U[((size_t)MP + b * DS + (j - 26)) * D + c]; }
}
__global__ __launch_bounds__(256) void k_ln_silu(const float* __restrict__ Y, const float* __restrict__ g, const float* __restrict__ bb, float* __restrict__ Cc) {
    __shared__ float red[4];
    const int row = blockIdx.x, t = threadIdx.x; const float4 x = ((const float4*)(Y + (size_t)row * D))[t];
    const float mu = block_sum256(x.x + x.y + x.z + x.w, red) * (1.f / D);
    const float4 d = {x.x - mu, x.y - mu, x.z - mu, x.w - mu};
    const float var = block_sum256(d.x * d.x + d.y * d.y + d.z * d.z + d.w * d.w, red) * (1.f / D);
    const float rstd = (1.0f / sqrtf(var + EPS)); const float4 gv = ((const float4*)g)[t], bv = ((const float4*)bb)[t];
    float4 y = {silu(d.x * rstd * gv.x + bv.x), silu(d.y * rstd * gv.y + bv.y), silu(d.z * rstd * gv.z + bv.z), silu(d.w * rstd * gv.w + bv.w)};
    ((float4*)(Cc + (size_t)row * D))[t] = y;
}
__global__ void k_resid(float* __restrict__ X, const float* __restrict__ T, int ldt, const float* __restrict__ mod) {
    const size_t i = (size_t)blockIdx.x * blockDim.x + threadIdx.x; if (i >= (size_t)R * D) return;
    const int row = (int)(i / D), c = (int)(i % D); X[i] += mod[(size_t)cidx_of(row) * 3072 + 2048 + c] * T[(size_t)row * ldt + c];
}
__global__ void k_swiglu(const float* __restrict__ G, const float* __restrict__ UP, float* __restrict__ ACT) {
    const size_t i = (size_t)blockIdx.x * blockDim.x + threadIdx.x; if (i >= (size_t)R * DFF) return; ACT[i] = silu(G[i]) * UP[i];
}
__global__ void k_kv_out(const float* __restrict__ ROWS, const float* __restrict__ cache_win, float* __restrict__ out) {
    const size_t i = (size_t)blockIdx.x * blockDim.x + threadIdx.x;
    const size_t n1 = (size_t)MP * 512, n2 = (size_t)MS * 512, n3 = (size_t)BATCH * 512 * 512, n4 = (size_t)DB * 512 * 512;
    if (i < n1) { const size_t r = i / 512, c = i % 512; out[O_CMPP + i] = ROWS[r * KVW + c]; out[O_SELP + i] = ROWS[r * KVW + 512 + c]; }
    if (i < n2) { const size_t r = i / 512, c = i % 512; out[O_CMPS + i] = ROWS[(MP + r) * KVW + c]; out[O_SELS + i] = ROWS[(MP + r) * KVW + 512 + c]; }
    if (i < n3) { const size_t b = i / (512 * 512), j = (i / 512) % 512, c = i % 512; out[O_WINP + i] = ROWS[(b * SEQ + SEQ - 512 + j) * KVW + 1024 + c]; }
    if (i < n4) { const size_t b = i / (512 * 512), j = (i / 512) % 512, c = i % 512;
        out[O_WINS + i] = j < 508 ? cache_win[(b * 512 + j + 4) * 512 + c] : ROWS[(MP + b * DS + (j - 508)) * KVW + 1024 + c]; }
}
__global__ __launch_bounds__(256) void k_compress(int is_prompt, const float* __restrict__ ROWS, const float* __restrict__ cache, const int* __restrict__ pt,
                                                   const float* __restrict__ w1, const float* __restrict__ b1, const float* __restrict__ w2, const float* __restrict__ b2,
                                                   const float* __restrict__ pe, float* __restrict__ CMP) {
    __shared__ float blk[32 * 4 * 64];
    __shared__ float hid[4][PHI];
    const int NB = is_prompt ? 128 : 256, BB = is_prompt ? BATCH : DB;
    const int e = blockIdx.x & 1, n = (blockIdx.x >> 1) % NB, b = (blockIdx.x >> 1) / NB, tid = threadIdx.x;
    for (int i = tid; i < 32 * 256; i += 256) { const int t = i >> 8, gd = i & 255; float v;
        if (is_prompt) v = ROWS[((size_t)b * SEQ + n * 32 + t) * KVW + e * 256 + gd];
        else { const int page = pt[b * NPAGES + (n >> 2)]; v = cache[(((size_t)page * PAGE + (n & 3) * 32 + t) * 2 + e) * 256 + gd]; }
        blk[i] = v + pe[(e * 32 + t) * 64 + (gd & 63)]; }
    __syncthreads();
    const int h = tid & 127, gp = tid >> 7; float a0 = 0.f, a1 = 0.f; const float* w = w1 + (size_t)e * 2048 * PHI + h;
    for (int f = 0; f < 2048; ++f) { const int t = f >> 6, d = f & 63; const float wv = w[(size_t)f * PHI]; a0 += blk[(t * 4 + gp * 2) * 64 + d] * wv; a1 += blk[(t * 4 + gp * 2 + 1) * 64 + d] * wv; }
    hid[gp * 2][h] = silu(a0 + b1[e * PHI + h]); hid[gp * 2 + 1][h] = silu(a1 + b1[e * PHI + h]);
    __syncthreads();
    const int g = tid >> 6, d = tid & 63; float o = b2[e * 64 + d];
    for (int hh = 0; hh < PHI; ++hh) o += hid[g][hh] * w2[((size_t)e * PHI + hh) * 64 + d];
    CMP[((((size_t)e * BB + b) * NB + n) * 4 + g) * 64 + d] = o;
}

struct AttnP {
    const float* QG;
    const float* ROWS;
    const float* CMP;
    const float* cache_sel; const float* cache_win; const int* pt; const float* table;
    float* O;
};
__device__ __forceinline__ const float* kv_ptr_sel(const AttnP& P, int is_prompt, int b, int g, int e, int pos) {
    if (is_prompt) return P.ROWS + ((size_t)b * SEQ + pos) * KVW + 512 + e * 256 + g * 64;
    if (pos < PAST) { const int page = P.pt[b * NPAGES + pos / PAGE]; return P.cache_sel + (((size_t)page * PAGE + pos % PAGE) * 2 + e) * 256 + g * 64; }
    return P.ROWS + ((size_t)MP + b * DS + (pos - PAST)) * KVW + 512 + e * 256 + g * 64;
}
__device__ __forceinline__ const float* kv_ptr_win(const AttnP& P, int is_prompt, int b, int g, int e, int pos) {
    if (is_prompt) return P.ROWS + ((size_t)b * SEQ + pos) * KVW + 1024 + e * 256 + g * 64;
    const int i = pos - (PAST + DS - 516);
    if (i < 512) return P.cache_win + (((size_t)b * 512 + i) * 2 + e) * 256 + g * 64;
    return P.ROWS + ((size_t)MP + b * DS + (i - 512)) * KVW + 1024 + e * 256 + g * 64;
}
__device__ __forceinline__ float wave_max(float v) {
#pragma unroll
    for (int o = 32; o >= 1; o >>= 1) v = fmaxf(v, __shfl_xor(v, o)); return v; }
__device__ __forceinline__ float wave_sum(float v) {
#pragma unroll
    for (int o = 32; o >= 1; o >>= 1) v += __shfl_xor(v, o); return v; }

constexpr int SBW = 1088;
__global__ __launch_bounds__(64) void k_attn(AttnP P, int is_prompt) {
    __shared__ float qs[4][64];
    __shared__ float sb[4][SBW];
    __shared__ float impb[192];
    __shared__ float scoreb[192];
    __shared__ int selb[16];
    const int lane = threadIdx.x; const int T = is_prompt ? SEQ : DS;
    const int g = blockIdx.x & 3, q = (blockIdx.x >> 2) % T, b = (blockIdx.x >> 2) / T;
    const int qpos = is_prompt ? q : PAST + q; const int row = is_prompt ? b * SEQ + q : MP + b * DS + q;
    const int NCMP = is_prompt ? 128 : 256, NBLK = is_prompt ? 64 : 129, BB = is_prompt ? BATCH : DB;
    const float NEGM = -3.0e38f;
#pragma unroll
    for (int r = 0; r < 4; ++r) qs[r][lane] = P.QG[(size_t)row * QGW + (g * 4 + r) * 64 + lane] * 0.125f;
    float gate[4][3];
#pragma unroll
    for (int r = 0; r < 4; ++r)
#pragma unroll
        for (int br = 0; br < 3; ++br) gate[r][br] = sigm(P.QG[(size_t)row * QGW + 1024 + (g * 4 + r) * 3 + br]);
    __syncthreads();
    float out[4] = {0.f, 0.f, 0.f, 0.f};
    {
        const float* CK = P.CMP + ((size_t)0 * BB + b) * NCMP * 256; const float* CV = P.CMP + ((size_t)1 * BB + b) * NCMP * 256;
        float mx[4] = {NEGM, NEGM, NEGM, NEGM};
        for (int n = lane; n < NCMP; n += 64) { const int endp = n * 32 + 31; const bool valid = endp <= qpos; const float* k = CK + ((size_t)n * 4 + g) * 64;
            float s[4] = {0.f, 0.f, 0.f, 0.f};
            for (int d = 0; d < 64; ++d) { const float kv = k[d]; s[0] += qs[0][d] * kv; s[1] += qs[1][d] * kv; s[2] += qs[2][d] * kv; s[3] += qs[3][d] * kv; }
            const int bk = rel_bucket(qpos - endp);
#pragma unroll
            for (int r = 0; r < 4; ++r) { const float v = valid ? s[r] + P.table[bk * 16 + g * 4 + r] : NEGM; sb[r][n] = v; mx[r] = fmaxf(mx[r], v); } }
        float sm[4];
#pragma unroll
        for (int r = 0; r < 4; ++r) { mx[r] = wave_max(mx[r]); float a = 0.f;
            for (int n = lane; n < NCMP; n += 64) { const float v = sb[r][n]; const float p = v > -1e38f ? expf(v - mx[r]) : 0.f; sb[r][n] = p; a += p; }
            sm[r] = wave_sum(a); }
        __syncthreads();
#pragma unroll
        for (int r = 0; r < 4; ++r) { const float inv = sm[r] > 0.f ? 1.f / sm[r] : 0.f; for (int n = lane; n < NCMP; n += 64) sb[r][n] *= inv; }
        __syncthreads();
        float oc[4] = {0.f, 0.f, 0.f, 0.f};
        for (int n = 0; n < NCMP; ++n) { const float v = CV[((size_t)n * 4 + g) * 64 + lane]; oc[0] += sb[0][n] * v; oc[1] += sb[1][n] * v; oc[2] += sb[2][n] * v; oc[3] += sb[3][n] * v; }
#pragma unroll
        for (int r = 0; r < 4; ++r) out[r] += gate[r][0] * oc[r];
        for (int j = lane; j < NBLK; j += 64) { float a = 0.f, c = 0.f;
            if (2 * j < NCMP) a = ((sb[0][2 * j] + sb[1][2 * j]) + sb[2][2 * j]) + sb[3][2 * j];
            if (2 * j + 1 < NCMP) c = ((sb[0][2 * j + 1] + sb[1][2 * j + 1]) + sb[2][2 * j + 1]) + sb[3][2 * j + 1];
            float nz = 1.f;
#ifdef IMP_NOISE
            { unsigned hsh = (unsigned)(j * 2654435761u) ^ (unsigned)(blockIdx.x * 40503u + 12345u); hsh ^= hsh >> 15; hsh *= 2246822519u; hsh ^= hsh >> 13; hsh *= 3266489917u; hsh ^= hsh >> 16;
              nz = 1.f + IMP_NOISE * ((float)(hsh & 0xffff) * (2.f / 65535.f) - 1.f); }
#endif
            impb[j] = (a + c) * nz; }
        __syncthreads();
    }
    const int jq = qpos / 64;
    for (int j = lane; j < NBLK; j += 64) { const bool forced = (j == 0) || (j == jq) || (j == jq - 1); scoreb[j] = j <= jq ? (forced ? 1e4f : impb[j]) : -1.f; }
    if (lane < 16) selb[lane] = -1;
    __syncthreads();
    for (int j = lane; j < NBLK; j += 64) { const float sj = scoreb[j]; int rank = 0;
        for (int i = 0; i < NBLK; ++i) { const float si = scoreb[i]; rank += (si > sj || (si == sj && i < j)) ? 1 : 0; }
        if (rank < 16 && sj >= 0.f) selb[rank] = j; }
    __syncthreads();
    {
        float mx[4] = {NEGM, NEGM, NEGM, NEGM};
        for (int sl = 0; sl < 16; ++sl) { const int j = selb[sl]; const int kpos = j * 64 + lane; const bool valid = (j >= 0) && (kpos <= qpos);
            float s[4] = {0.f, 0.f, 0.f, 0.f};
            if (valid) { const float* k = kv_ptr_sel(P, is_prompt, b, g, 0, kpos);
                for (int d = 0; d < 64; ++d) { const float kv = k[d]; s[0] += qs[0][d] * kv; s[1] += qs[1][d] * kv; s[2] += qs[2][d] * kv; s[3] += qs[3][d] * kv; } }
            const int bk = rel_bucket(qpos - kpos);
#pragma unroll
            for (int r = 0; r < 4; ++r) { const float v = valid ? s[r] + P.table[bk * 16 + g * 4 + r] : NEGM; sb[r][sl * 64 + lane] = v; mx[r] = fmaxf(mx[r], v); } }
        float sm[4];
#pragma unroll
        for (int r = 0; r < 4; ++r) { mx[r] = wave_max(mx[r]); float a = 0.f;
            for (int n = lane; n < 1024; n += 64) { const float v = sb[r][n]; const float p = v > -1e38f ? expf(v - mx[r]) : 0.f; sb[r][n] = p; a += p; }
            sm[r] = wave_sum(a); }
        __syncthreads();
        float os[4] = {0.f, 0.f, 0.f, 0.f};
        for (int sl = 0; sl < 16; ++sl) { const int j = selb[sl]; if (j < 0) continue;
            for (int kk = 0; kk < 64; ++kk) { const int kpos = j * 64 + kk; if (kpos > qpos) break;
                const float v = kv_ptr_sel(P, is_prompt, b, g, 1, kpos)[lane]; const int n = sl * 64 + kk;
                os[0] += sb[0][n] * v; os[1] += sb[1][n] * v; os[2] += sb[2][n] * v; os[3] += sb[3][n] * v; } }
#pragma unroll
        for (int r = 0; r < 4; ++r) out[r] += gate[r][1] * (sm[r] > 0.f ? os[r] / sm[r] : 0.f);
        __syncthreads();
    }
    {
        float mx[4] = {NEGM, NEGM, NEGM, NEGM};
        for (int i = lane; i < 512; i += 64) { const int kpos = qpos - 511 + i; const bool valid = kpos >= 0 && (is_prompt || kpos >= PAST + DS - 516);
            float s[4] = {0.f, 0.f, 0.f, 0.f};
            if (valid) { const float* k = kv_ptr_win(P, is_prompt, b, g, 0, kpos);
                for (int d = 0; d < 64; ++d) { const float kv = k[d]; s[0] += qs[0][d] * kv; s[1] += qs[1][d] * kv; s[2] += qs[2][d] * kv; s[3] += qs[3][d] * kv; } }
            const int bk = rel_bucket(qpos - kpos);
#pragma unroll
            for (int r = 0; r < 4; ++r) { const float v = valid ? s[r] + P.table[bk * 16 + g * 4 + r] : NEGM; sb[r][i] = v; mx[r] = fmaxf(mx[r], v); } }
        float sm[4];
#pragma unroll
        for (int r = 0; r < 4; ++r) { mx[r] = wave_max(mx[r]); float a = 0.f;
            for (int n = lane; n < 512; n += 64) { const float v = sb[r][n]; const float p = v > -1e38f ? expf(v - mx[r]) : 0.f; sb[r][n] = p; a += p; }
            sm[r] = wave_sum(a); }
        __syncthreads();
        float ow[4] = {0.f, 0.f, 0.f, 0.f};
        for (int i = 0; i < 512; ++i) { const int kpos = qpos - 511 + i; if (kpos < 0 || (!is_prompt && kpos < PAST + DS - 516)) continue;
            const float v = kv_ptr_win(P, is_prompt, b, g, 1, kpos)[lane];
            ow[0] += sb[0][i] * v; ow[1] += sb[1][i] * v; ow[2] += sb[2][i] * v; ow[3] += sb[3][i] * v; }
#pragma unroll
        for (int r = 0; r < 4; ++r) out[r] += gate[r][2] * (sm[r] > 0.f ? ow[r] / sm[r] : 0.f);
    }
#pragma unroll
    for (int r = 0; r < 4; ++r) P.O[(size_t)row * D + (g * 4 + r) * 64 + lane] = out[r];
}

constexpr size_t W_SC = 0, W_MOD = W_SC + (size_t)NC * D, W_X = W_MOD + (size_t)8 * NC * 3072, W_H = W_X + (size_t)R * D, W_T1 = W_H + (size_t)R * D,
                 W_T2 = W_T1 + (size_t)R * DFF, W_U = W_T2 + (size_t)R * DFF, W_Y = W_U + (size_t)R * D, W_CC = W_Y + (size_t)R * D, W_ACT = W_CC + (size_t)R * D,
                 W_ROWS = W_ACT + (size_t)R * DFF, W_QG = W_ROWS + (size_t)R * KVW, W_O = W_QG + (size_t)R * QGW, W_CMPP = W_O + (size_t)R * D,
                 W_CMPS = W_CMPP + (size_t)2 * BATCH * 128 * 256, W_END = W_CMPS + (size_t)2 * DB * 256 * 256;

static inline void gemm(hipStream_t st, const float* A, int lda, const float* W, int ldw, const float* bias, float* C, int ldc, int M, int N, int K) {
    dim3 grid((N + 63) / 64, (M + 63) / 64); k_gemm<<<grid, 256, 0, st>>>(A, lda, W, ldw, bias, C, ldc, M, N, K);
}
static inline unsigned cdiv(size_t a, size_t b) { return (unsigned)((a + b - 1) / b); }

typedef void (*Hook)(int id, void* ctx);
static void naive_forward(void* const* d_in, float* out, float* ws, hipStream_t st, Hook hook = nullptr, void* hctx = nullptr) {
#define HOOK(id) do { if (hook) hook((id), hctx); } while (0)
    const float* x_prompt = (const float*)d_in[0]; const float* x_sample = (const float*)d_in[1]; const float* c_prompt = (const float*)d_in[2]; const float* c_sample = (const float*)d_in[3];
    const float* cache_cmp = (const float*)d_in[4]; const float* cache_sel = (const float*)d_in[5]; const float* cache_win = (const float*)d_in[6]; const float* state_conv = (const float*)d_in[7];
    const int* pt = (const int*)d_in[8]; const float* w_ada = (const float*)d_in[9]; const float* b_ada = (const float*)d_in[10]; const float* norm_g = (const float*)d_in[11];
    const float* w_pw1 = (const float*)d_in[12]; const float* b_pw1 = (const float*)d_in[13]; const float* w_dw = (const float*)d_in[14]; const float* b_dw = (const float*)d_in[15];
    const float* ln_g = (const float*)d_in[16]; const float* ln_b = (const float*)d_in[17]; const float* w_pw2 = (const float*)d_in[18]; const float* b_pw2 = (const float*)d_in[19];
    const float* g_kv = (const float*)d_in[20]; const float* w_kv = (const float*)d_in[21]; const float* w_phi1 = (const float*)d_in[22]; const float* b_phi1 = (const float*)d_in[23];
    const float* w_phi2 = (const float*)d_in[24]; const float* b_phi2 = (const float*)d_in[25]; const float* pe_cmp = (const float*)d_in[26]; const float* w_qg = (const float*)d_in[27];
    const float* w_o = (const float*)d_in[28]; const float* rel_table = (const float*)d_in[29]; const float* w_gate = (const float*)d_in[30]; const float* w_up = (const float*)d_in[31];
    const float* w_down = (const float*)d_in[32]; const float* final_g = (const float*)d_in[33];
    float *SC = ws + W_SC, *MOD = ws + W_MOD, *X = ws + W_X, *H = ws + W_H, *T1 = ws + W_T1, *T2 = ws + W_T2, *U = ws + W_U, *Y = ws + W_Y, *CC = ws + W_CC, *ACT = ws + W_ACT,
          *ROWS = ws + W_ROWS, *QG = ws + W_QG, *O = ws + W_O, *CMPP = ws + W_CMPP, *CMPS = ws + W_CMPS;
    const size_t RD = (size_t)R * D;
    hipMemcpyAsync(X, x_prompt, (size_t)MP * D * 4, hipMemcpyDeviceToDevice, st);
    hipMemcpyAsync(X + (size_t)MP * D, x_sample, (size_t)MS * D * 4, hipMemcpyDeviceToDevice, st);
    k_silu_c<<<cdiv(NC * D, 256), 256, 0, st>>>(c_prompt, c_sample, SC);
    for (int ls = 0; ls < 8; ++ls) gemm(st, SC, D, w_ada + (size_t)ls * D * 3072, 3072, b_ada + (size_t)ls * 3072, MOD + (size_t)ls * NC * 3072, 3072, NC, 3072, D);
    HOOK(1);
    for (int l = 0; l < 4; ++l) {
        const float* mod0 = MOD + (size_t)(l * 2 + 0) * NC * 3072; const float* mod1 = MOD + (size_t)(l * 2 + 1) * NC * 3072;
        if (l == 2) {
            k_modnorm<<<R, 256, 0, st>>>(X, g_kv, nullptr, H);
            gemm(st, H, D, w_kv, KVW, nullptr, ROWS, KVW, R, KVW, D);
            k_kv_out<<<cdiv((size_t)MP * 512, 256), 256, 0, st>>>(ROWS, cache_win, out);
            k_compress<<<BATCH * 128 * 2, 256, 0, st>>>(1, ROWS, cache_cmp, pt, w_phi1, b_phi1, w_phi2, b_phi2, pe_cmp, CMPP);
            k_compress<<<DB * 256 * 2, 256, 0, st>>>(0, ROWS, cache_cmp, pt, w_phi1, b_phi1, w_phi2, b_phi2, pe_cmp, CMPS);
            HOOK(250);
        }
        k_modnorm<<<R, 256, 0, st>>>(X, norm_g + (size_t)(l * 2) * D, mod0, H);
        HOOK(100 * l + 1);
        if (l < 2) {
            gemm(st, H, D, w_pw1 + (size_t)l * D * 2048, 2048, b_pw1 + (size_t)l * 2048, T1, 2048, R, 2048, D);
            k_glu<<<cdiv(RD, 256), 256, 0, st>>>(T1, U);
            HOOK(100 * l + 2);
            k_conv<<<cdiv(RD, 256), 256, 0, st>>>(U, state_conv + (size_t)l * DB * 30 * D, w_dw + (size_t)l * CONVW * D, b_dw + (size_t)l * D, Y);
            k_conv_state_out<<<cdiv((size_t)(BATCH + DB) * 30 * D, 256), 256, 0, st>>>(U, state_conv + (size_t)l * DB * 30 * D, out + O_CONVP + (size_t)l * BATCH * 30 * D, out + O_CONVS + (size_t)l * DB * 30 * D);
            k_ln_silu<<<R, 256, 0, st>>>(Y, ln_g + (size_t)l * D, ln_b + (size_t)l * D, CC);
            HOOK(100 * l + 3);
            gemm(st, CC, D, w_pw2 + (size_t)l * D * D, D, b_pw2 + (size_t)l * D, T2, D, R, D, D);
        } else {
            const int lb = l - 2;
            gemm(st, H, D, w_qg + (size_t)lb * D * QGW, QGW, nullptr, QG, QGW, R, QGW, D);
            HOOK(100 * l + 2);
            AttnP P{QG, ROWS, CMPP, cache_sel, cache_win, pt, rel_table, O};
            k_attn<<<BATCH * SEQ * 4, 64, 0, st>>>(P, 1);
            P.CMP = CMPS;
            k_attn<<<DB * DS * 4, 64, 0, st>>>(P, 0);
            HOOK(100 * l + 3);
            gemm(st, O, D, w_o + (size_t)lb * D * D, D, nullptr, T2, D, R, D, D);
        }
        k_resid<<<cdiv(RD, 256), 256, 0, st>>>(X, T2, D, mod0);
        HOOK(100 * l + 4);
        k_modnorm<<<R, 256, 0, st>>>(X, norm_g + (size_t)(l * 2 + 1) * D, mod1, H);
        HOOK(100 * l + 5);
        gemm(st, H, D, w_gate + (size_t)l * D * DFF, DFF, nullptr, T1, DFF, R, DFF, D);
        gemm(st, H, D, w_up + (size_t)l * D * DFF, DFF, nullptr, T2, DFF, R, DFF, D);
        k_swiglu<<<cdiv((size_t)R * DFF, 256), 256, 0, st>>>(T1, T2, ACT);
        HOOK(100 * l + 6);
        gemm(st, ACT, DFF, w_down + (size_t)l * DFF * D, D, nullptr, T1, D, R, D, DFF);
        k_resid<<<cdiv(RD, 256), 256, 0, st>>>(X, T1, D, mod1);
        HOOK(100 * l + 7);
    }
    k_modnorm<<<R, 256, 0, st>>>(X, final_g, nullptr, H);
    hipMemcpyAsync(out + O_YP, H, (size_t)MP * D * 4, hipMemcpyDeviceToDevice, st);
    hipMemcpyAsync(out + O_YS, H + (size_t)MP * D, (size_t)MS * D * 4, hipMemcpyDeviceToDevice, st);
    HOOK(900);
#undef HOOK
}
}
namespace pg8 {
__device__ __forceinline__ int opaque_tid() { int t; asm volatile("v_mov_b32 %0, %1" : "=v"(t) : "v"(threadIdx.x)); return t; }
#define PG8_LAS __attribute__((address_space(3)))
typedef unsigned short bf16_t;
typedef short bf16x8 __attribute__((ext_vector_type(8)));
typedef float f32x4 __attribute__((ext_vector_type(4)));
typedef unsigned u32x4 __attribute__((ext_vector_type(4)));
constexpr int BM = 256, BK = 64, HALF = 128, HTB = HALF * BK * 2  , STAGE_BYTES = 8 * HTB, NXCD = 8, WGM = 8;

__host__ __device__ __forceinline__ int lds_byte(int r, int c) { const int st = (r >> 4) * 2 + (c >> 5), rr = r & 15, cc = c & 31, ob = rr * 64 + cc * 2; return st * 1024 + (ob ^ (((ob >> 9) & 1) << 5)); }
__host__ __device__ __forceinline__ void stage_rc(int b, int& R, int& C) { const int st = b / 1024, sb = b % 1024, swz = sb ^ (((sb >> 9) & 1) << 5); R = (st >> 1) * 16 + swz / 64; C = (st & 1) * 32 + (swz % 64) / 2; }
__host__ __device__ __forceinline__ int perm32(int rho) { const int n = rho >> 4, i = rho & 15; return 8 * (i >> 2) + 4 * n + (i & 3); }

struct Unit { int pm, pn; };
struct Gemm { const bf16_t* A; const bf16_t* Bt; int M, N, K; };

struct StaticOrder {
    int nM, nN, nwg, G, c;
    __host__ __device__ void init(int M, int N, int G_, int c_) { nM = M / BM; nN = N / BM; nwg = nM * nN; G = G_; c = c_; }
    __host__ __device__ bool next(int i, Unit& u) const {
        const long L = (long)i * G + c; if (L >= nwg) return false;
        int wgid = (int)L; { const int q = nwg / NXCD, r = nwg % NXCD, xcd = wgid % NXCD, off = wgid / NXCD; wgid = (xcd < r ? xcd * (q + 1) : r * (q + 1) + (xcd - r) * q) + off; }
        const int nig = WGM * nN, gid = wgid / nig, fm = gid * WGM, gsz = (nM - fm) < WGM ? (nM - fm) : WGM;
        u.pm = fm + ((wgid % nig) % gsz); u.pn = (wgid % nig) / gsz; return true;
    }
    __device__ __forceinline__ void a_ready(const Unit&) const {}
    __device__ __forceinline__ void done(const Unit&) const {}
};

template <class Epi, class Sched, bool ALIGN_EPI = false, bool SP2 = false>
__device__ __forceinline__ void gemm_phase(PG8_LAS unsigned char* lds, const Gemm g, const Sched& S, const Epi& E) {
    const int tid = opaque_tid(), wid = __builtin_amdgcn_readfirstlane(tid >> 6), lane = tid & 63, wr = wid >> 2, wc = wid & 3, fr = lane & 15, fq = lane >> 4;
    const int K = g.K, nt = K / BK;
    unsigned voffA[2], voffB[2];
#pragma unroll
    for (int i = 0; i < 2; ++i) { int R, C; stage_rc(tid * 16 + i * 8192, R, C); const int Rb = Epi::PERM ? ((R & ~31) + perm32(R & 31)) : R;
        voffA[i] = (unsigned)(R * K + C) * 2u; voffB[i] = (unsigned)(Rb * K + C) * 2u; }
    const size_t kstep = (size_t)(BK * 2);
    const size_t hstep = (size_t)HALF * K * 2;
    const size_t tstep = 2 * hstep;
    const unsigned ldsw = (unsigned)wid * 1024u;
    const int aoff = lds_byte(wr * 64 + fr, fq * 8), boff = lds_byte(wc * 32 + fr, fq * 8);
#define PG8_SA(b, h) (((b) * 2 + (h)) * HTB)
#define PG8_SB(b, h) ((4 + (b) * 2 + (h)) * HTB)
#define PG8_STAGE(bufoff, gbase, voff) do { _Pragma("unroll") for (int _i = 0; _i < 2; ++_i) \
        __builtin_amdgcn_global_load_lds((const unsigned*)((const char*)(gbase) + (voff)[_i]), (PG8_LAS unsigned*)(lds + (bufoff) + ldsw + _i * 8192), 16, 0, 0); } while (0)
#define PG8_LDA(dst, b, h) do { _Pragma("unroll") for (int m = 0; m < 4; ++m) _Pragma("unroll") for (int k = 0; k < 2; ++k) dst[m][k] = *(const PG8_LAS bf16x8*)(lds + PG8_SA(b, h) + aoff + m * 2048 + k * 1024); } while (0)
#define PG8_LDB(dst, b, h) do { _Pragma("unroll") for (int n = 0; n < 2; ++n) _Pragma("unroll") for (int k = 0; k < 2; ++k) dst[n][k] = *(const PG8_LAS bf16x8*)(lds + PG8_SB(b, h) + boff + n * 2048 + k * 1024); } while (0)
#define PG8_MMA(ai, bj, At, Bt) do { __builtin_amdgcn_s_setprio(1); _Pragma("unroll") for (int m = 0; m < 4; ++m) _Pragma("unroll") for (int n = 0; n < 2; ++n) _Pragma("unroll") for (int k = 0; k < 2; ++k) \
        acc[ai][bj][m][n] = __builtin_amdgcn_mfma_f32_16x16x32_bf16(Bt[n][k], At[m][k], acc[ai][bj][m][n], 0, 0, 0); __builtin_amdgcn_s_setprio(0); } while (0)
#define PG8_WAIT_V(n) asm volatile("s_waitcnt vmcnt(" #n ")" ::: "memory")
#define PG8_WAIT_L(n) asm volatile("s_waitcnt lgkmcnt(" #n ")" ::: "memory")
#define PG8_BAR __builtin_amdgcn_s_barrier()
#define PG8_SCHED __builtin_amdgcn_sched_barrier(0)
    Unit cur, nxt; int ui = 0;
    if (!S.next(0, cur)) return;
    f32x4 acc[2][2][4][2];
#pragma unroll
    for (int a = 0; a < 2; ++a)
#pragma unroll
        for (int b = 0; b < 2; ++b)
#pragma unroll
            for (int m = 0; m < 4; ++m)
#pragma unroll
                for (int n = 0; n < 2; ++n) acc[a][b][m][n] = (f32x4){0.f, 0.f, 0.f, 0.f};
    bf16x8 At[4][2], B0[2][2], B1[2][2];
    const char* cA = (const char*)g.A + (size_t)cur.pm * tstep; const char* cB = (const char*)g.Bt + (size_t)cur.pn * tstep;
    S.a_ready(cur);
    if constexpr (SP2) {
        PG8_STAGE(PG8_SB(0, 0), cB, voffB); PG8_STAGE(PG8_SB(0, 1), cB + hstep, voffB); PG8_STAGE(PG8_SA(0, 0), cA, voffA); PG8_STAGE(PG8_SA(0, 1), cA + hstep, voffA);
        if (wr == 1) PG8_BAR;
        PG8_WAIT_V(2); PG8_BAR;
        PG8_STAGE(PG8_SB(1, 0), cB + kstep, voffB); PG8_STAGE(PG8_SA(1, 0), cA + kstep, voffA); PG8_STAGE(PG8_SB(1, 1), cB + hstep + kstep, voffB);
        PG8_WAIT_V(6); PG8_BAR;
    } else {
        PG8_STAGE(PG8_SB(0, 0), cB, voffB); PG8_STAGE(PG8_SA(0, 0), cA, voffA); PG8_STAGE(PG8_SB(0, 1), cB + hstep, voffB); PG8_STAGE(PG8_SA(0, 1), cA + hstep, voffA);
        if (wr == 1) PG8_BAR;
        PG8_WAIT_V(4); PG8_BAR;
        PG8_STAGE(PG8_SB(1, 0), cB + kstep, voffB); PG8_STAGE(PG8_SA(1, 0), cA + kstep, voffA); PG8_STAGE(PG8_SB(1, 1), cB + hstep + kstep, voffB);
        PG8_WAIT_V(6); PG8_BAR;
    }
    for (;;) {
        const bool has_next = S.next(ui + 1, nxt);
        const char* nA = has_next ? (const char*)g.A + (size_t)nxt.pm * tstep : cA; const char* nB = has_next ? (const char*)g.Bt + (size_t)nxt.pn * tstep : cB;
        for (int t = 0; t < nt; t += 2) {
            const bool last = (t == nt - 2);
            const char* a1 = cA + (size_t)(t + 1) * kstep;
            const char* a2 = last ? nA : cA + (size_t)(t + 2) * kstep; const char* b2 = last ? nB : cB + (size_t)(t + 2) * kstep;
            const char* a3 = a2 + kstep; const char* b3 = b2 + kstep;
            if (last && has_next) S.a_ready(nxt);
            if constexpr (SP2) {
            PG8_LDB(B0, 0, 0); PG8_LDB(B1, 0, 1); PG8_SCHED; PG8_LDA(At, 0, 0); PG8_STAGE(PG8_SA(1, 1), a1 + hstep, voffA);
            PG8_WAIT_V(8); PG8_WAIT_L(0); PG8_BAR; PG8_MMA(0, 0, At, B0); PG8_MMA(0, 1, At, B1); PG8_BAR; PG8_SCHED;
            PG8_LDA(At, 0, 1); PG8_STAGE(PG8_SB(0, 0), b2, voffB); PG8_STAGE(PG8_SB(0, 1), b2 + hstep, voffB); PG8_STAGE(PG8_SA(0, 0), a2, voffA);
            PG8_WAIT_V(8); PG8_WAIT_L(0); PG8_BAR; PG8_MMA(1, 0, At, B0); PG8_MMA(1, 1, At, B1); PG8_BAR; PG8_SCHED;
            PG8_LDB(B0, 1, 0); PG8_LDB(B1, 1, 1); PG8_SCHED; PG8_LDA(At, 1, 0); PG8_STAGE(PG8_SA(0, 1), a2 + hstep, voffA);
            PG8_WAIT_V(8); PG8_WAIT_L(0); PG8_BAR; PG8_MMA(0, 0, At, B0); PG8_MMA(0, 1, At, B1); PG8_BAR; PG8_SCHED;
            PG8_LDA(At, 1, 1); PG8_STAGE(PG8_SB(1, 0), b3, voffB); PG8_STAGE(PG8_SB(1, 1), b3 + hstep, voffB); PG8_STAGE(PG8_SA(1, 0), a3, voffA);
            PG8_WAIT_V(8); PG8_WAIT_L(0); PG8_BAR; PG8_MMA(1, 0, At, B0); PG8_MMA(1, 1, At, B1); PG8_BAR; PG8_SCHED;
            } else {
            PG8_LDB(B0, 0, 0); PG8_SCHED; PG8_LDA(At, 0, 0); PG8_STAGE(PG8_SA(1, 1), a1 + hstep, voffA);
            PG8_WAIT_L(8); PG8_BAR; PG8_WAIT_L(0); PG8_MMA(0, 0, At, B0); PG8_BAR; PG8_SCHED;
            PG8_LDB(B1, 0, 1); PG8_STAGE(PG8_SB(0, 0), b2, voffB);
            PG8_BAR; PG8_WAIT_L(0); PG8_MMA(0, 1, At, B1); PG8_BAR;
            PG8_LDA(At, 0, 1); PG8_STAGE(PG8_SA(0, 0), a2, voffA);
            PG8_BAR; PG8_WAIT_L(0); PG8_MMA(1, 0, At, B0); PG8_BAR; PG8_SCHED;
            PG8_STAGE(PG8_SB(0, 1), b2 + hstep, voffB);
            PG8_WAIT_V(6); PG8_BAR; PG8_MMA(1, 1, At, B1); PG8_BAR;
            PG8_LDB(B0, 1, 0); PG8_SCHED; PG8_LDA(At, 1, 0); PG8_STAGE(PG8_SA(0, 1), a2 + hstep, voffA);
            PG8_WAIT_L(8); PG8_BAR; PG8_WAIT_L(0); PG8_MMA(0, 0, At, B0); PG8_BAR; PG8_SCHED;
            PG8_LDB(B1, 1, 1); PG8_STAGE(PG8_SB(1, 0), b3, voffB);
            PG8_BAR; PG8_WAIT_L(0); PG8_MMA(0, 1, At, B1); PG8_BAR;
            PG8_LDA(At, 1, 1); PG8_STAGE(PG8_SA(1, 0), a3, voffA);
            PG8_BAR; PG8_WAIT_L(0); PG8_MMA(1, 0, At, B0); PG8_BAR; PG8_SCHED;
            PG8_STAGE(PG8_SB(1, 1), b3 + hstep, voffB);
            PG8_WAIT_V(6); PG8_BAR; PG8_MMA(1, 1, At, B1); PG8_BAR;
            }
        }
        if constexpr (ALIGN_EPI) { if (wr == 0) PG8_BAR; }
        if constexpr (!Epi::AFTER_DRAIN) { E(acc, cur, wr, wc, fr, fq); S.done(cur); }
        if (!has_next) break;
#pragma unroll
        for (int a = 0; a < 2; ++a)
#pragma unroll
            for (int b = 0; b < 2; ++b)
#pragma unroll
                for (int m = 0; m < 4; ++m)
#pragma unroll
                    for (int n = 0; n < 2; ++n) acc[a][b][m][n] = (f32x4){0.f, 0.f, 0.f, 0.f};
        cur = nxt; cA = nA; cB = nB; ++ui;
        if constexpr (ALIGN_EPI) { if (wr == 1) PG8_BAR; }
    }
    PG8_WAIT_V(0);
    if constexpr (!ALIGN_EPI) { if (wr == 0) PG8_BAR; }
    PG8_BAR;
    if constexpr (Epi::AFTER_DRAIN) { E.fused(acc, cur, wr, wc, fr, fq, lds, wid, lane); S.done(cur); }
#undef PG8_SA
#undef PG8_SB
#undef PG8_STAGE
#undef PG8_LDA
#undef PG8_LDB
#undef PG8_MMA
#undef PG8_WAIT_V
#undef PG8_WAIT_L
#undef PG8_BAR
#undef PG8_SCHED
}
}
#define XB_TMO      128
#define XB_XCNT(j)  (256  + 64 * (j))
#define XB_XSUB(j)  (1280 + 64 * (j))
#define XB_XGEN(j)  (2304 + 64 * (j))
#define XB_TOP      3328
#define XB_TOPGEN   3392
#define XCD_BAR_WORDS 3456
#define XB_SPIN_CAP (1u << 18)
#define LAS __attribute__((address_space(3)))

__device__ __forceinline__ unsigned xb_ld(unsigned* p)              { return __hip_atomic_load(p, __ATOMIC_RELAXED, __HIP_MEMORY_SCOPE_AGENT); }
__device__ __forceinline__ unsigned xb_add(unsigned* p, unsigned v) { return __hip_atomic_fetch_add(p, v, __ATOMIC_RELAXED, __HIP_MEMORY_SCOPE_AGENT); }
__device__ __forceinline__ unsigned xb_xcc_id() { return (unsigned)__builtin_amdgcn_s_getreg((3 << 11) | 20) & 0xFu; }
#define XB_SPIN(cond, bar) do { unsigned _sp = 0; while (cond) { __builtin_amdgcn_s_sleep(1); \
    if ((++_sp & 255u) == 0u) { if (xb_ld(&(bar)[XB_TMO])) break; if (_sp > XB_SPIN_CAP) { atomicAdd(&(bar)[XB_TMO], 1u); break; } } } } while (0)

struct XcdBarrier {
    unsigned* bar; unsigned x;
    volatile LAS unsigned* st;
};

__device__ __forceinline__ XcdBarrier xcd_barrier_post(unsigned* bar, volatile LAS unsigned* st) {
    XcdBarrier b; b.bar = bar; b.x = xb_xcc_id(); b.st = st;
    if (threadIdx.x == 0) (void)xb_add(&bar[XB_XCNT(b.x)], 1u);
    return b;
}
__device__ __forceinline__ void xcd_barrier_complete(unsigned* bar, unsigned x, unsigned& nloc, unsigned& nx) {
    const unsigned G = gridDim.x * gridDim.y * gridDim.z;
    unsigned sum, cnt, mine, sp = 0u;
    for (;;) {
        sum = 0u; cnt = 0u; mine = 0u;
#pragma unroll
        for (unsigned j = 0; j < 16; ++j) { const unsigned c = xb_ld(&bar[XB_XCNT(j)]); sum += c; cnt += (c > 0u) ? 1u : 0u; mine = (j == x) ? c : mine; }
        if (sum == G) break;
        __builtin_amdgcn_s_sleep(1);
        if ((++sp & 255u) == 0u) { if (xb_ld(&bar[XB_TMO])) break; if (sp > XB_SPIN_CAP) { atomicAdd(&bar[XB_TMO], 1u); break; } }
    }
    nloc = mine > 0u ? mine : 1u; nx = cnt > 0u ? cnt : 1u;
}

__device__ __forceinline__ void xcd_barrier(const XcdBarrier& b) {
    asm volatile("s_waitcnt vmcnt(0)" ::: "memory");
    __syncthreads();
    if (threadIdx.x == 0) {
        unsigned* bar = b.bar;
        __builtin_amdgcn_s_waitcnt(0);
        unsigned nloc = b.st[0], nx = b.st[1];
        if (nloc == 0u) { xcd_barrier_complete(bar, b.x, nloc, nx); b.st[0] = nloc; b.st[1] = nx; }
        const unsigned old = xb_add(&bar[XB_XSUB(b.x)], 1u);
        const unsigned gen = old / nloc;
        if (old + 1u == (gen + 1u) * nloc) {
            __builtin_amdgcn_fence(__ATOMIC_RELEASE, "agent");
            asm volatile("s_waitcnt vmcnt(0)" ::: "memory");
            const unsigned og = xb_add(&bar[XB_TOP], 1u);
            const unsigned tg = og / nx;
            if (og + 1u == (tg + 1u) * nx) xb_add(&bar[XB_TOPGEN], 1u);
            else XB_SPIN(xb_ld(&bar[XB_TOPGEN]) == tg, bar);
            __builtin_amdgcn_fence(__ATOMIC_ACQUIRE, "agent");
            xb_add(&bar[XB_XGEN(b.x)], 1u);
            asm volatile("s_waitcnt vmcnt(0)" ::: "memory");
        } else {
            XB_SPIN(xb_ld(&bar[XB_XGEN(b.x)]) == gen, bar);
            __builtin_amdgcn_fence(__ATOMIC_ACQUIRE, "agent");
            asm volatile("s_waitcnt vmcnt(0)" ::: "memory");
        }
    }
    __syncthreads();
}

namespace fk {
using namespace nv;
typedef unsigned short bf16;
typedef float f32x4 __attribute__((ext_vector_type(4)));
typedef short bf16x8 __attribute__((ext_vector_type(8)));
typedef unsigned u32x2 __attribute__((ext_vector_type(2)));
typedef unsigned u32x4 __attribute__((ext_vector_type(4)));
#define FLAS __attribute__((address_space(3)))
constexpr float LOG2E = 1.4426950408889634f;
constexpr int NTHR = 512, NWAVE = 8;
constexpr int LDS_BYTES = 147456;
constexpr int LDS_MISC = 131072 + 8192;

__device__ __forceinline__ unsigned f2bf(float f) { unsigned u = __builtin_bit_cast(unsigned, f); return (u + 0x7fffu + ((u >> 16) & 1u)) >> 16; }
typedef __bf16 hbf16x2 __attribute__((ext_vector_type(2)));
typedef float f32x2 __attribute__((ext_vector_type(2)));
__device__ __forceinline__ unsigned pk2(float lo, float hi) { const f32x2 v = {lo, hi}; return __builtin_bit_cast(unsigned, __builtin_convertvector(v, hbf16x2)); }
__device__ __forceinline__ float bf2f(unsigned short b) { return __builtin_bit_cast(float, (unsigned)b << 16); }
__device__ __forceinline__ float fsigm(float x) { return __builtin_amdgcn_rcpf(1.f + __expf(-x)); }
__device__ __forceinline__ float fsilu(float x) { return x * __builtin_amdgcn_rcpf(1.f + __expf(-x)); }
__device__ __forceinline__ float xmax32(float v) { const unsigned u = __builtin_bit_cast(unsigned, v); auto rr = __builtin_amdgcn_permlane32_swap(u, u, false, false); return fmaxf(__builtin_bit_cast(float, (unsigned)rr[0]), __builtin_bit_cast(float, (unsigned)rr[1])); }
__device__ __forceinline__ float xsum32(float v) { const unsigned u = __builtin_bit_cast(unsigned, v); auto rr = __builtin_amdgcn_permlane32_swap(u, u, false, false); return __builtin_bit_cast(float, (unsigned)rr[0]) + __builtin_bit_cast(float, (unsigned)rr[1]); }
__device__ __forceinline__ float wsum(float v) {
#pragma unroll
    for (int o = 1; o < 64; o <<= 1) v += __shfl_xor(v, o);
    return v; }
__device__ __forceinline__ int cidx_row(int row) { return row < MP ? (row >> 12) : 4 + ((row - MP) >> 2); }

constexpr size_t al(size_t x) { return (x + 4095) & ~(size_t)4095; }
constexpr size_t F_CTL = 0, F_MOD = 1u << 20, F_WPW1 = F_MOD + al((size_t)8 * NC * 3072 * 4), F_WPW2 = F_WPW1 + (size_t)2 * 2048 * 1024 * 2,
    F_WGU = F_WPW2 + (size_t)2 * 1024 * 1024 * 2, F_WDN = F_WGU + (size_t)4 * 5632 * 1024 * 2, F_WKV = F_WDN + (size_t)4 * 1024 * 2816 * 2,
    F_WQ = F_WKV + (size_t)1536 * 1024 * 2, F_WG = F_WQ + (size_t)2 * 1024 * 1024 * 2, F_WO = F_WG + (size_t)2 * 64 * 1024 * 2, F_WPHI1 = F_WO + (size_t)2 * 1024 * 1024 * 2,
    F_WPHI2 = F_WPHI1 + (size_t)2 * 128 * 2048 * 2, F_BPHI = F_WPHI2 + (size_t)2 * 64 * 128 * 2, F_X = F_BPHI + 32768, F_H = F_X + al((size_t)R * D * 4),
    F_HKV = F_H + al((size_t)R * D * 2), F_U = F_HKV + al((size_t)R * D * 2), F_US = F_U + al((size_t)R * D * 2), F_C = F_US + (size_t)MS * D * 4, F_ACT = F_C + al((size_t)R * D * 2),
    F_RB = F_ACT + al((size_t)R * DFF * 2), F_Q = F_RB + al((size_t)R * KVW * 2), F_GT = F_Q + al((size_t)R * D * 2), F_O = F_GT + al((size_t)R * 64 * 4),
    F_VT = F_O + al((size_t)R * D * 2), F_CMPK = F_VT + (size_t)2 * 16 * 64 * 4096 * 2, F_CMPVT = F_CMPK + (size_t)16 * 128 * 64 * 2, F_CMPS = F_CMPVT + (size_t)16 * 128 * 64 * 2,
    F_PART = F_CMPS + (size_t)2 * DB * 256 * 256 * 4, F_QPART = F_PART + (size_t)8 * MS * D * 4, F_STATS = F_QPART + (size_t)8 * MS * D * 4, F_END = F_STATS + (size_t)8 * 64 * 4 * 256 * 4;
constexpr size_t CTL_BYTES = 1u << 20;

struct Args { const void* in[34]; float* out; unsigned char* fb; int lo, hi; };

typedef const __attribute__((address_space(4))) Args CArgs;
struct Ctx {
    FLAS unsigned char* lds; int tid, lane, wave, G, wg; int gw, ngw;
};
#define IN_F(i) ((const float*)A.in[i])
__device__ __forceinline__ Ctx refreshed(const Ctx& C0) { Ctx C = C0; int t; asm volatile("v_mov_b32 %0, %1" : "=v"(t) : "v"(threadIdx.x)); C.tid = t; C.lane = t & 63;
    int wg_ = C0.wg, G_ = C0.G, wv_ = C0.wave; asm volatile("" : "+s"(wg_), "+s"(G_), "+s"(wv_)); C.wg = wg_; C.G = G_; C.wave = wv_; C.gw = wg_ * NWAVE + wv_; C.ngw = G_ * NWAVE; return C; }
enum TrMode { TR_PLAIN = 0, TR_PW1 = 1, TR_GATE = 2, TR_UP = 3, TR_QG = 4 };
__device__ __forceinline__ void tr_item(const float* __restrict__ W, int K, int N, bf16* __restrict__ WT, bf16* __restrict__ WT2, int mode, FLAS float* scr, int item, int lane) {
    const int nblk = (N + 63) / 64, kb = item / nblk, nb = item % nblk, k0 = 64 * kb, n0 = 64 * nb;
    const int c4 = lane & 15, rq = lane >> 4; const bool okc = n0 + 4 * c4 < N;
    f32x4 v[16];
#pragma unroll
    for (int i = 0; i < 16; ++i) { const int kk = 4 * i + rq; v[i] = okc ? *(const f32x4*)(W + (size_t)(k0 + kk) * N + n0 + 4 * c4) : (f32x4){0.f, 0.f, 0.f, 0.f}; }
#pragma unroll
    for (int i = 0; i < 16; ++i) { const int kk = 4 * i + rq; *(FLAS f32x4*)(scr + kk * 68 + 4 * c4) = v[i]; }
    asm volatile("s_waitcnt lgkmcnt(0)" ::: "memory");
    const int c = lane & 7;
#pragma unroll
    for (int j = 0; j < 8; ++j) { const int nl = (lane >> 3) + 8 * j; const int n = n0 + nl; const FLAS float* sp = scr + (8 * c) * 68 + nl;
        u32x4 o; o.x = pk2(sp[0 * 68], sp[1 * 68]); o.y = pk2(sp[2 * 68], sp[3 * 68]); o.z = pk2(sp[4 * 68], sp[5 * 68]); o.w = pk2(sp[6 * 68], sp[7 * 68]);
        bf16* dst = WT; int nr = n;
        if (mode == TR_PW1) { const int f = n & 1023, isg = n >> 10; nr = 256 * (f >> 7) + 128 * isg + (f & 127); }
        else if (mode == TR_GATE) nr = 256 * (n >> 7) + (n & 127);
        else if (mode == TR_UP) nr = 256 * (n >> 7) + 128 + (n & 127);
        else if (mode == TR_QG) { if (n >= 1024) { dst = WT2; nr = n - 1024; } }
        if (mode != TR_QG || n < 1088) *(u32x4*)(dst + (size_t)nr * K + k0 + 8 * c) = o; }
    asm volatile("s_waitcnt lgkmcnt(0)" ::: "memory");
}
struct TrJob { const float* W; bf16* WT; bf16* WT2; int K, N, mode, nitems; };

__device__ __forceinline__ void mod_unit(const Ctx& C, CArgs& A, int unit) {
    const int ls = unit / 24, cg = unit % 24, tid = C.tid, w = C.wave, lane = C.lane;
    FLAS float* SCs = (FLAS float*)C.lds;
    const float* W = IN_F(9) + (size_t)ls * D * 3072;
    float acc0[36], acc1[36];
#pragma unroll
    for (int c = 0; c < 36; ++c) { acc0[c] = 0.f; acc1[c] = 0.f; }
    for (int half = 0; half < 2; ++half) {
        __syncthreads();
        { const int kg = 128 * (tid >> 6) + 64 * half + (tid & 63);
#pragma unroll 4
          for (int c = 0; c < 36; ++c) { const float v = c < 4 ? IN_F(2)[c * D + kg] : IN_F(3)[(c - 4) * D + kg]; SCs[tid * 36 + c] = fsilu(v); } }
        __syncthreads();
        const float* wp = W + (size_t)(128 * w + 64 * half) * 3072 + cg * 128 + lane;
        const FLAS f32x4* sp = (const FLAS f32x4*)(SCs + (w * 64) * 36);
#pragma unroll 2
        for (int kk = 0; kk < 64; ++kk) { const float w0 = wp[(size_t)kk * 3072], w1 = wp[(size_t)kk * 3072 + 64];
#pragma unroll
            for (int q = 0; q < 9; ++q) { const f32x4 sv = sp[kk * 9 + q];
#pragma unroll
                for (int j = 0; j < 4; ++j) { acc0[4 * q + j] += sv[j] * w0; acc1[4 * q + j] += sv[j] * w1; } } }
    }
    FLAS float* part = (FLAS float*)C.lds;
#pragma unroll
    for (int ps = 0; ps < 3; ++ps) {
        __syncthreads();
#pragma unroll
        for (int cc = 0; cc < 12; ++cc) { part[(w * 128 + lane) * 13 + cc] = acc0[12 * ps + cc]; part[(w * 128 + lane + 64) * 13 + cc] = acc1[12 * ps + cc]; }
        __syncthreads();
        for (int o = tid; o < 12 * 128; o += NTHR) { const int cc = o >> 7, nn = o & 127, c = 12 * ps + cc, ng = cg * 128 + nn; float v = IN_F(10)[ls * 3072 + ng];
#pragma unroll
            for (int ww = 0; ww < 8; ++ww) v += part[(ww * 128 + nn) * 13 + cc];
            if (ng >= 1024 && ng < 2048) v = IN_F(11)[ls * D + ng - 1024] * (1.f + v);
            ((float*)(A.fb + F_MOD))[((size_t)ls * NC + c) * 3072 + ng] = v; }
    }
    __syncthreads();
}

__device__ __forceinline__ void phase_prologue(const Ctx& C, CArgs& A) {
    unsigned char* fb = A.fb;
    {
        FLAS float* scr = (FLAS float*)(C.lds + C.wave * 17408);
        int it = C.gw;
#pragma unroll 1
        for (int job = 0; job < 25; ++job) {
            const float* Wp; bf16* WTp; bf16* WT2p = nullptr; int Kv, Nv, modev;
            if (job < 12) { const int l = job / 6, t = job % 6;
                if (t == 0) { Wp = IN_F(12) + (size_t)l * D * 2048; WTp = (bf16*)(fb + F_WPW1) + (size_t)l * 2048 * 1024; Kv = 1024; Nv = 2048; modev = TR_PW1; }
                else if (t == 1) { Wp = IN_F(18) + (size_t)l * D * D; WTp = (bf16*)(fb + F_WPW2) + (size_t)l * 1024 * 1024; Kv = 1024; Nv = 1024; modev = TR_PLAIN; }
                else if (t == 2) { Wp = IN_F(27) + (size_t)l * D * QGW; WTp = (bf16*)(fb + F_WQ) + (size_t)l * 1024 * 1024; WT2p = (bf16*)(fb + F_WG) + (size_t)l * 64 * 1024; Kv = 1024; Nv = QGW; modev = TR_QG; }
                else if (t == 3) { Wp = IN_F(28) + (size_t)l * D * D; WTp = (bf16*)(fb + F_WO) + (size_t)l * 1024 * 1024; Kv = 1024; Nv = 1024; modev = TR_PLAIN; }
                else if (t == 4) { Wp = IN_F(22) + (size_t)l * 2048 * PHI; WTp = (bf16*)(fb + F_WPHI1) + (size_t)l * 128 * 2048; Kv = 2048; Nv = 128; modev = TR_PLAIN; }
                else { Wp = IN_F(24) + (size_t)l * PHI * 64; WTp = (bf16*)(fb + F_WPHI2) + (size_t)l * 64 * 128; Kv = 128; Nv = 64; modev = TR_PLAIN; }
            } else if (job < 24) { const int l = (job - 12) / 3, t = (job - 12) % 3;
                if (t == 0) { Wp = IN_F(30) + (size_t)l * D * DFF; WTp = (bf16*)(fb + F_WGU) + (size_t)l * 5632 * 1024; Kv = 1024; Nv = DFF; modev = TR_GATE; }
                else if (t == 1) { Wp = IN_F(31) + (size_t)l * D * DFF; WTp = (bf16*)(fb + F_WGU) + (size_t)l * 5632 * 1024; Kv = 1024; Nv = DFF; modev = TR_UP; }
                else { Wp = IN_F(32) + (size_t)l * DFF * D; WTp = (bf16*)(fb + F_WDN) + (size_t)l * 1024 * 2816; Kv = 2816; Nv = 1024; modev = TR_PLAIN; }
            } else { Wp = IN_F(21); WTp = (bf16*)(fb + F_WKV); Kv = 1024; Nv = KVW; modev = TR_PLAIN; }
            const int nit = (Kv / 64) * ((Nv + 63) / 64);
            while (it < nit) { tr_item(Wp, Kv, Nv, WTp, WT2p, modev, scr, it, C.lane); it += C.ngw; }
            it -= nit;
        }
    }
    {
        const size_t gt = (size_t)C.wg * NTHR + C.tid, nt = (size_t)C.G * NTHR;
        const f32x4* src = (const f32x4*)IN_F(6); f32x4* dst = (f32x4*)(A.out + O_WINS);
        for (size_t i = gt; i < (size_t)DB * 508 * 128; i += nt) { const size_t b = i / (508 * 128), r = i % (508 * 128); dst[b * 512 * 128 + r] = src[b * 512 * 128 + 4 * 128 + r]; }
        const f32x4* s2 = (const f32x4*)IN_F(7); f32x4* d2 = (f32x4*)(A.out + O_CONVS);
        for (size_t i = gt; i < (size_t)2 * DB * 26 * 256; i += nt) { const size_t lb = i / (26 * 256), r = i % (26 * 256); d2[lb * 30 * 256 + r] = s2[lb * 30 * 256 + 4 * 256 + r]; }
    }
    { const int ck = C.G - 1 - C.wg;
      if (ck < 16 && C.tid < 256) { const int e = C.tid >> 7, h = C.tid & 127; float a = ck == 0 ? IN_F(23)[e * PHI + h] : 0.f; const float* w = IN_F(22) + ((size_t)e * 2048 + ck * 128) * PHI + h; const float* pe = IN_F(26) + e * 2048 + ck * 128;
#pragma unroll 16
          for (int f = 0; f < 128; ++f) a += pe[f] * w[(size_t)f * PHI];
          ((float*)(fb + F_BPHI))[ck * 256 + e * PHI + h] = a; } }
    __syncthreads();
    for (int u = C.wg; u < 192; u += C.G) mod_unit(C, A, u);
}

__device__ __forceinline__ f32x4 bfx4(unsigned lo, unsigned hi) { f32x4 r; r[0] = __builtin_bit_cast(float, lo << 16); r[1] = __builtin_bit_cast(float, lo & 0xffff0000u); r[2] = __builtin_bit_cast(float, hi << 16); r[3] = __builtin_bit_cast(float, hi & 0xffff0000u); return r; }
__device__ __forceinline__ void phase_norm(const Ctx& C, CArgs& A, int mode, int ls, bool from_input, int pend_ls, const float* pend_bias, bool pend_in, int first, int step, int limit) {
    unsigned char* fb = A.fb; const float* modf = (const float*)(fb + F_MOD) + (size_t)ls * NC * 3072; const bf16* XB = (const bf16*)(fb + F_X);
    if (from_input && C.wg == 0 && C.tid < 256) { const float* p = (const float*)(fb + F_BPHI); float a = 0.f;
#pragma unroll
        for (int ck = 0; ck < 16; ++ck) a += p[ck * 256 + C.tid];
        ((float*)(fb + F_BPHI))[4096 + C.tid] = a; }
    constexpr int NB = 4;
    for (int row0 = first; row0 < limit; row0 += NB * step) {
        f32x4 v[NB][4];
#pragma unroll
        for (int i = 0; i < NB; ++i) { const int rq = row0 + i * step; const int rr = rq < limit ? rq : row0;
            if (from_input || (pend_in && rr >= MP)) { const float* xr = rr < MP ? IN_F(0) + (size_t)rr * D : IN_F(1) + (size_t)(rr - MP) * D;
#pragma unroll
                for (int jj = 0; jj < 2; ++jj) { v[i][2 * jj] = *(const f32x4*)(xr + 8 * (C.lane + 64 * jj)); v[i][2 * jj + 1] = *(const f32x4*)(xr + 8 * (C.lane + 64 * jj) + 4); } }
            else { const bf16* xr = XB + (size_t)rr * D;
#pragma unroll
                for (int jj = 0; jj < 2; ++jj) { const u32x4 t = *(const u32x4*)(xr + 8 * (C.lane + 64 * jj)); v[i][2 * jj] = bfx4(t.x, t.y); v[i][2 * jj + 1] = bfx4(t.z, t.w); } } }
#pragma unroll
        for (int i = 0; i < NB; ++i) { const int row = row0 + i * step; if (row >= limit) break;
            if (pend_ls >= 0 && row >= MP) { const float* pp = (const float*)(fb + F_PART) + (size_t)(row - MP) * D; const float* gm = (const float*)(fb + F_MOD) + ((size_t)pend_ls * NC + cidx_row(row)) * 3072 + 2048;
#pragma unroll
                for (int j = 0; j < 4; ++j) { const int c0 = 8 * (C.lane + 64 * (j >> 1)) + 4 * (j & 1); f32x4 y = {0.f, 0.f, 0.f, 0.f}; if (pend_bias) y = *(const f32x4*)(pend_bias + c0);
#pragma unroll
                    for (int ksl = 0; ksl < 8; ++ksl) y += *(const f32x4*)(pp + (size_t)ksl * MS * D + c0);
                    v[i][j] += *(const f32x4*)(gm + c0) * y; }
#pragma unroll
                for (int jj = 0; jj < 2; ++jj) { u32x4 o; o.x = pk2(v[i][2 * jj][0], v[i][2 * jj][1]); o.y = pk2(v[i][2 * jj][2], v[i][2 * jj][3]); o.z = pk2(v[i][2 * jj + 1][0], v[i][2 * jj + 1][1]); o.w = pk2(v[i][2 * jj + 1][2], v[i][2 * jj + 1][3]);
                    *(u32x4*)((bf16*)(fb + F_X) + (size_t)row * D + 8 * (C.lane + 64 * jj)) = o; } }
            float ss = 0.f;
#pragma unroll
            for (int j = 0; j < 4; ++j) ss += (v[i][j][0] * v[i][j][0] + v[i][j][1] * v[i][j][1]) + (v[i][j][2] * v[i][j][2] + v[i][j][3] * v[i][j][3]);
            const float rstd = rsqrtf(wsum(ss) * (1.f / D) + EPS);
            if (mode == 2) { float* yo = row < MP ? A.out + O_YP + (size_t)row * D : A.out + O_YS + (size_t)(row - MP) * D;
#pragma unroll
                for (int j = 0; j < 4; ++j) { const int c0 = 8 * (C.lane + 64 * (j >> 1)) + 4 * (j & 1); const f32x4 g = *(const f32x4*)(IN_F(33) + c0); *(f32x4*)(yo + c0) = v[i][j] * rstd * g; }
                continue; }
            const float* m = modf + (size_t)cidx_row(row) * 3072;
#pragma unroll
            for (int jj = 0; jj < 2; ++jj) { const int c0 = 8 * (C.lane + 64 * jj);
                const f32x4 h0 = v[i][2 * jj] * rstd * *(const f32x4*)(m + D + c0) + *(const f32x4*)(m + c0), h1 = v[i][2 * jj + 1] * rstd * *(const f32x4*)(m + D + c0 + 4) + *(const f32x4*)(m + c0 + 4);
                u32x4 o; o.x = pk2(h0[0], h0[1]); o.y = pk2(h0[2], h0[3]); o.z = pk2(h1[0], h1[1]); o.w = pk2(h1[2], h1[3]); *(u32x4*)((bf16*)(fb + F_H) + (size_t)row * D + c0) = o; }
            if (mode == 1) {
#pragma unroll
                for (int jj = 0; jj < 2; ++jj) { const int c0 = 8 * (C.lane + 64 * jj);
                    const f32x4 h0 = v[i][2 * jj] * rstd * *(const f32x4*)(IN_F(20) + c0), h1 = v[i][2 * jj + 1] * rstd * *(const f32x4*)(IN_F(20) + c0 + 4);
                    u32x4 o; o.x = pk2(h0[0], h0[1]); o.y = pk2(h0[2], h0[3]); o.z = pk2(h1[0], h1[1]); o.w = pk2(h1[2], h1[3]); *(u32x4*)((bf16*)(fb + F_HKV) + (size_t)row * D + c0) = o; } }
        }
    }
}

struct EpGLU { static constexpr bool PERM = true, PAIRED = true;
    bf16* U; float* US; const float* b1; float* convp; float* convs;
    __device__ __forceinline__ void st2(int row, int f, f32x4 a, f32x4 g) const {
        const f32x4 ba = *(const f32x4*)(b1 + f), bg = *(const f32x4*)(b1 + 1024 + f); f32x4 u;
#pragma unroll
        for (int j = 0; j < 4; ++j) u[j] = (a[j] + ba[j]) * fsigm(g[j] + bg[j]);
        u32x2 o; o.x = pk2(u[0], u[1]); o.y = pk2(u[2], u[3]); *(u32x2*)(U + (size_t)row * D + f) = o;
        if (row < MP) { const int t = row & 4095; if (t >= 4066) *(f32x4*)(convp + ((size_t)(row >> 12) * 30 + (t - 4066)) * D + f) = u; }
        else { const int rs = row - MP; *(f32x4*)(US + (size_t)rs * D + f) = u; *(f32x4*)(convs + ((size_t)(rs >> 2) * 30 + 26 + (rs & 3)) * D + f) = u; }
    } };
struct EpSwiGLU { static constexpr bool PERM = true, PAIRED = true;
    bf16* ACT;
    __device__ __forceinline__ void st2(int row, int f, f32x4 g, f32x4 u) const {
        f32x4 a;
#pragma unroll
        for (int j = 0; j < 4; ++j) a[j] = fsilu(g[j]) * u[j];
        u32x2 o; o.x = pk2(a[0], a[1]); o.y = pk2(a[2], a[3]); *(u32x2*)(ACT + (size_t)row * DFF + f) = o;
    } };
struct EpResid { static constexpr bool PERM = false, PAIRED = false;
    const float* xp; const float* xs; bf16* X; const float* mod; const float* bias;
    __device__ __forceinline__ void st(int row, int col, f32x4 v) const {
        const f32x4 gt = *(const f32x4*)(mod + (size_t)cidx_row(row) * 3072 + 2048 + col);
        f32x4 x;
        if (xp) x = row < MP ? *(const f32x4*)(xp + (size_t)row * D + col) : *(const f32x4*)(xs + (size_t)(row - MP) * D + col);
        else { const u32x2 t = *(const u32x2*)(X + (size_t)row * D + col); x = bfx4(t.x, t.y); }
        f32x4 b = {0.f, 0.f, 0.f, 0.f}; if (bias) b = *(const f32x4*)(bias + col);
        const f32x4 y = x + gt * (v + b); u32x2 o; o.x = pk2(y[0], y[1]); o.y = pk2(y[2], y[3]); *(u32x2*)(X + (size_t)row * D + col) = o;
    } };
struct EpKV { static constexpr bool PERM = false, PAIRED = false;
    float* out; bf16* RB;
    __device__ __forceinline__ void st(int row, int col, f32x4 v) const {
        u32x2 o; o.x = pk2(v[0], v[1]); o.y = pk2(v[2], v[3]); *(u32x2*)(RB + (size_t)row * KVW + col) = o;
        const int br = col >> 9, c = col & 511;
        if (row < MP) {
            if (br == 0) *(f32x4*)(out + O_CMPP + (size_t)row * 512 + c) = v;
            else if (br == 1) *(f32x4*)(out + O_SELP + (size_t)row * 512 + c) = v;
            else { const int t = row & 4095; if (t >= 3584) *(f32x4*)(out + O_WINP + ((size_t)(row >> 12) * 512 + (t - 3584)) * 512 + c) = v; }
        } else { const int rs = row - MP;
            if (br == 0) *(f32x4*)(out + O_CMPS + (size_t)rs * 512 + c) = v;
            else if (br == 1) *(f32x4*)(out + O_SELS + (size_t)rs * 512 + c) = v;
            else *(f32x4*)(out + O_WINS + ((size_t)(rs >> 2) * 512 + 508 + (rs & 3)) * 512 + c) = v; }
    } };
struct EpQ { static constexpr bool PERM = true, PAIRED = false;
    bf16* Q;
    __device__ __forceinline__ void st(int row, int col, f32x4 v) const {
        const float s = 0.125f * LOG2E; u32x2 o; o.x = pk2(v[0] * s, v[1] * s); o.y = pk2(v[2] * s, v[3] * s); *(u32x2*)(Q + (size_t)row * D + col) = o;
    } };
struct EpGates { static constexpr bool PERM = false, PAIRED = false;
    float* GT;
    __device__ __forceinline__ void st(int row, int col, f32x4 v) const {
        f32x4 o; o[0] = fsigm(v[0]); o[1] = fsigm(v[1]); o[2] = fsigm(v[2]); o[3] = fsigm(v[3]); *(f32x4*)(GT + (size_t)row * 64 + col) = o;
    } };
struct EpResidNorm { static constexpr bool PERM = false, AFTER_DRAIN = true;
    const float* xp;
    bf16* X; const float* mod; const float* bias;
    int mode;
    const float* nmod; const float* gk; bf16* H; bf16* HKV; float* yout;
    float* stats; unsigned* cnt; unsigned* bar;
    __device__ __forceinline__ void operator()(const pg8::f32x4 (&)[2][2][4][2], const pg8::Unit&, int, int, int, int) const {}
    __device__ __forceinline__ void fused(pg8::f32x4 (&acc)[2][2][4][2], const pg8::Unit& u, int wr, int wc, int fr, int fq, PG8_LAS unsigned char* lds, int wid, int lane) const {
        const int cidx = u.pm >> 4; const float* gm = mod + (size_t)cidx * 3072 + 2048; const int tid = wid * 64 + lane;
        PG8_LAS float* sred = (PG8_LAS float*)lds; PG8_LAS float* srs = (PG8_LAS float*)(lds + 4096);
        f32x4 gv[2][2], gb[2][2];
#pragma unroll
        for (int bj = 0; bj < 2; ++bj)
#pragma unroll
            for (int n = 0; n < 2; ++n) { const int col = u.pn * 256 + bj * 128 + wc * 32 + 16 * n + 4 * fq; gv[bj][n] = *(const f32x4*)(gm + col);
                f32x4 b = {0.f, 0.f, 0.f, 0.f}; if (bias) b = *(const f32x4*)(bias + col); gb[bj][n] = gv[bj][n] * b; }
#pragma unroll
        for (int ai = 0; ai < 2; ++ai)
#pragma unroll
            for (int m = 0; m < 4; ++m) { const int rl = ai * 128 + wr * 64 + m * 16 + fr; const size_t row = (size_t)u.pm * 256 + rl; float ss = 0.f;
                f32x4 xv[2][2];
                if (xp) {
#pragma unroll
                    for (int bj = 0; bj < 2; ++bj)
#pragma unroll
                        for (int n = 0; n < 2; ++n) xv[bj][n] = *(const f32x4*)(xp + row * D + (u.pn * 256 + bj * 128 + wc * 32 + 16 * n + 4 * fq));
                    __builtin_amdgcn_sched_barrier(0);
                } else { u32x2 t[2][2];
#pragma unroll
                    for (int bj = 0; bj < 2; ++bj)
#pragma unroll
                        for (int n = 0; n < 2; ++n) t[bj][n] = *(const u32x2*)(X + row * D + (u.pn * 256 + bj * 128 + wc * 32 + 16 * n + 4 * fq));
                    __builtin_amdgcn_sched_barrier(0);
#pragma unroll
                    for (int bj = 0; bj < 2; ++bj)
#pragma unroll
                        for (int n = 0; n < 2; ++n) xv[bj][n] = bfx4(t[bj][n].x, t[bj][n].y); }
#pragma unroll
                for (int bj = 0; bj < 2; ++bj)
#pragma unroll
                    for (int n = 0; n < 2; ++n) { const int col = u.pn * 256 + bj * 128 + wc * 32 + 16 * n + 4 * fq;
                        const f32x4 y = (xv[bj][n] + gb[bj][n]) + gv[bj][n] * acc[ai][bj][m][n]; acc[ai][bj][m][n] = y;
                        u32x2 o; o.x = pk2(y[0], y[1]); o.y = pk2(y[2], y[3]); *(u32x2*)(X + row * D + col) = o;
                        ss += (y[0] * y[0] + y[1] * y[1]) + (y[2] * y[2] + y[3] * y[3]); }
                ss += __shfl_xor(ss, 16); ss += __shfl_xor(ss, 32);
                if (fq == 0) sred[rl * 4 + wc] = ss;
                asm volatile("" ::: "memory"); }
        __syncthreads();
        if (tid < 256) __hip_atomic_store((unsigned*)stats + ((size_t)u.pm * 4 + u.pn) * 256 + tid, __builtin_bit_cast(unsigned, (sred[tid * 4] + sred[tid * 4 + 1]) + (sred[tid * 4 + 2] + sred[tid * 4 + 3])), __ATOMIC_RELAXED, __HIP_MEMORY_SCOPE_AGENT);
        if (wid < 4) { asm volatile("s_waitcnt vmcnt(0)" ::: "memory"); if (lane == 0) (void)xb_add(cnt + 64 * u.pm, 1u); }
        if (tid == 0) { XB_SPIN(xb_ld(cnt + 64 * u.pm) < 16u, bar); __builtin_amdgcn_fence(__ATOMIC_ACQUIRE, "agent"); asm volatile("s_waitcnt vmcnt(0)" ::: "memory"); }
        __syncthreads();
        if (tid < 256) { float t = 0.f;
#pragma unroll
            for (int p2 = 0; p2 < 4; ++p2) t += __builtin_bit_cast(float, __hip_atomic_load((unsigned*)stats + ((size_t)u.pm * 4 + p2) * 256 + tid, __ATOMIC_RELAXED, __HIP_MEMORY_SCOPE_AGENT));
            srs[tid] = rsqrtf(t * (1.f / D) + EPS); }
        __syncthreads();
        const float* am = nmod + (size_t)cidx * 3072;
        f32x4 sc4[2][2], sh4[2][2], gk4[2][2];
#pragma unroll
        for (int bj = 0; bj < 2; ++bj)
#pragma unroll
            for (int n = 0; n < 2; ++n) { const int col = u.pn * 256 + bj * 128 + wc * 32 + 16 * n + 4 * fq; const f32x4 z = {0.f, 0.f, 0.f, 0.f};
                sc4[bj][n] = mode == 2 ? z : *(const f32x4*)(am + D + col); sh4[bj][n] = mode == 2 ? z : *(const f32x4*)(am + col); gk4[bj][n] = mode == 0 ? z : *(const f32x4*)(gk + col); }
#pragma unroll
        for (int ai = 0; ai < 2; ++ai)
#pragma unroll
            for (int m = 0; m < 4; ++m) { const int rl = ai * 128 + wr * 64 + m * 16 + fr; const size_t row = (size_t)u.pm * 256 + rl; const float rs = srs[rl];
#pragma unroll
                for (int bj = 0; bj < 2; ++bj)
#pragma unroll
                    for (int n = 0; n < 2; ++n) { const int col = u.pn * 256 + bj * 128 + wc * 32 + 16 * n + 4 * fq; const f32x4 yn = acc[ai][bj][m][n] * rs;
                        if (mode == 2) *(f32x4*)(yout + row * D + col) = yn * gk4[bj][n];
                        else { const f32x4 h = yn * sc4[bj][n] + sh4[bj][n]; u32x2 o; o.x = pk2(h[0], h[1]); o.y = pk2(h[2], h[3]); *(u32x2*)(H + row * D + col) = o;
                            if (mode == 1) { const f32x4 k = yn * gk4[bj][n]; u32x2 o2; o2.x = pk2(k[0], k[1]); o2.y = pk2(k[2], k[3]); *(u32x2*)(HKV + row * D + col) = o2; } } }
                asm volatile("" ::: "memory"); }
    } };
template <class E> struct PgE { static constexpr bool PERM = E::PERM, AFTER_DRAIN = false; E e;
    __device__ __forceinline__ void operator()(const pg8::f32x4 (&acc)[2][2][4][2], const pg8::Unit& u, int wr, int wc, int fr, int fq) const {
#pragma unroll
        for (int ai = 0; ai < 2; ++ai)
#pragma unroll
            for (int m = 0; m < 4; ++m) { const int row = u.pm * 256 + ai * 128 + wr * 64 + m * 16 + fr;
                if constexpr (E::PAIRED) {
#pragma unroll
                    for (int n = 0; n < 2; ++n) { const int f = u.pn * 128 + wc * 32 + (E::PERM ? 8 * fq + 4 * n : 16 * n + 4 * fq); e.st2(row, f, acc[ai][0][m][n], acc[ai][1][m][n]); }
                } else {
#pragma unroll
                    for (int bj = 0; bj < 2; ++bj)
#pragma unroll
                        for (int n = 0; n < 2; ++n) { const int col = u.pn * 256 + bj * 128 + wc * 32 + (E::PERM ? 8 * fq + 4 * n : 16 * n + 4 * fq); e.st(row, col, acc[ai][bj][m][n]); }
                }
                asm volatile("" ::: "memory"); }
    } };
template <class E> __device__ __forceinline__ void gemm_prompt(const Ctx& C, const bf16* Ap, const bf16* Bt, int N, int K, const E& e) {
    pg8::Gemm g{Ap, Bt, MP, N, K}; pg8::StaticOrder S; S.init(MP, N, C.G, C.wg); PgE<E> pe{e};
    pg8::gemm_phase<PgE<E>, pg8::StaticOrder, true, true>((PG8_LAS unsigned char*)C.lds, g, S, pe);
}
__device__ __forceinline__ void gemm_prompt_fused(const Ctx& C, const bf16* Ap, const bf16* Bt, int K, const EpResidNorm& e) {
    pg8::Gemm g{Ap, Bt, MP, 1024, K}; pg8::StaticOrder S; S.init(MP, 1024, C.G, C.wg);
    pg8::gemm_phase<EpResidNorm, pg8::StaticOrder, true, true>((PG8_LAS unsigned char*)C.lds, g, S, e);
}
__device__ __forceinline__ void sample_norm_part(const Ctx& C, CArgs& A, int mode, int ls, int pend_ls, const float* pend_bias, bool pend_in, unsigned* flag) {
    if (C.wg >= C.G - 16) {
        phase_norm(C, A, mode, ls, false, pend_ls, pend_bias, pend_in, MP + 8 * (C.wg - (C.G - 16)) + C.wave, MS, R);
        asm volatile("s_waitcnt vmcnt(0)" ::: "memory"); __syncthreads();
        if (C.tid == 0) { __builtin_amdgcn_fence(__ATOMIC_RELEASE, "agent"); asm volatile("s_waitcnt vmcnt(0)" ::: "memory"); (void)xb_add(flag, 1u); }
    }
}
__device__ __forceinline__ void sample_rows_ready(const Ctx& C, unsigned* flag, unsigned* bar) {
    if (C.tid == 0) { XB_SPIN(xb_ld(flag) < 16u, bar); __builtin_amdgcn_fence(__ATOMIC_ACQUIRE, "agent"); asm volatile("s_waitcnt vmcnt(0)" ::: "memory"); }
    __syncthreads();
}
__device__ __forceinline__ void phase_conv(const Ctx& C, CArgs& A, int l) {
    unsigned char* fb = A.fb; const bf16* U = (const bf16*)(fb + F_U); bf16* Cc = (bf16*)(fb + F_C); const float* US = (const float*)(fb + F_US);
    const int c0 = 2 * C.tid;
    constexpr int TOK = 8, NR = 528;
    const unsigned voff2 = (unsigned)c0 * 2u, voff4 = (unsigned)c0 * 4u;
    float w0[31], w1[31];
    { const char* wb = (const char*)(IN_F(14) + ((size_t)l * CONVW) * D);
#pragma unroll
      for (int k = 0; k < 31; ++k) { const float2 w = *(const float2*)(wb + (size_t)k * (D * 4) + voff4); w0[k] = w.x; w1[k] = w.y; } }
    const float2 bdw = *(const float2*)(IN_F(15) + l * D + c0), lg = *(const float2*)(IN_F(16) + l * D + c0), lb = *(const float2*)(IN_F(17) + l * D + c0);
    FLAS float* red = (FLAS float*)C.lds;
    FLAS float* ybuf = (FLAS float*)(C.lds + 65536);
    const int nPU = MP / TOK, nU = nPU + DB;
    for (int u = C.wg; u < nU; u += C.G) {
        int ntok; size_t orow0;
        __syncthreads();
        if (u < nPU) {
            const int row0 = u * TOK, t0 = row0 & 4095; ntok = TOK; orow0 = row0;
            {
                const char* up = (const char*)(U + (size_t)(row0 - 30) * D); float a0[TOK], a1[TOK];
#pragma unroll
                for (int tt = 0; tt < TOK; ++tt) { a0[tt] = bdw.x; a1[tt] = bdw.y; }
                unsigned xv[TOK + 30];
#pragma unroll
                for (int i = 0; i < TOK + 30; ++i) { const bool ok = t0 - 30 + i >= 0; const int ii = ok ? i : 30;
                    xv[i] = *(const unsigned*)(up + (size_t)ii * (D * 2) + voff2); }
                __builtin_amdgcn_sched_barrier(0);
#pragma unroll
                for (int i = 0; i < 30; ++i) { const bool ok = t0 - 30 + i >= 0; xv[i] = ok ? xv[i] : 0u; }
#pragma unroll
                for (int i = 0; i < TOK + 30; ++i) { const float x0 = __builtin_bit_cast(float, xv[i] << 16), x1 = __builtin_bit_cast(float, xv[i] & 0xffff0000u);
#pragma unroll
                    for (int tt = 0; tt < TOK; ++tt) { const int k = i - tt; if (k >= 0 && k < 31) { a0[tt] += w0[k] * x0; a1[tt] += w1[k] * x1; } } }
#pragma unroll
                for (int tt = 0; tt < TOK; ++tt) { const int t = tt; ybuf[(t * NTHR + C.tid) * 2] = a0[tt]; ybuf[(t * NTHR + C.tid) * 2 + 1] = a1[tt]; red[(2 * t) * NR + C.tid] = a0[tt] + a1[tt]; red[(2 * t + 1) * NR + C.tid] = a0[tt] * a0[tt] + a1[tt] * a1[tt]; } }
        } else {
            const int b = u - nPU; ntok = 4; orow0 = (size_t)MP + b * 4;
            const char* sp = (const char*)(IN_F(7) + (((size_t)l * DB + b) * 30) * D); const char* usp = (const char*)(US + ((size_t)b * 4) * D);
            for (int t = 0; t < TOK; ++t) { float a0 = bdw.x, a1 = bdw.y;
                if (t < 4) {
#pragma unroll
                    for (int k = 0; k < 31; ++k) { const int j = t + k; const char* p = j < 30 ? sp + (size_t)j * (D * 4) : usp + (size_t)(j - 30) * (D * 4); const float2 v = *(const float2*)(p + voff4);
                        a0 += w0[k] * v.x; a1 += w1[k] * v.y; } }
                ybuf[(t * NTHR + C.tid) * 2] = a0; ybuf[(t * NTHR + C.tid) * 2 + 1] = a1; red[(2 * t) * NR + C.tid] = a0 + a1; red[(2 * t + 1) * NR + C.tid] = a0 * a0 + a1 * a1; }
        }
        __syncthreads();
        { const int v = C.tid >> 5, part = C.tid & 31; float s = 0.f;
#pragma unroll 8
          for (int i = 0; i < 16; ++i) s += red[v * NR + i * 32 + part];
          s += __shfl_xor(s, 1); s += __shfl_xor(s, 2); s += __shfl_xor(s, 4); s += __shfl_xor(s, 8); s += __shfl_xor(s, 16);
          if (part == 0) red[2 * TOK * NR + v] = s; }
        __syncthreads();
        for (int t = 0; t < ntok; ++t) { const float mu = red[2 * TOK * NR + 2 * t] * (1.f / D); const float var = red[2 * TOK * NR + 2 * t + 1] * (1.f / D) - mu * mu; const float rstd = rsqrtf(fmaxf(var, 0.f) + EPS);
            const float yx = ybuf[(t * NTHR + C.tid) * 2], yy = ybuf[(t * NTHR + C.tid) * 2 + 1];
            const float o0 = fsilu((yx - mu) * rstd * lg.x + lb.x), o1 = fsilu((yy - mu) * rstd * lg.y + lb.y);
            *(unsigned*)(Cc + (orow0 + t) * D + c0) = pk2(o0, o1); }
    }
    __syncthreads();
}
#define FK_HAVE_ATTN 1
typedef float f32x16 __attribute__((ext_vector_type(16)));
template <class E> __device__ __forceinline__ void gemm128(const Ctx& C, const bf16* Arows  , int grow0, const bf16* Bt, int K, const E& e, int u) {
    const int fr = C.lane & 15, fq = C.lane >> 4, w = C.wave;
    int brow[2];
    if (E::PAIRED) { const int f = u * 16; brow[0] = 256 * (f >> 7) + (f & 127); brow[1] = brow[0] + 128; } else { brow[0] = u * 32; brow[1] = u * 32 + 16; }
    f32x4 acc[8][2];
#pragma unroll
    for (int rt = 0; rt < 8; ++rt) { acc[rt][0] = (f32x4){0.f, 0.f, 0.f, 0.f}; acc[rt][1] = (f32x4){0.f, 0.f, 0.f, 0.f}; }
    const int kw = K >> 3, k0 = w * kw;
    const bf16* ap = Arows + (size_t)fr * K + k0 + fq * 8; const bf16* bp0 = Bt + (size_t)(brow[0] + fr) * K + k0 + fq * 8; const bf16* bp1 = Bt + (size_t)(brow[1] + fr) * K + k0 + fq * 8;
    bf16x8 b0 = *(const bf16x8*)bp0, b1 = *(const bf16x8*)bp1, a[8];
#pragma unroll
    for (int rt = 0; rt < 8; ++rt) a[rt] = *(const bf16x8*)(ap + (size_t)rt * 16 * K);
#pragma unroll 1
    for (int k = 32; k <= kw; k += 32) { const int kn = k < kw ? k : 0;
        const bf16x8 nb0 = *(const bf16x8*)(bp0 + kn), nb1 = *(const bf16x8*)(bp1 + kn); bf16x8 na[8];
#pragma unroll
        for (int rt = 0; rt < 8; ++rt) na[rt] = *(const bf16x8*)(ap + (size_t)rt * 16 * K + kn);
#pragma unroll
        for (int rt = 0; rt < 8; ++rt) { acc[rt][0] = __builtin_amdgcn_mfma_f32_16x16x32_bf16(b0, a[rt], acc[rt][0], 0, 0, 0); acc[rt][1] = __builtin_amdgcn_mfma_f32_16x16x32_bf16(b1, a[rt], acc[rt][1], 0, 0, 0); }
        b0 = nb0; b1 = nb1;
#pragma unroll
        for (int rt = 0; rt < 8; ++rt) a[rt] = na[rt]; }
    __syncthreads();
    FLAS f32x4* slab = (FLAS f32x4*)C.lds;
#pragma unroll
    for (int rt = 0; rt < 8; ++rt) { slab[((w * 8 + rt) * 2 + 0) * 64 + C.lane] = acc[rt][0]; slab[((w * 8 + rt) * 2 + 1) * 64 + C.lane] = acc[rt][1]; }
    __syncthreads();
    f32x4 s0 = (f32x4){0.f, 0.f, 0.f, 0.f}, s1 = s0;
#pragma unroll
    for (int ww = 0; ww < 8; ++ww) { s0 += slab[((ww * 8 + w) * 2 + 0) * 64 + C.lane]; s1 += slab[((ww * 8 + w) * 2 + 1) * 64 + C.lane]; }
    const int row = grow0 + w * 16 + fr;
    if constexpr (E::PAIRED) e.st2(row, u * 16 + 4 * fq, s0, s1);
    else { e.st(row, u * 32 + 4 * fq, s0); e.st(row, u * 32 + 16 + 4 * fq, s1); }
}
template <class E> __device__ __forceinline__ void gemm_sample(const Ctx& C0, const bf16* As  , const bf16* Bt, int N, int K, const E& e) {
    const Ctx C = refreshed(C0); const int nunits = N / 32;
#ifdef FK_TIMING
    unsigned long long* tsq = (unsigned long long*)(((CArgs*)__builtin_amdgcn_kernarg_segment_ptr())->fb + F_CTL + 65536 + 1024);
    unsigned long long t0 = 0; if (C.wg == FK_TWG && C.tid == 0) t0 = __builtin_amdgcn_s_memrealtime();
#endif
    { const int rank = C.G - 1 - C.wg, half = C.G >> 1;
      if (rank < half) { if (rank < nunits) gemm128(C, As, MP, Bt, K, e, rank);
          for (int u2 = half + (rank - (half >> 1)); rank >= (half >> 1) && u2 < nunits; u2 += half) gemm128(C, As, MP, Bt, K, e, u2); } }
    __syncthreads();
#ifdef FK_TIMING
    if (C.wg == FK_TWG && C.tid == 0) tsq[N == 1024 ? 6 : 7] += __builtin_amdgcn_s_memrealtime() - t0;
#endif
}

__device__ __forceinline__ void gemm_sample_ksplit(const Ctx& C0, const bf16* As  , const bf16* Bt  , int K, float* PART) {
    const Ctx C = refreshed(C0); const int fr = C.lane & 15, fq = C.lane >> 4, w = C.wave, rh = w >> 2, kq = w & 3;
    for (int u = C.wg; u < 256; u += C.G) { const int cg = u & 31, ks = u >> 5; const int nsteps = K >> 8, k0 = ks * (K >> 3);
        f32x4 acc[4][2];
#pragma unroll
        for (int rt = 0; rt < 4; ++rt) { acc[rt][0] = (f32x4){0.f, 0.f, 0.f, 0.f}; acc[rt][1] = (f32x4){0.f, 0.f, 0.f, 0.f}; }
        const bf16* ap = As + (size_t)(64 * rh + fr) * K + k0 + fq * 8; const bf16* bp = Bt + (size_t)(32 * cg + fr) * K + k0 + fq * 8;
#pragma unroll
        for (int i = 0; i < 3; ++i) { const int st = kq + 4 * i; if (st < nsteps) { const bf16x8 b0 = *(const bf16x8*)(bp + 32 * st), b1 = *(const bf16x8*)(bp + (size_t)16 * K + 32 * st);
#pragma unroll
            for (int rt = 0; rt < 4; ++rt) { const bf16x8 a = *(const bf16x8*)(ap + (size_t)rt * 16 * K + 32 * st);
                acc[rt][0] = __builtin_amdgcn_mfma_f32_16x16x32_bf16(b0, a, acc[rt][0], 0, 0, 0); acc[rt][1] = __builtin_amdgcn_mfma_f32_16x16x32_bf16(b1, a, acc[rt][1], 0, 0, 0); } } }
        __syncthreads();
        FLAS f32x4* slab = (FLAS f32x4*)C.lds;
#pragma unroll
        for (int rt = 0; rt < 4; ++rt) { slab[(w * 8 + rt * 2 + 0) * 64 + C.lane] = acc[rt][0]; slab[(w * 8 + rt * 2 + 1) * 64 + C.lane] = acc[rt][1]; }
        __syncthreads();
#pragma unroll
        for (int h = 0; h < 2; ++h) { const int pi = kq * 2 + h, rt = pi >> 1, ct = pi & 1; f32x4 sv = slab[((rh * 4 + 0) * 8 + pi) * 64 + C.lane];
#pragma unroll
            for (int x = 1; x < 4; ++x) sv += slab[((rh * 4 + x) * 8 + pi) * 64 + C.lane];
            *(f32x4*)(PART + ((size_t)ks * MS + 64 * rh + 16 * rt + fr) * D + 32 * cg + 16 * ct + 4 * fq) = sv; }
    }
    __syncthreads();
}

__device__ __forceinline__ void phase_qkv(const Ctx& C0, CArgs& A, int l) {
    unsigned char* fb = A.fb; const bf16* HF = (const bf16*)(fb + F_H); const bf16* HKV = (const bf16*)(fb + F_HKV);
    unsigned* flag = (unsigned*)(fb + F_CTL) + 32768 + 64 * (2 * l - 1);
    { const Ctx C = refreshed(C0); sample_norm_part(C, A, l == 2 ? 1 : 0, 2 * l, 2 * l - 1, nullptr, false, flag); }
    if (l == 2) { const Ctx C = refreshed(C0); EpKV e{A.out, (bf16*)(fb + F_RB)}; gemm_prompt(C, HKV, (const bf16*)(fb + F_WKV), KVW, 1024, e); }
    { const Ctx C = refreshed(C0); EpQ e{(bf16*)(fb + F_Q)}; gemm_prompt(C, HF, (const bf16*)(fb + F_WQ) + (size_t)(l - 2) * 1024 * 1024, 1024, 1024, e); }
    { const Ctx C = refreshed(C0); sample_rows_ready(C, flag, (unsigned*)(fb + F_CTL) + 1024); }
    if (l == 2) { const Ctx C = refreshed(C0); EpKV e{A.out, (bf16*)(fb + F_RB)}; gemm_sample(C, HKV + (size_t)MP * D, (const bf16*)(fb + F_WKV), KVW, 1024, e); }
    { const Ctx C = refreshed(C0); gemm_sample_ksplit(C, HF + (size_t)MP * D, (const bf16*)(fb + F_WQ) + (size_t)(l - 2) * 1024 * 1024, 1024, (float*)(fb + F_QPART)); }
    { const Ctx C = refreshed(C0); EpGates e{(float*)(fb + F_GT)}; const bf16* W = (const bf16*)(fb + F_WG) + (size_t)(l - 2) * 64 * 1024;
      for (int it = (C.wg + 64) % C.G; it < 2 * (R / 128); it += C.G) gemm128(C, HF + (size_t)(it >> 1) * 128 * D, (it >> 1) * 128, W, 1024, e, it & 1);
      __syncthreads(); }
}

__device__ __forceinline__ void compress_prompt_wg(const Ctx& C, CArgs& A, int task) {
    unsigned char* fb = A.fb; const int fr = C.lane & 15, fq = C.lane >> 4, nl = fr >> 2, g = fr & 3, w = C.wave;
    const int e = task & 1, grp = (task >> 1) & 31, b = task >> 6;
    const bf16* W1 = (const bf16*)(fb + F_WPHI1) + (size_t)e * 128 * 2048; const bf16* W2 = (const bf16*)(fb + F_WPHI2) + (size_t)e * 64 * 128;
    f32x4 acc[8];
#pragma unroll
    for (int j = 0; j < 8; ++j) acc[j] = (f32x4){0.f, 0.f, 0.f, 0.f};
    const bf16* w1p = W1 + (size_t)fr * 2048 + fq * 8 + w * 256;
    const bf16* ap = (const bf16*)(fb + F_RB) + ((size_t)b * SEQ + (grp * 4 + nl) * 32 + 4 * w) * KVW + e * 256 + g * 64 + fq * 8;
#pragma unroll 2
    for (int s2 = 0; s2 < 8; ++s2) { const bf16x8 a = *(const bf16x8*)(ap + (size_t)(s2 >> 1) * KVW + (s2 & 1) * 32);
#pragma unroll
        for (int j = 0; j < 8; ++j) { const bf16x8 wv = *(const bf16x8*)(w1p + (size_t)j * 16 * 2048 + s2 * 32); acc[j] = __builtin_amdgcn_mfma_f32_16x16x32_bf16(wv, a, acc[j], 0, 0, 0); } }
    FLAS f32x4* slab = (FLAS f32x4*)C.lds;
    FLAS bf16* hid = (FLAS bf16*)(C.lds + 65536);
#pragma unroll
    for (int j = 0; j < 8; ++j) slab[(w * 8 + j) * 64 + C.lane] = acc[j];
    __syncthreads();
    { f32x4 h = (f32x4){0.f, 0.f, 0.f, 0.f};
#pragma unroll
      for (int ww = 0; ww < 8; ++ww) h += slab[(ww * 8 + w) * 64 + C.lane];
      const f32x4 bb = *(const f32x4*)((const float*)(fb + F_BPHI) + 4096 + e * PHI + 16 * w + 4 * fq);
      u32x2 o; o.x = pk2(fsilu(h[0] + bb[0]), fsilu(h[1] + bb[1])); o.y = pk2(fsilu(h[2] + bb[2]), fsilu(h[3] + bb[3]));
      *(FLAS u32x2*)(hid + fr * 136 + 16 * w + 4 * fq) = o; }
    __syncthreads();
    if (w < 4) { const int jj = w; f32x4 o2 = (f32x4){0.f, 0.f, 0.f, 0.f};
#pragma unroll
        for (int kq = 0; kq < 4; ++kq) { const bf16x8 a2 = *(const FLAS bf16x8*)(hid + fr * 136 + 32 * kq + 8 * fq); const bf16x8 wv = *(const bf16x8*)(W2 + (size_t)(16 * jj + fr) * 128 + 32 * kq + 8 * fq);
            o2 = __builtin_amdgcn_mfma_f32_16x16x32_bf16(wv, a2, o2, 0, 0, 0); }
        const int n = grp * 4 + nl, od = 16 * jj + 4 * fq; const f32x4 v = o2 + *(const f32x4*)(IN_F(25) + e * 64 + od);
        if (e == 0) { u32x2 o; o.x = pk2(v[0], v[1]); o.y = pk2(v[2], v[3]); *(u32x2*)((bf16*)(fb + F_CMPK) + (((size_t)b * 4 + g) * 128 + n) * 64 + od) = o; }
        else { bf16* vt = (bf16*)(fb + F_CMPVT) + (((size_t)b * 4 + g) * 64 + od) * 128 + n;
#pragma unroll
            for (int r = 0; r < 4; ++r) vt[r * 128] = (bf16)f2bf(v[r]); } }
    __syncthreads();
}
__device__ __forceinline__ void compress_sample_round(const Ctx& C, CArgs& A, int round) {
    unsigned char* fb = A.fb; const int fr = C.lane & 15, fq = C.lane >> 4, nl = fr >> 2, g = fr & 3, tid = C.tid;
    const int e = round & 1, pg = ((round >> 1) & 7) * 8 + C.wave, b = round >> 4;
    const bf16* W1 = (const bf16*)(fb + F_WPHI1) + (size_t)e * 128 * 2048; const bf16* W2 = (const bf16*)(fb + F_WPHI2) + (size_t)e * 64 * 128;
    FLAS unsigned char* L = C.lds;
    const int page = ((const int*)A.in[8])[b * NPAGES + pg];
    const float* ap = IN_F(4) + ((((size_t)page * PAGE + nl * 32) * 2 + e) * 4 + g) * 64 + fq * 8;
    f32x4 acc[8];
#pragma unroll
    for (int j = 0; j < 8; ++j) acc[j] = (f32x4){0.f, 0.f, 0.f, 0.f};
    f32x4 xa[8], xb[8];
#define CS_LOAD(dst, blk) { _Pragma("unroll") for (int q4 = 0; q4 < 4; ++q4) { const int s_ = (blk) * 4 + q4; const float* p_ = ap + (size_t)(s_ >> 1) * 512 + (s_ & 1) * 32; \
        dst[2 * q4] = __builtin_nontemporal_load((const f32x4*)p_); dst[2 * q4 + 1] = __builtin_nontemporal_load((const f32x4*)(p_ + 4)); } }
#define CS_COMP(src, blk) { _Pragma("unroll") for (int q4 = 0; q4 < 4; ++q4) { const int kl_ = ((blk) & 1) * 4 + q4; \
        u32x4 pa_; pa_.x = pk2(src[2 * q4][0], src[2 * q4][1]); pa_.y = pk2(src[2 * q4][2], src[2 * q4][3]); pa_.z = pk2(src[2 * q4 + 1][0], src[2 * q4 + 1][1]); pa_.w = pk2(src[2 * q4 + 1][2], src[2 * q4 + 1][3]); \
        const bf16x8 a_ = __builtin_bit_cast(bf16x8, pa_); \
        _Pragma("unroll") for (int j = 0; j < 8; ++j) { const bf16x8 w_ = *(const FLAS bf16x8*)(L + (16 * j + fr) * 528 + (kl_ * 32 + fq * 8) * 2); acc[j] = __builtin_amdgcn_mfma_f32_16x16x32_bf16(w_, a_, acc[j], 0, 0, 0); } } }
    CS_LOAD(xa, 0)
#pragma unroll 1
    for (int c = 0; c < 8; ++c) {
        __syncthreads();
        u32x4 wst[8];
#pragma unroll
        for (int i = 0; i < 8; ++i) { const int idx = tid + NTHR * i, nn = idx >> 5, ch = idx & 31; wst[i] = *(const u32x4*)(W1 + (size_t)nn * 2048 + c * 256 + ch * 8); }
        CS_LOAD(xb, 2 * c + 1)
#pragma unroll
        for (int i = 0; i < 8; ++i) { const int idx = tid + NTHR * i, nn = idx >> 5, ch = idx & 31; *(FLAS u32x4*)(L + nn * 528 + ch * 16) = wst[i]; }
        __syncthreads();
        CS_COMP(xa, 2 * c)
        if (c < 7) CS_LOAD(xa, 2 * c + 2)
        CS_COMP(xb, 2 * c + 1)
    }
#undef CS_LOAD
#undef CS_COMP
    const float* bph = (const float*)(fb + F_BPHI) + 4096 + e * PHI; const float* b2 = IN_F(25) + e * 64;
#pragma unroll
    for (int j = 0; j < 8; ++j) { const f32x4 bb = *(const f32x4*)(bph + 16 * j + 4 * fq);
#pragma unroll
        for (int r = 0; r < 4; ++r) acc[j][r] = fsilu(acc[j][r] + bb[r]); }
    f32x4 o2[4];
#pragma unroll
    for (int jj = 0; jj < 4; ++jj) o2[jj] = (f32x4){0.f, 0.f, 0.f, 0.f};
#pragma unroll
    for (int kq = 0; kq < 4; ++kq) {
        u32x4 pa; pa.x = pk2(acc[2 * kq][0], acc[2 * kq][1]); pa.y = pk2(acc[2 * kq][2], acc[2 * kq][3]); pa.z = pk2(acc[2 * kq + 1][0], acc[2 * kq + 1][1]); pa.w = pk2(acc[2 * kq + 1][2], acc[2 * kq + 1][3]);
        const bf16x8 a2 = __builtin_bit_cast(bf16x8, pa);
#pragma unroll
        for (int jj = 0; jj < 4; ++jj) { const bf16* wp = W2 + (size_t)(16 * jj + fr) * 128 + 32 * kq + 4 * fq; const u32x2 lo = *(const u32x2*)wp, hi = *(const u32x2*)(wp + 16);
            u32x4 pw; pw.x = lo.x; pw.y = lo.y; pw.z = hi.x; pw.w = hi.y; o2[jj] = __builtin_amdgcn_mfma_f32_16x16x32_bf16(__builtin_bit_cast(bf16x8, pw), a2, o2[jj], 0, 0, 0); } }
    const int n = pg * 4 + nl;
#pragma unroll
    for (int jj = 0; jj < 4; ++jj) { const int od = 16 * jj + 4 * fq; const f32x4 v = o2[jj] + *(const f32x4*)(b2 + od);
        if (e == 0) { u32x2 o; o.x = pk2(v[0], v[1]); o.y = pk2(v[2], v[3]); *(u32x2*)((bf16*)(fb + F_CMPS) + (((size_t)b * 4 + g) * 256 + n) * 64 + od) = o; }
        else { bf16* vt = (bf16*)(fb + F_CMPS) + (size_t)DB * 4 * 256 * 64 + (((size_t)b * 4 + g) * 64 + od) * 256 + n;
#pragma unroll
            for (int r = 0; r < 4; ++r) vt[r * 256] = (bf16)f2bf(v[r]); } }
}
__device__ __forceinline__ void phase_prep(const Ctx& C, CArgs& A) {
    unsigned char* fb = A.fb; const bf16* RB = (const bf16*)(fb + F_RB); bf16* VT = (bf16*)(fb + F_VT);
    FLAS unsigned char* scr = C.lds + C.wave * 9216;
    for (int it = C.gw; it < 2048; it += C.ngw) {
        const int tc = it & 63, g = (it >> 6) & 3, b = (it >> 8) & 3, br = it >> 10; const int t0 = tc * 64, col0 = 512 * (br + 1) + 256 + g * 64;
#pragma unroll
        for (int i = 0; i < 8; ++i) { const int tok = i * 8 + (C.lane >> 3), ch = C.lane & 7; *(FLAS u32x4*)(scr + tok * 144 + ch * 16) = *(const u32x4*)(RB + ((size_t)b * SEQ + t0 + tok) * KVW + col0 + ch * 8); }
        asm volatile("s_waitcnt lgkmcnt(0)" ::: "memory");
        bf16* dst = VT + ((((size_t)br * 4 + b) * 4 + g) * 64 + C.lane) * SEQ + t0;
#pragma unroll
        for (int i = 0; i < 8; ++i) { unsigned w[4];
#pragma unroll
            for (int j = 0; j < 4; ++j) { const unsigned lo = *(const FLAS unsigned short*)(scr + (8 * i + 2 * j) * 144 + C.lane * 2), hi = *(const FLAS unsigned short*)(scr + (8 * i + 2 * j + 1) * 144 + C.lane * 2); w[j] = lo | (hi << 16); }
            u32x4 o; o.x = w[0]; o.y = w[1]; o.z = w[2]; o.w = w[3]; *(u32x4*)(dst + 8 * i) = o; }
        asm volatile("s_waitcnt lgkmcnt(0)" ::: "memory");
    }
    __syncthreads();
    for (int task = C.wg; task < 256; task += C.G) compress_prompt_wg(C, A, task);
    for (int rd = C.wg; rd < 512; rd += C.G) compress_sample_round(C, A, rd);
    __syncthreads();
}

__device__ __forceinline__ float dpp_xor1(float v) { return __builtin_bit_cast(float, __builtin_amdgcn_update_dpp(0, __builtin_bit_cast(int, v), 0xB1, 0xF, 0xF, true)); }
__device__ __forceinline__ float dpp_xor2(float v) { return __builtin_bit_cast(float, __builtin_amdgcn_update_dpp(0, __builtin_bit_cast(int, v), 0x4E, 0xF, 0xF, true)); }
template <int N> struct IC { static constexpr int value = N; };
__device__ __forceinline__ int swz23(int m) { return (m & 0x13) | ((m & 4) << 1) | ((m & 8) >> 1); }
constexpr int AL_KB0 = 0, AL_VB0 = 9216, AL_KB1 = 18432, AL_VB1 = 27648, AL_LUT = 36864, AL_CK = 51712, AL_CV = 70144, AL_IMP = 87552, AL_SELM = 103936, AL_SCR = 104448, AL_LUTW = 110592  , AL_STASH = AL_CK;
constexpr int DMAXB = 790, LUTN = 928, LUTO = 64;
__device__ __forceinline__ bf16x8 pack8(const f32x16& p, int s) {
    u32x4 o; o.x = pk2(p[8 * s], p[8 * s + 1]); o.y = pk2(p[8 * s + 2], p[8 * s + 3]); o.z = pk2(p[8 * s + 4], p[8 * s + 5]); o.w = pk2(p[8 * s + 6], p[8 * s + 7]); return __builtin_bit_cast(bf16x8, o); }

__device__ __forceinline__ void attn_prompt_unit(const Ctx& C, CArgs& A, int b, int g, int qt, bool load_bg) {
    unsigned char* fb = A.fb; FLAS unsigned char* L = C.lds;
    const bf16* RB = (const bf16*)(fb + F_RB); const bf16* VT = (const bf16*)(fb + F_VT); const bf16* Q = (const bf16*)(fb + F_Q); const float* GT = (const float*)(fb + F_GT);
    const int tid = C.tid, lane = C.lane, w = C.wave, n = lane & 31, h = lane >> 5, ql = n >> 2, r = n & 3;
    const int q0 = qt * 64, qpos = q0 + 8 * w + ql, jq = qt; const size_t qrow = (size_t)b * SEQ + qpos;
    __syncthreads();
    {
        if (load_bg) for (int i = tid; i < LUTN * 4; i += NTHR) { const int d = (i >> 2) - LUTO, rr = i & 3; const float bv = IN_F(29)[rel_bucket(d) * 16 + g * 4 + rr] * LOG2E;
            ((FLAS float*)(L + AL_LUT))[i] = d < 0 ? -INFINITY : bv; if (i < 640 * 4) ((FLAS float*)(L + AL_LUTW))[i] = (d < 0 || d >= 512) ? -INFINITY : bv; }
    }
    bf16x8 qf[4]; float gt0, gt1, gt2;
    {
        const bf16* ck = (const bf16*)(fb + F_CMPK) + ((size_t)b * 4 + g) * 128 * 64; const bf16* cv = (const bf16*)(fb + F_CMPVT) + ((size_t)b * 4 + g) * 64 * 128;
        u32x4 ckr[2], cvr[2];
#pragma unroll
        for (int it = 0; it < 2; ++it) { const int i = tid + it * NTHR; ckr[it] = *(const u32x4*)(ck + (i >> 3) * 64 + (i & 7) * 8); cvr[it] = *(const u32x4*)(cv + (i >> 4) * 128 + (i & 15) * 8); }
#pragma unroll
        for (int s2 = 0; s2 < 4; ++s2) qf[s2] = *(const bf16x8*)(Q + qrow * D + (g * 4 + r) * 64 + 16 * s2 + 8 * h);
        gt0 = GT[qrow * 64 + (g * 4 + r) * 3 + 0]; gt1 = GT[qrow * 64 + (g * 4 + r) * 3 + 1]; gt2 = GT[qrow * 64 + (g * 4 + r) * 3 + 2];
        __builtin_amdgcn_sched_barrier(0);
#pragma unroll
        for (int it = 0; it < 2; ++it) { const int i = tid + it * NTHR; *(FLAS u32x4*)(L + AL_CK + (i >> 3) * 144 + (i & 7) * 16) = ckr[it]; *(FLAS u32x4*)(L + AL_CV + (i >> 4) * 272 + (i & 15) * 16) = cvr[it]; }
    }
    __syncthreads();
    const FLAS float* LUT = (const FLAS float*)(L + AL_LUT);
    FLAS u32x2* stash = (FLAS u32x2*)(L + AL_STASH) + (w * 64 + lane) * 8;
    const int krow = swz23(n);
    {
        f32x16 S[4]; float mx = -1e30f;
#pragma unroll
        for (int sub = 0; sub < 4; ++sub) { f32x16 acc;
#pragma unroll
            for (int i = 0; i < 16; ++i) acc[i] = 0.f;
#pragma unroll
            for (int ks = 0; ks < 4; ++ks) { const bf16x8 a = *(const FLAS bf16x8*)(L + AL_CK + (32 * sub + krow) * 144 + (16 * ks + 8 * h) * 2); acc = __builtin_amdgcn_mfma_f32_32x32x16_bf16(a, qf[ks], acc, 0, 0, 0); }
#pragma unroll
            for (int i = 0; i < 16; ++i) { const int nb = 32 * sub + (i & 7) + 8 * h + 16 * (i >> 3); const int d = qpos - (32 * nb + 31); const bool valid = d >= 0;
                const int dc = d > DMAXB ? DMAXB : (d < 0 ? 0 : d); const float bias = LUT[(dc + LUTO) * 4 + r]; float v = acc[i] + bias; v = valid ? v : -INFINITY; acc[i] = v; mx = fmaxf(mx, v); }
            S[sub] = acc; }
        mx = xmax32(mx);
        float sum = 0.f;
#pragma unroll
        for (int sub = 0; sub < 4; ++sub)
#pragma unroll
            for (int i = 0; i < 16; ++i) { const float p = __builtin_amdgcn_exp2f(S[sub][i] - mx); S[sub][i] = p; sum += p; }
        sum = xsum32(sum);
        const float inv = sum > 0.f ? 1.f / sum : 0.f;
        f32x16 oc[2];
#pragma unroll
        for (int d2 = 0; d2 < 2; ++d2)
#pragma unroll
            for (int i = 0; i < 16; ++i) oc[d2][i] = 0.f;
        FLAS float* IMP = (FLAS float*)(L + AL_IMP) + (w * 8 + ql) * 64;
#pragma unroll
        for (int sub = 0; sub < 4; ++sub) {
#pragma unroll
            for (int i = 0; i < 16; ++i) S[sub][i] *= inv;
#pragma unroll
            for (int i = 0; i < 16; i += 2) { float v = S[sub][i] + S[sub][i + 1]; v += dpp_xor1(v); v += dpp_xor2(v);
                const int j = 16 * sub + ((i & 7) >> 1) + 4 * h + 8 * (i >> 3); if (r == 0) IMP[j] = v; }
#pragma unroll
            for (int s = 0; s < 2; ++s) { const bf16x8 pb = pack8(S[sub], s);
#pragma unroll
                for (int d2 = 0; d2 < 2; ++d2) { const bf16x8 a = *(const FLAS bf16x8*)(L + AL_CV + (32 * d2 + n) * 272 + (32 * sub + 16 * s + 8 * h) * 2); oc[d2] = __builtin_amdgcn_mfma_f32_32x32x16_bf16(a, pb, oc[d2], 0, 0, 0); } }
        }
#pragma unroll
        for (int d2 = 0; d2 < 2; ++d2) oc[d2] *= gt0;
        __syncthreads();
#pragma unroll
        for (int d2 = 0; d2 < 2; ++d2)
#pragma unroll
            for (int c = 0; c < 4; ++c) { u32x2 o; o.x = pk2(oc[d2][4 * c], oc[d2][4 * c + 1]); o.y = pk2(oc[d2][4 * c + 2], oc[d2][4 * c + 3]); stash[d2 * 4 + c] = o; }
    }
    asm volatile("s_waitcnt lgkmcnt(0)" ::: "memory");
    {
        FLAS unsigned long long* SCR64 = (FLAS unsigned long long*)(L + AL_SCR) + w * 64; FLAS unsigned* SELM = (FLAS unsigned*)(L + AL_SELM) + w * 16;
        for (int qq = 0; qq < 8; ++qq) {
            unsigned long long mask;
            if (jq < 16) mask = (2ull << jq) - 1ull;
            else {
                const int j = lane; const float impj = ((const FLAS float*)(L + AL_IMP))[(w * 8 + qq) * 64 + j];
                const bool forced = (j == 0) || (j == jq) || (j == jq - 1); const bool okj = j <= jq; const float sj = forced ? 1e4f : impj;
                const unsigned long long keyj = okj ? (((unsigned long long)(__builtin_bit_cast(unsigned, sj) + 1u) << 32) | (unsigned)(63 - j)) : 0ull;
                SCR64[j] = keyj; asm volatile("s_waitcnt lgkmcnt(0)" ::: "memory");
                int rank = 0;
#pragma unroll
                for (int i2 = 0; i2 < 32; ++i2) { const u32x4 kv = *(const FLAS u32x4*)(SCR64 + 2 * i2);
                    const unsigned long long k0 = ((unsigned long long)kv.y << 32) | kv.x, k1 = ((unsigned long long)kv.w << 32) | kv.z;
                    rank += (k0 > keyj) ? 1 : 0; rank += (k1 > keyj) ? 1 : 0; }
                mask = __ballot(rank < 16 && okj);
                asm volatile("s_waitcnt lgkmcnt(0)" ::: "memory");
            }
            if (lane == 0) { SELM[2 * qq] = (unsigned)mask; SELM[2 * qq + 1] = (unsigned)(mask >> 32); }
        }
        asm volatile("s_waitcnt lgkmcnt(0)" ::: "memory");
    }
    const unsigned selLo = ((const FLAS unsigned*)(L + AL_SELM))[w * 16 + 2 * ql], selHi = ((const FLAS unsigned*)(L + AL_SELM))[w * 16 + 2 * ql + 1];
    const int jw0 = jq - 8 > 0 ? jq - 8 : 0; const int NTL = (jq + 1) + (jq - jw0 + 1);
    const int skey = tid >> 3, sch = tid & 7;
    const bf16* kbase = RB + ((size_t)b * SEQ + skey) * KVW + g * 64 + sch * 8;
    const bf16* vbase = VT + (((size_t)b * 4 + g) * 64 + skey) * SEQ + sch * 8;
    float m = -1e30f, lsum = 0.f; f32x16 oa[2];
#pragma unroll
    for (int d2 = 0; d2 < 2; ++d2)
#pragma unroll
        for (int i = 0; i < 16; ++i) oa[d2][i] = 0.f;
    u32x4 kreg0, vreg0, kreg1, vreg1;
    { kreg0 = *(const u32x4*)(kbase + 512); vreg0 = *(const u32x4*)vbase; }
    { const bool nw = 1 > jq; const int nj = nw ? jw0 : 1; kreg1 = *(const u32x4*)(kbase + (size_t)64 * nj * KVW + (nw ? 1024 : 512)); vreg1 = *(const u32x4*)(vbase + (nw ? (size_t)16 * 64 * SEQ : 0) + 64 * nj); }
    *(FLAS u32x4*)(L + AL_KB0 + skey * 144 + sch * 16) = kreg0; *(FLAS u32x4*)(L + AL_VB0 + skey * 144 + sch * 16) = vreg0;
    __syncthreads();
    const float b31 = LUT[(DMAXB + LUTO) * 4 + r];
    for (int ti = 0; ti < NTL; ++ti) {
        const bool isw = ti > jq; const int j = isw ? jw0 + (ti - jq - 1) : ti; const int buf = ti & 1;
        kreg0 = kreg1; vreg0 = vreg1;
        if (ti + 2 < NTL) { const bool nw = (ti + 2) > jq; const int nj = nw ? jw0 + (ti + 1 - jq) : ti + 2;
            kreg1 = *(const u32x4*)(kbase + (size_t)64 * nj * KVW + (nw ? 1024 : 512)); vreg1 = *(const u32x4*)(vbase + (nw ? (size_t)16 * 64 * SEQ : 0) + 64 * nj); }
        if (ti == jq + 1) {
            const float lt = xsum32(lsum); const float f = lt > 0.f ? gt1 / lt : 0.f;
#pragma unroll
            for (int d2 = 0; d2 < 2; ++d2) {
#pragma unroll
                for (int c = 0; c < 4; ++c) { const u32x2 o = stash[d2 * 4 + c]; u32x2 n2;
                    n2.x = pk2(__builtin_bit_cast(float, o.x << 16) + oa[d2][4 * c] * f, __builtin_bit_cast(float, o.x & 0xffff0000u) + oa[d2][4 * c + 1] * f);
                    n2.y = pk2(__builtin_bit_cast(float, o.y << 16) + oa[d2][4 * c + 2] * f, __builtin_bit_cast(float, o.y & 0xffff0000u) + oa[d2][4 * c + 3] * f); stash[d2 * 4 + c] = n2; }
#pragma unroll
                for (int i = 0; i < 16; ++i) oa[d2][i] = 0.f; }
            m = -1e30f; lsum = 0.f; }
        const bool selbit = ((j < 32 ? selLo >> j : selHi >> (j - 32)) & 1u) != 0u;
        const bool active = isw ? true : (__any(selbit) != 0);
        if (active) {
            const FLAS unsigned char* KB = L + (buf ? AL_KB1 : AL_KB0); const FLAS unsigned char* VB = L + (buf ? AL_VB1 : AL_VB0);
            f32x16 S[2];
            { bf16x8 kf[2][4];
#pragma unroll
              for (int sub = 0; sub < 2; ++sub)
#pragma unroll
                  for (int ks = 0; ks < 4; ++ks) kf[sub][ks] = *(const FLAS bf16x8*)(KB + (32 * sub + krow) * 144 + (16 * ks + 8 * h) * 2);
              __builtin_amdgcn_sched_barrier(0);
#pragma unroll
              for (int sub = 0; sub < 2; ++sub) { f32x16 acc;
#pragma unroll
                  for (int i = 0; i < 16; ++i) acc[i] = 0.f;
#pragma unroll
                  for (int ks = 0; ks < 4; ++ks) acc = __builtin_amdgcn_mfma_f32_32x32x16_bf16(kf[sub][ks], qf[ks], acc, 0, 0, 0);
                  S[sub] = acc; }
            }
            const int dbase = qpos - 64 * j;
            const bool far = !isw && ((q0 + 8 * w) - (64 * j + 63) >= DMAXB);
            auto body = [&](auto tag) { constexpr int MODE = decltype(tag)::value;
                float tmax = -INFINITY, poff;
                if constexpr (MODE == 0) {
#pragma unroll
                    for (int sub = 0; sub < 2; ++sub)
#pragma unroll
                        for (int i = 0; i < 16; ++i) tmax = fmaxf(tmax, S[sub][i]);
                    tmax = selbit ? tmax + b31 : -INFINITY;
                } else {
                    const int dl = dbase - 8 * h;
                    const int dle = (MODE == 2 || selbit) ? dl : -1;
                    const FLAS float* lpb = (MODE == 2 ? (const FLAS float*)(L + AL_LUTW) : LUT) + ((dle + LUTO - 55) * 4 + r);
                    float bv[2][16];
#pragma unroll
                    for (int sub = 0; sub < 2; ++sub)
#pragma unroll
                        for (int i = 0; i < 16; ++i) { const int koff = 32 * sub + (i & 7) + 16 * (i >> 3); bv[sub][i] = lpb[(55 - koff) * 4]; }
                    __builtin_amdgcn_sched_barrier(0);
#pragma unroll
                    for (int sub = 0; sub < 2; ++sub)
#pragma unroll
                        for (int i = 0; i < 16; ++i) { const float v = S[sub][i] + bv[sub][i]; S[sub][i] = v; tmax = fmaxf(tmax, v); }
                }
                tmax = xmax32(tmax);
                const float mnew = fmaxf(m, tmax); const float sc = __builtin_amdgcn_exp2f(m - mnew); m = mnew;
                poff = MODE == 0 ? (selbit ? b31 - mnew : -INFINITY) : -mnew;
                float ps = 0.f;
#pragma unroll
                for (int sub = 0; sub < 2; ++sub)
#pragma unroll
                    for (int i = 0; i < 16; ++i) { const float p = __builtin_amdgcn_exp2f(S[sub][i] + poff); S[sub][i] = p; ps += p; }
                lsum = lsum * sc + ps;
#pragma unroll
                for (int d2 = 0; d2 < 2; ++d2) oa[d2] *= sc;
#pragma unroll
                for (int sub = 0; sub < 2; ++sub)
#pragma unroll
                    for (int s2 = 0; s2 < 2; ++s2) { const bf16x8 pb = pack8(S[sub], s2);
#pragma unroll
                        for (int d2 = 0; d2 < 2; ++d2) { const bf16x8 av = *(const FLAS bf16x8*)(VB + (32 * d2 + n) * 144 + (32 * sub + 16 * s2 + 8 * h) * 2); oa[d2] = __builtin_amdgcn_mfma_f32_32x32x16_bf16(av, pb, oa[d2], 0, 0, 0); } }
            };
            if (isw) body(IC<2>{}); else if (far) body(IC<0>{}); else body(IC<1>{});
        }
        if (ti + 1 < NTL) { FLAS unsigned char* KBn = L + (buf ? AL_KB0 : AL_KB1); FLAS unsigned char* VBn = L + (buf ? AL_VB0 : AL_VB1);
            *(FLAS u32x4*)(KBn + skey * 144 + sch * 16) = kreg0; *(FLAS u32x4*)(VBn + skey * 144 + sch * 16) = vreg0; }
        __syncthreads();
    }
    { const float lt = xsum32(lsum); const float f = lt > 0.f ? gt2 / lt : 0.f;
#pragma unroll
      for (int d2 = 0; d2 < 2; ++d2) oa[d2] *= f; }
    bf16* op = (bf16*)(fb + F_O) + qrow * D + (g * 4 + r) * 64;
#pragma unroll
    for (int d2 = 0; d2 < 2; ++d2)
#pragma unroll
        for (int c = 0; c < 4; ++c) { const u32x2 sv = stash[d2 * 4 + c]; u32x2 o;
            o.x = pk2(__builtin_bit_cast(float, sv.x << 16) + oa[d2][4 * c], __builtin_bit_cast(float, sv.x & 0xffff0000u) + oa[d2][4 * c + 1]);
            o.y = pk2(__builtin_bit_cast(float, sv.y << 16) + oa[d2][4 * c + 2], __builtin_bit_cast(float, sv.y & 0xffff0000u) + oa[d2][4 * c + 3]); *(u32x2*)(op + 32 * d2 + 8 * c + 4 * h) = o; }
}

typedef short v4i16_t __attribute__((ext_vector_type(4)));
__device__ __forceinline__ float fexp2(float x) { return __builtin_amdgcn_exp2f(x); }
constexpr int SM_LUT = 0, SM_P = 12800, SM_ML = 29184, SM_FAC = 29696, SM_SC = 29952, SM_SELQ = 32064, SM_PUB0 = 12800  , SM_LIST = 45568, SM_NIT = 46112, SM_V = 46208, SM_PUBML = 119936;
constexpr int SDMAX = 790;
struct SAcc { float m, l; f32x4 o[4]; };
__device__ __forceinline__ void sa_init(SAcc& a) { a.m = -1e30f; a.l = 0.f;
#pragma unroll
    for (int dt = 0; dt < 4; ++dt) a.o[dt] = (f32x4){0.f, 0.f, 0.f, 0.f}; }
__device__ __forceinline__ bf16x8 pack44(const f32x4& x, const f32x4& y) { u32x4 o; o.x = pk2(x[0], x[1]); o.y = pk2(x[2], x[3]); o.z = pk2(y[0], y[1]); o.w = pk2(y[2], y[3]); return __builtin_bit_cast(bf16x8, o); }
__device__ __forceinline__ void sa_update(f32x4 (&S)[4], SAcc& a, bf16x8 (&P)[2]) {
    float tmax = fmaxf(fmaxf(S[0][0], S[0][1]), fmaxf(S[0][2], S[0][3]));
#pragma unroll
    for (int kt = 1; kt < 4; ++kt) tmax = fmaxf(tmax, fmaxf(fmaxf(S[kt][0], S[kt][1]), fmaxf(S[kt][2], S[kt][3])));
    tmax = fmaxf(tmax, __shfl_xor(tmax, 16)); tmax = xmax32(tmax);
    const float mnew = fmaxf(a.m, tmax), sc = fexp2(a.m - mnew); a.m = mnew;
    float ps = 0.f;
#pragma unroll
    for (int kt = 0; kt < 4; ++kt)
#pragma unroll
        for (int t = 0; t < 4; ++t) { const float p = fexp2(S[kt][t] - mnew); S[kt][t] = p; ps += p; }
    a.l = a.l * sc + ps;
#pragma unroll
    for (int dt = 0; dt < 4; ++dt) a.o[dt] *= sc;
    P[0] = pack44(S[0], S[1]); P[1] = pack44(S[2], S[3]);
}
__device__ __forceinline__ void sa_block_f32(FLAS unsigned char* Vt, int lane, const float* kb, const float* vb, int nk, const bf16x8 (&qf)[2], SAcc& a, const FLAS float* lut, int d0, int dmax, bool rowok) {
    const int fr = lane & 15, fq = lane >> 4, r = fr & 3;
    f32x4 kr[4][4];
#pragma unroll
    for (int kt = 0; kt < 4; ++kt) { const int kk = 32 * (kt >> 1) + 8 * (fr >> 2) + 4 * (kt & 1) + (fr & 3); const float* kp = kb + (size_t)kk * 512 + 8 * fq;
        kr[kt][0] = *(const f32x4*)kp; kr[kt][1] = *(const f32x4*)(kp + 4); kr[kt][2] = *(const f32x4*)(kp + 32); kr[kt][3] = *(const f32x4*)(kp + 36); }
    f32x4 vr[8][2]; const float* vp0 = vb + (size_t)(lane >> 3) * 512 + 8 * (lane & 7);
#pragma unroll
    for (int i = 0; i < 4; ++i) { const float* vp = vp0 + (size_t)i * 4096; vr[i][0] = *(const f32x4*)vp; vr[i][1] = *(const f32x4*)(vp + 4); }
    f32x4 S[4];
#pragma unroll
    for (int kt = 0; kt < 4; ++kt) { f32x4 acc = (f32x4){0.f, 0.f, 0.f, 0.f};
        acc = __builtin_amdgcn_mfma_f32_16x16x32_bf16(pack44(kr[kt][0], kr[kt][1]), qf[0], acc, 0, 0, 0); acc = __builtin_amdgcn_mfma_f32_16x16x32_bf16(pack44(kr[kt][2], kr[kt][3]), qf[1], acc, 0, 0, 0); S[kt] = acc; }
    asm volatile("" ::: "memory");
#pragma unroll
    for (int i = 4; i < 8; ++i) { const float* vp = vp0 + (size_t)i * 4096; vr[i][0] = *(const f32x4*)vp; vr[i][1] = *(const f32x4*)(vp + 4); }
#pragma unroll
    for (int kt = 0; kt < 4; ++kt)
#pragma unroll
        for (int t = 0; t < 4; ++t) { const int kk = 32 * (kt >> 1) + 8 * fq + 4 * (kt & 1) + t; const int d = d0 - kk; const bool valid = rowok && kk < nk && d >= 0 && d < dmax;
            const int dc = d < 0 ? 0 : (d > SDMAX ? SDMAX : d); const float v = S[kt][t] + lut[dc * 4 + r]; S[kt][t] = valid ? v : -INFINITY; }
    bf16x8 P[2]; sa_update(S, a, P);
#pragma unroll
    for (int i = 0; i < 8; ++i) { const int key = 8 * i + (lane >> 3); *(FLAS bf16x8*)(Vt + key * 144 + (lane & 7) * 16) = pack44(vr[i][0], vr[i][1]); }
    asm volatile("s_waitcnt lgkmcnt(0)" ::: "memory");
#pragma unroll
    for (int s2 = 0; s2 < 2; ++s2)
#pragma unroll
        for (int dt = 0; dt < 4; ++dt) { const FLAS unsigned char* p = Vt + (32 * s2 + 8 * fq + (fr >> 2)) * 144 + (16 * dt + 4 * (fr & 3)) * 2;
            const v4i16_t lo = __builtin_amdgcn_ds_read_tr16_b64_v4i16((FLAS v4i16_t*)p), hi = __builtin_amdgcn_ds_read_tr16_b64_v4i16((FLAS v4i16_t*)(p + 4 * 144));
            bf16x8 vf; vf[0] = lo[0]; vf[1] = lo[1]; vf[2] = lo[2]; vf[3] = lo[3]; vf[4] = hi[0]; vf[5] = hi[1]; vf[6] = hi[2]; vf[7] = hi[3];
            a.o[dt] = __builtin_amdgcn_mfma_f32_16x16x32_bf16(vf, P[s2], a.o[dt], 0, 0, 0); }
    asm volatile("s_waitcnt lgkmcnt(0)" ::: "memory");
}
__device__ __forceinline__ void attn_sample_unit(const Ctx& C, CArgs& A, int u) {
    unsigned char* fb = A.fb; const int lane = C.lane, tid = C.tid, w = C.wave, fr = lane & 15, fq = lane >> 4, q = fr >> 2, r = fr & 3; FLAS unsigned char* L = C.lds;
    const int b = u >> 2, g = u & 3;
    FLAS float* lut = (FLAS float*)(L + SM_LUT); FLAS float* Pc = (FLAS float*)(L + SM_P); FLAS float* ML = (FLAS float*)(L + SM_ML); FLAS float* FAC = (FLAS float*)(L + SM_FAC); FLAS float* SC = (FLAS float*)(L + SM_SC);
    FLAS unsigned* SELQ = (FLAS unsigned*)(L + SM_SELQ); FLAS unsigned* LIST = (FLAS unsigned*)(L + SM_LIST); FLAS unsigned* NIT = (FLAS unsigned*)(L + SM_NIT); FLAS unsigned char* Vt = L + SM_V + w * 9216;
    const float* table = IN_F(29); const int* pt = (const int*)A.in[8];
    __syncthreads();
    for (int i = tid; i < (SDMAX + 2) * 4; i += NTHR) lut[i] = table[rel_bucket(i >> 2) * 16 + g * 4 + (i & 3)] * LOG2E;
    bf16x8 qf[2];
    { const float* qp = (const float*)(fb + F_QPART) + ((size_t)b * 4 + q) * D + (g * 4 + r) * 64 + 8 * fq; const float qs = 0.125f * LOG2E;
#pragma unroll
      for (int k2 = 0; k2 < 2; ++k2) { f32x4 s0 = {0.f, 0.f, 0.f, 0.f}, s1 = s0;
#pragma unroll
          for (int ksl = 0; ksl < 8; ++ksl) { s0 += *(const f32x4*)(qp + (size_t)ksl * MS * D + 32 * k2); s1 += *(const f32x4*)(qp + (size_t)ksl * MS * D + 32 * k2 + 4); }
          qf[k2] = pack44(s0 * qs, s1 * qs); } }
    SAcc a0, a1; sa_init(a0); sa_init(a1);
    __syncthreads();
    const float* winK = IN_F(6) + ((size_t)b * 512 * 2) * 256 + g * 64;
    const float* winN = A.out + O_WINS + ((size_t)b * 512 + 508) * 512 + g * 64;
    if (w < 4) {
        const int cb = w; const bf16* ck = (const bf16*)(fb + F_CMPS) + (((size_t)b * 4 + g) * 256 + 64 * cb) * 64; const bf16* vt = (const bf16*)(fb + F_CMPS) + (size_t)DB * 4 * 256 * 64 + ((size_t)b * 4 + g) * 64 * 256 + 64 * cb;
        f32x4 S[4];
#pragma unroll
        for (int kt = 0; kt < 4; ++kt) { const int kk = 32 * (kt >> 1) + 8 * (fr >> 2) + 4 * (kt & 1) + (fr & 3); const bf16* kp = ck + kk * 64 + 8 * fq; f32x4 acc = (f32x4){0.f, 0.f, 0.f, 0.f};
            acc = __builtin_amdgcn_mfma_f32_16x16x32_bf16(*(const bf16x8*)kp, qf[0], acc, 0, 0, 0); acc = __builtin_amdgcn_mfma_f32_16x16x32_bf16(*(const bf16x8*)(kp + 32), qf[1], acc, 0, 0, 0); S[kt] = acc; }
        const int d0 = PAST + q - 31 - 32 * 64 * cb;
#pragma unroll
        for (int kt = 0; kt < 4; ++kt)
#pragma unroll
            for (int t = 0; t < 4; ++t) { const int kk = 32 * (kt >> 1) + 8 * fq + 4 * (kt & 1) + t; const int d = d0 - 32 * kk; S[kt][t] += lut[(d > SDMAX ? SDMAX : d) * 4 + r]; }
        bf16x8 P[2]; sa_update(S, a0, P);
#pragma unroll
        for (int kt = 0; kt < 4; ++kt) *(FLAS f32x4*)(Pc + fr * 256 + 64 * cb + 32 * (kt >> 1) + 8 * fq + 4 * (kt & 1)) = S[kt];
#pragma unroll
        for (int s2 = 0; s2 < 2; ++s2)
#pragma unroll
            for (int dt = 0; dt < 4; ++dt) a0.o[dt] = __builtin_amdgcn_mfma_f32_16x16x32_bf16(*(const bf16x8*)(vt + (size_t)(16 * dt + fr) * 256 + 32 * s2 + 8 * fq), P[s2], a0.o[dt], 0, 0, 0);
        float lr = a0.l; lr += __shfl_xor(lr, 16); lr += __shfl_xor(lr, 32);
        if (fq == 0) { ML[(w * 16 + fr) * 2] = a0.m; ML[(w * 16 + fr) * 2 + 1] = lr; }
    } else { const int wb = w - 4; sa_block_f32(Vt, lane, winK + (size_t)64 * wb * 512, winK + (size_t)64 * wb * 512 + 256, 64, qf, a0, lut, 512 + q - 64 * wb, 512, true); }
    __syncthreads();
    if (tid < 64) { const int row = tid >> 2, ww = tid & 3; float M = -1e30f;
#pragma unroll
        for (int x = 0; x < 4; ++x) M = fmaxf(M, ML[(x * 16 + row) * 2]);
        float Ls = 0.f;
#pragma unroll
        for (int x = 0; x < 4; ++x) Ls += ML[(x * 16 + row) * 2 + 1] * fexp2(ML[(x * 16 + row) * 2] - M);
        FAC[row * 4 + ww] = fexp2(ML[(ww * 16 + row) * 2] - M) / Ls; }
    __syncthreads();
    { const int qq = tid >> 7, j = tid & 127; float sv = 0.f;
#pragma unroll
      for (int rr = 0; rr < 4; ++rr) { const int row = qq * 4 + rr; const f32x2 pp = *(const FLAS f32x2*)(Pc + row * 256 + 2 * j); sv += (pp[0] + pp[1]) * FAC[row * 4 + (j >> 5)]; }
      SC[qq * 132 + j] = (j == 0 || j == 127) ? 1e4f : sv; }
    __syncthreads();
    { const int qq = w >> 1, j = 64 * (w & 1) + lane; const float sj = SC[qq * 132 + j]; int rank = 0;
#pragma unroll 4
      for (int i4 = 0; i4 < 32; ++i4) { const f32x4 sv = *(const FLAS f32x4*)(SC + qq * 132 + 4 * i4);
#pragma unroll
          for (int k = 0; k < 4; ++k) { const int i = 4 * i4 + k; rank += (sv[k] > sj || (sv[k] == sj && i < j)) ? 1 : 0; } }
      SELQ[qq * 132 + j] = rank < 15 ? 1u : 0u; }
    __syncthreads();
    if (w == 0) { unsigned base = 0;
        for (int c = 0; c < 3; ++c) { const int j = 64 * c + lane; unsigned msk = 0u;
            if (j < 128) msk = SELQ[j] | (SELQ[132 + j] << 1) | (SELQ[264 + j] << 2) | (SELQ[396 + j] << 3); else if (j == 128) msk = 0xFu;
            const unsigned long long ball = __ballot(msk != 0u); const unsigned pos = base + (unsigned)__builtin_popcountll(ball & ((1ull << lane) - 1ull));
            if (msk != 0u) LIST[pos] = (unsigned)j | (msk << 8);
            base += (unsigned)__builtin_popcountll(ball); }
        if (lane == 0) NIT[0] = base; }
    __syncthreads();
    const int nit = (int)NIT[0];
    if (w >= 4) {
        sa_block_f32(Vt, lane, winK + (size_t)64 * w * 512, winK + (size_t)64 * w * 512 + 256, 64, qf, a0, lut, 512 + q - 64 * w, 512, true);
        if (w == 4) sa_block_f32(Vt, lane, winN, winN + 256, 4, qf, a0, lut, q, 512, true); }
    { FLAS float* PO = (FLAS float*)(L + SM_PUB0); FLAS float* PM = (FLAS float*)(L + SM_PUBML);
#pragma unroll
      for (int dt = 0; dt < 4; ++dt) *(FLAS f32x4*)(PO + (w * 16 + fr) * 64 + 16 * dt + 4 * fq) = a0.o[dt];
      float l0 = a0.l; l0 += __shfl_xor(l0, 16); l0 += __shfl_xor(l0, 32);
      if (fq == 0) { PM[((w * 2 + 0) * 16 + fr) * 2] = a0.m; PM[((w * 2 + 0) * 16 + fr) * 2 + 1] = l0; } }
#pragma unroll 1
    for (int i = 0; i < nit; ++i) { const int p12 = i % 12; if ((p12 < 8 ? p12 : p12 - 8) != w) continue;
        const unsigned item = LIST[i]; const int j = (int)(item & 255u); const bool rowok = ((item >> (8 + q)) & 1u) != 0u;
        const float* kb; int nk;
        if (j < 128) { const int page = pt[b * NPAGES + (j >> 1)]; kb = IN_F(5) + (((size_t)page * PAGE + (j & 1) * 64) * 2) * 256 + g * 64; nk = 64; }
        else { kb = A.out + O_SELS + ((size_t)b * DS) * 512 + g * 64; nk = DS; }
        sa_block_f32(Vt, lane, kb, kb + 256, nk, qf, a1, lut, PAST + q - 64 * j, 1 << 30, rowok); }
    __syncthreads();
    { FLAS float* PO = (FLAS float*)(L + SM_V); FLAS float* PM = (FLAS float*)(L + SM_PUBML);
#pragma unroll
      for (int dt = 0; dt < 4; ++dt) *(FLAS f32x4*)(PO + (w * 16 + fr) * 64 + 16 * dt + 4 * fq) = a1.o[dt];
      float l1 = a1.l; l1 += __shfl_xor(l1, 16); l1 += __shfl_xor(l1, 32);
      if (fq == 0) { PM[((w * 2 + 1) * 16 + fr) * 2] = a1.m; PM[((w * 2 + 1) * 16 + fr) * 2 + 1] = l1; } }
    __syncthreads();
    { const FLAS float* PM = (const FLAS float*)(L + SM_PUBML);
      const int row = tid >> 5, dim = 2 * (tid & 31), qq = row >> 2, rr = row & 3; const size_t grow = (size_t)MP + b * DS + qq;
      const float* gt = (const float*)(fb + F_GT) + grow * 64 + (g * 4 + rr) * 3; float o0 = 0.f, o1 = 0.f;
#pragma unroll
      for (int br = 0; br < 3; ++br) {
          const int w0 = br == 2 ? 4 : 0, w1 = br == 0 ? 4 : 8, set = br == 1 ? 1 : 0; const FLAS float* PO = (const FLAS float*)(L + (br == 1 ? SM_V : SM_PUB0)); float M = -1e30f;
          for (int x = w0; x < w1; ++x) M = fmaxf(M, PM[((x * 2 + set) * 16 + row) * 2]);
          float Ls = 0.f, x0 = 0.f, x1 = 0.f;
          for (int x = w0; x < w1; ++x) { const float f = fexp2(PM[((x * 2 + set) * 16 + row) * 2] - M); Ls += PM[((x * 2 + set) * 16 + row) * 2 + 1] * f;
              const f32x2 ov = *(const FLAS f32x2*)(PO + (x * 16 + row) * 64 + dim); x0 += ov[0] * f; x1 += ov[1] * f; }
          const float gv = Ls > 0.f ? gt[br] / Ls : 0.f; o0 += gv * x0; o1 += gv * x1; }
      *(unsigned*)((bf16*)(fb + F_O) + grow * D + (g * 4 + rr) * 64 + dim) = pk2(o0, o1); }
}

__device__ __forceinline__ void phase_attn(const Ctx& C, CArgs& A, int l) {
    int prev_bg = -1;
    for (int u = C.wg; u < 1024; u += C.G) { const int i = u >> 8, wv = u & 255, bg = wv & 15, k = wv >> 4;
        const int qt = i == 0 ? 63 - k : (i == 1 ? (k == 7 ? 47 : (k == 15 ? 39 : 32 + k)) : (i == 2 ? (k <= 6 ? 14 - k : (k == 15 ? 7 : 31 - k)) : ((k >= 8 && k <= 14) ? 17 + k : (k == 7 ? 16 : k))));
        attn_prompt_unit(C, A, bg >> 2, bg & 3, qt, bg != prev_bg); prev_bg = bg; }
    __syncthreads();
#ifdef FK_TIMING
    unsigned long long* ts2 = (unsigned long long*)(A.fb + F_CTL + 65536 + 1024);
    if (C.wg == FK_TWG && C.tid == 0) ts2[0] = __builtin_amdgcn_s_memrealtime();
#endif
    { const int su = C.wg < 112 ? C.wg : (C.wg >= 240 ? 112 + (C.wg - 240) : -1); if (su >= 0 && su < DB * 4) attn_sample_unit(C, A, su); }
    __syncthreads();
#ifdef FK_TIMING
    if (C.wg == FK_TWG && C.tid == 0) ts2[1] = __builtin_amdgcn_s_memrealtime();
#endif
}
constexpr int NPHASE = 24;
#ifdef FK_TIMING
#define FK_TIMING_ON 1
#else
#define FK_TIMING_ON 0
#endif
__global__ void __launch_bounds__(NTHR, 2) mega(Args A_unused) {
    extern __shared__ __attribute__((aligned(16))) unsigned char lds_raw[];
    Ctx C; C.lds = (FLAS unsigned char*)lds_raw; C.tid = threadIdx.x; C.lane = C.tid & 63; C.wave = __builtin_amdgcn_readfirstlane(C.tid >> 6); C.G = gridDim.x; C.wg = blockIdx.x;
    C.gw = C.wg * NWAVE + C.wave; C.ngw = C.G * NWAVE;
    CArgs* Ap0 = (CArgs*)__builtin_amdgcn_kernarg_segment_ptr();
    unsigned char* fb = Ap0->fb;
    volatile FLAS unsigned* misc = (volatile FLAS unsigned*)(C.lds + LDS_MISC);
    if (C.tid < 8) misc[C.tid] = 0u;
    __syncthreads();
    const int lo = Ap0->lo, hi = Ap0->hi;
    const bool use_bar = (hi - lo) > 1;
    XcdBarrier bar; bar.bar = (unsigned*)(fb + F_CTL) + 1024; bar.x = 0; bar.st = nullptr;
    if (use_bar) bar = xcd_barrier_post((unsigned*)(fb + F_CTL) + 1024, misc);
    int pidx = 0;
#ifdef FK_TIMING
    unsigned long long* ts = (unsigned long long*)(fb + F_CTL + 65536);
    if (C.wg == 0 && C.tid == 0) ts[0] = __builtin_amdgcn_s_memrealtime();
#define TSTAMP() do { if (C.wg == 0 && threadIdx.x == 0) ts[pidx + 1] = __builtin_amdgcn_s_memrealtime(); } while (0)
#else
#define TSTAMP() do {} while (0)
#endif
#define PH_BEGIN if (lo <= pidx && pidx < hi) { C.tid = pg8::opaque_tid(); C.lane = C.tid & 63; { int wg_ = blockIdx.x, G_ = gridDim.x, wv_ = C.wave; asm volatile("" : "+s"(wg_), "+s"(G_), "+s"(wv_)); C.wg = wg_; C.G = G_; C.wave = wv_; C.gw = wg_ * NWAVE + wv_; C.ngw = G_ * NWAVE; } CArgs* Ap = (CArgs*)__builtin_amdgcn_kernarg_segment_ptr(); asm volatile("" : "+s"(Ap)); CArgs& A = *Ap; unsigned char* fb = A.fb; \
        bf16* XF = (bf16*)(fb + F_X); bf16* HF = (bf16*)(fb + F_H); const float* MODF = (const float*)(fb + F_MOD); \
        const float* mod0 = MODF + (size_t)(2 * l) * NC * 3072; const float* mod1 = MODF + (size_t)(2 * l + 1) * NC * 3072; (void)XF; (void)HF; (void)mod0; (void)mod1;
#define PH_END   if (pidx + 1 < hi || FK_TIMING_ON) xcd_barrier(bar); TSTAMP(); } ++pidx;
    { const int l = 0; PH_BEGIN phase_prologue(C, A); PH_END }

    for (int l = 0; l < 4; ++l) {
        if (l == 0) { PH_BEGIN phase_norm(C, A, 0, 0, true, -1, nullptr, false, C.gw, C.ngw, R); PH_END }
        if (l < 2) {
            PH_BEGIN {
                unsigned* flag = (unsigned*)(fb + F_CTL) + 32768 + 64 * (2 * l - 1);
                if (l > 0) { const Ctx Cn = refreshed(C); sample_norm_part(Cn, A, 0, 2 * l, 2 * l - 1, nullptr, false, flag); }
                C = refreshed(C);
                EpGLU e{(bf16*)(fb + F_U), (float*)(fb + F_US), IN_F(13) + (size_t)l * 2048, A.out + O_CONVP + (size_t)l * BATCH * 30 * D, A.out + O_CONVS + (size_t)l * DB * 30 * D};
                const bf16* W = (const bf16*)(fb + F_WPW1) + (size_t)l * 2048 * 1024;
                gemm_prompt(C, HF, W, 2048, 1024, e);
                C = refreshed(C);
                if (l > 0) sample_rows_ready(C, flag, (unsigned*)(fb + F_CTL) + 1024);
                gemm_sample(C, HF + (size_t)MP * D, W, 2048, 1024, e);
            } PH_END
            PH_BEGIN phase_conv(C, A, l); PH_END
            PH_BEGIN {
                EpResidNorm e{l == 0 ? IN_F(0) : nullptr, XF, mod0, IN_F(19) + (size_t)l * D, 0, mod1, nullptr, HF, nullptr, nullptr,
                              (float*)(fb + F_STATS) + (size_t)(2 * l) * 65536, (unsigned*)(fb + F_CTL) + 65536 + (2 * l) * 4096, (unsigned*)(fb + F_CTL) + 1024};
                const bf16* W = (const bf16*)(fb + F_WPW2) + (size_t)l * 1024 * 1024; const bf16* Ain = (const bf16*)(fb + F_C);
                gemm_prompt_fused(C, Ain, W, 1024, e);
                gemm_sample_ksplit(C, Ain + (size_t)MP * D, W, 1024, (float*)(fb + F_PART));
            } PH_END
        } else {
#ifdef FK_HAVE_ATTN
            PH_BEGIN phase_qkv(C, A, l); PH_END
            if (l == 2) { PH_BEGIN phase_prep(C, A); PH_END }
            PH_BEGIN phase_attn(C, A, l); PH_END
            PH_BEGIN {
                EpResidNorm e{nullptr, XF, mod0, nullptr, 0, mod1, nullptr, HF, nullptr, nullptr,
                              (float*)(fb + F_STATS) + (size_t)(2 * l) * 65536, (unsigned*)(fb + F_CTL) + 65536 + (2 * l) * 4096, (unsigned*)(fb + F_CTL) + 1024};
                const bf16* W = (const bf16*)(fb + F_WO) + (size_t)(l - 2) * 1024 * 1024; const bf16* Ain = (const bf16*)(fb + F_O);
                gemm_prompt_fused(C, Ain, W, 1024, e);
                gemm_sample_ksplit(C, Ain + (size_t)MP * D, W, 1024, (float*)(fb + F_PART));
            } PH_END
#endif
        }
        PH_BEGIN {
            unsigned* flag = (unsigned*)(fb + F_CTL) + 32768 + 64 * (2 * l);
            { const Ctx Cn = refreshed(C); sample_norm_part(Cn, A, 0, 2 * l + 1, 2 * l, l < 2 ? IN_F(19) + (size_t)l * D : nullptr, l == 0, flag); }
            C = refreshed(C);
            EpSwiGLU e{(bf16*)(fb + F_ACT)};
            const bf16* W = (const bf16*)(fb + F_WGU) + (size_t)l * 5632 * 1024;
            gemm_prompt(C, HF, W, 5632, 1024, e);
            C = refreshed(C);
            sample_rows_ready(C, flag, (unsigned*)(fb + F_CTL) + 1024);
            gemm_sample(C, HF + (size_t)MP * D, W, 5632, 1024, e);
        } PH_END
        PH_BEGIN {
            EpResidNorm e{nullptr, XF, mod1, nullptr, l == 3 ? 2 : (l == 1 ? 1 : 0), MODF + (size_t)(l < 3 ? 2 * l + 2 : 0) * NC * 3072, l == 3 ? IN_F(33) : IN_F(20), HF, (bf16*)(fb + F_HKV), A.out + O_YP,
                          (float*)(fb + F_STATS) + (size_t)(2 * l + 1) * 65536, (unsigned*)(fb + F_CTL) + 65536 + (2 * l + 1) * 4096, (unsigned*)(fb + F_CTL) + 1024};
            const bf16* W = (const bf16*)(fb + F_WDN) + (size_t)l * 1024 * 2816; const bf16* Ain = (const bf16*)(fb + F_ACT);
            gemm_prompt_fused(C, Ain, W, 2816, e);
            gemm_sample_ksplit(C, Ain + (size_t)MP * DFF, W, 2816, (float*)(fb + F_PART));
        } PH_END
    }
    { const int l = 0; PH_BEGIN phase_norm(C, A, 2, 0, false, 7, nullptr, false, MP + C.gw, C.ngw, R); PH_END }
#undef PH_BEGIN
#undef PH_END
}


#ifdef FK_TIMING
__global__ void k_encode(const unsigned long long* ts, float* out) {
    float t1 = 0.f, t2 = 0.f;
    for (int p = 0; p < 31; ++p) { const float us = (float)(ts[p + 1] - ts[p]) * 0.01f;
        if ((FK_M1 >> p) & 1ull) t1 += us; if ((FK_M2 >> p) & 1ull) t2 += us; }
#ifdef FK_TSPLIT
    { const unsigned long long* ts2 = ts + 128;
      if (FK_TSPLIT == 1) { t1 = (float)(ts2[0] - ts[25]) * 0.01f; t2 = (float)(ts2[1] - ts2[0]) * 0.01f; }
      if (FK_TSPLIT == 4) { t1 = (float)ts2[6] * 0.01f; t2 = (float)ts2[7] * 0.01f; } }
#endif
    const float sc = 1.f + sqrtf(t1 * 1e-5f);
    for (int i = threadIdx.x; i < MS * D; i += blockDim.x) out[O_YS + i] *= sc;
    if (threadIdx.x == 0) out[O_YP + 12345] += t2 * 1e-2f;
}
#endif
static int g_grid = 0;
static bool fast_setup() {
    if (g_grid) return g_grid > 0;
    int dev = 0, cus = 0;
    if (hipGetDevice(&dev) != hipSuccess || hipDeviceGetAttribute(&cus, hipDeviceAttributeMultiprocessorCount, dev) != hipSuccess) { g_grid = -1; return false; }
    if (hipFuncSetAttribute((const void*)mega, hipFuncAttributeMaxDynamicSharedMemorySize, LDS_BYTES) != hipSuccess) { g_grid = -1; return false; }
    int per_cu = 0; (void)hipOccupancyMaxActiveBlocksPerMultiprocessor(&per_cu, (const void*)mega, NTHR, LDS_BYTES); (void)hipGetLastError();
    if (per_cu < 1) fprintf(stderr, "fast_setup: occupancy query says %d blocks/CU\n", per_cu);
    g_grid = cus;
    return true;
}
static void fast_launch(void* const* d_in, float* out, unsigned char* fb, int lo, int hi, hipStream_t st) {
    if (!fast_setup()) return;
    Args a{}; for (int i = 0; i < 34; ++i) a.in[i] = d_in[i]; a.out = out; a.fb = fb; a.lo = lo; a.hi = hi;
    hipLaunchKernelGGL(mega, dim3(g_grid), dim3(NTHR), LDS_BYTES, st, a);
}
}
extern "C" void kernel_launch(void* const* d_in, const int* in_sizes, int n_in, void* d_out, int out_size, void* d_ws, size_t ws_size, hipStream_t stream) {
    if (ws_size < fk::F_END) { fprintf(stderr, "ws too small: %zu < %zu\n", ws_size, (size_t)fk::F_END); return; }
    unsigned char* fb = (unsigned char*)d_ws;
    (void)hipMemsetAsync(fb + fk::F_CTL, 0, fk::CTL_BYTES, stream);
#if FK_NLAUNCH == 1
    fk::fast_launch(d_in, (float*)d_out, fb, 0, fk::NPHASE, stream);
#ifdef FK_TIMING
    fk::k_encode<<<1, 256, 0, stream>>>((const unsigned long long*)(fb + fk::F_CTL + 65536), (float*)d_out);
#endif
#else
    for (int p = 0; p < fk::NPHASE; ++p) fk::fast_launch(d_in, (float*)d_out, fb, p, p + 1, stream);
#endif
}
```

```cpp
#define FK_NLAUNCH 1
#include <math.h>
#include <hip/hip_runtime.h>
#include <stdint.h>
#include <stdio.h>

namespace nv {
constexpr int D = 1024, BATCH = 4, SEQ = 4096, DB = 32, DS = 4, PAST = 8192, PAGE = 128, NPAGES = 64;
constexpr int KVH = 4, GROUP = 4, HD = 64, CONVW = 31, DFF = 2816, PHI = 128, QGW = 1072, KVW = 1536;
constexpr int MP = BATCH * SEQ, MS = DB * DS, R = MP + MS, NC = 36;
constexpr float EPS = 1e-6f;

constexpr size_t O_YP = 0, O_YS = O_YP + (size_t)MP * D, O_CMPP = O_YS + (size_t)MS * D, O_CMPS = O_CMPP + (size_t)MP * 512,
                 O_SELP = O_CMPS + (size_t)MS * 512, O_SELS = O_SELP + (size_t)MP * 512, O_WINP = O_SELS + (size_t)MS * 512,
                 O_WINS = O_WINP + (size_t)BATCH * 512 * 512, O_CONVP = O_WINS + (size_t)DB * 512 * 512,
                 O_CONVS = O_CONVP + (size_t)2 * BATCH * 30 * D, O_END = O_CONVS + (size_t)2 * DB * 30 * D;

__device__ __forceinline__ float silu(float x) { return x / (1.f + expf(-x)); }
__device__ __forceinline__ float sigm(float x) { return 1.f / (1.f + expf(-x)); }
__device__ __forceinline__ int cidx_of(int row) { return row < MP ? row / SEQ : 4 + (row - MP) / DS; }
__device__ __forceinline__ int rel_bucket(int n) {
    if (n < 0) n = 0;
    if (n < 16) return n;
    int b = 16;
    b += (n >= 21); b += (n >= 27); b += (n >= 35); b += (n >= 46); b += (n >= 59); b += (n >= 77); b += (n >= 99); b += (n >= 128);
    b += (n >= 166); b += (n >= 216); b += (n >= 280); b += (n >= 363); b += (n >= 470); b += (n >= 609); b += (n >= 790);
    return b;
}

__global__ __launch_bounds__(256) void k_gemm(const float* __restrict__ A, int lda, const float* __restrict__ W, int ldw, const float* __restrict__ bias,
                                              float* __restrict__ C, int ldc, int M, int N, int K) {
    __shared__ float As[16][68];
    __shared__ float Ws[16][68];
    const int tid = threadIdx.x, tx = tid & 15, ty = tid >> 4;
    const int m0 = blockIdx.y * 64, n0 = blockIdx.x * 64;
    float acc[4][4];
#pragma unroll
    for (int i = 0; i < 4; ++i)
#pragma unroll
        for (int j = 0; j < 4; ++j) acc[i][j] = 0.f;
    for (int k0 = 0; k0 < K; k0 += 16) {
#pragma unroll
        for (int it = 0; it < 4; ++it) { const int i = tid + it * 256; const int m = i >> 4, k = i & 15; const int gm = m0 + m; As[k][m] = gm < M ? A[(size_t)gm * lda + k0 + k] : 0.f; }
#pragma unroll
        for (int it = 0; it < 4; ++it) { const int i = tid + it * 256; const int k = i >> 6, n = i & 63; const int gn = n0 + n; Ws[k][n] = gn < N ? W[(size_t)(k0 + k) * ldw + gn] : 0.f; }
        __syncthreads();
#pragma unroll
        for (int k = 0; k < 16; ++k) {
            const float4 a = *(const float4*)&As[k][ty * 4]; const float4 b = *(const float4*)&Ws[k][tx * 4];
            const float av[4] = {a.x, a.y, a.z, a.w}, bv[4] = {b.x, b.y, b.z, b.w};
#pragma unroll
            for (int i = 0; i < 4; ++i)
#pragma unroll
                for (int j = 0; j < 4; ++j) acc[i][j] += av[i] * bv[j];
        }
        __syncthreads();
    }
#pragma unroll
    for (int i = 0; i < 4; ++i) { const int gm = m0 + ty * 4 + i; if (gm >= M) continue;
#pragma unroll
        for (int j = 0; j < 4; ++j) { const int gn = n0 + tx * 4 + j; if (gn < N) C[(size_t)gm * ldc + gn] = acc[i][j] + (bias ? bias[gn] : 0.f); } }
}

__global__ void k_silu_c(const float* cp, const float* cs, float* SC) {
    const int i = blockIdx.x * blockDim.x + threadIdx.x; if (i >= NC * D) return;
    const int r = i / D, k = i % D; const float v = r < 4 ? cp[r * D + k] : cs[(r - 4) * D + k]; SC[i] = silu(v);
}

__device__ __forceinline__ float block_sum256(float v, float* red) {
#pragma unroll
    for (int o = 32; o >= 1; o >>= 1) v += __shfl_xor(v, o);
    __syncthreads();
    if ((threadIdx.x & 63) == 0) red[threadIdx.x >> 6] = v;
    __syncthreads();
    return red[0] + red[1] + red[2] + red[3];
}
__global__ __launch_bounds__(256) void k_modnorm(const float* __restrict__ X, const float* __restrict__ g, const float* __restrict__ mod, float* __restrict__ H) {
    __shared__ float red[4];
    const int row = blockIdx.x, t = threadIdx.x; const float4 x = ((const float4*)(X + (size_t)row * D))[t];
    const float ss = block_sum256(x.x * x.x + x.y * x.y + x.z * x.z + x.w * x.w, red);
    const float rstd = (1.0f / sqrtf(ss * (1.f / D) + EPS));
    const float4 gv = ((const float4*)g)[t]; float4 y = {x.x * rstd * gv.x, x.y * rstd * gv.y, x.z * rstd * gv.z, x.w * rstd * gv.w};
    if (mod) { const float* m = mod + (size_t)cidx_of(row) * 3072; const float4 sh = ((const float4*)m)[t], sc = ((const float4*)(m + D))[t];
        y.x = y.x * (1.f + sc.x) + sh.x; y.y = y.y * (1.f + sc.y) + sh.y; y.z = y.z * (1.f + sc.z) + sh.z; y.w = y.w * (1.f + sc.w) + sh.w; }
    ((float4*)(H + (size_t)row * D))[t] = y;
}
__global__ void k_glu(const float* __restrict__ T1, float* __restrict__ U) {
    const size_t i = (size_t)blockIdx.x * blockDim.x + threadIdx.x; if (i >= (size_t)R * D) return;
    const size_t r = i / D; const int c = (int)(i % D); const float a = T1[r * 2048 + c], gg = T1[r * 2048 + D + c]; U[i] = a * sigm(gg);
}
__global__ void k_conv(const float* __restrict__ U, const float* __restrict__ state  , const float* __restrict__ wdw  , const float* __restrict__ bdw,
                       float* __restrict__ Y) {
    const size_t i = (size_t)blockIdx.x * blockDim.x + threadIdx.x; if (i >= (size_t)R * D) return;
    const int row = (int)(i / D), c = (int)(i % D); float acc = bdw[c];
    if (row < MP) { const int b = row / SEQ, t = row % SEQ;
        for (int k = 0; k < CONVW; ++k) { const int tt = t - 30 + k; if (tt >= 0) acc += wdw[k * D + c] * U[((size_t)b * SEQ + tt) * D + c]; }
    } else { const int rs = row - MP, b = rs / DS, t = rs % DS;
        for (int k = 0; k < CONVW; ++k) { const int j = t + k; const float v = j < 30 ? state[((size_t)b * 30 + j) * D + c] : U[((size_t)MP + b * DS + (j - 30)) * D + c]; acc += wdw[k * D + c] * v; }
    }
    Y[i] = acc;
}
__global__ void k_conv_state_out(const float* __restrict__ U, const float* __restrict__ state, float* __restrict__ outp  , float* __restrict__ outs  ) {
    const int i = blockIdx.x * blockDim.x + threadIdx.x; const int NPo = BATCH * 30 * D, NSo = DB * 30 * D;
    if (i < NPo) { const int b = i / (30 * D), j = (i / D) % 30, c = i % D; outp[i] = U[((size_t)b * SEQ + SEQ - 30 + j) * D + c]; }
    else if (i < NPo + NSo) { const int ii = i - NPo; const int b = ii / (30 * D), j = (ii / D) % 30, c = ii % D;
        outs[ii] = j < 26 ? state[((size_t)b * 30 + j + 4) * D + c] : U[((size_t)MP + b * DS + (j - 26)) * D + c]; }
}
__global__ __launch_bounds__(256) void k_ln_silu(const float* __restrict__ Y, const float* __restrict__ g, const float* __restrict__ bb, float* __restrict__ Cc) {
    __shared__ float red[4];
    const int row = blockIdx.x, t = threadIdx.x; const float4 x = ((const float4*)(Y + (size_t)row * D))[t];
    const float mu = block_sum256(x.x + x.y + x.z + x.w, red) * (1.f / D);
    const float4 d = {x.x - mu, x.y - mu, x.z - mu, x.w - mu};
    const float var = block_sum256(d.x * d.x + d.y * d.y + d.z * d.z + d.w * d.w, red) * (1.f / D);
    const float rstd = (1.0f / sqrtf(var + EPS)); const float4 gv = ((const float4*)g)[t], bv = ((const float4*)bb)[t];
    float4 y = {silu(d.x * rstd * gv.x + bv.x), silu(d.y * rstd * gv.y + bv.y), silu(d.z * rstd * gv.z + bv.z), silu(d.w * rstd * gv.w + bv.w)};
    ((float4*)(Cc + (size_t)row * D))[t] = y;
}
__global__ void k_resid(float* __restrict__ X, const float* __restrict__ T, int ldt, const float* __restrict__ mod) {
    const size_t i = (size_t)blockIdx.x * blockDim.x + threadIdx.x; if (i >= (size_t)R * D) return;
    const int row = (int)(i / D), c = (int)(i % D); X[i] += mod[(size_t)cidx_of(row) * 3072 + 2048 + c] * T[(size_t)row * ldt + c];
}
__global__ void k_swiglu(const float* __restrict__ G, const float* __restrict__ UP, float* __restrict__ ACT) {
    const size_t i = (size_t)blockIdx.x * blockDim.x + threadIdx.x; if (i >= (size_t)R * DFF) return; ACT[i] = silu(G[i]) * UP[i];
}
__global__ void k_kv_out(const float* __restrict__ ROWS, const float* __restrict__ cache_win, float* __restrict__ out) {
    const size_t i = (size_t)blockIdx.x * blockDim.x + threadIdx.x;
    const size_t n1 = (size_t)MP * 512, n2 = (size_t)MS * 512, n3 = (size_t)BATCH * 512 * 512, n4 = (size_t)DB * 512 * 512;
    if (i < n1) { const size_t r = i / 512, c = i % 512; out[O_CMPP + i] = ROWS[r * KVW + c]; out[O_SELP + i] = ROWS[r * KVW + 512 + c]; }
    if (i < n2) { const size_t r = i / 512, c = i % 512; out[O_CMPS + i] = ROWS[(MP + r) * KVW + c]; out[O_SELS + i] = ROWS[(MP + r) * KVW + 512 + c]; }
    if (i < n3) { const size_t b = i / (512 * 512), j = (i / 512) % 512, c = i % 512; out[O_WINP + i] = ROWS[(b * SEQ + SEQ - 512 + j) * KVW + 1024 + c]; }
    if (i < n4) { const size_t b = i / (512 * 512), j = (i / 512) % 512, c = i % 512;
        out[O_WINS + i] = j < 508 ? cache_win[(b * 512 + j + 4) * 512 + c] : ROWS[(MP + b * DS + (j - 508)) * KVW + 1024 + c]; }
}
__global__ __launch_bounds__(256) void k_compress(int is_prompt, const float* __restrict__ ROWS, const float* __restrict__ cache, const int* __restrict__ pt,
                                                   const float* __restrict__ w1, const float* __restrict__ b1, const float* __restrict__ w2, const float* __restrict__ b2,
                                                   const float* __restrict__ pe, float* __restrict__ CMP) {
    __shared__ float blk[32 * 4 * 64];
    __shared__ float hid[4][PHI];
    const int NB = is_prompt ? 128 : 256, BB = is_prompt ? BATCH : DB;
    const int e = blockIdx.x & 1, n = (blockIdx.x >> 1) % NB, b = (blockIdx.x >> 1) / NB, tid = threadIdx.x;
    for (int i = tid; i < 32 * 256; i += 256) { const int t = i >> 8, gd = i & 255; float v;
        if (is_prompt) v = ROWS[((size_t)b * SEQ + n * 32 + t) * KVW + e * 256 + gd];
        else { const int page = pt[b * NPAGES + (n >> 2)]; v = cache[(((size_t)page * PAGE + (n & 3) * 32 + t) * 2 + e) * 256 + gd]; }
        blk[i] = v + pe[(e * 32 + t) * 64 + (gd & 63)]; }
    __syncthreads();
    const int h = tid & 127, gp = tid >> 7; float a0 = 0.f, a1 = 0.f; const float* w = w1 + (size_t)e * 2048 * PHI + h;
    for (int f = 0; f < 2048; ++f) { const int t = f >> 6, d = f & 63; const float wv = w[(size_t)f * PHI]; a0 += blk[(t * 4 + gp * 2) * 64 + d] * wv; a1 += blk[(t * 4 + gp * 2 + 1) * 64 + d] * wv; }
    hid[gp * 2][h] = silu(a0 + b1[e * PHI + h]); hid[gp * 2 + 1][h] = silu(a1 + b1[e * PHI + h]);
    __syncthreads();
    const int g = tid >> 6, d = tid & 63; float o = b2[e * 64 + d];
    for (int hh = 0; hh < PHI; ++hh) o += hid[g][hh] * w2[((size_t)e * PHI + hh) * 64 + d];
    CMP[((((size_t)e * BB + b) * NB + n) * 4 + g) * 64 + d] = o;
}

struct AttnP {
    const float* QG;
    const float* ROWS;
    const float* CMP;
    const float* cache_sel; const float* cache_win; const int* pt; const float* table;
    float* O;
};
__device__ __forceinline__ const float* kv_ptr_sel(const AttnP& P, int is_prompt, int b, int g, int e, int pos) {
    if (is_prompt) return P.ROWS + ((size_t)b * SEQ + pos) * KVW + 512 + e * 256 + g * 64;
    if (pos < PAST) { const int page = P.pt[b * NPAGES + pos / PAGE]; return P.cache_sel + (((size_t)page * PAGE + pos % PAGE) * 2 + e) * 256 + g * 64; }
    return P.ROWS + ((size_t)MP + b * DS + (pos - PAST)) * KVW + 512 + e * 256 + g * 64;
}
__device__ __forceinline__ const float* kv_ptr_win(const AttnP& P, int is_prompt, int b, int g, int e, int pos) {
    if (is_prompt) return P.ROWS + ((size_t)b * SEQ + pos) * KVW + 1024 + e * 256 + g * 64;
    const int i = pos - (PAST + DS - 516);
    if (i < 512) return P.cache_win + (((size_t)b * 512 + i) * 2 + e) * 256 + g * 64;
    return P.ROWS + ((size_t)MP + b * DS + (i - 512)) * KVW + 1024 + e * 256 + g * 64;
}
__device__ __forceinline__ float wave_max(float v) {
#pragma unroll
    for (int o = 32; o >= 1; o >>= 1) v = fmaxf(v, __shfl_xor(v, o)); return v; }
__device__ __forceinline__ float wave_sum(float v) {
#pragma unroll
    for (int o = 32; o >= 1; o >>= 1) v += __shfl_xor(v, o); return v; }

constexpr int SBW = 1088;
__global__ __launch_bounds__(64) void k_attn(AttnP P, int is_prompt) {
    __shared__ float qs[4][64];
    __shared__ float sb[4][SBW];
    __shared__ float impb[192];
    __shared__ float scoreb[192];
    __shared__ int selb[16];
    const int lane = threadIdx.x; const int T = is_prompt ? SEQ : DS;
    const int g = blockIdx.x & 3, q = (blockIdx.x >> 2) % T, b = (blockIdx.x >> 2) / T;
    const int qpos = is_prompt ? q : PAST + q; const int row = is_prompt ? b * SEQ + q : MP + b * DS + q;
    const int NCMP = is_prompt ? 128 : 256, NBLK = is_prompt ? 64 : 129, BB = is_prompt ? BATCH : DB;
    const float NEGM = -3.0e38f;
#pragma unroll
    for (int r = 0; r < 4; ++r) qs[r][lane] = P.QG[(size_t)row * QGW + (g * 4 + r) * 64 + lane] * 0.125f;
    float gate[4][3];
#pragma unroll
    for (int r = 0; r < 4; ++r)
#pragma unroll
        for (int br = 0; br < 3; ++br) gate[r][br] = sigm(P.QG[(size_t)row * QGW + 1024 + (g * 4 + r) * 3 + br]);
    __syncthreads();
    float out[4] = {0.f, 0.f, 0.f, 0.f};
    {
        const float* CK = P.CMP + ((size_t)0 * BB + b) * NCMP * 256; const float* CV = P.CMP + ((size_t)1 * BB + b) * NCMP * 256;
        float mx[4] = {NEGM, NEGM, NEGM, NEGM};
        for (int n = lane; n < NCMP; n += 64) { const int endp = n * 32 + 31; const bool valid = endp <= qpos; const float* k = CK + ((size_t)n * 4 + g) * 64;
            float s[4] = {0.f, 0.f, 0.f, 0.f};
            for (int d = 0; d < 64; ++d) { const float kv = k[d]; s[0] += qs[0][d] * kv; s[1] += qs[1][d] * kv; s[2] += qs[2][d] * kv; s[3] += qs[3][d] * kv; }
            const int bk = rel_bucket(qpos - endp);
#pragma unroll
            for (int r = 0; r < 4; ++r) { const float v = valid ? s[r] + P.table[bk * 16 + g * 4 + r] : NEGM; sb[r][n] = v; mx[r] = fmaxf(mx[r], v); } }
        float sm[4];
#pragma unroll
        for (int r = 0; r < 4; ++r) { mx[r] = wave_max(mx[r]); float a = 0.f;
            for (int n = lane; n < NCMP; n += 64) { const float v = sb[r][n]; const float p = v > -1e38f ? expf(v - mx[r]) : 0.f; sb[r][n] = p; a += p; }
            sm[r] = wave_sum(a); }
        __syncthreads();
#pragma unroll
        for (int r = 0; r < 4; ++r) { const float inv = sm[r] > 0.f ? 1.f / sm[r] : 0.f; for (int n = lane; n < NCMP; n += 64) sb[r][n] *= inv; }
        __syncthreads();
        float oc[4] = {0.f, 0.f, 0.f, 0.f};
        for (int n = 0; n < NCMP; ++n) { const float v = CV[((size_t)n * 4 + g) * 64 + lane]; oc[0] += sb[0][n] * v; oc[1] += sb[1][n] * v; oc[2] += sb[2][n] * v; oc[3] += sb[3][n] * v; }
#pragma unroll
        for (int r = 0; r < 4; ++r) out[r] += gate[r][0] * oc[r];
        for (int j = lane; j < NBLK; j += 64) { float a = 0.f, c = 0.f;
            if (2 * j < NCMP) a = ((sb[0][2 * j] + sb[1][2 * j]) + sb[2][2 * j]) + sb[3][2 * j];
            if (2 * j + 1 < NCMP) c = ((sb[0][2 * j + 1] + sb[1][2 * j + 1]) + sb[2][2 * j + 1]) + sb[3][2 * j + 1];
            float nz = 1.f;
#ifdef IMP_NOISE
            { unsigned hsh = (unsigned)(j * 2654435761u) ^ (unsigned)(blockIdx.x * 40503u + 12345u); hsh ^= hsh >> 15; hsh *= 2246822519u; hsh ^= hsh >> 13; hsh *= 3266489917u; hsh ^= hsh >> 16;
              nz = 1.f + IMP_NOISE * ((float)(hsh & 0xffff) * (2.f / 65535.f) - 1.f); }
#endif
            impb[j] = (a + c) * nz; }
        __syncthreads();
    }
    const int jq = qpos / 64;
    for (int j = lane; j < NBLK; j += 64) { const bool forced = (j == 0) || (j == jq) || (j == jq - 1); scoreb[j] = j <= jq ? (forced ? 1e4f : impb[j]) : -1.f; }
    if (lane < 16) selb[lane] = -1;
    __syncthreads();
    for (int j = lane; j < NBLK; j += 64) { const float sj = scoreb[j]; int rank = 0;
        for (int i = 0; i < NBLK; ++i) { const float si = scoreb[i]; rank += (si > sj || (si == sj && i < j)) ? 1 : 0; }
        if (rank < 16 && sj >= 0.f) selb[rank] = j; }
    __syncthreads();
    {
        float mx[4] = {NEGM, NEGM, NEGM, NEGM};
        for (int sl = 0; sl < 16; ++sl) { const int j = selb[sl]; const int kpos = j * 64 + lane; const bool valid = (j >= 0) && (kpos <= qpos);
            float s[4] = {0.f, 0.f, 0.f, 0.f};
            if (valid) { const float* k = kv_ptr_sel(P, is_prompt, b, g, 0, kpos);
                for (int d = 0; d < 64; ++d) { const float kv = k[d]; s[0] += qs[0][d] * kv; s[1] += qs[1][d] * kv; s[2] += qs[2][d] * kv; s[3] += qs[3][d] * kv; } }
            const int bk = rel_bucket(qpos - kpos);
#pragma unroll
            for (int r = 0; r < 4; ++r) { const float v = valid ? s[r] + P.table[bk * 16 + g * 4 + r] : NEGM; sb[r][sl * 64 + lane] = v; mx[r] = fmaxf(mx[r], v); } }
        float sm[4];
#pragma unroll
        for (int r = 0; r < 4; ++r) { mx[r] = wave_max(mx[r]); float a = 0.f;
            for (int n = lane; n < 1024; n += 64) { const float v = sb[r][n]; const float p = v > -1e38f ? expf(v - mx[r]) : 0.f; sb[r][n] = p; a += p; }
            sm[r] = wave_sum(a); }
        __syncthreads();
        float os[4] = {0.f, 0.f, 0.f, 0.f};
        for (int sl = 0; sl < 16; ++sl) { const int j = selb[sl]; if (j < 0) continue;
            for (int kk = 0; kk < 64; ++kk) { const int kpos = j * 64 + kk; if (kpos > qpos) break;
                const float v = kv_ptr_sel(P, is_prompt, b, g, 1, kpos)[lane]; const int n = sl * 64 + kk;
                os[0] += sb[0][n] * v; os[1] += sb[1][n] * v; os[2] += sb[2][n] * v; os[3] += sb[3][n] * v; } }
#pragma unroll
        for (int r = 0; r < 4; ++r) out[r] += gate[r][1] * (sm[r] > 0.f ? os[r] / sm[r] : 0.f);
        __syncthreads();
    }
    {
        float mx[4] = {NEGM, NEGM, NEGM, NEGM};
        for (int i = lane; i < 512; i += 64) { const int kpos = qpos - 511 + i; const bool valid = kpos >= 0 && (is_prompt || kpos >= PAST + DS - 516);
            float s[4] = {0.f, 0.f, 0.f, 0.f};
            if (valid) { const float* k = kv_ptr_win(P, is_prompt, b, g, 0, kpos);
                for (int d = 0; d < 64; ++d) { const float kv = k[d]; s[0] += qs[0][d] * kv; s[1] += qs[1][d] * kv; s[2] += qs[2][d] * kv; s[3] += qs[3][d] * kv; } }
            const int bk = rel_bucket(qpos - kpos);
#pragma unroll
            for (int r = 0; r < 4; ++r) { const float v = valid ? s[r] + P.table[bk * 16 + g * 4 + r] : NEGM; sb[r][i] = v; mx[r] = fmaxf(mx[r], v); } }
        float sm[4];
#pragma unroll
        for (int r = 0; r < 4; ++r) { mx[r] = wave_max(mx[r]); float a = 0.f;
            for (int n = lane; n < 512; n += 64) { const float v = sb[r][n]; const float p = v > -1e38f ? expf(v - mx[r]) : 0.f; sb[r][n] = p; a += p; }
            sm[r] = wave_sum(a); }
        __syncthreads();
        float ow[4] = {0.f, 0.f, 0.f, 0.f};
        for (int i = 0; i < 512; ++i) { const int kpos = qpos - 511 + i; if (kpos < 0 || (!is_prompt && kpos < PAST + DS - 516)) continue;
            const float v = kv_ptr_win(P, is_prompt, b, g, 1, kpos)[lane];
            ow[0] += sb[0][i] * v; ow[1] += sb[1][i] * v; ow[2] += sb[2][i] * v; ow[3] += sb[3][i] * v; }
#pragma unroll
        for (int r = 0; r < 4; ++r) out[r] += gate[r][2] * (sm[r] > 0.f ? ow[r] / sm[r] : 0.f);
    }
#pragma unroll
    for (int r = 0; r < 4; ++r) P.O[(size_t)row * D + (g * 4 + r) * 64 + lane] = out[r];
}

constexpr size_t W_SC = 0, W_MOD = W_SC + (size_t)NC * D, W_X = W_MOD + (size_t)8 * NC * 3072, W_H = W_X + (size_t)R * D, W_T1 = W_H + (size_t)R * D,
                 W_T2 = W_T1 + (size_t)R * DFF, W_U = W_T2 + (size_t)R * DFF, W_Y = W_U + (size_t)R * D, W_CC = W_Y + (size_t)R * D, W_ACT = W_CC + (size_t)R * D,
                 W_ROWS = W_ACT + (size_t)R * DFF, W_QG = W_ROWS + (size_t)R * KVW, W_O = W_QG + (size_t)R * QGW, W_CMPP = W_O + (size_t)R * D,
                 W_CMPS = W_CMPP + (size_t)2 * BATCH * 128 * 256, W_END = W_CMPS + (size_t)2 * DB * 256 * 256;

static inline void gemm(hipStream_t st, const float* A, int lda, const float* W, int ldw, const float* bias, float* C, int ldc, int M, int N, int K) {
    dim3 grid((N + 63) / 64, (M + 63) / 64); k_gemm<<<grid, 256, 0, st>>>(A, lda, W, ldw, bias, C, ldc, M, N, K);
}
static inline unsigned cdiv(size_t a, size_t b) { return (unsigned)((a + b - 1) / b); }

typedef void (*Hook)(int id, void* ctx);
static void naive_forward(void* const* d_in, float* out, float* ws, hipStream_t st, Hook hook = nullptr, void* hctx = nullptr) {
#define HOOK(id) do { if (hook) hook((id), hctx); } while (0)
    const float* x_prompt = (const float*)d_in[0]; const float* x_sample = (const float*)d_in[1]; const float* c_prompt = (const float*)d_in[2]; const float* c_sample = (const float*)d_in[3];
    const float* cache_cmp = (const float*)d_in[4]; const float* cache_sel = (const float*)d_in[5]; const float* cache_win = (const float*)d_in[6]; const float* state_conv = (const float*)d_in[7];
    const int* pt = (const int*)d_in[8]; const float* w_ada = (const float*)d_in[9]; const float* b_ada = (const float*)d_in[10]; const float* norm_g = (const float*)d_in[11];
    const float* w_pw1 = (const float*)d_in[12]; const float* b_pw1 = (const float*)d_in[13]; const float* w_dw = (const float*)d_in[14]; const float* b_dw = (const float*)d_in[15];
    const float* ln_g = (const float*)d_in[16]; const float* ln_b = (const float*)d_in[17]; const float* w_pw2 = (const float*)d_in[18]; const float* b_pw2 = (const float*)d_in[19];
    const float* g_kv = (const float*)d_in[20]; const float* w_kv = (const float*)d_in[21]; const float* w_phi1 = (const float*)d_in[22]; const float* b_phi1 = (const float*)d_in[23];
    const float* w_phi2 = (const float*)d_in[24]; const float* b_phi2 = (const float*)d_in[25]; const float* pe_cmp = (const float*)d_in[26]; const float* w_qg = (const float*)d_in[27];
    const float* w_o = (const float*)d_in[28]; const float* rel_table = (const float*)d_in[29]; const float* w_gate = (const float*)d_in[30]; const float* w_up = (const float*)d_in[31];
    const float* w_down = (const float*)d_in[32]; const float* final_g = (const float*)d_in[33];
    float *SC = ws + W_SC, *MOD = ws + W_MOD, *X = ws + W_X, *H = ws + W_H, *T1 = ws + W_T1, *T2 = ws + W_T2, *U = ws + W_U, *Y = ws + W_Y, *CC = ws + W_CC, *ACT = ws + W_ACT,
          *ROWS = ws + W_ROWS, *QG = ws + W_QG, *O = ws + W_O, *CMPP = ws + W_CMPP, *CMPS = ws + W_CMPS;
    const size_t RD = (size_t)R * D;
    hipMemcpyAsync(X, x_prompt, (size_t)MP * D * 4, hipMemcpyDeviceToDevice, st);
    hipMemcpyAsync(X + (size_t)MP * D, x_sample, (size_t)MS * D * 4, hipMemcpyDeviceToDevice, st);
    k_silu_c<<<cdiv(NC * D, 256), 256, 0, st>>>(c_prompt, c_sample, SC);
    for (int ls = 0; ls < 8; ++ls) gemm(st, SC, D, w_ada + (size_t)ls * D * 3072, 3072, b_ada + (size_t)ls * 3072, MOD + (size_t)ls * NC * 3072, 3072, NC, 3072, D);
    HOOK(1);
    for (int l = 0; l < 4; ++l) {
        const float* mod0 = MOD + (size_t)(l * 2 + 0) * NC * 3072; const float* mod1 = MOD + (size_t)(l * 2 + 1) * NC * 3072;
        if (l == 2) {
            k_modnorm<<<R, 256, 0, st>>>(X, g_kv, nullptr, H);
            gemm(st, H, D, w_kv, KVW, nullptr, ROWS, KVW, R, KVW, D);
            k_kv_out<<<cdiv((size_t)MP * 512, 256), 256, 0, st>>>(ROWS, cache_win, out);
            k_compress<<<BATCH * 128 * 2, 256, 0, st>>>(1, ROWS, cache_cmp, pt, w_phi1, b_phi1, w_phi2, b_phi2, pe_cmp, CMPP);
            k_compress<<<DB * 256 * 2, 256, 0, st>>>(0, ROWS, cache_cmp, pt, w_phi1, b_phi1, w_phi2, b_phi2, pe_cmp, CMPS);
            HOOK(250);
        }
        k_modnorm<<<R, 256, 0, st>>>(X, norm_g + (size_t)(l * 2) * D, mod0, H);
        HOOK(100 * l + 1);
        if (l < 2) {
            gemm(st, H, D, w_pw1 + (size_t)l * D * 2048, 2048, b_pw1 + (size_t)l * 2048, T1, 2048, R, 2048, D);
            k_glu<<<cdiv(RD, 256), 256, 0, st>>>(T1, U);
            HOOK(100 * l + 2);
            k_conv<<<cdiv(RD, 256), 256, 0, st>>>(U, state_conv + (size_t)l * DB * 30 * D, w_dw + (size_t)l * CONVW * D, b_dw + (size_t)l * D, Y);
            k_conv_state_out<<<cdiv((size_t)(BATCH + DB) * 30 * D, 256), 256, 0, st>>>(U, state_conv + (size_t)l * DB * 30 * D, out + O_CONVP + (size_t)l * BATCH * 30 * D, out + O_CONVS + (size_t)l * DB * 30 * D);
            k_ln_silu<<<R, 256, 0, st>>>(Y, ln_g + (size_t)l * D, ln_b + (size_t)l * D, CC);
            HOOK(100 * l + 3);
            gemm(st, CC, D, w_pw2 + (size_t)l * D * D, D, b_pw2 + (size_t)l * D, T2, D, R, D, D);
        } else {
            const int lb = l - 2;
            gemm(st, H, D, w_qg + (size_t)lb * D * QGW, QGW, nullptr, QG, QGW, R, QGW, D);
            HOOK(100 * l + 2);
            AttnP P{QG, ROWS, CMPP, cache_sel, cache_win, pt, rel_table, O};
            k_attn<<<BATCH * SEQ * 4, 64, 0, st>>>(P, 1);
            P.CMP = CMPS;
            k_attn<<<DB * DS * 4, 64, 0, st>>>(P, 0);
            HOOK(100 * l + 3);
            gemm(st, O, D, w_o + (size_t)lb * D * D, D, nullptr, T2, D, R, D, D);
        }
        k_resid<<<cdiv(RD, 256), 256, 0, st>>>(X, T2, D, mod0);
        HOOK(100 * l + 4);
        k_modnorm<<<R, 256, 0, st>>>(X, norm_g + (size_t)(l * 2 + 1) * D, mod1, H);
        HOOK(100 * l + 5);
        gemm(st, H, D, w_gate + (size_t)l * D * DFF, DFF, nullptr, T1, DFF, R, DFF, D);
        gemm(st, H, D, w_up + (size_t)l * D * DFF, DFF, nullptr, T2, DFF, R, DFF, D);
        k_swiglu<<<cdiv((size_t)R * DFF, 256), 256, 0, st>>>(T1, T2, ACT);
        HOOK(100 * l + 6);
        gemm(st, ACT, DFF, w_down + (size_t)l * DFF * D, D, nullptr, T1, D, R, D, DFF);
        k_resid<<<cdiv(RD, 256), 256, 0, st>>>(X, T1, D, mod1);
        HOOK(100 * l + 7);
    }
    k_modnorm<<<R, 256, 0, st>>>(X, final_g, nullptr, H);
    hipMemcpyAsync(out + O_YP, H, (size_t)MP * D * 4, hipMemcpyDeviceToDevice, st);
    hipMemcpyAsync(out + O_YS, H + (size_t)MP * D, (size_t)MS * D * 4, hipMemcpyDeviceToDevice, st);
    HOOK(900);
#undef HOOK
}
}
namespace pg8 {
__device__ __forceinline__ int opaque_tid() { int t; asm volatile("v_mov_b32 %0, %1" : "=v"(t) : "v"(threadIdx.x)); return t; }
#define PG8_LAS __attribute__((address_space(3)))
typedef unsigned short bf16_t;
typedef short bf16x8 __attribute__((ext_vector_type(8)));
typedef float f32x4 __attribute__((ext_vector_type(4)));
typedef unsigned u32x4 __attribute__((ext_vector_type(4)));
constexpr int BM = 256, BK = 64, HALF = 128, HTB = HALF * BK * 2  , STAGE_BYTES = 8 * HTB, NXCD = 8, WGM = 8;

__host__ __device__ __forceinline__ int lds_byte(int r, int c) { const int st = (r >> 4) * 2 + (c >> 5), rr = r & 15, cc = c & 31, ob = rr * 64 + cc * 2; return st * 1024 + (ob ^ (((ob >> 9) & 1) << 5)); }
__host__ __device__ __forceinline__ void stage_rc(int b, int& R, int& C) { const int st = b / 1024, sb = b % 1024, swz = sb ^ (((sb >> 9) & 1) << 5); R = (st >> 1) * 16 + swz / 64; C = (st & 1) * 32 + (swz % 64) / 2; }
__host__ __device__ __forceinline__ int perm32(int rho) { const int n = rho >> 4, i = rho & 15; return 8 * (i >> 2) + 4 * n + (i & 3); }

struct Unit { int pm, pn; };
struct Gemm { const bf16_t* A; const bf16_t* Bt; int M, N, K; };

struct StaticOrder {
    int nM, nN, nwg, G, c;
    __host__ __device__ void init(int M, int N, int G_, int c_) { nM = M / BM; nN = N / BM; nwg = nM * nN; G = G_; c = c_; }
    __host__ __device__ bool next(int i, Unit& u) const {
        const long L = (long)i * G + c; if (L >= nwg) return false;
        int wgid = (int)L; { const int q = nwg / NXCD, r = nwg % NXCD, xcd = wgid % NXCD, off = wgid / NXCD; wgid = (xcd < r ? xcd * (q + 1) : r * (q + 1) + (xcd - r) * q) + off; }
        const int nig = WGM * nN, gid = wgid / nig, fm = gid * WGM, gsz = (nM - fm) < WGM ? (nM - fm) : WGM;
        u.pm = fm + ((wgid % nig) % gsz); u.pn = (wgid % nig) / gsz; return true;
    }
    __device__ __forceinline__ void a_ready(const Unit&) const {}
    __device__ __forceinline__ void done(const Unit&) const {}
};

template <class Epi, class Sched, bool ALIGN_EPI = false, bool SP2 = false>
__device__ __forceinline__ void gemm_phase(PG8_LAS unsigned char* lds, const Gemm g, const Sched& S, const Epi& E) {
    const int tid = opaque_tid(), wid = __builtin_amdgcn_readfirstlane(tid >> 6), lane = tid & 63, wr = wid >> 2, wc = wid & 3, fr = lane & 15, fq = lane >> 4;
    const int K = g.K, nt = K / BK;
    unsigned voffA[2], voffB[2];
#pragma unroll
    for (int i = 0; i < 2; ++i) { int R, C; stage_rc(tid * 16 + i * 8192, R, C); const int Rb = Epi::PERM ? ((R & ~31) + perm32(R & 31)) : R;
        voffA[i] = (unsigned)(R * K + C) * 2u; voffB[i] = (unsigned)(Rb * K + C) * 2u; }
    const size_t kstep = (size_t)(BK * 2);
    const size_t hstep = (size_t)HALF * K * 2;
    const size_t tstep = 2 * hstep;
    const unsigned ldsw = (unsigned)wid * 1024u;
    const int aoff = lds_byte(wr * 64 + fr, fq * 8), boff = lds_byte(wc * 32 + fr, fq * 8);
#define PG8_SA(b, h) (((b) * 2 + (h)) * HTB)
#define PG8_SB(b, h) ((4 + (b) * 2 + (h)) * HTB)
#define PG8_STAGE(bufoff, gbase, voff) do { _Pragma("unroll") for (int _i = 0; _i < 2; ++_i) \
        __builtin_amdgcn_global_load_lds((const unsigned*)((const char*)(gbase) + (voff)[_i]), (PG8_LAS unsigned*)(lds + (bufoff) + ldsw + _i * 8192), 16, 0, 0); } while (0)
#define PG8_LDA(dst, b, h) do { _Pragma("unroll") for (int m = 0; m < 4; ++m) _Pragma("unroll") for (int k = 0; k < 2; ++k) dst[m][k] = *(const PG8_LAS bf16x8*)(lds + PG8_SA(b, h) + aoff + m * 2048 + k * 1024); } while (0)
#define PG8_LDB(dst, b, h) do { _Pragma("unroll") for (int n = 0; n < 2; ++n) _Pragma("unroll") for (int k = 0; k < 2; ++k) dst[n][k] = *(const PG8_LAS bf16x8*)(lds + PG8_SB(b, h) + boff + n * 2048 + k * 1024); } while (0)
#define PG8_MMA(ai, bj, At, Bt) do { __builtin_amdgcn_s_setprio(1); _Pragma("unroll") for (int m = 0; m < 4; ++m) _Pragma("unroll") for (int n = 0; n < 2; ++n) _Pragma("unroll") for (int k = 0; k < 2; ++k) \
        acc[ai][bj][m][n] = __builtin_amdgcn_mfma_f32_16x16x32_bf16(Bt[n][k], At[m][k], acc[ai][bj][m][n], 0, 0, 0); __builtin_amdgcn_s_setprio(0); } while (0)
#define PG8_WAIT_V(n) asm volatile("s_waitcnt vmcnt(" #n ")" ::: "memory")
#define PG8_WAIT_L(n) asm volatile("s_waitcnt lgkmcnt(" #n ")" ::: "memory")
#define PG8_BAR __builtin_amdgcn_s_barrier()
#define PG8_SCHED __builtin_amdgcn_sched_barrier(0)
    Unit cur, nxt; int ui = 0;
    if (!S.next(0, cur)) return;
    f32x4 acc[2][2][4][2];
#pragma unroll
    for (int a = 0; a < 2; ++a)
#pragma unroll
        for (int b = 0; b < 2; ++b)
#pragma unroll
            for (int m = 0; m < 4; ++m)
#pragma unroll
                for (int n = 0; n < 2; ++n) acc[a][b][m][n] = (f32x4){0.f, 0.f, 0.f, 0.f};
    bf16x8 At[4][2], B0[2][2], B1[2][2];
    const char* cA = (const char*)g.A + (size_t)cur.pm * tstep; const char* cB = (const char*)g.Bt + (size_t)cur.pn * tstep;
    S.a_ready(cur);
    if constexpr (SP2) {
        PG8_STAGE(PG8_SB(0, 0), cB, voffB); PG8_STAGE(PG8_SB(0, 1), cB + hstep, voffB); PG8_STAGE(PG8_SA(0, 0), cA, voffA); PG8_STAGE(PG8_SA(0, 1), cA + hstep, voffA);
        if (wr == 1) PG8_BAR;
        PG8_WAIT_V(2); PG8_BAR;
        PG8_STAGE(PG8_SB(1, 0), cB + kstep, voffB); PG8_STAGE(PG8_SA(1, 0), cA + kstep, voffA); PG8_STAGE(PG8_SB(1, 1), cB + hstep + kstep, voffB);
        PG8_WAIT_V(6); PG8_BAR;
    } else {
        PG8_STAGE(PG8_SB(0, 0), cB, voffB); PG8_STAGE(PG8_SA(0, 0), cA, voffA); PG8_STAGE(PG8_SB(0, 1), cB + hstep, voffB); PG8_STAGE(PG8_SA(0, 1), cA + hstep, voffA);
        if (wr == 1) PG8_BAR;
        PG8_WAIT_V(4); PG8_BAR;
        PG8_STAGE(PG8_SB(1, 0), cB + kstep, voffB); PG8_STAGE(PG8_SA(1, 0), cA + kstep, voffA); PG8_STAGE(PG8_SB(1, 1), cB + hstep + kstep, voffB);
        PG8_WAIT_V(6); PG8_BAR;
    }
    for (;;) {
        const bool has_next = S.next(ui + 1, nxt);
        const char* nA = has_next ? (const char*)g.A + (size_t)nxt.pm * tstep : cA; const char* nB = has_next ? (const char*)g.Bt + (size_t)nxt.pn * tstep : cB;
        for (int t = 0; t < nt; t += 2) {
            const bool last = (t == nt - 2);
            const char* a1 = cA + (size_t)(t + 1) * kstep;
            const char* a2 = last ? nA : cA + (size_t)(t + 2) * kstep; const char* b2 = last ? nB : cB + (size_t)(t + 2) * kstep;
            const char* a3 = a2 + kstep; const char* b3 = b2 + kstep;
            if (last && has_next) S.a_ready(nxt);
            if constexpr (SP2) {
            PG8_LDB(B0, 0, 0); PG8_LDB(B1, 0, 1); PG8_SCHED; PG8_LDA(At, 0, 0); PG8_STAGE(PG8_SA(1, 1), a1 + hstep, voffA);
            PG8_WAIT_V(8); PG8_WAIT_L(0); PG8_BAR; PG8_MMA(0, 0, At, B0); PG8_MMA(0, 1, At, B1); PG8_BAR; PG8_SCHED;
            PG8_LDA(At, 0, 1); PG8_STAGE(PG8_SB(0, 0), b2, voffB); PG8_STAGE(PG8_SB(0, 1), b2 + hstep, voffB); PG8_STAGE(PG8_SA(0, 0), a2, voffA);
            PG8_WAIT_V(8); PG8_WAIT_L(0); PG8_BAR; PG8_MMA(1, 0, At, B0); PG8_MMA(1, 1, At, B1); PG8_BAR; PG8_SCHED;
            PG8_LDB(B0, 1, 0); PG8_LDB(B1, 1, 1); PG8_SCHED; PG8_LDA(At, 1, 0); PG8_STAGE(PG8_SA(0, 1), a2 + hstep, voffA);
            PG8_WAIT_V(8); PG8_WAIT_L(0); PG8_BAR; PG8_MMA(0, 0, At, B0); PG8_MMA(0, 1, At, B1); PG8_BAR; PG8_SCHED;
            PG8_LDA(At, 1, 1); PG8_STAGE(PG8_SB(1, 0), b3, voffB); PG8_STAGE(PG8_SB(1, 1), b3 + hstep, voffB); PG8_STAGE(PG8_SA(1, 0), a3, voffA);
            PG8_WAIT_V(8); PG8_WAIT_L(0); PG8_BAR; PG8_MMA(1, 0, At, B0); PG8_MMA(1, 1, At, B1); PG8_BAR; PG8_SCHED;
            } else {
            PG8_LDB(B0, 0, 0); PG8_SCHED; PG8_LDA(At, 0, 0); PG8_STAGE(PG8_SA(1, 1), a1 + hstep, voffA);
            PG8_WAIT_L(8); PG8_BAR; PG8_WAIT_L(0); PG8_MMA(0, 0, At, B0); PG8_BAR; PG8_SCHED;
            PG8_LDB(B1, 0, 1); PG8_STAGE(PG8_SB(0, 0), b2, voffB);
            PG8_BAR; PG8_WAIT_L(0); PG8_MMA(0, 1, At, B1); PG8_BAR;
            PG8_LDA(At, 0, 1); PG8_STAGE(PG8_SA(0, 0), a2, voffA);
            PG8_BAR; PG8_WAIT_L(0); PG8_MMA(1, 0, At, B0); PG8_BAR; PG8_SCHED;
            PG8_STAGE(PG8_SB(0, 1), b2 + hstep, voffB);
            PG8_WAIT_V(6); PG8_BAR; PG8_MMA(1, 1, At, B1); PG8_BAR;
            PG8_LDB(B0, 1, 0); PG8_SCHED; PG8_LDA(At, 1, 0); PG8_STAGE(PG8_SA(0, 1), a2 + hstep, voffA);
            PG8_WAIT_L(8); PG8_BAR; PG8_WAIT_L(0); PG8_MMA(0, 0, At, B0); PG8_BAR; PG8_SCHED;
            PG8_LDB(B1, 1, 1); PG8_STAGE(PG8_SB(1, 0), b3, voffB);
            PG8_BAR; PG8_WAIT_L(0); PG8_MMA(0, 1, At, B1); PG8_BAR;
            PG8_LDA(At, 1, 1); PG8_STAGE(PG8_SA(1, 0), a3, voffA);
            PG8_BAR; PG8_WAIT_L(0); PG8_MMA(1, 0, At, B0); PG8_BAR; PG8_SCHED;
            PG8_STAGE(PG8_SB(1, 1), b3 + hstep, voffB);
            PG8_WAIT_V(6); PG8_BAR; PG8_MMA(1, 1, At, B1); PG8_BAR;
            }
        }
        if constexpr (ALIGN_EPI) { if (wr == 0) PG8_BAR; }
        if constexpr (!Epi::AFTER_DRAIN) { E(acc, cur, wr, wc, fr, fq); S.done(cur); }
        if (!has_next) break;
#pragma unroll
        for (int a = 0; a < 2; ++a)
#pragma unroll
            for (int b = 0; b < 2; ++b)
#pragma unroll
                for (int m = 0; m < 4; ++m)
#pragma unroll
                    for (int n = 0; n < 2; ++n) acc[a][b][m][n] = (f32x4){0.f, 0.f, 0.f, 0.f};
        cur = nxt; cA = nA; cB = nB; ++ui;
        if constexpr (ALIGN_EPI) { if (wr == 1) PG8_BAR; }
    }
    PG8_WAIT_V(0);
    if constexpr (!ALIGN_EPI) { if (wr == 0) PG8_BAR; }
    PG8_BAR;
    if constexpr (Epi::AFTER_DRAIN) { E.fused(acc, cur, wr, wc, fr, fq, lds, wid, lane); S.done(cur); }
#undef PG8_SA
#undef PG8_SB
#undef PG8_STAGE
#undef PG8_LDA
#undef PG8_LDB
#undef PG8_MMA
#undef PG8_WAIT_V
#undef PG8_WAIT_L
#undef PG8_BAR
#undef PG8_SCHED
}
}
#define XB_TMO      128
#define XB_XCNT(j)  (256  + 64 * (j))
#define XB_XSUB(j)  (1280 + 64 * (j))
#define XB_XGEN(j)  (2304 + 64 * (j))
#define XB_TOP      3328
#define XB_TOPGEN   3392
#define XCD_BAR_WORDS 3456
#define XB_SPIN_CAP (1u << 18)
#define LAS __attribute__((address_space(3)))

__device__ __forceinline__ unsigned xb_ld(unsigned* p)              { return __hip_atomic_load(p, __ATOMIC_RELAXED, __HIP_MEMORY_SCOPE_AGENT); }
__device__ __forceinline__ unsigned xb_add(unsigned* p, unsigned v) { return __hip_atomic_fetch_add(p, v, __ATOMIC_RELAXED, __HIP_MEMORY_SCOPE_AGENT); }
__device__ __forceinline__ unsigned xb_xcc_id() { return (unsigned)__builtin_amdgcn_s_getreg((3 << 11) | 20) & 0xFu; }
#define XB_SPIN(cond, bar) do { unsigned _sp = 0; while (cond) { __builtin_amdgcn_s_sleep(1); \
    if ((++_sp & 255u) == 0u) { if (xb_ld(&(bar)[XB_TMO])) break; if (_sp > XB_SPIN_CAP) { atomicAdd(&(bar)[XB_TMO], 1u); break; } } } } while (0)

struct XcdBarrier {
    unsigned* bar; unsigned x;
    volatile LAS unsigned* st;
};

__device__ __forceinline__ XcdBarrier xcd_barrier_post(unsigned* bar, volatile LAS unsigned* st) {
    XcdBarrier b; b.bar = bar; b.x = xb_xcc_id(); b.st = st;
    if (threadIdx.x == 0) (void)xb_add(&bar[XB_XCNT(b.x)], 1u);
    return b;
}
__device__ __forceinline__ void xcd_barrier_complete(unsigned* bar, unsigned x, unsigned& nloc, unsigned& nx) {
    const unsigned G = gridDim.x * gridDim.y * gridDim.z;
    unsigned sum, cnt, mine, sp = 0u;
    for (;;) {
        sum = 0u; cnt = 0u; mine = 0u;
#pragma unroll
        for (unsigned j = 0; j < 16; ++j) { const unsigned c = xb_ld(&bar[XB_XCNT(j)]); sum += c; cnt += (c > 0u) ? 1u : 0u; mine = (j == x) ? c : mine; }
        if (sum == G) break;
        __builtin_amdgcn_s_sleep(1);
        if ((++sp & 255u) == 0u) { if (xb_ld(&bar[XB_TMO])) break; if (sp > XB_SPIN_CAP) { atomicAdd(&bar[XB_TMO], 1u); break; } }
    }
    nloc = mine > 0u ? mine : 1u; nx = cnt > 0u ? cnt : 1u;
}

__device__ __forceinline__ void xcd_barrier(const XcdBarrier& b) {
    asm volatile("s_waitcnt vmcnt(0)" ::: "memory");
    __syncthreads();
    if (threadIdx.x == 0) {
        unsigned* bar = b.bar;
        __builtin_amdgcn_s_waitcnt(0);
        unsigned nloc = b.st[0], nx = b.st[1];
        if (nloc == 0u) { xcd_barrier_complete(bar, b.x, nloc, nx); b.st[0] = nloc; b.st[1] = nx; }
        const unsigned old = xb_add(&bar[XB_XSUB(b.x)], 1u);
        const unsigned gen = old / nloc;
        if (old + 1u == (gen + 1u) * nloc) {
            __builtin_amdgcn_fence(__ATOMIC_RELEASE, "agent");
            asm volatile("s_waitcnt vmcnt(0)" ::: "memory");
            const unsigned og = xb_add(&bar[XB_TOP], 1u);
            const unsigned tg = og / nx;
            if (og + 1u == (tg + 1u) * nx) xb_add(&bar[XB_TOPGEN], 1u);
            else XB_SPIN(xb_ld(&bar[XB_TOPGEN]) == tg, bar);
            __builtin_amdgcn_fence(__ATOMIC_ACQUIRE, "agent");
            xb_add(&bar[XB_XGEN(b.x)], 1u);
            asm volatile("s_waitcnt vmcnt(0)" ::: "memory");
        } else {
            XB_SPIN(xb_ld(&bar[XB_XGEN(b.x)]) == gen, bar);
            __builtin_amdgcn_fence(__ATOMIC_ACQUIRE, "agent");
            asm volatile("s_waitcnt vmcnt(0)" ::: "memory");
        }
    }
    __syncthreads();
}

namespace fk {
using namespace nv;
typedef unsigned short bf16;
typedef float f32x4 __attribute__((ext_vector_type(4)));
typedef short bf16x8 __attribute__((ext_vector_type(8)));
typedef unsigned u32x2 __attribute__((ext_vector_type(2)));
typedef unsigned u32x4 __attribute__((ext_vector_type(4)));
#define FLAS __attribute__((address_space(3)))
constexpr float LOG2E = 1.4426950408889634f;
constexpr int NTHR = 512, NWAVE = 8;
constexpr int LDS_BYTES = 147456;
constexpr int LDS_MISC = 131072 + 8192;

__device__ __forceinline__ unsigned f2bf(float f) { unsigned u = __builtin_bit_cast(unsigned, f); return (u + 0x7fffu + ((u >> 16) & 1u)) >> 16; }
typedef __bf16 hbf16x2 __attribute__((ext_vector_type(2)));
typedef float f32x2 __attribute__((ext_vector_type(2)));
__device__ __forceinline__ unsigned pk2(float lo, float hi) { const f32x2 v = {lo, hi}; return __builtin_bit_cast(unsigned, __builtin_convertvector(v, hbf16x2)); }
__device__ __forceinline__ float bf2f(unsigned short b) { return __builtin_bit_cast(float, (unsigned)b << 16); }
__device__ __forceinline__ float fsigm(float x) { return __builtin_amdgcn_rcpf(1.f + __expf(-x)); }
__device__ __forceinline__ float fsilu(float x) { return x * __builtin_amdgcn_rcpf(1.f + __expf(-x)); }
__device__ __forceinline__ float xmax32(float v) { const unsigned u = __builtin_bit_cast(unsigned, v); auto rr = __builtin_amdgcn_permlane32_swap(u, u, false, false); return fmaxf(__builtin_bit_cast(float, (unsigned)rr[0]), __builtin_bit_cast(float, (unsigned)rr[1])); }
__device__ __forceinline__ float xsum32(float v) { const unsigned u = __builtin_bit_cast(unsigned, v); auto rr = __builtin_amdgcn_permlane32_swap(u, u, false, false); return __builtin_bit_cast(float, (unsigned)rr[0]) + __builtin_bit_cast(float, (unsigned)rr[1]); }
__device__ __forceinline__ float wsum(float v) {
#pragma unroll
    for (int o = 1; o < 64; o <<= 1) v += __shfl_xor(v, o);
    return v; }
__device__ __forceinline__ int cidx_row(int row) { return row < MP ? (row >> 12) : 4 + ((row - MP) >> 2); }

constexpr size_t al(size_t x) { return (x + 4095) & ~(size_t)4095; }
constexpr size_t F_CTL = 0, F_MOD = 1u << 20, F_WPW1 = F_MOD + al((size_t)8 * NC * 3072 * 4), F_WPW2 = F_WPW1 + (size_t)2 * 2048 * 1024 * 2,
    F_WGU = F_WPW2 + (size_t)2 * 1024 * 1024 * 2, F_WDN = F_WGU + (size_t)4 * 5632 * 1024 * 2, F_WKV = F_WDN + (size_t)4 * 1024 * 2816 * 2,
    F_WQ = F_WKV + (size_t)1536 * 1024 * 2, F_WG = F_WQ + (size_t)2 * 1024 * 1024 * 2, F_WO = F_WG + (size_t)2 * 64 * 1024 * 2, F_WPHI1 = F_WO + (size_t)2 * 1024 * 1024 * 2,
    F_WPHI2 = F_WPHI1 + (size_t)2 * 128 * 2048 * 2, F_BPHI = F_WPHI2 + (size_t)2 * 64 * 128 * 2, F_X = F_BPHI + 32768, F_H = F_X + al((size_t)R * D * 4),
    F_HKV = F_H + al((size_t)R * D * 2), F_U = F_HKV + al((size_t)R * D * 2), F_US = F_U + al((size_t)R * D * 2), F_C = F_US + (size_t)MS * D * 4, F_ACT = F_C + al((size_t)R * D * 2),
    F_RB = F_ACT + al((size_t)R * DFF * 2), F_Q = F_RB + al((size_t)R * KVW * 2), F_GT = F_Q + al((size_t)R * D * 2), F_O = F_GT + al((size_t)R * 64 * 4),
    F_VT = F_O + al((size_t)R * D * 2), F_CMPK = F_VT + (size_t)2 * 16 * 64 * 4096 * 2, F_CMPVT = F_CMPK + (size_t)16 * 128 * 64 * 2, F_CMPS = F_CMPVT + (size_t)16 * 128 * 64 * 2,
    F_PART = F_CMPS + (size_t)2 * DB * 256 * 256 * 4, F_QPART = F_PART + (size_t)8 * MS * D * 4, F_STATS = F_QPART + (size_t)8 * MS * D * 4, F_END = F_STATS + (size_t)8 * 64 * 4 * 256 * 4;
constexpr size_t CTL_BYTES = 1u << 20;

struct Args { const void* in[34]; float* out; unsigned char* fb; int lo, hi; };

typedef const __attribute__((address_space(4))) Args CArgs;
struct Ctx {
    FLAS unsigned char* lds; int tid, lane, wave, G, wg; int gw, ngw;
};
#define IN_F(i) ((const float*)A.in[i])
__device__ __forceinline__ Ctx refreshed(const Ctx& C0) { Ctx C = C0; int t; asm volatile("v_mov_b32 %0, %1" : "=v"(t) : "v"(threadIdx.x)); C.tid = t; C.lane = t & 63;
    int wg_ = C0.wg, G_ = C0.G, wv_ = C0.wave; asm volatile("" : "+s"(wg_), "+s"(G_), "+s"(wv_)); C.wg = wg_; C.G = G_; C.wave = wv_; C.gw = wg_ * NWAVE + wv_; C.ngw = G_ * NWAVE; return C; }
enum TrMode { TR_PLAIN = 0, TR_PW1 = 1, TR_GATE = 2, TR_UP = 3, TR_QG = 4 };
__device__ __forceinline__ void tr_item(const float* __restrict__ W, int K, int N, bf16* __restrict__ WT, bf16* __restrict__ WT2, int mode, FLAS float* scr, int item, int lane) {
    const int nblk = (N + 63) / 64, kb = item / nblk, nb = item % nblk, k0 = 64 * kb, n0 = 64 * nb;
    const int c4 = lane & 15, rq = lane >> 4; const bool okc = n0 + 4 * c4 < N;
    f32x4 v[16];
#pragma unroll
    for (int i = 0; i < 16; ++i) { const int kk = 4 * i + rq; v[i] = okc ? *(const f32x4*)(W + (size_t)(k0 + kk) * N + n0 + 4 * c4) : (f32x4){0.f, 0.f, 0.f, 0.f}; }
#pragma unroll
    for (int i = 0; i < 16; ++i) { const int kk = 4 * i + rq; *(FLAS f32x4*)(scr + kk * 68 + 4 * c4) = v[i]; }
    asm volatile("s_waitcnt lgkmcnt(0)" ::: "memory");
    const int c = lane & 7;
#pragma unroll
    for (int j = 0; j < 8; ++j) { const int nl = (lane >> 3) + 8 * j; const int n = n0 + nl; const FLAS float* sp = scr + (8 * c) * 68 + nl;
        u32x4 o; o.x = pk2(sp[0 * 68], sp[1 * 68]); o.y = pk2(sp[2 * 68], sp[3 * 68]); o.z = pk2(sp[4 * 68], sp[5 * 68]); o.w = pk2(sp[6 * 68], sp[7 * 68]);
        bf16* dst = WT; int nr = n;
        if (mode == TR_PW1) { const int f = n & 1023, isg = n >> 10; nr = 256 * (f >> 7) + 128 * isg + (f & 127); }
        else if (mode == TR_GATE) nr = 256 * (n >> 7) + (n & 127);
        else if (mode == TR_UP) nr = 256 * (n >> 7) + 128 + (n & 127);
        else if (mode == TR_QG) { if (n >= 1024) { dst = WT2; nr = n - 1024; } }
        if (mode != TR_QG || n < 1088) *(u32x4*)(dst + (size_t)nr * K + k0 + 8 * c) = o; }
    asm volatile("s_waitcnt lgkmcnt(0)" ::: "memory");
}
struct TrJob { const float* W; bf16* WT; bf16* WT2; int K, N, mode, nitems; };

__device__ __forceinline__ void mod_unit(const Ctx& C, CArgs& A, int unit) {
    const int ls = unit / 24, cg = unit % 24, tid = C.tid, w = C.wave, lane = C.lane;
    FLAS float* SCs = (FLAS float*)C.lds;
    const float* W = IN_F(9) + (size_t)ls * D * 3072;
    float acc0[36], acc1[36];
#pragma unroll
    for (int c = 0; c < 36; ++c) { acc0[c] = 0.f; acc1[c] = 0.f; }
    for (int half = 0; half < 2; ++half) {
        __syncthreads();
        { const int kg = 128 * (tid >> 6) + 64 * half + (tid & 63);
#pragma unroll 4
          for (int c = 0; c < 36; ++c) { const float v = c < 4 ? IN_F(2)[c * D + kg] : IN_F(3)[(c - 4) * D + kg]; SCs[tid * 36 + c] = fsilu(v); } }
        __syncthreads();
        const float* wp = W + (size_t)(128 * w + 64 * half) * 3072 + cg * 128 + lane;
        const FLAS f32x4* sp = (const FLAS f32x4*)(SCs + (w * 64) * 36);
#pragma unroll 2
        for (int kk = 0; kk < 64; ++kk) { const float w0 = wp[(size_t)kk * 3072], w1 = wp[(size_t)kk * 3072 + 64];
#pragma unroll
            for (int q = 0; q < 9; ++q) { const f32x4 sv = sp[kk * 9 + q];
#pragma unroll
                for (int j = 0; j < 4; ++j) { acc0[4 * q + j] += sv[j] * w0; acc1[4 * q + j] += sv[j] * w1; } } }
    }
    FLAS float* part = (FLAS float*)C.lds;
#pragma unroll
    for (int ps = 0; ps < 3; ++ps) {
        __syncthreads();
#pragma unroll
        for (int cc = 0; cc < 12; ++cc) { part[(w * 128 + lane) * 13 + cc] = acc0[12 * ps + cc]; part[(w * 128 + lane + 64) * 13 + cc] = acc1[12 * ps + cc]; }
        __syncthreads();
        for (int o = tid; o < 12 * 128; o += NTHR) { const int cc = o >> 7, nn = o & 127, c = 12 * ps + cc, ng = cg * 128 + nn; float v = IN_F(10)[ls * 3072 + ng];
#pragma unroll
            for (int ww = 0; ww < 8; ++ww) v += part[(ww * 128 + nn) * 13 + cc];
            if (ng >= 1024 && ng < 2048) v = IN_F(11)[ls * D + ng - 1024] * (1.f + v);
            ((float*)(A.fb + F_MOD))[((size_t)ls * NC + c) * 3072 + ng] = v; }
    }
    __syncthreads();
}

__device__ __forceinline__ void phase_prologue(const Ctx& C, CArgs& A) {
    unsigned char* fb = A.fb;
    {
        FLAS float* scr = (FLAS float*)(C.lds + C.wave * 17408);
        int it = C.gw;
#pragma unroll 1
        for (int job = 0; job < 25; ++job) {
            const float* Wp; bf16* WTp; bf16* WT2p = nullptr; int Kv, Nv, modev;
            if (job < 12) { const int l = job / 6, t = job % 6;
                if (t == 0) { Wp = IN_F(12) + (size_t)l * D * 2048; WTp = (bf16*)(fb + F_WPW1) + (size_t)l * 2048 * 1024; Kv = 1024; Nv = 2048; modev = TR_PW1; }
                else if (t == 1) { Wp = IN_F(18) + (size_t)l * D * D; WTp = (bf16*)(fb + F_WPW2) + (size_t)l * 1024 * 1024; Kv = 1024; Nv = 1024; modev = TR_PLAIN; }
                else if (t == 2) { Wp = IN_F(27) + (size_t)l * D * QGW; WTp = (bf16*)(fb + F_WQ) + (size_t)l * 1024 * 1024; WT2p = (bf16*)(fb + F_WG) + (size_t)l * 64 * 1024; Kv = 1024; Nv = QGW; modev = TR_QG; }
                else if (t == 3) { Wp = IN_F(28) + (size_t)l * D * D; WTp = (bf16*)(fb + F_WO) + (size_t)l * 1024 * 1024; Kv = 1024; Nv = 1024; modev = TR_PLAIN; }
                else if (t == 4) { Wp = IN_F(22) + (size_t)l * 2048 * PHI; WTp = (bf16*)(fb + F_WPHI1) + (size_t)l * 128 * 2048; Kv = 2048; Nv = 128; modev = TR_PLAIN; }
                else { Wp = IN_F(24) + (size_t)l * PHI * 64; WTp = (bf16*)(fb + F_WPHI2) + (size_t)l * 64 * 128; Kv = 128; Nv = 64; modev = TR_PLAIN; }
            } else if (job < 24) { const int l = (job - 12) / 3, t = (job - 12) % 3;
                if (t == 0) { Wp = IN_F(30) + (size_t)l * D * DFF; WTp = (bf16*)(fb + F_WGU) + (size_t)l * 5632 * 1024; Kv = 1024; Nv = DFF; modev = TR_GATE; }
                else if (t == 1) { Wp = IN_F(31) + (size_t)l * D * DFF; WTp = (bf16*)(fb + F_WGU) + (size_t)l * 5632 * 1024; Kv = 1024; Nv = DFF; modev = TR_UP; }
                else { Wp = IN_F(32) + (size_t)l * DFF * D; WTp = (bf16*)(fb + F_WDN) + (size_t)l * 1024 * 2816; Kv = 2816; Nv = 1024; modev = TR_PLAIN; }
            } else { Wp = IN_F(21); WTp = (bf16*)(fb + F_WKV); Kv = 1024; Nv = KVW; modev = TR_PLAIN; }
            const int nit = (Kv / 64) * ((Nv + 63) / 64);
            while (it < nit) { tr_item(Wp, Kv, Nv, WTp, WT2p, modev, scr, it, C.lane); it += C.ngw; }
            it -= nit;
        }
    }
    {
        const size_t gt = (size_t)C.wg * NTHR + C.tid, nt = (size_t)C.G * NTHR;
        const f32x4* src = (const f32x4*)IN_F(6); f32x4* dst = (f32x4*)(A.out + O_WINS);
        for (size_t i = gt; i < (size_t)DB * 508 * 128; i += nt) { const size_t b = i / (508 * 128), r = i % (508 * 128); dst[b * 512 * 128 + r] = src[b * 512 * 128 + 4 * 128 + r]; }
        const f32x4* s2 = (const f32x4*)IN_F(7); f32x4* d2 = (f32x4*)(A.out + O_CONVS);
        for (size_t i = gt; i < (size_t)2 * DB * 26 * 256; i += nt) { const size_t lb = i / (26 * 256), r = i % (26 * 256); d2[lb * 30 * 256 + r] = s2[lb * 30 * 256 + 4 * 256 + r]; }
    }
    { const int ck = C.G - 1 - C.wg;
      if (ck < 16 && C.tid < 256) { const int e = C.tid >> 7, h = C.tid & 127; float a = ck == 0 ? IN_F(23)[e * PHI + h] : 0.f; const float* w = IN_F(22) + ((size_t)e * 2048 + ck * 128) * PHI + h; const float* pe = IN_F(26) + e * 2048 + ck * 128;
#pragma unroll 16
          for (int f = 0; f < 128; ++f) a += pe[f] * w[(size_t)f * PHI];
          ((float*)(fb + F_BPHI))[ck * 256 + e * PHI + h] = a; } }
    __syncthreads();
    for (int u = C.wg; u < 192; u += C.G) mod_unit(C, A, u);
}

__device__ __forceinline__ f32x4 bfx4(unsigned lo, unsigned hi) { f32x4 r; r[0] = __builtin_bit_cast(float, lo << 16); r[1] = __builtin_bit_cast(float, lo & 0xffff0000u); r[2] = __builtin_bit_cast(float, hi << 16); r[3] = __builtin_bit_cast(float, hi & 0xffff0000u); return r; }
__device__ __forceinline__ void phase_norm(const Ctx& C, CArgs& A, int mode, int ls, bool from_input, int pend_ls, const float* pend_bias, bool pend_in, int first, int step, int limit) {
    unsigned char* fb = A.fb; const float* modf = (const float*)(fb + F_MOD) + (size_t)ls * NC * 3072; const bf16* XB = (const bf16*)(fb + F_X);
    if (from_input && C.wg == 0 && C.tid < 256) { const float* p = (const float*)(fb + F_BPHI); float a = 0.f;
#pragma unroll
        for (int ck = 0; ck < 16; ++ck) a += p[ck * 256 + C.tid];
        ((float*)(fb + F_BPHI))[4096 + C.tid] = a; }
    constexpr int NB = 4;
    for (int row0 = first; row0 < limit; row0 += NB * step) {
        f32x4 v[NB][4];
#pragma unroll
        for (int i = 0; i < NB; ++i) { const int rq = row0 + i * step; const int rr = rq < limit ? rq : row0;
            if (from_input || (pend_in && rr >= MP)) { const float* xr = rr < MP ? IN_F(0) + (size_t)rr * D : IN_F(1) + (size_t)(rr - MP) * D;
#pragma unroll
                for (int jj = 0; jj < 2; ++jj) { v[i][2 * jj] = *(const f32x4*)(xr + 8 * (C.lane + 64 * jj)); v[i][2 * jj + 1] = *(const f32x4*)(xr + 8 * (C.lane + 64 * jj) + 4); } }
            else { const bf16* xr = XB + (size_t)rr * D;
#pragma unroll
                for (int jj = 0; jj < 2; ++jj) { const u32x4 t = *(const u32x4*)(xr + 8 * (C.lane + 64 * jj)); v[i][2 * jj] = bfx4(t.x, t.y); v[i][2 * jj + 1] = bfx4(t.z, t.w); } } }
#pragma unroll
        for (int i = 0; i < NB; ++i) { const int row = row0 + i * step; if (row >= limit) break;
            if (pend_ls >= 0 && row >= MP) { const float* pp = (const float*)(fb + F_PART) + (size_t)(row - MP) * D; const float* gm = (const float*)(fb + F_MOD) + ((size_t)pend_ls * NC + cidx_row(row)) * 3072 + 2048;
#pragma unroll
                for (int j = 0; j < 4; ++j) { const int c0 = 8 * (C.lane + 64 * (j >> 1)) + 4 * (j & 1); f32x4 y = {0.f, 0.f, 0.f, 0.f}; if (pend_bias) y = *(const f32x4*)(pend_bias + c0);
#pragma unroll
                    for (int ksl = 0; ksl < 8; ++ksl) y += *(const f32x4*)(pp + (size_t)ksl * MS * D + c0);
                    v[i][j] += *(const f32x4*)(gm + c0) * y; }
#pragma unroll
                for (int jj = 0; jj < 2; ++jj) { u32x4 o; o.x = pk2(v[i][2 * jj][0], v[i][2 * jj][1]); o.y = pk2(v[i][2 * jj][2], v[i][2 * jj][3]); o.z = pk2(v[i][2 * jj + 1][0], v[i][2 * jj + 1][1]); o.w = pk2(v[i][2 * jj + 1][2], v[i][2 * jj + 1][3]);
                    *(u32x4*)((bf16*)(fb + F_X) + (size_t)row * D + 8 * (C.lane + 64 * jj)) = o; } }
            float ss = 0.f;
#pragma unroll
            for (int j = 0; j < 4; ++j) ss += (v[i][j][0] * v[i][j][0] + v[i][j][1] * v[i][j][1]) + (v[i][j][2] * v[i][j][2] + v[i][j][3] * v[i][j][3]);
            const float rstd = rsqrtf(wsum(ss) * (1.f / D) + EPS);
            if (mode == 2) { float* yo = row < MP ? A.out + O_YP + (size_t)row * D : A.out + O_YS + (size_t)(row - MP) * D;
#pragma unroll
                for (int j = 0; j < 4; ++j) { const int c0 = 8 * (C.lane + 64 * (j >> 1)) + 4 * (j & 1); const f32x4 g = *(const f32x4*)(IN_F(33) + c0); *(f32x4*)(yo + c0) = v[i][j] * rstd * g; }
                continue; }
            const float* m = modf + (size_t)cidx_row(row) * 3072;
#pragma unroll
            for (int jj = 0; jj < 2; ++jj) { const int c0 = 8 * (C.lane + 64 * jj);
                const f32x4 h0 = v[i][2 * jj] * rstd * *(const f32x4*)(m + D + c0) + *(const f32x4*)(m + c0), h1 = v[i][2 * jj + 1] * rstd * *(const f32x4*)(m + D + c0 + 4) + *(const f32x4*)(m + c0 + 4);
                u32x4 o; o.x = pk2(h0[0], h0[1]); o.y = pk2(h0[2], h0[3]); o.z = pk2(h1[0], h1[1]); o.w = pk2(h1[2], h1[3]); *(u32x4*)((bf16*)(fb + F_H) + (size_t)row * D + c0) = o; }
            if (mode == 1) {
#pragma unroll
                for (int jj = 0; jj < 2; ++jj) { const int c0 = 8 * (C.lane + 64 * jj);
                    const f32x4 h0 = v[i][2 * jj] * rstd * *(const f32x4*)(IN_F(20) + c0), h1 = v[i][2 * jj + 1] * rstd * *(const f32x4*)(IN_F(20) + c0 + 4);
                    u32x4 o; o.x = pk2(h0[0], h0[1]); o.y = pk2(h0[2], h0[3]); o.z = pk2(h1[0], h1[1]); o.w = pk2(h1[2], h1[3]); *(u32x4*)((bf16*)(fb + F_HKV) + (size_t)row * D + c0) = o; } }
        }
    }
}

struct EpGLU { static constexpr bool PERM = true, PAIRED = true;
    bf16* U; float* US; const float* b1; float* convp; float* convs;
    __device__ __forceinline__ void st2(int row, int f, f32x4 a, f32x4 g) const {
        const f32x4 ba = *(const f32x4*)(b1 + f), bg = *(const f32x4*)(b1 + 1024 + f); f32x4 u;
#pragma unroll
        for (int j = 0; j < 4; ++j) u[j] = (a[j] + ba[j]) * fsigm(g[j] + bg[j]);
        u32x2 o; o.x = pk2(u[0], u[1]); o.y = pk2(u[2], u[3]); *(u32x2*)(U + (size_t)row * D + f) = o;
        if (row < MP) { const int t = row & 4095; if (t >= 4066) *(f32x4*)(convp + ((size_t)(row >> 12) * 30 + (t - 4066)) * D + f) = u; }
        else { const int rs = row - MP; *(f32x4*)(US + (size_t)rs * D + f) = u; *(f32x4*)(convs + ((size_t)(rs >> 2) * 30 + 26 + (rs & 3)) * D + f) = u; }
    } };
struct EpSwiGLU { static constexpr bool PERM = true, PAIRED = true;
    bf16* ACT;
    __device__ __forceinline__ void st2(int row, int f, f32x4 g, f32x4 u) const {
        f32x4 a;
#pragma unroll
        for (int j = 0; j < 4; ++j) a[j] = fsilu(g[j]) * u[j];
        u32x2 o; o.x = pk2(a[0], a[1]); o.y = pk2(a[2], a[3]); *(u32x2*)(ACT + (size_t)row * DFF + f) = o;
    } };
struct EpResid { static constexpr bool PERM = false, PAIRED = false;
    const float* xp; const float* xs; bf16* X; const float* mod; const float* bias;
    __device__ __forceinline__ void st(int row, int col, f32x4 v) const {
        const f32x4 gt = *(const f32x4*)(mod + (size_t)cidx_row(row) * 3072 + 2048 + col);
        f32x4 x;
        if (xp) x = row < MP ? *(const f32x4*)(xp + (size_t)row * D + col) : *(const f32x4*)(xs + (size_t)(row - MP) * D + col);
        else { const u32x2 t = *(const u32x2*)(X + (size_t)row * D + col); x = bfx4(t.x, t.y); }
        f32x4 b = {0.f, 0.f, 0.f, 0.f}; if (bias) b = *(const f32x4*)(bias + col);
        const f32x4 y = x + gt * (v + b); u32x2 o; o.x = pk2(y[0], y[1]); o.y = pk2(y[2], y[3]); *(u32x2*)(X + (size_t)row * D + col) = o;
    } };
struct EpKV { static constexpr bool PERM = false, PAIRED = false;
    float* out; bf16* RB;
    __device__ __forceinline__ void st(int row, int col, f32x4 v) const {
        u32x2 o; o.x = pk2(v[0], v[1]); o.y = pk2(v[2], v[3]); *(u32x2*)(RB + (size_t)row * KVW + col) = o;
        const int br = col >> 9, c = col & 511;
        if (row < MP) {
            if (br == 0) *(f32x4*)(out + O_CMPP + (size_t)row * 512 + c) = v;
            else if (br == 1) *(f32x4*)(out + O_SELP + (size_t)row * 512 + c) = v;
            else { const int t = row & 4095; if (t >= 3584) *(f32x4*)(out + O_WINP + ((size_t)(row >> 12) * 512 + (t - 3584)) * 512 + c) = v; }
        } else { const int rs = row - MP;
            if (br == 0) *(f32x4*)(out + O_CMPS + (size_t)rs * 512 + c) = v;
            else if (br == 1) *(f32x4*)(out + O_SELS + (size_t)rs * 512 + c) = v;
            else *(f32x4*)(out + O_WINS + ((size_t)(rs >> 2) * 512 + 508 + (rs & 3)) * 512 + c) = v; }
    } };
struct EpQ { static constexpr bool PERM = true, PAIRED = false;
    bf16* Q;
    __device__ __forceinline__ void st(int row, int col, f32x4 v) const {
        const float s = 0.125f * LOG2E; u32x2 o; o.x = pk2(v[0] * s, v[1] * s); o.y = pk2(v[2] * s, v[3] * s); *(u32x2*)(Q + (size_t)row * D + col) = o;
    } };
struct EpGates { static constexpr bool PERM = false, PAIRED = false;
    float* GT;
    __device__ __forceinline__ void st(int row, int col, f32x4 v) const {
        f32x4 o; o[0] = fsigm(v[0]); o[1] = fsigm(v[1]); o[2] = fsigm(v[2]); o[3] = fsigm(v[3]); *(f32x4*)(GT + (size_t)row * 64 + col) = o;
    } };
struct EpResidNorm { static constexpr bool PERM = false, AFTER_DRAIN = true;
    const float* xp;
    bf16* X; const float* mod; const float* bias;
    int mode;
    const float* nmod; const float* gk; bf16* H; bf16* HKV; float* yout;
    float* stats; unsigned* cnt; unsigned* bar;
    __device__ __forceinline__ void operator()(const pg8::f32x4 (&)[2][2][4][2], const pg8::Unit&, int, int, int, int) const {}
    __device__ __forceinline__ void fused(pg8::f32x4 (&acc)[2][2][4][2], const pg8::Unit& u, int wr, int wc, int fr, int fq, PG8_LAS unsigned char* lds, int wid, int lane) const {
        const int cidx = u.pm >> 4; const float* gm = mod + (size_t)cidx * 3072 + 2048; const int tid = wid * 64 + lane;
        PG8_LAS float* sred = (PG8_LAS float*)lds; PG8_LAS float* srs = (PG8_LAS float*)(lds + 4096);
        f32x4 gv[2][2], gb[2][2];
#pragma unroll
        for (int bj = 0; bj < 2; ++bj)
#pragma unroll
            for (int n = 0; n < 2; ++n) { const int col = u.pn * 256 + bj * 128 + wc * 32 + 16 * n + 4 * fq; gv[bj][n] = *(const f32x4*)(gm + col);
                f32x4 b = {0.f, 0.f, 0.f, 0.f}; if (bias) b = *(const f32x4*)(bias + col); gb[bj][n] = gv[bj][n] * b; }
#pragma unroll
        for (int ai = 0; ai < 2; ++ai)
#pragma unroll
            for (int m = 0; m < 4; ++m) { const int rl = ai * 128 + wr * 64 + m * 16 + fr; const size_t row = (size_t)u.pm * 256 + rl; float ss = 0.f;
                f32x4 xv[2][2];
                if (xp) {
#pragma unroll
                    for (int bj = 0; bj < 2; ++bj)
#pragma unroll
                        for (int n = 0; n < 2; ++n) xv[bj][n] = *(const f32x4*)(xp + row * D + (u.pn * 256 + bj * 128 + wc * 32 + 16 * n + 4 * fq));
                    __builtin_amdgcn_sched_barrier(0);
                } else { u32x2 t[2][2];
#pragma unroll
                    for (int bj = 0; bj < 2; ++bj)
#pragma unroll
                        for (int n = 0; n < 2; ++n) t[bj][n] = *(const u32x2*)(X + row * D + (u.pn * 256 + bj * 128 + wc * 32 + 16 * n + 4 * fq));
                    __builtin_amdgcn_sched_barrier(0);
#pragma unroll
                    for (int bj = 0; bj < 2; ++bj)
#pragma unroll
                        for (int n = 0; n < 2; ++n) xv[bj][n] = bfx4(t[bj][n].x, t[bj][n].y); }
#pragma unroll
                for (int bj = 0; bj < 2; ++bj)
#pragma unroll
                    for (int n = 0; n < 2; ++n) { const int col = u.pn * 256 + bj * 128 + wc * 32 + 16 * n + 4 * fq;
                        const f32x4 y = (xv[bj][n] + gb[bj][n]) + gv[bj][n] * acc[ai][bj][m][n]; acc[ai][bj][m][n] = y;
                        u32x2 o; o.x = pk2(y[0], y[1]); o.y = pk2(y[2], y[3]); *(u32x2*)(X + row * D + col) = o;
                        ss += (y[0] * y[0] + y[1] * y[1]) + (y[2] * y[2] + y[3] * y[3]); }
                ss += __shfl_xor(ss, 16); ss += __shfl_xor(ss, 32);
                if (fq == 0) sred[rl * 4 + wc] = ss;
                asm volatile("" ::: "memory"); }
        __syncthreads();
        if (tid < 256) __hip_atomic_store((unsigned*)stats + ((size_t)u.pm * 4 + u.pn) * 256 + tid, __builtin_bit_cast(unsigned, (sred[tid * 4] + sred[tid * 4 + 1]) + (sred[tid * 4 + 2] + sred[tid * 4 + 3])), __ATOMIC_RELAXED, __HIP_MEMORY_SCOPE_AGENT);
        if (wid < 4) { asm volatile("s_waitcnt vmcnt(0)" ::: "memory"); if (lane == 0) (void)xb_add(cnt + 64 * u.pm, 1u); }
        if (tid == 0) { XB_SPIN(xb_ld(cnt + 64 * u.pm) < 16u, bar); __builtin_amdgcn_fence(__ATOMIC_ACQUIRE, "agent"); asm volatile("s_waitcnt vmcnt(0)" ::: "memory"); }
        __syncthreads();
        if (tid < 256) { float t = 0.f;
#pragma unroll
            for (int p2 = 0; p2 < 4; ++p2) t += __builtin_bit_cast(float, __hip_atomic_load((unsigned*)stats + ((size_t)u.pm * 4 + p2) * 256 + tid, __ATOMIC_RELAXED, __HIP_MEMORY_SCOPE_AGENT));
            srs[tid] = rsqrtf(t * (1.f / D) + EPS); }
        __syncthreads();
        const float* am = nmod + (size_t)cidx * 3072;
        f32x4 sc4[2][2], sh4[2][2], gk4[2][2];
#pragma unroll
        for (int bj = 0; bj < 2; ++bj)
#pragma unroll
            for (int n = 0; n < 2; ++n) { const int col = u.pn * 256 + bj * 128 + wc * 32 + 16 * n + 4 * fq; const f32x4 z = {0.f, 0.f, 0.f, 0.f};
                sc4[bj][n] = mode == 2 ? z : *(const f32x4*)(am + D + col); sh4[bj][n] = mode == 2 ? z : *(const f32x4*)(am + col); gk4[bj][n] = mode == 0 ? z : *(const f32x4*)(gk + col); }
#pragma unroll
        for (int ai = 0; ai < 2; ++ai)
#pragma unroll
            for (int m = 0; m < 4; ++m) { const int rl = ai * 128 + wr * 64 + m * 16 + fr; const size_t row = (size_t)u.pm * 256 + rl; const float rs = srs[rl];
#pragma unroll
                for (int bj = 0; bj < 2; ++bj)
#pragma unroll
                    for (int n = 0; n < 2; ++n) { const int col = u.pn * 256 + bj * 128 + wc * 32 + 16 * n + 4 * fq; const f32x4 yn = acc[ai][bj][m][n] * rs;
                        if (mode == 2) *(f32x4*)(yout + row * D + col) = yn * gk4[bj][n];
                        else { const f32x4 h = yn * sc4[bj][n] + sh4[bj][n]; u32x2 o; o.x = pk2(h[0], h[1]); o.y = pk2(h[2], h[3]); *(u32x2*)(H + row * D + col) = o;
                            if (mode == 1) { const f32x4 k = yn * gk4[bj][n]; u32x2 o2; o2.x = pk2(k[0], k[1]); o2.y = pk2(k[2], k[3]); *(u32x2*)(HKV + row * D + col) = o2; } } }
                asm volatile("" ::: "memory"); }
    } };
template <class E> struct PgE { static constexpr bool PERM = E::PERM, AFTER_DRAIN = false; E e;
    __device__ __forceinline__ void operator()(const pg8::f32x4 (&acc)[2][2][4][2], const pg8::Unit& u, int wr, int wc, int fr, int fq) const {
#pragma unroll
        for (int ai = 0; ai < 2; ++ai)
#pragma unroll
            for (int m = 0; m < 4; ++m) { const int row = u.pm * 256 + ai * 128 + wr * 64 + m * 16 + fr;
                if constexpr (E::PAIRED) {
#pragma unroll
                    for (int n = 0; n < 2; ++n) { const int f = u.pn * 128 + wc * 32 + (E::PERM ? 8 * fq + 4 * n : 16 * n + 4 * fq); e.st2(row, f, acc[ai][0][m][n], acc[ai][1][m][n]); }
                } else {
#pragma unroll
                    for (int bj = 0; bj < 2; ++bj)
#pragma unroll
                        for (int n = 0; n < 2; ++n) { const int col = u.pn * 256 + bj * 128 + wc * 32 + (E::PERM ? 8 * fq + 4 * n : 16 * n + 4 * fq); e.st(row, col, acc[ai][bj][m][n]); }
                }
                asm volatile("" ::: "memory"); }
    } };
template <class E> __device__ __forceinline__ void gemm_prompt(const Ctx& C, const bf16* Ap, const bf16* Bt, int N, int K, const E& e) {
    pg8::Gemm g{Ap, Bt, MP, N, K}; pg8::StaticOrder S; S.init(MP, N, C.G, C.wg); PgE<E> pe{e};
    pg8::gemm_phase<PgE<E>, pg8::StaticOrder, true, true>((PG8_LAS unsigned char*)C.lds, g, S, pe);
}
__device__ __forceinline__ void gemm_prompt_fused(const Ctx& C, const bf16* Ap, const bf16* Bt, int K, const EpResidNorm& e) {
    pg8::Gemm g{Ap, Bt, MP, 1024, K}; pg8::StaticOrder S; S.init(MP, 1024, C.G, C.wg);
    pg8::gemm_phase<EpResidNorm, pg8::StaticOrder, true, true>((PG8_LAS unsigned char*)C.lds, g, S, e);
}
__device__ __forceinline__ void sample_norm_part(const Ctx& C, CArgs& A, int mode, int ls, int pend_ls, const float* pend_bias, bool pend_in, unsigned* flag) {
    if (C.wg >= C.G - 16) {
        phase_norm(C, A, mode, ls, false, pend_ls, pend_bias, pend_in, MP + 8 * (C.wg - (C.G - 16)) + C.wave, MS, R);
        asm volatile("s_waitcnt vmcnt(0)" ::: "memory"); __syncthreads();
        if (C.tid == 0) { __builtin_amdgcn_fence(__ATOMIC_RELEASE, "agent"); asm volatile("s_waitcnt vmcnt(0)" ::: "memory"); (void)xb_add(flag, 1u); }
    }
}
__device__ __forceinline__ void sample_rows_ready(const Ctx& C, unsigned* flag, unsigned* bar) {
    if (C.tid == 0) { XB_SPIN(xb_ld(flag) < 16u, bar); __builtin_amdgcn_fence(__ATOMIC_ACQUIRE, "agent"); asm volatile("s_waitcnt vmcnt(0)" ::: "memory"); }
    __syncthreads();
}
__device__ __forceinline__ void phase_conv(const Ctx& C, CArgs& A, int l) {
    unsigned char* fb = A.fb; const bf16* U = (const bf16*)(fb + F_U); bf16* Cc = (bf16*)(fb + F_C); const float* US = (const float*)(fb + F_US);
    const int c0 = 2 * C.tid;
    constexpr int TOK = 8, NR = 528;
    const unsigned voff2 = (unsigned)c0 * 2u, voff4 = (unsigned)c0 * 4u;
    float w0[31], w1[31];
    { const char* wb = (const char*)(IN_F(14) + ((size_t)l * CONVW) * D);
#pragma unroll
      for (int k = 0; k < 31; ++k) { const float2 w = *(const float2*)(wb + (size_t)k * (D * 4) + voff4); w0[k] = w.x; w1[k] = w.y; } }
    const float2 bdw = *(const float2*)(IN_F(15) + l * D + c0), lg = *(const float2*)(IN_F(16) + l * D + c0), lb = *(const float2*)(IN_F(17) + l * D + c0);
    FLAS float* red = (FLAS float*)C.lds;
    FLAS float* ybuf = (FLAS float*)(C.lds + 65536);
    const int nPU = MP / TOK, nU = nPU + DB;
    for (int u = C.wg; u < nU; u += C.G) {
        int ntok; size_t orow0;
        __syncthreads();
        if (u < nPU) {
            const int row0 = u * TOK, t0 = row0 & 4095; ntok = TOK; orow0 = row0;
            {
                const char* up = (const char*)(U + (size_t)(row0 - 30) * D); float a0[TOK], a1[TOK];
#pragma unroll
                for (int tt = 0; tt < TOK; ++tt) { a0[tt] = bdw.x; a1[tt] = bdw.y; }
                unsigned xv[TOK + 30];
#pragma unroll
                for (int i = 0; i < TOK + 30; ++i) { xv[i] = 0u; if (t0 - 30 + i >= 0) xv[i] = *(const unsigned*)(up + (size_t)i * (D * 2) + voff2); }
#pragma unroll
                for (int i = 0; i < TOK + 30; ++i) { const float x0 = __builtin_bit_cast(float, xv[i] << 16), x1 = __builtin_bit_cast(float, xv[i] & 0xffff0000u);
#pragma unroll
                    for (int tt = 0; tt < TOK; ++tt) { const int k = i - tt; if (k >= 0 && k < 31) { a0[tt] += w0[k] * x0; a1[tt] += w1[k] * x1; } } }
#pragma unroll
                for (int tt = 0; tt < TOK; ++tt) { const int t = tt; ybuf[(t * NTHR + C.tid) * 2] = a0[tt]; ybuf[(t * NTHR + C.tid) * 2 + 1] = a1[tt]; red[(2 * t) * NR + C.tid] = a0[tt] + a1[tt]; red[(2 * t + 1) * NR + C.tid] = a0[tt] * a0[tt] + a1[tt] * a1[tt]; } }
        } else {
            const int b = u - nPU; ntok = 4; orow0 = (size_t)MP + b * 4;
            const char* sp = (const char*)(IN_F(7) + (((size_t)l * DB + b) * 30) * D); const char* usp = (const char*)(US + ((size_t)b * 4) * D);
            for (int t = 0; t < TOK; ++t) { float a0 = bdw.x, a1 = bdw.y;
                if (t < 4) {
#pragma unroll
                    for (int k = 0; k < 31; ++k) { const int j = t + k; const char* p = j < 30 ? sp + (size_t)j * (D * 4) : usp + (size_t)(j - 30) * (D * 4); const float2 v = *(const float2*)(p + voff4);
                        a0 += w0[k] * v.x; a1 += w1[k] * v.y; } }
                ybuf[(t * NTHR + C.tid) * 2] = a0; ybuf[(t * NTHR + C.tid) * 2 + 1] = a1; red[(2 * t) * NR + C.tid] = a0 + a1; red[(2 * t + 1) * NR + C.tid] = a0 * a0 + a1 * a1; }
        }
        __syncthreads();
        { const int v = C.tid >> 5, part = C.tid & 31; float s = 0.f;
#pragma unroll 8
          for (int i = 0; i < 16; ++i) s += red[v * NR + i * 32 + part];
          s += __shfl_xor(s, 1); s += __shfl_xor(s, 2); s += __shfl_xor(s, 4); s += __shfl_xor(s, 8); s += __shfl_xor(s, 16);
          if (part == 0) red[2 * TOK * NR + v] = s; }
        __syncthreads();
        for (int t = 0; t < ntok; ++t) { const float mu = red[2 * TOK * NR + 2 * t] * (1.f / D); const float var = red[2 * TOK * NR + 2 * t + 1] * (1.f / D) - mu * mu; const float rstd = rsqrtf(fmaxf(var, 0.f) + EPS);
            const float yx = ybuf[(t * NTHR + C.tid) * 2], yy = ybuf[(t * NTHR + C.tid) * 2 + 1];
            const float o0 = fsilu((yx - mu) * rstd * lg.x + lb.x), o1 = fsilu((yy - mu) * rstd * lg.y + lb.y);
            *(unsigned*)(Cc + (orow0 + t) * D + c0) = pk2(o0, o1); }
    }
    __syncthreads();
}
#define FK_HAVE_ATTN 1
typedef float f32x16 __attribute__((ext_vector_type(16)));
template <class E> __device__ __forceinline__ void gemm128(const Ctx& C, const bf16* Arows  , int grow0, const bf16* Bt, int K, const E& e, int u) {
    const int fr = C.lane & 15, fq = C.lane >> 4, w = C.wave;
    int brow[2];
    if (E::PAIRED) { const int f = u * 16; brow[0] = 256 * (f >> 7) + (f & 127); brow[1] = brow[0] + 128; } else { brow[0] = u * 32; brow[1] = u * 32 + 16; }
    f32x4 acc[8][2];
#pragma unroll
    for (int rt = 0; rt < 8; ++rt) { acc[rt][0] = (f32x4){0.f, 0.f, 0.f, 0.f}; acc[rt][1] = (f32x4){0.f, 0.f, 0.f, 0.f}; }
    const int kw = K >> 3, k0 = w * kw;
    const bf16* ap = Arows + (size_t)fr * K + k0 + fq * 8; const bf16* bp0 = Bt + (size_t)(brow[0] + fr) * K + k0 + fq * 8; const bf16* bp1 = Bt + (size_t)(brow[1] + fr) * K + k0 + fq * 8;
    bf16x8 b0 = *(const bf16x8*)bp0, b1 = *(const bf16x8*)bp1, a[8];
#pragma unroll
    for (int rt = 0; rt < 8; ++rt) a[rt] = *(const bf16x8*)(ap + (size_t)rt * 16 * K);
#pragma unroll 1
    for (int k = 32; k <= kw; k += 32) { const int kn = k < kw ? k : 0;
        const bf16x8 nb0 = *(const bf16x8*)(bp0 + kn), nb1 = *(const bf16x8*)(bp1 + kn); bf16x8 na[8];
#pragma unroll
        for (int rt = 0; rt < 8; ++rt) na[rt] = *(const bf16x8*)(ap + (size_t)rt * 16 * K + kn);
#pragma unroll
        for (int rt = 0; rt < 8; ++rt) { acc[rt][0] = __builtin_amdgcn_mfma_f32_16x16x32_bf16(b0, a[rt], acc[rt][0], 0, 0, 0); acc[rt][1] = __builtin_amdgcn_mfma_f32_16x16x32_bf16(b1, a[rt], acc[rt][1], 0, 0, 0); }
        b0 = nb0; b1 = nb1;
#pragma unroll
        for (int rt = 0; rt < 8; ++rt) a[rt] = na[rt]; }
    __syncthreads();
    FLAS f32x4* slab = (FLAS f32x4*)C.lds;
#pragma unroll
    for (int rt = 0; rt < 8; ++rt) { slab[((w * 8 + rt) * 2 + 0) * 64 + C.lane] = acc[rt][0]; slab[((w * 8 + rt) * 2 + 1) * 64 + C.lane] = acc[rt][1]; }
    __syncthreads();
    f32x4 s0 = (f32x4){0.f, 0.f, 0.f, 0.f}, s1 = s0;
#pragma unroll
    for (int ww = 0; ww < 8; ++ww) { s0 += slab[((ww * 8 + w) * 2 + 0) * 64 + C.lane]; s1 += slab[((ww * 8 + w) * 2 + 1) * 64 + C.lane]; }
    const int row = grow0 + w * 16 + fr;
    if constexpr (E::PAIRED) e.st2(row, u * 16 + 4 * fq, s0, s1);
    else { e.st(row, u * 32 + 4 * fq, s0); e.st(row, u * 32 + 16 + 4 * fq, s1); }
}
template <class E> __device__ __forceinline__ void gemm_sample(const Ctx& C0, const bf16* As  , const bf16* Bt, int N, int K, const E& e) {
    const Ctx C = refreshed(C0); const int nunits = N / 32;
#ifdef FK_TIMING
    unsigned long long* tsq = (unsigned long long*)(((CArgs*)__builtin_amdgcn_kernarg_segment_ptr())->fb + F_CTL + 65536 + 1024);
    unsigned long long t0 = 0; if (C.wg == FK_TWG && C.tid == 0) t0 = __builtin_amdgcn_s_memrealtime();
#endif
    { const int rank = C.G - 1 - C.wg, half = C.G >> 1;
      if (rank < half) { if (rank < nunits) gemm128(C, As, MP, Bt, K, e, rank);
          for (int u2 = half + (rank - (half >> 1)); rank >= (half >> 1) && u2 < nunits; u2 += half) gemm128(C, As, MP, Bt, K, e, u2); } }
    __syncthreads();
#ifdef FK_TIMING
    if (C.wg == FK_TWG && C.tid == 0) tsq[N == 1024 ? 6 : 7] += __builtin_amdgcn_s_memrealtime() - t0;
#endif
}

__device__ __forceinline__ void gemm_sample_ksplit(const Ctx& C0, const bf16* As  , const bf16* Bt  , int K, float* PART) {
    const Ctx C = refreshed(C0); const int fr = C.lane & 15, fq = C.lane >> 4, w = C.wave, rh = w >> 2, kq = w & 3;
    for (int u = C.wg; u < 256; u += C.G) { const int cg = u & 31, ks = u >> 5; const int nsteps = K >> 8, k0 = ks * (K >> 3);
        f32x4 acc[4][2];
#pragma unroll
        for (int rt = 0; rt < 4; ++rt) { acc[rt][0] = (f32x4){0.f, 0.f, 0.f, 0.f}; acc[rt][1] = (f32x4){0.f, 0.f, 0.f, 0.f}; }
        const bf16* ap = As + (size_t)(64 * rh + fr) * K + k0 + fq * 8; const bf16* bp = Bt + (size_t)(32 * cg + fr) * K + k0 + fq * 8;
        bf16x8 b0[3], b1[3], af[3][4];
#pragma unroll
        for (int i = 0; i < 3; ++i) { const int st = kq + 4 * i; const int sc = st < nsteps ? st : nsteps - 1; b0[i] = *(const bf16x8*)(bp + 32 * sc); b1[i] = *(const bf16x8*)(bp + (size_t)16 * K + 32 * sc);
#pragma unroll
            for (int rt = 0; rt < 4; ++rt) af[i][rt] = *(const bf16x8*)(ap + (size_t)rt * 16 * K + 32 * sc); }
        __builtin_amdgcn_sched_barrier(0);
#pragma unroll
        for (int i = 0; i < 3; ++i) { const int st = kq + 4 * i; if (st < nsteps) {
#pragma unroll
            for (int rt = 0; rt < 4; ++rt) { acc[rt][0] = __builtin_amdgcn_mfma_f32_16x16x32_bf16(b0[i], af[i][rt], acc[rt][0], 0, 0, 0); acc[rt][1] = __builtin_amdgcn_mfma_f32_16x16x32_bf16(b1[i], af[i][rt], acc[rt][1], 0, 0, 0); } } }
        __syncthreads();
        FLAS f32x4* slab = (FLAS f32x4*)C.lds;
#pragma unroll
        for (int rt = 0; rt < 4; ++rt) { slab[(w * 8 + rt * 2 + 0) * 64 + C.lane] = acc[rt][0]; slab[(w * 8 + rt * 2 + 1) * 64 + C.lane] = acc[rt][1]; }
        __syncthreads();
#pragma unroll
        for (int h = 0; h < 2; ++h) { const int pi = kq * 2 + h, rt = pi >> 1, ct = pi & 1; f32x4 sv = slab[((rh * 4 + 0) * 8 + pi) * 64 + C.lane];
#pragma unroll
            for (int x = 1; x < 4; ++x) sv += slab[((rh * 4 + x) * 8 + pi) * 64 + C.lane];
            *(f32x4*)(PART + ((size_t)ks * MS + 64 * rh + 16 * rt + fr) * D + 32 * cg + 16 * ct + 4 * fq) = sv; }
    }
    __syncthreads();
}

__device__ __forceinline__ void phase_qkv(const Ctx& C0, CArgs& A, int l) {
    unsigned char* fb = A.fb; const bf16* HF = (const bf16*)(fb + F_H); const bf16* HKV = (const bf16*)(fb + F_HKV);
    unsigned* flag = (unsigned*)(fb + F_CTL) + 32768 + 64 * (2 * l - 1);
    { const Ctx C = refreshed(C0); sample_norm_part(C, A, l == 2 ? 1 : 0, 2 * l, 2 * l - 1, nullptr, false, flag); }
    if (l == 2) { const Ctx C = refreshed(C0); EpKV e{A.out, (bf16*)(fb + F_RB)}; gemm_prompt(C, HKV, (const bf16*)(fb + F_WKV), KVW, 1024, e); }
    { const Ctx C = refreshed(C0); EpQ e{(bf16*)(fb + F_Q)}; gemm_prompt(C, HF, (const bf16*)(fb + F_WQ) + (size_t)(l - 2) * 1024 * 1024, 1024, 1024, e); }
    { const Ctx C = refreshed(C0); sample_rows_ready(C, flag, (unsigned*)(fb + F_CTL) + 1024); }
    if (l == 2) { const Ctx C = refreshed(C0); EpKV e{A.out, (bf16*)(fb + F_RB)}; gemm_sample(C, HKV + (size_t)MP * D, (const bf16*)(fb + F_WKV), KVW, 1024, e); }
    { const Ctx C = refreshed(C0); gemm_sample_ksplit(C, HF + (size_t)MP * D, (const bf16*)(fb + F_WQ) + (size_t)(l - 2) * 1024 * 1024, 1024, (float*)(fb + F_QPART)); }
    { const Ctx C = refreshed(C0); EpGates e{(float*)(fb + F_GT)}; const bf16* W = (const bf16*)(fb + F_WG) + (size_t)(l - 2) * 64 * 1024;
      for (int it = (C.wg + 64) % C.G; it < 2 * (R / 128); it += C.G) gemm128(C, HF + (size_t)(it >> 1) * 128 * D, (it >> 1) * 128, W, 1024, e, it & 1);
      __syncthreads(); }
}

__device__ __forceinline__ void compress_prompt_wg(const Ctx& C, CArgs& A, int task) {
    unsigned char* fb = A.fb; const int fr = C.lane & 15, fq = C.lane >> 4, nl = fr >> 2, g = fr & 3, w = C.wave;
    const int e = task & 1, grp = (task >> 1) & 31, b = task >> 6;
    const bf16* W1 = (const bf16*)(fb + F_WPHI1) + (size_t)e * 128 * 2048; const bf16* W2 = (const bf16*)(fb + F_WPHI2) + (size_t)e * 64 * 128;
    f32x4 acc[8];
#pragma unroll
    for (int j = 0; j < 8; ++j) acc[j] = (f32x4){0.f, 0.f, 0.f, 0.f};
    const bf16* w1p = W1 + (size_t)fr * 2048 + fq * 8 + w * 256;
    const bf16* ap = (const bf16*)(fb + F_RB) + ((size_t)b * SEQ + (grp * 4 + nl) * 32 + 4 * w) * KVW + e * 256 + g * 64 + fq * 8;
#pragma unroll 2
    for (int s2 = 0; s2 < 8; ++s2) { const bf16x8 a = *(const bf16x8*)(ap + (size_t)(s2 >> 1) * KVW + (s2 & 1) * 32);
#pragma unroll
        for (int j = 0; j < 8; ++j) { const bf16x8 wv = *(const bf16x8*)(w1p + (size_t)j * 16 * 2048 + s2 * 32); acc[j] = __builtin_amdgcn_mfma_f32_16x16x32_bf16(wv, a, acc[j], 0, 0, 0); } }
    FLAS f32x4* slab = (FLAS f32x4*)C.lds;
    FLAS bf16* hid = (FLAS bf16*)(C.lds + 65536);
#pragma unroll
    for (int j = 0; j < 8; ++j) slab[(w * 8 + j) * 64 + C.lane] = acc[j];
    __syncthreads();
    { f32x4 h = (f32x4){0.f, 0.f, 0.f, 0.f};
#pragma unroll
      for (int ww = 0; ww < 8; ++ww) h += slab[(ww * 8 + w) * 64 + C.lane];
      const f32x4 bb = *(const f32x4*)((const float*)(fb + F_BPHI) + 4096 + e * PHI + 16 * w + 4 * fq);
      u32x2 o; o.x = pk2(fsilu(h[0] + bb[0]), fsilu(h[1] + bb[1])); o.y = pk2(fsilu(h[2] + bb[2]), fsilu(h[3] + bb[3]));
      *(FLAS u32x2*)(hid + fr * 136 + 16 * w + 4 * fq) = o; }
    __syncthreads();
    if (w < 4) { const int jj = w; f32x4 o2 = (f32x4){0.f, 0.f, 0.f, 0.f};
#pragma unroll
        for (int kq = 0; kq < 4; ++kq) { const bf16x8 a2 = *(const FLAS bf16x8*)(hid + fr * 136 + 32 * kq + 8 * fq); const bf16x8 wv = *(const bf16x8*)(W2 + (size_t)(16 * jj + fr) * 128 + 32 * kq + 8 * fq);
            o2 = __builtin_amdgcn_mfma_f32_16x16x32_bf16(wv, a2, o2, 0, 0, 0); }
        const int n = grp * 4 + nl, od = 16 * jj + 4 * fq; const f32x4 v = o2 + *(const f32x4*)(IN_F(25) + e * 64 + od);
        if (e == 0) { u32x2 o; o.x = pk2(v[0], v[1]); o.y = pk2(v[2], v[3]); *(u32x2*)((bf16*)(fb + F_CMPK) + (((size_t)b * 4 + g) * 128 + n) * 64 + od) = o; }
        else { bf16* vt = (bf16*)(fb + F_CMPVT) + (((size_t)b * 4 + g) * 64 + od) * 128 + n;
#pragma unroll
            for (int r = 0; r < 4; ++r) vt[r * 128] = (bf16)f2bf(v[r]); } }
    __syncthreads();
}
__device__ __forceinline__ void compress_sample_round(const Ctx& C, CArgs& A, int round) {
    unsigned char* fb = A.fb; const int fr = C.lane & 15, fq = C.lane >> 4, nl = fr >> 2, g = fr & 3, tid = C.tid;
    const int e = round & 1, pg = ((round >> 1) & 7) * 8 + C.wave, b = round >> 4;
    const bf16* W1 = (const bf16*)(fb + F_WPHI1) + (size_t)e * 128 * 2048; const bf16* W2 = (const bf16*)(fb + F_WPHI2) + (size_t)e * 64 * 128;
    FLAS unsigned char* L = C.lds;
    const int page = ((const int*)A.in[8])[b * NPAGES + pg];
    const float* ap = IN_F(4) + ((((size_t)page * PAGE + nl * 32) * 2 + e) * 4 + g) * 64 + fq * 8;
    f32x4 acc[8];
#pragma unroll
    for (int j = 0; j < 8; ++j) acc[j] = (f32x4){0.f, 0.f, 0.f, 0.f};
    f32x4 xa[8], xb[8];
#define CS_LOAD(dst, blk) { _Pragma("unroll") for (int q4 = 0; q4 < 4; ++q4) { const int s_ = (blk) * 4 + q4; const float* p_ = ap + (size_t)(s_ >> 1) * 512 + (s_ & 1) * 32; \
        dst[2 * q4] = __builtin_nontemporal_load((const f32x4*)p_); dst[2 * q4 + 1] = __builtin_nontemporal_load((const f32x4*)(p_ + 4)); } }
#define CS_COMP(src, blk) { _Pragma("unroll") for (int q4 = 0; q4 < 4; ++q4) { const int kl_ = ((blk) & 1) * 4 + q4; \
        u32x4 pa_; pa_.x = pk2(src[2 * q4][0], src[2 * q4][1]); pa_.y = pk2(src[2 * q4][2], src[2 * q4][3]); pa_.z = pk2(src[2 * q4 + 1][0], src[2 * q4 + 1][1]); pa_.w = pk2(src[2 * q4 + 1][2], src[2 * q4 + 1][3]); \
        const bf16x8 a_ = __builtin_bit_cast(bf16x8, pa_); \
        _Pragma("unroll") for (int j = 0; j < 8; ++j) { const bf16x8 w_ = *(const FLAS bf16x8*)(L + (16 * j + fr) * 528 + (kl_ * 32 + fq * 8) * 2); acc[j] = __builtin_amdgcn_mfma_f32_16x16x32_bf16(w_, a_, acc[j], 0, 0, 0); } } }
    CS_LOAD(xa, 0)
#pragma unroll 1
    for (int c = 0; c < 8; ++c) {
        __syncthreads();
        u32x4 wst[8];
#pragma unroll
        for (int i = 0; i < 8; ++i) { const int idx = tid + NTHR * i, nn = idx >> 5, ch = idx & 31; wst[i] = *(const u32x4*)(W1 + (size_t)nn * 2048 + c * 256 + ch * 8); }
        CS_LOAD(xb, 2 * c + 1)
#pragma unroll
        for (int i = 0; i < 8; ++i) { const int idx = tid + NTHR * i, nn = idx >> 5, ch = idx & 31; *(FLAS u32x4*)(L + nn * 528 + ch * 16) = wst[i]; }
        __syncthreads();
        CS_COMP(xa, 2 * c)
        if (c < 7) CS_LOAD(xa, 2 * c + 2)
        CS_COMP(xb, 2 * c + 1)
    }
#undef CS_LOAD
#undef CS_COMP
    const float* bph = (const float*)(fb + F_BPHI) + 4096 + e * PHI; const float* b2 = IN_F(25) + e * 64;
#pragma unroll
    for (int j = 0; j < 8; ++j) { const f32x4 bb = *(const f32x4*)(bph + 16 * j + 4 * fq);
#pragma unroll
        for (int r = 0; r < 4; ++r) acc[j][r] = fsilu(acc[j][r] + bb[r]); }
    f32x4 o2[4];
#pragma unroll
    for (int jj = 0; jj < 4; ++jj) o2[jj] = (f32x4){0.f, 0.f, 0.f, 0.f};
#pragma unroll
    for (int kq = 0; kq < 4; ++kq) {
        u32x4 pa; pa.x = pk2(acc[2 * kq][0], acc[2 * kq][1]); pa.y = pk2(acc[2 * kq][2], acc[2 * kq][3]); pa.z = pk2(acc[2 * kq + 1][0], acc[2 * kq + 1][1]); pa.w = pk2(acc[2 * kq + 1][2], acc[2 * kq + 1][3]);
        const bf16x8 a2 = __builtin_bit_cast(bf16x8, pa);
#pragma unroll
        for (int jj = 0; jj < 4; ++jj) { const bf16* wp = W2 + (size_t)(16 * jj + fr) * 128 + 32 * kq + 4 * fq; const u32x2 lo = *(const u32x2*)wp, hi = *(const u32x2*)(wp + 16);
            u32x4 pw; pw.x = lo.x; pw.y = lo.y; pw.z = hi.x; pw.w = hi.y; o2[jj] = __builtin_amdgcn_mfma_f32_16x16x32_bf16(__builtin_bit_cast(bf16x8, pw), a2, o2[jj], 0, 0, 0); } }
    const int n = pg * 4 + nl;
#pragma unroll
    for (int jj = 0; jj < 4; ++jj) { const int od = 16 * jj + 4 * fq; const f32x4 v = o2[jj] + *(const f32x4*)(b2 + od);
        if (e == 0) { u32x2 o; o.x = pk2(v[0], v[1]); o.y = pk2(v[2], v[3]); *(u32x2*)((bf16*)(fb + F_CMPS) + (((size_t)b * 4 + g) * 256 + n) * 64 + od) = o; }
        else { bf16* vt = (bf16*)(fb + F_CMPS) + (size_t)DB * 4 * 256 * 64 + (((size_t)b * 4 + g) * 64 + od) * 256 + n;
#pragma unroll
            for (int r = 0; r < 4; ++r) vt[r * 256] = (bf16)f2bf(v[r]); } }
}
__device__ __forceinline__ void phase_prep(const Ctx& C, CArgs& A) {
    unsigned char* fb = A.fb; const bf16* RB = (const bf16*)(fb + F_RB); bf16* VT = (bf16*)(fb + F_VT);
    FLAS unsigned char* scr = C.lds + C.wave * 9216;
    for (int it = C.gw; it < 2048; it += C.ngw) {
        const int tc = it & 63, g = (it >> 6) & 3, b = (it >> 8) & 3, br = it >> 10; const int t0 = tc * 64, col0 = 512 * (br + 1) + 256 + g * 64;
#pragma unroll
        for (int i = 0; i < 8; ++i) { const int tok = i * 8 + (C.lane >> 3), ch = C.lane & 7; *(FLAS u32x4*)(scr + tok * 144 + ch * 16) = *(const u32x4*)(RB + ((size_t)b * SEQ + t0 + tok) * KVW + col0 + ch * 8); }
        asm volatile("s_waitcnt lgkmcnt(0)" ::: "memory");
        bf16* dst = VT + ((((size_t)br * 4 + b) * 4 + g) * 64 + C.lane) * SEQ + t0;
#pragma unroll
        for (int i = 0; i < 8; ++i) { unsigned w[4];
#pragma unroll
            for (int j = 0; j < 4; ++j) { const unsigned lo = *(const FLAS unsigned short*)(scr + (8 * i + 2 * j) * 144 + C.lane * 2), hi = *(const FLAS unsigned short*)(scr + (8 * i + 2 * j + 1) * 144 + C.lane * 2); w[j] = lo | (hi << 16); }
            u32x4 o; o.x = w[0]; o.y = w[1]; o.z = w[2]; o.w = w[3]; *(u32x4*)(dst + 8 * i) = o; }
        asm volatile("s_waitcnt lgkmcnt(0)" ::: "memory");
    }
    __syncthreads();
    for (int task = C.wg; task < 256; task += C.G) compress_prompt_wg(C, A, task);
    for (int rd = C.wg; rd < 512; rd += C.G) compress_sample_round(C, A, rd);
    __syncthreads();
}

__device__ __forceinline__ float dpp_xor1(float v) { return __builtin_bit_cast(float, __builtin_amdgcn_update_dpp(0, __builtin_bit_cast(int, v), 0xB1, 0xF, 0xF, true)); }
__device__ __forceinline__ float dpp_xor2(float v) { return __builtin_bit_cast(float, __builtin_amdgcn_update_dpp(0, __builtin_bit_cast(int, v), 0x4E, 0xF, 0xF, true)); }
template <int N> struct IC { static constexpr int value = N; };
__device__ __forceinline__ int swz23(int m) { return (m & 0x13) | ((m & 4) << 1) | ((m & 8) >> 1); }
constexpr int AL_KB0 = 0, AL_VB0 = 9216, AL_KB1 = 18432, AL_VB1 = 27648, AL_LUT = 36864, AL_CK = 51712, AL_CV = 70144, AL_IMP = 87552, AL_SELM = 103936, AL_SCR = 104448, AL_LUTW = 110592  , AL_STASH = AL_CK;
constexpr int DMAXB = 790, LUTN = 928, LUTO = 64;
__device__ __forceinline__ bf16x8 pack8(const f32x16& p, int s) {
    u32x4 o; o.x = pk2(p[8 * s], p[8 * s + 1]); o.y = pk2(p[8 * s + 2], p[8 * s + 3]); o.z = pk2(p[8 * s + 4], p[8 * s + 5]); o.w = pk2(p[8 * s + 6], p[8 * s + 7]); return __builtin_bit_cast(bf16x8, o); }

__device__ __forceinline__ void attn_prompt_unit(const Ctx& C, CArgs& A, int b, int g, int qt, bool load_bg) {
    unsigned char* fb = A.fb; FLAS unsigned char* L = C.lds;
    const bf16* RB = (const bf16*)(fb + F_RB); const bf16* VT = (const bf16*)(fb + F_VT); const bf16* Q = (const bf16*)(fb + F_Q); const float* GT = (const float*)(fb + F_GT);
    const int tid = C.tid, lane = C.lane, w = C.wave, n = lane & 31, h = lane >> 5, ql = n >> 2, r = n & 3;
    const int q0 = qt * 64, qpos = q0 + 8 * w + ql, jq = qt; const size_t qrow = (size_t)b * SEQ + qpos;
    __syncthreads();
    {
        const bf16* ck = (const bf16*)(fb + F_CMPK) + ((size_t)b * 4 + g) * 128 * 64; const bf16* cv = (const bf16*)(fb + F_CMPVT) + ((size_t)b * 4 + g) * 64 * 128;
        for (int i = tid; i < 1024; i += NTHR) { const int key = i >> 3, ch = i & 7; *(FLAS u32x4*)(L + AL_CK + key * 144 + ch * 16) = *(const u32x4*)(ck + key * 64 + ch * 8); }
        for (int i = tid; i < 1024; i += NTHR) { const int dim = i >> 4, ch = i & 15; *(FLAS u32x4*)(L + AL_CV + dim * 272 + ch * 16) = *(const u32x4*)(cv + dim * 128 + ch * 8); }
        if (load_bg) for (int i = tid; i < LUTN * 4; i += NTHR) { const int d = (i >> 2) - LUTO, rr = i & 3; const float bv = IN_F(29)[rel_bucket(d) * 16 + g * 4 + rr] * LOG2E;
            ((FLAS float*)(L + AL_LUT))[i] = d < 0 ? -INFINITY : bv; if (i < 640 * 4) ((FLAS float*)(L + AL_LUTW))[i] = (d < 0 || d >= 512) ? -INFINITY : bv; }
    }
    bf16x8 qf[4];
#pragma unroll
    for (int s = 0; s < 4; ++s) qf[s] = *(const bf16x8*)(Q + qrow * D + (g * 4 + r) * 64 + 16 * s + 8 * h);
    const float gt0 = GT[qrow * 64 + (g * 4 + r) * 3 + 0], gt1 = GT[qrow * 64 + (g * 4 + r) * 3 + 1], gt2 = GT[qrow * 64 + (g * 4 + r) * 3 + 2];
    __syncthreads();
    const FLAS float* LUT = (const FLAS float*)(L + AL_LUT);
    FLAS u32x2* stash = (FLAS u32x2*)(L + AL_STASH) + (w * 64 + lane) * 8;
    const int krow = swz23(n);
    {
        f32x16 S[4]; float mx = -1e30f;
#pragma unroll
        for (int sub = 0; sub < 4; ++sub) { f32x16 acc;
#pragma unroll
            for (int i = 0; i < 16; ++i) acc[i] = 0.f;
#pragma unroll
            for (int ks = 0; ks < 4; ++ks) { const bf16x8 a = *(const FLAS bf16x8*)(L + AL_CK + (32 * sub + krow) * 144 + (16 * ks + 8 * h) * 2); acc = __builtin_amdgcn_mfma_f32_32x32x16_bf16(a, qf[ks], acc, 0, 0, 0); }
#pragma unroll
            for (int i = 0; i < 16; ++i) { const int nb = 32 * sub + (i & 7) + 8 * h + 16 * (i >> 3); const int d = qpos - (32 * nb + 31); const bool valid = d >= 0;
                const int dc = d > DMAXB ? DMAXB : (d < 0 ? 0 : d); const float bias = LUT[(dc + LUTO) * 4 + r]; float v = acc[i] + bias; v = valid ? v : -INFINITY; acc[i] = v; mx = fmaxf(mx, v); }
            S[sub] = acc; }
        mx = xmax32(mx);
        float sum = 0.f;
#pragma unroll
        for (int sub = 0; sub < 4; ++sub)
#pragma unroll
            for (int i = 0; i < 16; ++i) { const float p = __builtin_amdgcn_exp2f(S[sub][i] - mx); S[sub][i] = p; sum += p; }
        sum = xsum32(sum);
        const float inv = sum > 0.f ? 1.f / sum : 0.f;
        f32x16 oc[2];
#pragma unroll
        for (int d2 = 0; d2 < 2; ++d2)
#pragma unroll
            for (int i = 0; i < 16; ++i) oc[d2][i] = 0.f;
        FLAS float* IMP = (FLAS float*)(L + AL_IMP) + (w * 8 + ql) * 64;
#pragma unroll
        for (int sub = 0; sub < 4; ++sub) {
#pragma unroll
            for (int i = 0; i < 16; ++i) S[sub][i] *= inv;
#pragma unroll
            for (int i = 0; i < 16; i += 2) { float v = S[sub][i] + S[sub][i + 1]; v += dpp_xor1(v); v += dpp_xor2(v);
                const int j = 16 * sub + ((i & 7) >> 1) + 4 * h + 8 * (i >> 3); if (r == 0) IMP[j] = v; }
#pragma unroll
            for (int s = 0; s < 2; ++s) { const bf16x8 pb = pack8(S[sub], s);
#pragma unroll
                for (int d2 = 0; d2 < 2; ++d2) { const bf16x8 a = *(const FLAS bf16x8*)(L + AL_CV + (32 * d2 + n) * 272 + (32 * sub + 16 * s + 8 * h) * 2); oc[d2] = __builtin_amdgcn_mfma_f32_32x32x16_bf16(a, pb, oc[d2], 0, 0, 0); } }
        }
#pragma unroll
        for (int d2 = 0; d2 < 2; ++d2) oc[d2] *= gt0;
        __syncthreads();
#pragma unroll
        for (int d2 = 0; d2 < 2; ++d2)
#pragma unroll
            for (int c = 0; c < 4; ++c) { u32x2 o; o.x = pk2(oc[d2][4 * c], oc[d2][4 * c + 1]); o.y = pk2(oc[d2][4 * c + 2], oc[d2][4 * c + 3]); stash[d2 * 4 + c] = o; }
    }
    asm volatile("s_waitcnt lgkmcnt(0)" ::: "memory");
    {
        FLAS unsigned long long* SCR64 = (FLAS unsigned long long*)(L + AL_SCR) + w * 64; FLAS unsigned* SELM = (FLAS unsigned*)(L + AL_SELM) + w * 16;
        for (int qq = 0; qq < 8; ++qq) {
            unsigned long long mask;
            if (jq < 16) mask = (2ull << jq) - 1ull;
            else {
                const int j = lane; const float impj = ((const FLAS float*)(L + AL_IMP))[(w * 8 + qq) * 64 + j];
                const bool forced = (j == 0) || (j == jq) || (j == jq - 1); const bool okj = j <= jq; const float sj = forced ? 1e4f : impj;
                const unsigned long long keyj = okj ? (((unsigned long long)(__builtin_bit_cast(unsigned, sj) + 1u) << 32) | (unsigned)(63 - j)) : 0ull;
                SCR64[j] = keyj; asm volatile("s_waitcnt lgkmcnt(0)" ::: "memory");
                int rank = 0;
#pragma unroll
                for (int i2 = 0; i2 < 32; ++i2) { const u32x4 kv = *(const FLAS u32x4*)(SCR64 + 2 * i2);
                    const unsigned long long k0 = ((unsigned long long)kv.y << 32) | kv.x, k1 = ((unsigned long long)kv.w << 32) | kv.z;
                    rank += (k0 > keyj) ? 1 : 0; rank += (k1 > keyj) ? 1 : 0; }
                mask = __ballot(rank < 16 && okj);
                asm volatile("s_waitcnt lgkmcnt(0)" ::: "memory");
            }
            if (lane == 0) { SELM[2 * qq] = (unsigned)mask; SELM[2 * qq + 1] = (unsigned)(mask >> 32); }
        }
        asm volatile("s_waitcnt lgkmcnt(0)" ::: "memory");
    }
    const unsigned selLo = ((const FLAS unsigned*)(L + AL_SELM))[w * 16 + 2 * ql], selHi = ((const FLAS unsigned*)(L + AL_SELM))[w * 16 + 2 * ql + 1];
    const int jw0 = jq - 8 > 0 ? jq - 8 : 0; const int NTL = (jq + 1) + (jq - jw0 + 1);
    const int skey = tid >> 3, sch = tid & 7;
    const bf16* kbase = RB + ((size_t)b * SEQ + skey) * KVW + g * 64 + sch * 8;
    const bf16* vbase = VT + (((size_t)b * 4 + g) * 64 + skey) * SEQ + sch * 8;
    float m = -1e30f, lsum = 0.f; f32x16 oa[2];
#pragma unroll
    for (int d2 = 0; d2 < 2; ++d2)
#pragma unroll
        for (int i = 0; i < 16; ++i) oa[d2][i] = 0.f;
    u32x4 kreg0, vreg0, kreg1, vreg1;
    { kreg0 = *(const u32x4*)(kbase + 512); vreg0 = *(const u32x4*)vbase; }
    { const bool nw = 1 > jq; const int nj = nw ? jw0 : 1; kreg1 = *(const u32x4*)(kbase + (size_t)64 * nj * KVW + (nw ? 1024 : 512)); vreg1 = *(const u32x4*)(vbase + (nw ? (size_t)16 * 64 * SEQ : 0) + 64 * nj); }
    *(FLAS u32x4*)(L + AL_KB0 + skey * 144 + sch * 16) = kreg0; *(FLAS u32x4*)(L + AL_VB0 + skey * 144 + sch * 16) = vreg0;
    __syncthreads();
    const float b31 = LUT[(DMAXB + LUTO) * 4 + r];
    for (int ti = 0; ti < NTL; ++ti) {
        const bool isw = ti > jq; const int j = isw ? jw0 + (ti - jq - 1) : ti; const int buf = ti & 1;
        kreg0 = kreg1; vreg0 = vreg1;
        if (ti + 2 < NTL) { const bool nw = (ti + 2) > jq; const int nj = nw ? jw0 + (ti + 1 - jq) : ti + 2;
            kreg1 = *(const u32x4*)(kbase + (size_t)64 * nj * KVW + (nw ? 1024 : 512)); vreg1 = *(const u32x4*)(vbase + (nw ? (size_t)16 * 64 * SEQ : 0) + 64 * nj); }
        if (ti == jq + 1) {
            const float lt = xsum32(lsum); const float f = lt > 0.f ? gt1 / lt : 0.f;
#pragma unroll
            for (int d2 = 0; d2 < 2; ++d2) {
#pragma unroll
                for (int c = 0; c < 4; ++c) { const u32x2 o = stash[d2 * 4 + c]; u32x2 n2;
                    n2.x = pk2(__builtin_bit_cast(float, o.x << 16) + oa[d2][4 * c] * f, __builtin_bit_cast(float, o.x & 0xffff0000u) + oa[d2][4 * c + 1] * f);
                    n2.y = pk2(__builtin_bit_cast(float, o.y << 16) + oa[d2][4 * c + 2] * f, __builtin_bit_cast(float, o.y & 0xffff0000u) + oa[d2][4 * c + 3] * f); stash[d2 * 4 + c] = n2; }
#pragma unroll
                for (int i = 0; i < 16; ++i) oa[d2][i] = 0.f; }
            m = -1e30f; lsum = 0.f; }
        const bool selbit = ((j < 32 ? selLo >> j : selHi >> (j - 32)) & 1u) != 0u;
        const bool active = isw ? true : (__any(selbit) != 0);
        if (active) {
            const FLAS unsigned char* KB = L + (buf ? AL_KB1 : AL_KB0); const FLAS unsigned char* VB = L + (buf ? AL_VB1 : AL_VB0);
            f32x16 S[2];
            { bf16x8 kf[2][4];
#pragma unroll
              for (int sub = 0; sub < 2; ++sub)
#pragma unroll
                  for (int ks = 0; ks < 4; ++ks) kf[sub][ks] = *(const FLAS bf16x8*)(KB + (32 * sub + krow) * 144 + (16 * ks + 8 * h) * 2);
              __builtin_amdgcn_sched_barrier(0);
#pragma unroll
              for (int sub = 0; sub < 2; ++sub) { f32x16 acc;
#pragma unroll
                  for (int i = 0; i < 16; ++i) acc[i] = 0.f;
#pragma unroll
                  for (int ks = 0; ks < 4; ++ks) acc = __builtin_amdgcn_mfma_f32_32x32x16_bf16(kf[sub][ks], qf[ks], acc, 0, 0, 0);
                  S[sub] = acc; }
            }
            const int dbase = qpos - 64 * j;
            const bool far = !isw && ((q0 + 8 * w) - (64 * j + 63) >= DMAXB);
            auto body = [&](auto tag) { constexpr int MODE = decltype(tag)::value;
                float tmax = -INFINITY, poff;
                if constexpr (MODE == 0) {
#pragma unroll
                    for (int sub = 0; sub < 2; ++sub)
#pragma unroll
                        for (int i = 0; i < 16; ++i) tmax = fmaxf(tmax, S[sub][i]);
                    tmax = selbit ? tmax + b31 : -INFINITY;
                } else {
                    const int dl = dbase - 8 * h;
                    const int dle = (MODE == 2 || selbit) ? dl : -1;
                    const FLAS float* lpb = (MODE == 2 ? (const FLAS float*)(L + AL_LUTW) : LUT) + ((dle + LUTO - 55) * 4 + r);
                    float bv[2][16];
#pragma unroll
                    for (int sub = 0; sub < 2; ++sub)
#pragma unroll
                        for (int i = 0; i < 16; ++i) { const int koff = 32 * sub + (i & 7) + 16 * (i >> 3); bv[sub][i] = lpb[(55 - koff) * 4]; }
                    __builtin_amdgcn_sched_barrier(0);
#pragma unroll
                    for (int sub = 0; sub < 2; ++sub)
#pragma unroll
                        for (int i = 0; i < 16; ++i) { const float v = S[sub][i] + bv[sub][i]; S[sub][i] = v; tmax = fmaxf(tmax, v); }
                }
                tmax = xmax32(tmax);
                const float mnew = fmaxf(m, tmax); const float sc = __builtin_amdgcn_exp2f(m - mnew); m = mnew;
                poff = MODE == 0 ? (selbit ? b31 - mnew : -INFINITY) : -mnew;
                float ps = 0.f;
#pragma unroll
                for (int sub = 0; sub < 2; ++sub)
#pragma unroll
                    for (int i = 0; i < 16; ++i) { const float p = __builtin_amdgcn_exp2f(S[sub][i] + poff); S[sub][i] = p; ps += p; }
                lsum = lsum * sc + ps;
#pragma unroll
                for (int d2 = 0; d2 < 2; ++d2) oa[d2] *= sc;
#pragma unroll
                for (int sub = 0; sub < 2; ++sub)
#pragma unroll
                    for (int s2 = 0; s2 < 2; ++s2) { const bf16x8 pb = pack8(S[sub], s2);
#pragma unroll
                        for (int d2 = 0; d2 < 2; ++d2) { const bf16x8 av = *(const FLAS bf16x8*)(VB + (32 * d2 + n) * 144 + (32 * sub + 16 * s2 + 8 * h) * 2); oa[d2] = __builtin_amdgcn_mfma_f32_32x32x16_bf16(av, pb, oa[d2], 0, 0, 0); } }
            };
            if (isw) body(IC<2>{}); else if (far) body(IC<0>{}); else body(IC<1>{});
        }
        if (ti + 1 < NTL) { FLAS unsigned char* KBn = L + (buf ? AL_KB0 : AL_KB1); FLAS unsigned char* VBn = L + (buf ? AL_VB0 : AL_VB1);
            *(FLAS u32x4*)(KBn + skey * 144 + sch * 16) = kreg0; *(FLAS u32x4*)(VBn + skey * 144 + sch * 16) = vreg0; }
        __syncthreads();
    }
    { const float lt = xsum32(lsum); const float f = lt > 0.f ? gt2 / lt : 0.f;
#pragma unroll
      for (int d2 = 0; d2 < 2; ++d2) oa[d2] *= f; }
    bf16* op = (bf16*)(fb + F_O) + qrow * D + (g * 4 + r) * 64;
#pragma unroll
    for (int d2 = 0; d2 < 2; ++d2)
#pragma unroll
        for (int c = 0; c < 4; ++c) { const u32x2 sv = stash[d2 * 4 + c]; u32x2 o;
            o.x = pk2(__builtin_bit_cast(float, sv.x << 16) + oa[d2][4 * c], __builtin_bit_cast(float, sv.x & 0xffff0000u) + oa[d2][4 * c + 1]);
            o.y = pk2(__builtin_bit_cast(float, sv.y << 16) + oa[d2][4 * c + 2], __builtin_bit_cast(float, sv.y & 0xffff0000u) + oa[d2][4 * c + 3]); *(u32x2*)(op + 32 * d2 + 8 * c + 4 * h) = o; }
}

typedef short v4i16_t __attribute__((ext_vector_type(4)));
__device__ __forceinline__ float fexp2(float x) { return __builtin_amdgcn_exp2f(x); }
constexpr int SM_LUT = 0, SM_P = 12800, SM_ML = 29184, SM_FAC = 29696, SM_SC = 29952, SM_SELQ = 32064, SM_PUB0 = 12800  , SM_LIST = 45568, SM_NIT = 46112, SM_V = 46208, SM_PUBML = 119936;
constexpr int SDMAX = 790;
struct SAcc { float m, l; f32x4 o[4]; };
__device__ __forceinline__ void sa_init(SAcc& a) { a.m = -1e30f; a.l = 0.f;
#pragma unroll
    for (int dt = 0; dt < 4; ++dt) a.o[dt] = (f32x4){0.f, 0.f, 0.f, 0.f}; }
__device__ __forceinline__ bf16x8 pack44(const f32x4& x, const f32x4& y) { u32x4 o; o.x = pk2(x[0], x[1]); o.y = pk2(x[2], x[3]); o.z = pk2(y[0], y[1]); o.w = pk2(y[2], y[3]); return __builtin_bit_cast(bf16x8, o); }
__device__ __forceinline__ void sa_update(f32x4 (&S)[4], SAcc& a, bf16x8 (&P)[2]) {
    float tmax = fmaxf(fmaxf(S[0][0], S[0][1]), fmaxf(S[0][2], S[0][3]));
#pragma unroll
    for (int kt = 1; kt < 4; ++kt) tmax = fmaxf(tmax, fmaxf(fmaxf(S[kt][0], S[kt][1]), fmaxf(S[kt][2], S[kt][3])));
    tmax = fmaxf(tmax, __shfl_xor(tmax, 16)); tmax = xmax32(tmax);
    const float mnew = fmaxf(a.m, tmax), sc = fexp2(a.m - mnew); a.m = mnew;
    float ps = 0.f;
#pragma unroll
    for (int kt = 0; kt < 4; ++kt)
#pragma unroll
        for (int t = 0; t < 4; ++t) { const float p = fexp2(S[kt][t] - mnew); S[kt][t] = p; ps += p; }
    a.l = a.l * sc + ps;
#pragma unroll
    for (int dt = 0; dt < 4; ++dt) a.o[dt] *= sc;
    P[0] = pack44(S[0], S[1]); P[1] = pack44(S[2], S[3]);
}
__device__ __forceinline__ void sa_block_f32(FLAS unsigned char* Vt, int lane, const float* kb, const float* vb, int nk, const bf16x8 (&qf)[2], SAcc& a, const FLAS float* lut, int d0, int dmax, bool rowok) {
    const int fr = lane & 15, fq = lane >> 4, r = fr & 3;
    f32x4 kr[4][4];
#pragma unroll
    for (int kt = 0; kt < 4; ++kt) { const int kk = 32 * (kt >> 1) + 8 * (fr >> 2) + 4 * (kt & 1) + (fr & 3); const float* kp = kb + (size_t)kk * 512 + 8 * fq;
        kr[kt][0] = *(const f32x4*)kp; kr[kt][1] = *(const f32x4*)(kp + 4); kr[kt][2] = *(const f32x4*)(kp + 32); kr[kt][3] = *(const f32x4*)(kp + 36); }
    f32x4 vr[8][2]; const float* vp0 = vb + (size_t)(lane >> 3) * 512 + 8 * (lane & 7);
#pragma unroll
    for (int i = 0; i < 4; ++i) { const float* vp = vp0 + (size_t)i * 4096; vr[i][0] = *(const f32x4*)vp; vr[i][1] = *(const f32x4*)(vp + 4); }
    f32x4 S[4];
#pragma unroll
    for (int kt = 0; kt < 4; ++kt) { f32x4 acc = (f32x4){0.f, 0.f, 0.f, 0.f};
        acc = __builtin_amdgcn_mfma_f32_16x16x32_bf16(pack44(kr[kt][0], kr[kt][1]), qf[0], acc, 0, 0, 0); acc = __builtin_amdgcn_mfma_f32_16x16x32_bf16(pack44(kr[kt][2], kr[kt][3]), qf[1], acc, 0, 0, 0); S[kt] = acc; }
    asm volatile("" ::: "memory");
#pragma unroll
    for (int i = 4; i < 8; ++i) { const float* vp = vp0 + (size_t)i * 4096; vr[i][0] = *(const f32x4*)vp; vr[i][1] = *(const f32x4*)(vp + 4); }
#pragma unroll
    for (int kt = 0; kt < 4; ++kt)
#pragma unroll
        for (int t = 0; t < 4; ++t) { const int kk = 32 * (kt >> 1) + 8 * fq + 4 * (kt & 1) + t; const int d = d0 - kk; const bool valid = rowok && kk < nk && d >= 0 && d < dmax;
            const int dc = d < 0 ? 0 : (d > SDMAX ? SDMAX : d); const float v = S[kt][t] + lut[dc * 4 + r]; S[kt][t] = valid ? v : -INFINITY; }
    bf16x8 P[2]; sa_update(S, a, P);
#pragma unroll
    for (int i = 0; i < 8; ++i) { const int key = 8 * i + (lane >> 3); *(FLAS bf16x8*)(Vt + key * 144 + (lane & 7) * 16) = pack44(vr[i][0], vr[i][1]); }
    asm volatile("s_waitcnt lgkmcnt(0)" ::: "memory");
#pragma unroll
    for (int s2 = 0; s2 < 2; ++s2)
#pragma unroll
        for (int dt = 0; dt < 4; ++dt) { const FLAS unsigned char* p = Vt + (32 * s2 + 8 * fq + (fr >> 2)) * 144 + (16 * dt + 4 * (fr & 3)) * 2;
            const v4i16_t lo = __builtin_amdgcn_ds_read_tr16_b64_v4i16((FLAS v4i16_t*)p), hi = __builtin_amdgcn_ds_read_tr16_b64_v4i16((FLAS v4i16_t*)(p + 4 * 144));
            bf16x8 vf; vf[0] = lo[0]; vf[1] = lo[1]; vf[2] = lo[2]; vf[3] = lo[3]; vf[4] = hi[0]; vf[5] = hi[1]; vf[6] = hi[2]; vf[7] = hi[3];
            a.o[dt] = __builtin_amdgcn_mfma_f32_16x16x32_bf16(vf, P[s2], a.o[dt], 0, 0, 0); }
    asm volatile("s_waitcnt lgkmcnt(0)" ::: "memory");
}
__device__ __forceinline__ void attn_sample_unit(const Ctx& C, CArgs& A, int u) {
    unsigned char* fb = A.fb; const int lane = C.lane, tid = C.tid, w = C.wave, fr = lane & 15, fq = lane >> 4, q = fr >> 2, r = fr & 3; FLAS unsigned char* L = C.lds;
    const int b = u >> 2, g = u & 3;
    FLAS float* lut = (FLAS float*)(L + SM_LUT); FLAS float* Pc = (FLAS float*)(L + SM_P); FLAS float* ML = (FLAS float*)(L + SM_ML); FLAS float* FAC = (FLAS float*)(L + SM_FAC); FLAS float* SC = (FLAS float*)(L + SM_SC);
    FLAS unsigned* SELQ = (FLAS unsigned*)(L + SM_SELQ); FLAS unsigned* LIST = (FLAS unsigned*)(L + SM_LIST); FLAS unsigned* NIT = (FLAS unsigned*)(L + SM_NIT); FLAS unsigned char* Vt = L + SM_V + w * 9216;
    const float* table = IN_F(29); const int* pt = (const int*)A.in[8];
    __syncthreads();
    for (int i = tid; i < (SDMAX + 2) * 4; i += NTHR) lut[i] = table[rel_bucket(i >> 2) * 16 + g * 4 + (i & 3)] * LOG2E;
    bf16x8 qf[2];
    { const float* qp = (const float*)(fb + F_QPART) + ((size_t)b * 4 + q) * D + (g * 4 + r) * 64 + 8 * fq; const float qs = 0.125f * LOG2E;
#pragma unroll
      for (int k2 = 0; k2 < 2; ++k2) { f32x4 s0 = {0.f, 0.f, 0.f, 0.f}, s1 = s0;
#pragma unroll
          for (int ksl = 0; ksl < 8; ++ksl) { s0 += *(const f32x4*)(qp + (size_t)ksl * MS * D + 32 * k2); s1 += *(const f32x4*)(qp + (size_t)ksl * MS * D + 32 * k2 + 4); }
          qf[k2] = pack44(s0 * qs, s1 * qs); } }
    SAcc a0, a1; sa_init(a0); sa_init(a1);
    __syncthreads();
    const float* winK = IN_F(6) + ((size_t)b * 512 * 2) * 256 + g * 64;
    const float* winN = A.out + O_WINS + ((size_t)b * 512 + 508) * 512 + g * 64;
    if (w < 4) {
        const int cb = w; const bf16* ck = (const bf16*)(fb + F_CMPS) + (((size_t)b * 4 + g) * 256 + 64 * cb) * 64; const bf16* vt = (const bf16*)(fb + F_CMPS) + (size_t)DB * 4 * 256 * 64 + ((size_t)b * 4 + g) * 64 * 256 + 64 * cb;
        f32x4 S[4];
#pragma unroll
        for (int kt = 0; kt < 4; ++kt) { const int kk = 32 * (kt >> 1) + 8 * (fr >> 2) + 4 * (kt & 1) + (fr & 3); const bf16* kp = ck + kk * 64 + 8 * fq; f32x4 acc = (f32x4){0.f, 0.f, 0.f, 0.f};
            acc = __builtin_amdgcn_mfma_f32_16x16x32_bf16(*(const bf16x8*)kp, qf[0], acc, 0, 0, 0); acc = __builtin_amdgcn_mfma_f32_16x16x32_bf16(*(const bf16x8*)(kp + 32), qf[1], acc, 0, 0, 0); S[kt] = acc; }
        const int d0 = PAST + q - 31 - 32 * 64 * cb;
#pragma unroll
        for (int kt = 0; kt < 4; ++kt)
#pragma unroll
            for (int t = 0; t < 4; ++t) { const int kk = 32 * (kt >> 1) + 8 * fq + 4 * (kt & 1) + t; const int d = d0 - 32 * kk; S[kt][t] += lut[(d > SDMAX ? SDMAX : d) * 4 + r]; }
        bf16x8 P[2]; sa_update(S, a0, P);
#pragma unroll
        for (int kt = 0; kt < 4; ++kt) *(FLAS f32x4*)(Pc + fr * 256 + 64 * cb + 32 * (kt >> 1) + 8 * fq + 4 * (kt & 1)) = S[kt];
#pragma unroll
        for (int s2 = 0; s2 < 2; ++s2)
#pragma unroll
            for (int dt = 0; dt < 4; ++dt) a0.o[dt] = __builtin_amdgcn_mfma_f32_16x16x32_bf16(*(const bf16x8*)(vt + (size_t)(16 * dt + fr) * 256 + 32 * s2 + 8 * fq), P[s2], a0.o[dt], 0, 0, 0);
        float lr = a0.l; lr += __shfl_xor(lr, 16); lr += __shfl_xor(lr, 32);
        if (fq == 0) { ML[(w * 16 + fr) * 2] = a0.m; ML[(w * 16 + fr) * 2 + 1] = lr; }
    } else { const int wb = w - 4; sa_block_f32(Vt, lane, winK + (size_t)64 * wb * 512, winK + (size_t)64 * wb * 512 + 256, 64, qf, a0, lut, 512 + q - 64 * wb, 512, true); }
    __syncthreads();
    if (tid < 64) { const int row = tid >> 2, ww = tid & 3; float M = -1e30f;
#pragma unroll
        for (int x = 0; x < 4; ++x) M = fmaxf(M, ML[(x * 16 + row) * 2]);
        float Ls = 0.f;
#pragma unroll
        for (int x = 0; x < 4; ++x) Ls += ML[(x * 16 + row) * 2 + 1] * fexp2(ML[(x * 16 + row) * 2] - M);
        FAC[row * 4 + ww] = fexp2(ML[(ww * 16 + row) * 2] - M) / Ls; }
    __syncthreads();
    { const int qq = tid >> 7, j = tid & 127; float sv = 0.f;
#pragma unroll
      for (int rr = 0; rr < 4; ++rr) { const int row = qq * 4 + rr; const f32x2 pp = *(const FLAS f32x2*)(Pc + row * 256 + 2 * j); sv += (pp[0] + pp[1]) * FAC[row * 4 + (j >> 5)]; }
      SC[qq * 132 + j] = (j == 0 || j == 127) ? 1e4f : sv; }
    __syncthreads();
    { const int qq = w >> 1, j = 64 * (w & 1) + lane; const float sj = SC[qq * 132 + j]; int rank = 0;
#pragma unroll 4
      for (int i4 = 0; i4 < 32; ++i4) { const f32x4 sv = *(const FLAS f32x4*)(SC + qq * 132 + 4 * i4);
#pragma unroll
          for (int k = 0; k < 4; ++k) { const int i = 4 * i4 + k; rank += (sv[k] > sj || (sv[k] == sj && i < j)) ? 1 : 0; } }
      SELQ[qq * 132 + j] = rank < 15 ? 1u : 0u; }
    __syncthreads();
    if (w == 0) { unsigned base = 0;
        for (int c = 0; c < 3; ++c) { const int j = 64 * c + lane; unsigned msk = 0u;
            if (j < 128) msk = SELQ[j] | (SELQ[132 + j] << 1) | (SELQ[264 + j] << 2) | (SELQ[396 + j] << 3); else if (j == 128) msk = 0xFu;
            const unsigned long long ball = __ballot(msk != 0u); const unsigned pos = base + (unsigned)__builtin_popcountll(ball & ((1ull << lane) - 1ull));
            if (msk != 0u) LIST[pos] = (unsigned)j | (msk << 8);
            base += (unsigned)__builtin_popcountll(ball); }
        if (lane == 0) NIT[0] = base; }
    __syncthreads();
    const int nit = (int)NIT[0];
    if (w >= 4) {
        sa_block_f32(Vt, lane, winK + (size_t)64 * w * 512, winK + (size_t)64 * w * 512 + 256, 64, qf, a0, lut, 512 + q - 64 * w, 512, true);
        if (w == 4) sa_block_f32(Vt, lane, winN, winN + 256, 4, qf, a0, lut, q, 512, true); }
    { FLAS float* PO = (FLAS float*)(L + SM_PUB0); FLAS float* PM = (FLAS float*)(L + SM_PUBML);
#pragma unroll
      for (int dt = 0; dt < 4; ++dt) *(FLAS f32x4*)(PO + (w * 16 + fr) * 64 + 16 * dt + 4 * fq) = a0.o[dt];
      float l0 = a0.l; l0 += __shfl_xor(l0, 16); l0 += __shfl_xor(l0, 32);
      if (fq == 0) { PM[((w * 2 + 0) * 16 + fr) * 2] = a0.m; PM[((w * 2 + 0) * 16 + fr) * 2 + 1] = l0; } }
#pragma unroll 1
    for (int i = 0; i < nit; ++i) { const int p12 = i % 12; if ((p12 < 8 ? p12 : p12 - 8) != w) continue;
        const unsigned item = LIST[i]; const int j = (int)(item & 255u); const bool rowok = ((item >> (8 + q)) & 1u) != 0u;
        const float* kb; int nk;
        if (j < 128) { const int page = pt[b * NPAGES + (j >> 1)]; kb = IN_F(5) + (((size_t)page * PAGE + (j & 1) * 64) * 2) * 256 + g * 64; nk = 64; }
        else { kb = A.out + O_SELS + ((size_t)b * DS) * 512 + g * 64; nk = DS; }
        sa_block_f32(Vt, lane, kb, kb + 256, nk, qf, a1, lut, PAST + q - 64 * j, 1 << 30, rowok); }
    __syncthreads();
    { FLAS float* PO = (FLAS float*)(L + SM_V); FLAS float* PM = (FLAS float*)(L + SM_PUBML);
#pragma unroll
      for (int dt = 0; dt < 4; ++dt) *(FLAS f32x4*)(PO + (w * 16 + fr) * 64 + 16 * dt + 4 * fq) = a1.o[dt];
      float l1 = a1.l; l1 += __shfl_xor(l1, 16); l1 += __shfl_xor(l1, 32);
      if (fq == 0) { PM[((w * 2 + 1) * 16 + fr) * 2] = a1.m; PM[((w * 2 + 1) * 16 + fr) * 2 + 1] = l1; } }
    __syncthreads();
    { const FLAS float* PM = (const FLAS float*)(L + SM_PUBML);
      const int row = tid >> 5, dim = 2 * (tid & 31), qq = row >> 2, rr = row & 3; const size_t grow = (size_t)MP + b * DS + qq;
      const float* gt = (const float*)(fb + F_GT) + grow * 64 + (g * 4 + rr) * 3; float o0 = 0.f, o1 = 0.f;
#pragma unroll
      for (int br = 0; br < 3; ++br) {
          const int w0 = br == 2 ? 4 : 0, w1 = br == 0 ? 4 : 8, set = br == 1 ? 1 : 0; const FLAS float* PO = (const FLAS float*)(L + (br == 1 ? SM_V : SM_PUB0)); float M = -1e30f;
          for (int x = w0; x < w1; ++x) M = fmaxf(M, PM[((x * 2 + set) * 16 + row) * 2]);
          float Ls = 0.f, x0 = 0.f, x1 = 0.f;
          for (int x = w0; x < w1; ++x) { const float f = fexp2(PM[((x * 2 + set) * 16 + row) * 2] - M); Ls += PM[((x * 2 + set) * 16 + row) * 2 + 1] * f;
              const f32x2 ov = *(const FLAS f32x2*)(PO + (x * 16 + row) * 64 + dim); x0 += ov[0] * f; x1 += ov[1] * f; }
          const float gv = Ls > 0.f ? gt[br] / Ls : 0.f; o0 += gv * x0; o1 += gv * x1; }
      *(unsigned*)((bf16*)(fb + F_O) + grow * D + (g * 4 + rr) * 64 + dim) = pk2(o0, o1); }
}

__device__ __forceinline__ void phase_attn(const Ctx& C, CArgs& A, int l) {
    int prev_bg = -1;
    for (int u = C.wg; u < 1024; u += C.G) { const int i = u >> 8, wv = u & 255, bg = wv & 15, k = wv >> 4;
        const int qt = i == 0 ? 63 - k : (i == 1 ? (k == 7 ? 47 : (k == 15 ? 39 : 32 + k)) : (i == 2 ? (k <= 6 ? 14 - k : (k == 15 ? 7 : 31 - k)) : ((k >= 8 && k <= 14) ? 17 + k : (k == 7 ? 16 : k))));
        attn_prompt_unit(C, A, bg >> 2, bg & 3, qt, bg != prev_bg); prev_bg = bg; }
    __syncthreads();
#ifdef FK_TIMING
    unsigned long long* ts2 = (unsigned long long*)(A.fb + F_CTL + 65536 + 1024);
    if (C.wg == FK_TWG && C.tid == 0) ts2[0] = __builtin_amdgcn_s_memrealtime();
#endif
    { const int su = C.wg < 112 ? C.wg : (C.wg >= 240 ? 112 + (C.wg - 240) : -1); if (su >= 0 && su < DB * 4) attn_sample_unit(C, A, su); }
    __syncthreads();
#ifdef FK_TIMING
    if (C.wg == FK_TWG && C.tid == 0) ts2[1] = __builtin_amdgcn_s_memrealtime();
#endif
}
constexpr int NPHASE = 24;
#ifdef FK_TIMING
#define FK_TIMING_ON 1
#else
#define FK_TIMING_ON 0
#endif
__global__ void __launch_bounds__(NTHR, 2) mega(Args A_unused) {
    extern __shared__ __attribute__((aligned(16))) unsigned char lds_raw[];
    Ctx C; C.lds = (FLAS unsigned char*)lds_raw; C.tid = threadIdx.x; C.lane = C.tid & 63; C.wave = __builtin_amdgcn_readfirstlane(C.tid >> 6); C.G = gridDim.x; C.wg = blockIdx.x;
    C.gw = C.wg * NWAVE + C.wave; C.ngw = C.G * NWAVE;
    CArgs* Ap0 = (CArgs*)__builtin_amdgcn_kernarg_segment_ptr();
    unsigned char* fb = Ap0->fb;
    volatile FLAS unsigned* misc = (volatile FLAS unsigned*)(C.lds + LDS_MISC);
    if (C.tid < 8) misc[C.tid] = 0u;
    __syncthreads();
    const int lo = Ap0->lo, hi = Ap0->hi;
    const bool use_bar = (hi - lo) > 1;
    XcdBarrier bar; bar.bar = (unsigned*)(fb + F_CTL) + 1024; bar.x = 0; bar.st = nullptr;
    if (use_bar) bar = xcd_barrier_post((unsigned*)(fb + F_CTL) + 1024, misc);
    int pidx = 0;
#ifdef FK_TIMING
    unsigned long long* ts = (unsigned long long*)(fb + F_CTL + 65536);
    if (C.wg == 0 && C.tid == 0) ts[0] = __builtin_amdgcn_s_memrealtime();
#define TSTAMP() do { if (C.wg == 0 && threadIdx.x == 0) ts[pidx + 1] = __builtin_amdgcn_s_memrealtime(); } while (0)
#else
#define TSTAMP() do {} while (0)
#endif
#define PH_BEGIN if (lo <= pidx && pidx < hi) { C.tid = pg8::opaque_tid(); C.lane = C.tid & 63; { int wg_ = blockIdx.x, G_ = gridDim.x, wv_ = C.wave; asm volatile("" : "+s"(wg_), "+s"(G_), "+s"(wv_)); C.wg = wg_; C.G = G_; C.wave = wv_; C.gw = wg_ * NWAVE + wv_; C.ngw = G_ * NWAVE; } CArgs* Ap = (CArgs*)__builtin_amdgcn_kernarg_segment_ptr(); asm volatile("" : "+s"(Ap)); CArgs& A = *Ap; unsigned char* fb = A.fb; \
        bf16* XF = (bf16*)(fb + F_X); bf16* HF = (bf16*)(fb + F_H); const float* MODF = (const float*)(fb + F_MOD); \
        const float* mod0 = MODF + (size_t)(2 * l) * NC * 3072; const float* mod1 = MODF + (size_t)(2 * l + 1) * NC * 3072; (void)XF; (void)HF; (void)mod0; (void)mod1;
#define PH_END   if (pidx + 1 < hi || FK_TIMING_ON) xcd_barrier(bar); TSTAMP(); } ++pidx;
    { const int l = 0; PH_BEGIN phase_prologue(C, A); PH_END }

    for (int l = 0; l < 4; ++l) {
        if (l == 0) { PH_BEGIN phase_norm(C, A, 0, 0, true, -1, nullptr, false, C.gw, C.ngw, R); PH_END }
        if (l < 2) {
            PH_BEGIN {
                unsigned* flag = (unsigned*)(fb + F_CTL) + 32768 + 64 * (2 * l - 1);
                if (l > 0) { const Ctx Cn = refreshed(C); sample_norm_part(Cn, A, 0, 2 * l, 2 * l - 1, nullptr, false, flag); }
                C = refreshed(C);
                EpGLU e{(bf16*)(fb + F_U), (float*)(fb + F_US), IN_F(13) + (size_t)l * 2048, A.out + O_CONVP + (size_t)l * BATCH * 30 * D, A.out + O_CONVS + (size_t)l * DB * 30 * D};
                const bf16* W = (const bf16*)(fb + F_WPW1) + (size_t)l * 2048 * 1024;
                gemm_prompt(C, HF, W, 2048, 1024, e);
                C = refreshed(C);
                if (l > 0) sample_rows_ready(C, flag, (unsigned*)(fb + F_CTL) + 1024);
                gemm_sample(C, HF + (size_t)MP * D, W, 2048, 1024, e);
            } PH_END
            PH_BEGIN phase_conv(C, A, l); PH_END
            PH_BEGIN {
                EpResidNorm e{l == 0 ? IN_F(0) : nullptr, XF, mod0, IN_F(19) + (size_t)l * D, 0, mod1, nullptr, HF, nullptr, nullptr,
                              (float*)(fb + F_STATS) + (size_t)(2 * l) * 65536, (unsigned*)(fb + F_CTL) + 65536 + (2 * l) * 4096, (unsigned*)(fb + F_CTL) + 1024};
                const bf16* W = (const bf16*)(fb + F_WPW2) + (size_t)l * 1024 * 1024; const bf16* Ain = (const bf16*)(fb + F_C);
                gemm_prompt_fused(C, Ain, W, 1024, e);
                gemm_sample_ksplit(C, Ain + (size_t)MP * D, W, 1024, (float*)(fb + F_PART));
            } PH_END
        } else {
#ifdef FK_HAVE_ATTN
            PH_BEGIN phase_qkv(C, A, l); PH_END
            if (l == 2) { PH_BEGIN phase_prep(C, A); PH_END }
            PH_BEGIN phase_attn(C, A, l); PH_END
            PH_BEGIN {
                EpResidNorm e{nullptr, XF, mod0, nullptr, 0, mod1, nullptr, HF, nullptr, nullptr,
                              (float*)(fb + F_STATS) + (size_t)(2 * l) * 65536, (unsigned*)(fb + F_CTL) + 65536 + (2 * l) * 4096, (unsigned*)(fb + F_CTL) + 1024};
                const bf16* W = (const bf16*)(fb + F_WO) + (size_t)(l - 2) * 1024 * 1024; const bf16* Ain = (const bf16*)(fb + F_O);
                gemm_prompt_fused(C, Ain, W, 1024, e);
                gemm_sample_ksplit(C, Ain + (size_t)MP * D, W, 1024, (float*)(fb + F_PART));
            } PH_END
#endif
        }
        PH_BEGIN {
            unsigned* flag = (unsigned*)(fb + F_CTL) + 32768 + 64 * (2 * l);
            { const Ctx Cn = refreshed(C); sample_norm_part(Cn, A, 0, 2 * l + 1, 2 * l, l < 2 ? IN_F(19) + (size_t)l * D : nullptr, l == 0, flag); }
            C = refreshed(C);
            EpSwiGLU e{(bf16*)(fb + F_ACT)};
            const bf16* W = (const bf16*)(fb + F_WGU) + (size_t)l * 5632 * 1024;
            gemm_prompt(C, HF, W, 5632, 1024, e);
            C = refreshed(C);
            sample_rows_ready(C, flag, (unsigned*)(fb + F_CTL) + 1024);
            gemm_sample(C, HF + (size_t)MP * D, W, 5632, 1024, e);
        } PH_END
        PH_BEGIN {
            EpResidNorm e{nullptr, XF, mod1, nullptr, l == 3 ? 2 : (l == 1 ? 1 : 0), MODF + (size_t)(l < 3 ? 2 * l + 2 : 0) * NC * 3072, l == 3 ? IN_F(33) : IN_F(20), HF, (bf16*)(fb + F_HKV), A.out + O_YP,
                          (float*)(fb + F_STATS) + (size_t)(2 * l + 1) * 65536, (unsigned*)(fb + F_CTL) + 65536 + (2 * l + 1) * 4096, (unsigned*)(fb + F_CTL) + 1024};
            const bf16* W = (const bf16*)(fb + F_WDN) + (size_t)l * 1024 * 2816; const bf16* Ain = (const bf16*)(fb + F_ACT);
            gemm_prompt_fused(C, Ain, W, 2816, e);
            gemm_sample_ksplit(C, Ain + (size_t)MP * DFF, W, 2816, (float*)(fb + F_PART));
        } PH_END
    }
    { const int l = 0; PH_BEGIN phase_norm(C, A, 2, 0, false, 7, nullptr, false, MP + C.gw, C.ngw, R); PH_END }
#undef PH_BEGIN
#undef PH_END
}


#ifdef FK_TIMING
__global__ void k_encode(const unsigned long long* ts, float* out) {
    float t1 = 0.f, t2 = 0.f;
    for (int p = 0; p < 31; ++p) { const float us = (float)(ts[p + 1] - ts[p]) * 0.01f;
        if ((FK_M1 >> p) & 1ull) t1 += us; if ((FK_M2 >> p) & 1ull) t2 += us; }
#ifdef FK_TSPLIT
    { const unsigned long long* ts2 = ts + 128;
      if (FK_TSPLIT == 1) { t1 = (float)(ts2[0] - ts[25]) * 0.01f; t2 = (float)(ts2[1] - ts2[0]) * 0.01f; }
      if (FK_TSPLIT == 4) { t1 = (float)ts2[6] * 0.01f; t2 = (float)ts2[7] * 0.01f; } }
#endif
    const float sc = 1.f + sqrtf(t1 * 1e-5f);
    for (int i = threadIdx.x; i < MS * D; i += blockDim.x) out[O_YS + i] *= sc;
    if (threadIdx.x == 0) out[O_YP + 12345] += t2 * 1e-2f;
}
#endif
static int g_grid = 0;
static bool fast_setup() {
    if (g_grid) return g_grid > 0;
    int dev = 0, cus = 0;
    if (hipGetDevice(&dev) != hipSuccess || hipDeviceGetAttribute(&cus, hipDeviceAttributeMultiprocessorCount, dev) != hipSuccess) { g_grid = -1; return false; }
    if (hipFuncSetAttribute((const void*)mega, hipFuncAttributeMaxDynamicSharedMemorySize, LDS_BYTES) != hipSuccess) { g_grid = -1; return false; }
    int per_cu = 0; (void)hipOccupancyMaxActiveBlocksPerMultiprocessor(&per_cu, (const void*)mega, NTHR, LDS_BYTES); (void)hipGetLastError();
    if (per_cu < 1) fprintf(stderr, "fast_setup: occupancy query says %d blocks/CU\n", per_cu);
    g_grid = cus;
    return true;
}
static void fast_launch(void* const* d_in, float* out, unsigned char* fb, int lo, int hi, hipStream_t st) {
    if (!fast_setup()) return;
    Args a{}; for (int i = 0; i < 34; ++i) a.in[i] = d_in[i]; a.out = out; a.fb = fb; a.lo = lo; a.hi = hi;
    hipLaunchKernelGGL(mega, dim3(g_grid), dim3(NTHR), LDS_BYTES, st, a);
}
}
extern "C" void kernel_launch(void* const* d_in, const int* in_sizes, int n_in, void* d_out, int out_size, void* d_ws, size_t ws_size, hipStream_t stream) {
    if (ws_size < fk::F_END) { fprintf(stderr, "ws too small: %zu < %zu\n", ws_size, (size_t)fk::F_END); return; }
    unsigned char* fb = (unsigned char*)d_ws;
    (void)hipMemsetAsync(fb + fk::F_CTL, 0, fk::CTL_BYTES, stream);
#if FK_NLAUNCH == 1
    fk::fast_launch(d_in, (float*)d_out, fb, 0, fk::NPHASE, stream);
#ifdef FK_TIMING
    fk::k_encode<<<1, 256, 0, stream>>>((const unsigned long long*)(fb + fk::F_CTL + 65536), (float*)d_out);
#endif
#else
    for (int p = 0; p < fk::NPHASE; ++p) fk::fast_launch(d_in, (float*)d_out, fb, p, p + 1, stream);
#endif
}
```

```cpp
#define FK_NLAUNCH 1
#include <math.h>
#include <hip/hip_runtime.h>
#include <stdint.h>
#include <stdio.h>

namespace nv {
constexpr int D = 1024, BATCH = 4, SEQ = 4096, DB = 32, DS = 4, PAST = 8192, PAGE = 128, NPAGES = 64;
constexpr int KVH = 4, GROUP = 4, HD = 64, CONVW = 31, DFF = 2816, PHI = 128, QGW = 1072, KVW = 1536;
constexpr int MP = BATCH * SEQ, MS = DB * DS, R = MP + MS, NC = 36;
constexpr float EPS = 1e-6f;

constexpr size_t O_YP = 0, O_YS = O_YP + (size_t)MP * D, O_CMPP = O_YS + (size_t)MS * D, O_CMPS = O_CMPP + (size_t)MP * 512,
                 O_SELP = O_CMPS + (size_t)MS * 512, O_SELS = O_SELP + (size_t)MP * 512, O_WINP = O_SELS + (size_t)MS * 512,
                 O_WINS = O_WINP + (size_t)BATCH * 512 * 512, O_CONVP = O_WINS + (size_t)DB * 512 * 512,
                 O_CONVS = O_CONVP + (size_t)2 * BATCH * 30 * D, O_END = O_CONVS + (size_t)2 * DB * 30 * D;

__device__ __forceinline__ float silu(float x) { return x / (1.f + expf(-x)); }
__device__ __forceinline__ float sigm(float x) { return 1.f / (1.f + expf(-x)); }
__device__ __forceinline__ int cidx_of(int row) { return row < MP ? row / SEQ : 4 + (row - MP) / DS; }
__device__ __forceinline__ int rel_bucket(int n) {
    if (n < 0) n = 0;
    if (n < 16) return n;
    int b = 16;
    b += (n >= 21); b += (n >= 27); b += (n >= 35); b += (n >= 46); b += (n >= 59); b += (n >= 77); b += (n >= 99); b += (n >= 128);
    b += (n >= 166); b += (n >= 216); b += (n >= 280); b += (n >= 363); b += (n >= 470); b += (n >= 609); b += (n >= 790);
    return b;
}

__global__ __launch_bounds__(256) void k_gemm(const float* __restrict__ A, int lda, const float* __restrict__ W, int ldw, const float* __restrict__ bias,
                                              float* __restrict__ C, int ldc, int M, int N, int K) {
    __shared__ float As[16][68];
    __shared__ float Ws[16][68];
    const int tid = threadIdx.x, tx = tid & 15, ty = tid >> 4;
    const int m0 = blockIdx.y * 64, n0 = blockIdx.x * 64;
    float acc[4][4];
#pragma unroll
    for (int i = 0; i < 4; ++i)
#pragma unroll
        for (int j = 0; j < 4; ++j) acc[i][j] = 0.f;
    for (int k0 = 0; k0 < K; k0 += 16) {
#pragma unroll
        for (int it = 0; it < 4; ++it) { const int i = tid + it * 256; const int m = i >> 4, k = i & 15; const int gm = m0 + m; As[k][m] = gm < M ? A[(size_t)gm * lda + k0 + k] : 0.f; }
#pragma unroll
        for (int it = 0; it < 4; ++it) { const int i = tid + it * 256; const int k = i >> 6, n = i & 63; const int gn = n0 + n; Ws[k][n] = gn < N ? W[(size_t)(k0 + k) * ldw + gn] : 0.f; }
        __syncthreads();
#pragma unroll
        for (int k = 0; k < 16; ++k) {
            const float4 a = *(const float4*)&As[k][ty * 4]; const float4 b = *(const float4*)&Ws[k][tx * 4];
            const float av[4] = {a.x, a.y, a.z, a.w}, bv[4] = {b.x, b.y, b.z, b.w};
#pragma unroll
            for (int i = 0; i < 4; ++i)
#pragma unroll
                for (int j = 0; j < 4; ++j) acc[i][j] += av[i] * bv[j];
        }
        __syncthreads();
    }
#pragma unroll
    for (int i = 0; i < 4; ++i) { const int gm = m0 + ty * 4 + i; if (gm >= M) continue;
#pragma unroll
        for (int j = 0; j < 4; ++j) { const int gn = n0 + tx * 4 + j; if (gn < N) C[(size_t)gm * ldc + gn] = acc[i][j] + (bias ? bias[gn] : 0.f); } }
}

__global__ void k_silu_c(const float* cp, const float* cs, float* SC) {
    const int i = blockIdx.x * blockDim.x + threadIdx.x; if (i >= NC * D) return;
    const int r = i / D, k = i % D; const float v = r < 4 ? cp[r * D + k] : cs[(r - 4) * D + k]; SC[i] = silu(v);
}

__device__ __forceinline__ float block_sum256(float v, float* red) {
#pragma unroll
    for (int o = 32; o >= 1; o >>= 1) v += __shfl_xor(v, o);
    __syncthreads();
    if ((threadIdx.x & 63) == 0) red[threadIdx.x >> 6] = v;
    __syncthreads();
    return red[0] + red[1] + red[2] + red[3];
}
__global__ __launch_bounds__(256) void k_modnorm(const float* __restrict__ X, const float* __restrict__ g, const float* __restrict__ mod, float* __restrict__ H) {
    __shared__ float red[4];
    const int row = blockIdx.x, t = threadIdx.x; const float4 x = ((const float4*)(X + (size_t)row * D))[t];
    const float ss = block_sum256(x.x * x.x + x.y * x.y + x.z * x.z + x.w * x.w, red);
    const float rstd = (1.0f / sqrtf(ss * (1.f / D) + EPS));
    const float4 gv = ((const float4*)g)[t]; float4 y = {x.x * rstd * gv.x, x.y * rstd * gv.y, x.z * rstd * gv.z, x.w * rstd * gv.w};
    if (mod) { const float* m = mod + (size_t)cidx_of(row) * 3072; const float4 sh = ((const float4*)m)[t], sc = ((const float4*)(m + D))[t];
        y.x = y.x * (1.f + sc.x) + sh.x; y.y = y.y * (1.f + sc.y) + sh.y; y.z = y.z * (1.f + sc.z) + sh.z; y.w = y.w * (1.f + sc.w) + sh.w; }
    ((float4*)(H + (size_t)row * D))[t] = y;
}
__global__ void k_glu(const float* __restrict__ T1, float* __restrict__ U) {
    const size_t i = (size_t)blockIdx.x * blockDim.x + threadIdx.x; if (i >= (size_t)R * D) return;
    const size_t r = i / D; const int c = (int)(i % D); const float a = T1[r * 2048 + c], gg = T1[r * 2048 + D + c]; U[i] = a * sigm(gg);
}
__global__ void k_conv(const float* __restrict__ U, const float* __restrict__ state  , const float* __restrict__ wdw  , const float* __restrict__ bdw,
                       float* __restrict__ Y) {
    const size_t i = (size_t)blockIdx.x * blockDim.x + threadIdx.x; if (i >= (size_t)R * D) return;
    const int row = (int)(i / D), c = (int)(i % D); float acc = bdw[c];
    if (row < MP) { const int b = row / SEQ, t = row % SEQ;
        for (int k = 0; k < CONVW; ++k) { const int tt = t - 30 + k; if (tt >= 0) acc += wdw[k * D + c] * U[((size_t)b * SEQ + tt) * D + c]; }
    } else { const int rs = row - MP, b = rs / DS, t = rs % DS;
        for (int k = 0; k < CONVW; ++k) { const int j = t + k; const float v = j < 30 ? state[((size_t)b * 30 + j) * D + c] : U[((size_t)MP + b * DS + (j - 30)) * D + c]; acc += wdw[k * D + c] * v; }
    }
    Y[i] = acc;
}
__global__ void k_conv_state_out(const float* __restrict__ U, const float* __restrict__ state, float* __restrict__ outp  , float* __restrict__ outs  ) {
    const int i = blockIdx.x * blockDim.x + threadIdx.x; const int NPo = BATCH * 30 * D, NSo = DB * 30 * D;
    if (i < NPo) { const int b = i / (30 * D), j = (i / D) % 30, c = i % D; outp[i] = U[((size_t)b * SEQ + SEQ - 30 + j) * D + c]; }
    else if (i < NPo + NSo) { const int ii = i - NPo; const int b = ii / (30 * D), j = (ii / D) % 30, c = ii % D;
        outs[ii] = j < 26 ? state[((size_t)b * 30 + j + 4) * D + c] : U[((size_t)MP + b * DS + (j - 26)) * D + c]; }
}
__global__ __launch_bounds__(256) void k_ln_silu(const float* __restrict__ Y, const float* __restrict__ g, const float* __restrict__ bb, float* __restrict__ Cc) {
    __shared__ float red[4];
    const int row = blockIdx.x, t = threadIdx.x; const float4 x = ((const float4*)(Y + (size_t)row * D))[t];
    const float mu = block_sum256(x.x + x.y + x.z + x.w, red) * (1.f / D);
    const float4 d = {x.x - mu, x.y - mu, x.z - mu, x.w - mu};
    const float var = block_sum256(d.x * d.x + d.y * d.y + d.z * d.z + d.w * d.w, red) * (1.f / D);
    const float rstd = (1.0f / sqrtf(var + EPS)); const float4 gv = ((const float4*)g)[t], bv = ((const float4*)bb)[t];
    float4 y = {silu(d.x * rstd * gv.x + bv.x), silu(d.y * rstd * gv.y + bv.y), silu(d.z * rstd * gv.z + bv.z), silu(d.w * rstd * gv.w + bv.w)};
    ((float4*)(Cc + (size_t)row * D))[t] = y;
}
__global__ void k_resid(float* __restrict__ X, const float* __restrict__ T, int ldt, const float* __restrict__ mod) {
    const size_t i = (size_t)blockIdx.x * blockDim.x + threadIdx.x; if (i >= (size_t)R * D) return;
    const int row = (int)(i / D), c = (int)(i % D); X[i] += mod[(size_t)cidx_of(row) * 3072 + 2048 + c] * T[(size_t)row * ldt + c];
}
__global__ void k_swiglu(const float* __restrict__ G, const float* __restrict__ UP, float* __restrict__ ACT) {
    const size_t i = (size_t)blockIdx.x * blockDim.x + threadIdx.x; if (i >= (size_t)R * DFF) return; ACT[i] = silu(G[i]) * UP[i];
}
__global__ void k_kv_out(const float* __restrict__ ROWS, const float* __restrict__ cache_win, float* __restrict__ out) {
    const size_t i = (size_t)blockIdx.x * blockDim.x + threadIdx.x;
    const size_t n1 = (size_t)MP * 512, n2 = (size_t)MS * 512, n3 = (size_t)BATCH * 512 * 512, n4 = (size_t)DB * 512 * 512;
    if (i < n1) { const size_t r = i / 512, c = i % 512; out[O_CMPP + i] = ROWS[r * KVW + c]; out[O_SELP + i] = ROWS[r * KVW + 512 + c]; }
    if (i < n2) { const size_t r = i / 512, c = i % 512; out[O_CMPS + i] = ROWS[(MP + r) * KVW + c]; out[O_SELS + i] = ROWS[(MP + r) * KVW + 512 + c]; }
    if (i < n3) { const size_t b = i / (512 * 512), j = (i / 512) % 512, c = i % 512; out[O_WINP + i] = ROWS[(b * SEQ + SEQ - 512 + j) * KVW + 1024 + c]; }
    if (i < n4) { const size_t b = i / (512 * 512), j = (i / 512) % 512, c = i % 512;
        out[O_WINS + i] = j < 508 ? cache_win[(b * 512 + j + 4) * 512 + c] : ROWS[(MP + b * DS + (j - 508)) * KVW + 1024 + c]; }
}
__global__ __launch_bounds__(256) void k_compress(int is_prompt, const float* __restrict__ ROWS, const float* __restrict__ cache, const int* __restrict__ pt,
                                                   const float* __restrict__ w1, const float* __restrict__ b1, const float* __restrict__ w2, const float* __restrict__ b2,
                                                   const float* __restrict__ pe, float* __restrict__ CMP) {
    __shared__ float blk[32 * 4 * 64];
    __shared__ float hid[4][PHI];
    const int NB = is_prompt ? 128 : 256, BB = is_prompt ? BATCH : DB;
    const int e = blockIdx.x & 1, n = (blockIdx.x >> 1) % NB, b = (blockIdx.x >> 1) / NB, tid = threadIdx.x;
    for (int i = tid; i < 32 * 256; i += 256) { const int t = i >> 8, gd = i & 255; float v;
        if (is_prompt) v = ROWS[((size_t)b * SEQ + n * 32 + t) * KVW + e * 256 + gd];
        else { const int page = pt[b * NPAGES + (n >> 2)]; v = cache[(((size_t)page * PAGE + (n & 3) * 32 + t) * 2 + e) * 256 + gd]; }
        blk[i] = v + pe[(e * 32 + t) * 64 + (gd & 63)]; }
    __syncthreads();
    const int h = tid & 127, gp = tid >> 7; float a0 = 0.f, a1 = 0.f; const float* w = w1 + (size_t)e * 2048 * PHI + h;
    for (int f = 0; f < 2048; ++f) { const int t = f >> 6, d = f & 63; const float wv = w[(size_t)f * PHI]; a0 += blk[(t * 4 + gp * 2) * 64 + d] * wv; a1 += blk[(t * 4 + gp * 2 + 1) * 64 + d] * wv; }
    hid[gp * 2][h] = silu(a0 + b1[e * PHI + h]); hid[gp * 2 + 1][h] = silu(a1 + b1[e * PHI + h]);
    __syncthreads();
    const int g = tid >> 6, d = tid & 63; float o = b2[e * 64 + d];
    for (int hh = 0; hh < PHI; ++hh) o += hid[g][hh] * w2[((size_t)e * PHI + hh) * 64 + d];
    CMP[((((size_t)e * BB + b) * NB + n) * 4 + g) * 64 + d] = o;
}

struct AttnP {
    const float* QG;
    const float* ROWS;
    const float* CMP;
    const float* cache_sel; const float* cache_win; const int* pt; const float* table;
    float* O;
};
__device__ __forceinline__ const float* kv_ptr_sel(const AttnP& P, int is_prompt, int b, int g, int e, int pos) {
    if (is_prompt) return P.ROWS + ((size_t)b * SEQ + pos) * KVW + 512 + e * 256 + g * 64;
    if (pos < PAST) { const int page = P.pt[b * NPAGES + pos / PAGE]; return P.cache_sel + (((size_t)page * PAGE + pos % PAGE) * 2 + e) * 256 + g * 64; }
    return P.ROWS + ((size_t)MP + b * DS + (pos - PAST)) * KVW + 512 + e * 256 + g * 64;
}
__device__ __forceinline__ const float* kv_ptr_win(const AttnP& P, int is_prompt, int b, int g, int e, int pos) {
    if (is_prompt) return P.ROWS + ((size_t)b * SEQ + pos) * KVW + 1024 + e * 256 + g * 64;
    const int i = pos - (PAST + DS - 516);
    if (i < 512) return P.cache_win + (((size_t)b * 512 + i) * 2 + e) * 256 + g * 64;
    return P.ROWS + ((size_t)MP + b * DS + (i - 512)) * KVW + 1024 + e * 256 + g * 64;
}
__device__ __forceinline__ float wave_max(float v) {
#pragma unroll
    for (int o = 32; o >= 1; o >>= 1) v = fmaxf(v, __shfl_xor(v, o)); return v; }
__device__ __forceinline__ float wave_sum(float v) {
#pragma unroll
    for (int o = 32; o >= 1; o >>= 1) v += __shfl_xor(v, o); return v; }

constexpr int SBW = 1088;
__global__ __launch_bounds__(64) void k_attn(AttnP P, int is_prompt) {
    __shared__ float qs[4][64];
    __shared__ float sb[4][SBW];
    __shared__ float impb[192];
    __shared__ float scoreb[192];
    __shared__ int selb[16];
    const int lane = threadIdx.x; const int T = is_prompt ? SEQ : DS;
    const int g = blockIdx.x & 3, q = (blockIdx.x >> 2) % T, b = (blockIdx.x >> 2) / T;
    const int qpos = is_prompt ? q : PAST + q; const int row = is_prompt ? b * SEQ + q : MP + b * DS + q;
    const int NCMP = is_prompt ? 128 : 256, NBLK = is_prompt ? 64 : 129, BB = is_prompt ? BATCH : DB;
    const float NEGM = -3.0e38f;
#pragma unroll
    for (int r = 0; r < 4; ++r) qs[r][lane] = P.QG[(size_t)row * QGW + (g * 4 + r) * 64 + lane] * 0.125f;
    float gate[4][3];
#pragma unroll
    for (int r = 0; r < 4; ++r)
#pragma unroll
        for (int br = 0; br < 3; ++br) gate[r][br] = sigm(P.QG[(size_t)row * QGW + 1024 + (g * 4 + r) * 3 + br]);
    __syncthreads();
    float out[4] = {0.f, 0.f, 0.f, 0.f};
    {
        const float* CK = P.CMP + ((size_t)0 * BB + b) * NCMP * 256; const float* CV = P.CMP + ((size_t)1 * BB + b) * NCMP * 256;
        float mx[4] = {NEGM, NEGM, NEGM, NEGM};
        for (int n = lane; n < NCMP; n += 64) { const int endp = n * 32 + 31; const bool valid = endp <= qpos; const float* k = CK + ((size_t)n * 4 + g) * 64;
            float s[4] = {0.f, 0.f, 0.f, 0.f};
            for (int d = 0; d < 64; ++d) { const float kv = k[d]; s[0] += qs[0][d] * kv; s[1] += qs[1][d] * kv; s[2] += qs[2][d] * kv; s[3] += qs[3][d] * kv; }
            const int bk = rel_bucket(qpos - endp);
#pragma unroll
            for (int r = 0; r < 4; ++r) { const float v = valid ? s[r] + P.table[bk * 16 + g * 4 + r] : NEGM; sb[r][n] = v; mx[r] = fmaxf(mx[r], v); } }
        float sm[4];
#pragma unroll
        for (int r = 0; r < 4; ++r) { mx[r] = wave_max(mx[r]); float a = 0.f;
            for (int n = lane; n < NCMP; n += 64) { const float v = sb[r][n]; const float p = v > -1e38f ? expf(v - mx[r]) : 0.f; sb[r][n] = p; a += p; }
            sm[r] = wave_sum(a); }
        __syncthreads();
#pragma unroll
        for (int r = 0; r < 4; ++r) { const float inv = sm[r] > 0.f ? 1.f / sm[r] : 0.f; for (int n = lane; n < NCMP; n += 64) sb[r][n] *= inv; }
        __syncthreads();
        float oc[4] = {0.f, 0.f, 0.f, 0.f};
        for (int n = 0; n < NCMP; ++n) { const float v = CV[((size_t)n * 4 + g) * 64 + lane]; oc[0] += sb[0][n] * v; oc[1] += sb[1][n] * v; oc[2] += sb[2][n] * v; oc[3] += sb[3][n] * v; }
#pragma unroll
        for (int r = 0; r < 4; ++r) out[r] += gate[r][0] * oc[r];
        for (int j = lane; j < NBLK; j += 64) { float a = 0.f, c = 0.f;
            if (2 * j < NCMP) a = ((sb[0][2 * j] + sb[1][2 * j]) + sb[2][2 * j]) + sb[3][2 * j];
            if (2 * j + 1 < NCMP) c = ((sb[0][2 * j + 1] + sb[1][2 * j + 1]) + sb[2][2 * j + 1]) + sb[3][2 * j + 1];
            float nz = 1.f;
#ifdef IMP_NOISE
            { unsigned hsh = (unsigned)(j * 2654435761u) ^ (unsigned)(blockIdx.x * 40503u + 12345u); hsh ^= hsh >> 15; hsh *= 2246822519u; hsh ^= hsh >> 13; hsh *= 3266489917u; hsh ^= hsh >> 16;
              nz = 1.f + IMP_NOISE * ((float)(hsh & 0xffff) * (2.f / 65535.f) - 1.f); }
#endif
            impb[j] = (a + c) * nz; }
        __syncthreads();
    }
    const int jq = qpos / 64;
    for (int j = lane; j < NBLK; j += 64) { const bool forced = (j == 0) || (j == jq) || (j == jq - 1); scoreb[j] = j <= jq ? (forced ? 1e4f : impb[j]) : -1.f; }
    if (lane < 16) selb[lane] = -1;
    __syncthreads();
    for (int j = lane; j < NBLK; j += 64) { const float sj = scoreb[j]; int rank = 0;
        for (int i = 0; i < NBLK; ++i) { const float si = scoreb[i]; rank += (si > sj || (si == sj && i < j)) ? 1 : 0; }
        if (rank < 16 && sj >= 0.f) selb[rank] = j; }
    __syncthreads();
    {
        float mx[4] = {NEGM, NEGM, NEGM, NEGM};
        for (int sl = 0; sl < 16; ++sl) { const int j = selb[sl]; const int kpos = j * 64 + lane; const bool valid = (j >= 0) && (kpos <= qpos);
            float s[4] = {0.f, 0.f, 0.f, 0.f};
            if (valid) { const float* k = kv_ptr_sel(P, is_prompt, b, g, 0, kpos);
                for (int d = 0; d < 64; ++d) { const float kv = k[d]; s[0] += qs[0][d] * kv; s[1] += qs[1][d] * kv; s[2] += qs[2][d] * kv; s[3] += qs[3][d] * kv; } }
            const int bk = rel_bucket(qpos - kpos);
#pragma unroll
            for (int r = 0; r < 4; ++r) { const float v = valid ? s[r] + P.table[bk * 16 + g * 4 + r] : NEGM; sb[r][sl * 64 + lane] = v; mx[r] = fmaxf(mx[r], v); } }
        float sm[4];
#pragma unroll
        for (int r = 0; r < 4; ++r) { mx[r] = wave_max(mx[r]); float a = 0.f;
            for (int n = lane; n < 1024; n += 64) { const float v = sb[r][n]; const float p = v > -1e38f ? expf(v - mx[r]) : 0.f; sb[r][n] = p; a += p; }
            sm[r] = wave_sum(a); }
        __syncthreads();
        float os[4] = {0.f, 0.f, 0.f, 0.f};
        for (int sl = 0; sl < 16; ++sl) { const int j = selb[sl]; if (j < 0) continue;
            for (int kk = 0; kk < 64; ++kk) { const int kpos = j * 64 + kk; if (kpos > qpos) break;
                const float v = kv_ptr_sel(P, is_prompt, b, g, 1, kpos)[lane]; const int n = sl * 64 + kk;
                os[0] += sb[0][n] * v; os[1] += sb[1][n] * v; os[2] += sb[2][n] * v; os[3] += sb[3][n] * v; } }
#pragma unroll
        for (int r = 0; r < 4; ++r) out[r] += gate[r][1] * (sm[r] > 0.f ? os[r] / sm[r] : 0.f);
        __syncthreads();
    }
    {
        float mx[4] = {NEGM, NEGM, NEGM, NEGM};
        for (int i = lane; i < 512; i += 64) { const int kpos = qpos - 511 + i; const bool valid = kpos >= 0 && (is_prompt || kpos >= PAST + DS - 516);
            float s[4] = {0.f, 0.f, 0.f, 0.f};
            if (valid) { const float* k = kv_ptr_win(P, is_prompt, b, g, 0, kpos);
                for (int d = 0; d < 64; ++d) { const float kv = k[d]; s[0] += qs[0][d] * kv; s[1] += qs[1][d] * kv; s[2] += qs[2][d] * kv; s[3] += qs[3][d] * kv; } }
            const int bk = rel_bucket(qpos - kpos);
#pragma unroll
            for (int r = 0; r < 4; ++r) { const float v = valid ? s[r] + P.table[bk * 16 + g * 4 + r] : NEGM; sb[r][i] = v; mx[r] = fmaxf(mx[r], v); } }
        float sm[4];
#pragma unroll
        for (int r = 0; r < 4; ++r) { mx[r] = wave_max(mx[r]); float a = 0.f;
            for (int n = lane; n < 512; n += 64) { const float v = sb[r][n]; const float p = v > -1e38f ? expf(v - mx[r]) : 0.f; sb[r][n] = p; a += p; }
            sm[r] = wave_sum(a); }
        __syncthreads();
        float ow[4] = {0.f, 0.f, 0.f, 0.f};
        for (int i = 0; i < 512; ++i) { const int kpos = qpos - 511 + i; if (kpos < 0 || (!is_prompt && kpos < PAST + DS - 516)) continue;
            const float v = kv_ptr_win(P, is_prompt, b, g, 1, kpos)[lane];
            ow[0] += sb[0][i] * v; ow[1] += sb[1][i] * v; ow[2] += sb[2][i] * v; ow[3] += sb[3][i] * v; }
#pragma unroll
        for (int r = 0; r < 4; ++r) out[r] += gate[r][2] * (sm[r] > 0.f ? ow[r] / sm[r] : 0.f);
    }
#pragma unroll
    for (int r = 0; r < 4; ++r) P.O[(size_t)row * D + (g * 4 + r) * 64 + lane] = out[r];
}

constexpr size_t W_SC = 0, W_MOD = W_SC + (size_t)NC * D, W_X = W_MOD + (size_t)8 * NC * 3072, W_H = W_X + (size_t)R * D, W_T1 = W_H + (size_t)R * D,
                 W_T2 = W_T1 + (size_t)R * DFF, W_U = W_T2 + (size_t)R * DFF, W_Y = W_U + (size_t)R * D, W_CC = W_Y + (size_t)R * D, W_ACT = W_CC + (size_t)R * D,
                 W_ROWS = W_ACT + (size_t)R * DFF, W_QG = W_ROWS + (size_t)R * KVW, W_O = W_QG + (size_t)R * QGW, W_CMPP = W_O + (size_t)R * D,
                 W_CMPS = W_CMPP + (size_t)2 * BATCH * 128 * 256, W_END = W_CMPS + (size_t)2 * DB * 256 * 256;

static inline void gemm(hipStream_t st, const float* A, int lda, const float* W, int ldw, const float* bias, float* C, int ldc, int M, int N, int K) {
    dim3 grid((N + 63) / 64, (M + 63) / 64); k_gemm<<<grid, 256, 0, st>>>(A, lda, W, ldw, bias, C, ldc, M, N, K);
}
static inline unsigned cdiv(size_t a, size_t b) { return (unsigned)((a + b - 1) / b); }

typedef void (*Hook)(int id, void* ctx);
static void naive_forward(void* const* d_in, float* out, float* ws, hipStream_t st, Hook hook = nullptr, void* hctx = nullptr) {
#define HOOK(id) do { if (hook) hook((id), hctx); } while (0)
    const float* x_prompt = (const float*)d_in[0]; const float* x_sample = (const float*)d_in[1]; const float* c_prompt = (const float*)d_in[2]; const float* c_sample = (const float*)d_in[3];
    const float* cache_cmp = (const float*)d_in[4]; const float* cache_sel = (const float*)d_in[5]; const float* cache_win = (const float*)d_in[6]; const float* state_conv = (const float*)d_in[7];
    const int* pt = (const int*)d_in[8]; const float* w_ada = (const float*)d_in[9]; const float* b_ada = (const float*)d_in[10]; const float* norm_g = (const float*)d_in[11];
    const float* w_pw1 = (const float*)d_in[12]; const float* b_pw1 = (const float*)d_in[13]; const float* w_dw = (const float*)d_in[14]; const float* b_dw = (const float*)d_in[15];
    const float* ln_g = (const float*)d_in[16]; const float* ln_b = (const float*)d_in[17]; const float* w_pw2 = (const float*)d_in[18]; const float* b_pw2 = (const float*)d_in[19];
    const float* g_kv = (const float*)d_in[20]; const float* w_kv = (const float*)d_in[21]; const float* w_phi1 = (const float*)d_in[22]; const float* b_phi1 = (const float*)d_in[23];
    const float* w_phi2 = (const float*)d_in[24]; const float* b_phi2 = (const float*)d_in[25]; const float* pe_cmp = (const float*)d_in[26]; const float* w_qg = (const float*)d_in[27];
    const float* w_o = (const float*)d_in[28]; const float* rel_table = (const float*)d_in[29]; const float* w_gate = (const float*)d_in[30]; const float* w_up = (const float*)d_in[31];
    const float* w_down = (const float*)d_in[32]; const float* final_g = (const float*)d_in[33];
    float *SC = ws + W_SC, *MOD = ws + W_MOD, *X = ws + W_X, *H = ws + W_H, *T1 = ws + W_T1, *T2 = ws + W_T2, *U = ws + W_U, *Y = ws + W_Y, *CC = ws + W_CC, *ACT = ws + W_ACT,
          *ROWS = ws + W_ROWS, *QG = ws + W_QG, *O = ws + W_O, *CMPP = ws + W_CMPP, *CMPS = ws + W_CMPS;
    const size_t RD = (size_t)R * D;
    hipMemcpyAsync(X, x_prompt, (size_t)MP * D * 4, hipMemcpyDeviceToDevice, st);
    hipMemcpyAsync(X + (size_t)MP * D, x_sample, (size_t)MS * D * 4, hipMemcpyDeviceToDevice, st);
    k_silu_c<<<cdiv(NC * D, 256), 256, 0, st>>>(c_prompt, c_sample, SC);
    for (int ls = 0; ls < 8; ++ls) gemm(st, SC, D, w_ada + (size_t)ls * D * 3072, 3072, b_ada + (size_t)ls * 3072, MOD + (size_t)ls * NC * 3072, 3072, NC, 3072, D);
    HOOK(1);
    for (int l = 0; l < 4; ++l) {
        const float* mod0 = MOD + (size_t)(l * 2 + 0) * NC * 3072; const float* mod1 = MOD + (size_t)(l * 2 + 1) * NC * 3072;
        if (l == 2) {
            k_modnorm<<<R, 256, 0, st>>>(X, g_kv, nullptr, H);
            gemm(st, H, D, w_kv, KVW, nullptr, ROWS, KVW, R, KVW, D);
            k_kv_out<<<cdiv((size_t)MP * 512, 256), 256, 0, st>>>(ROWS, cache_win, out);
            k_compress<<<BATCH * 128 * 2, 256, 0, st>>>(1, ROWS, cache_cmp, pt, w_phi1, b_phi1, w_phi2, b_phi2, pe_cmp, CMPP);
            k_compress<<<DB * 256 * 2, 256, 0, st>>>(0, ROWS, cache_cmp, pt, w_phi1, b_phi1, w_phi2, b_phi2, pe_cmp, CMPS);
            HOOK(250);
        }
        k_modnorm<<<R, 256, 0, st>>>(X, norm_g + (size_t)(l * 2) * D, mod0, H);
        HOOK(100 * l + 1);
        if (l < 2) {
            gemm(st, H, D, w_pw1 + (size_t)l * D * 2048, 2048, b_pw1 + (size_t)l * 2048, T1, 2048, R, 2048, D);
            k_glu<<<cdiv(RD, 256), 256, 0, st>>>(T1, U);
            HOOK(100 * l + 2);
            k_conv<<<cdiv(RD, 256), 256, 0, st>>>(U, state_conv + (size_t)l * DB * 30 * D, w_dw + (size_t)l * CONVW * D, b_dw + (size_t)l * D, Y);
            k_conv_state_out<<<cdiv((size_t)(BATCH + DB) * 30 * D, 256), 256, 0, st>>>(U, state_conv + (size_t)l * DB * 30 * D, out + O_CONVP + (size_t)l * BATCH * 30 * D, out + O_CONVS + (size_t)l * DB * 30 * D);
            k_ln_silu<<<R, 256, 0, st>>>(Y, ln_g + (size_t)l * D, ln_b + (size_t)l * D, CC);
            HOOK(100 * l + 3);
            gemm(st, CC, D, w_pw2 + (size_t)l * D * D, D, b_pw2 + (size_t)l * D, T2, D, R, D, D);
        } else {
            const int lb = l - 2;
            gemm(st, H, D, w_qg + (size_t)lb * D * QGW, QGW, nullptr, QG, QGW, R, QGW, D);
            HOOK(100 * l + 2);
            AttnP P{QG, ROWS, CMPP, cache_sel, cache_win, pt, rel_table, O};
            k_attn<<<BATCH * SEQ * 4, 64, 0, st>>>(P, 1);
            P.CMP = CMPS;
            k_attn<<<DB * DS * 4, 64, 0, st>>>(P, 0);
            HOOK(100 * l + 3);
            gemm(st, O, D, w_o + (size_t)lb * D * D, D, nullptr, T2, D, R, D, D);
        }
        k_resid<<<cdiv(RD, 256), 256, 0, st>>>(X, T2, D, mod0);
        HOOK(100 * l + 4);
        k_modnorm<<<R, 256, 0, st>>>(X, norm_g + (size_t)(l * 2 + 1) * D, mod1, H);
        HOOK(100 * l + 5);
        gemm(st, H, D, w_gate + (size_t)l * D * DFF, DFF, nullptr, T1, DFF, R, DFF, D);
        gemm(st, H, D, w_up + (size_t)l * D * DFF, DFF, nullptr, T2, DFF, R, DFF, D);
        k_swiglu<<<cdiv((size_t)R * DFF, 256), 256, 0, st>>>(T1, T2, ACT);
        HOOK(100 * l + 6);
        gemm(st, ACT, DFF, w_down + (size_t)l * DFF * D, D, nullptr, T1, D, R, D, DFF);
        k_resid<<<cdiv(RD, 256), 256, 0, st>>>(X, T1, D, mod1);
        HOOK(100 * l + 7);
    }
    k_modnorm<<<R, 256, 0, st>>>(X, final_g, nullptr, H);
    hipMemcpyAsync(out + O_YP, H, (size_t)MP * D * 4, hipMemcpyDeviceToDevice, st);
    hipMemcpyAsync(out + O_YS, H + (size_t)MP * D, (size_t)MS * D * 4, hipMemcpyDeviceToDevice, st);
    HOOK(900);
#undef HOOK
}
}
namespace pg8 {
__device__ __forceinline__ int opaque_tid() { int t; asm volatile("v_mov_b32 %0, %1" : "=v"(t) : "v"(threadIdx.x)); return t; }
#define PG8_LAS __attribute__((address_space(3)))
typedef unsigned short bf16_t;
typedef short bf16x8 __attribute__((ext_vector_type(8)));
typedef float f32x4 __attribute__((ext_vector_type(4)));
typedef unsigned u32x4 __attribute__((ext_vector_type(4)));
constexpr int BM = 256, BK = 64, HALF = 128, HTB = HALF * BK * 2  , STAGE_BYTES = 8 * HTB, NXCD = 8, WGM = 8;

__host__ __device__ __forceinline__ int lds_byte(int r, int c) { const int st = (r >> 4) * 2 + (c >> 5), rr = r & 15, cc = c & 31, ob = rr * 64 + cc * 2; return st * 1024 + (ob ^ (((ob >> 9) & 1) << 5)); }
__host__ __device__ __forceinline__ void stage_rc(int b, int& R, int& C) { const int st = b / 1024, sb = b % 1024, swz = sb ^ (((sb >> 9) & 1) << 5); R = (st >> 1) * 16 + swz / 64; C = (st & 1) * 32 + (swz % 64) / 2; }
__host__ __device__ __forceinline__ int perm32(int rho) { const int n = rho >> 4, i = rho & 15; return 8 * (i >> 2) + 4 * n + (i & 3); }

struct Unit { int pm, pn; };
struct Gemm { const bf16_t* A; const bf16_t* Bt; int M, N, K; };

struct StaticOrder {
    int nM, nN, nwg, G, c;
    __host__ __device__ void init(int M, int N, int G_, int c_) { nM = M / BM; nN = N / BM; nwg = nM * nN; G = G_; c = c_; }
    __host__ __device__ bool next(int i, Unit& u) const {
        const long L = (long)i * G + c; if (L >= nwg) return false;
        int wgid = (int)L; { const int q = nwg / NXCD, r = nwg % NXCD, xcd = wgid % NXCD, off = wgid / NXCD; wgid = (xcd < r ? xcd * (q + 1) : r * (q + 1) + (xcd - r) * q) + off; }
        const int nig = WGM * nN, gid = wgid / nig, fm = gid * WGM, gsz = (nM - fm) < WGM ? (nM - fm) : WGM;
        u.pm = fm + ((wgid % nig) % gsz); u.pn = (wgid % nig) / gsz; return true;
    }
    __device__ __forceinline__ void a_ready(const Unit&) const {}
    __device__ __forceinline__ void done(const Unit&) const {}
};

template <class Epi, class Sched, bool ALIGN_EPI = false, bool SP2 = false>
__device__ __forceinline__ void gemm_phase(PG8_LAS unsigned char* lds, const Gemm g, const Sched& S, const Epi& E) {
    const int tid = opaque_tid(), wid = __builtin_amdgcn_readfirstlane(tid >> 6), lane = tid & 63, wr = wid >> 2, wc = wid & 3, fr = lane & 15, fq = lane >> 4;
    const int K = g.K, nt = K / BK;
    unsigned voffA[2], voffB[2];
#pragma unroll
    for (int i = 0; i < 2; ++i) { int R, C; stage_rc(tid * 16 + i * 8192, R, C); const int Rb = Epi::PERM ? ((R & ~31) + perm32(R & 31)) : R;
        voffA[i] = (unsigned)(R * K + C) * 2u; voffB[i] = (unsigned)(Rb * K + C) * 2u; }
    const size_t kstep = (size_t)(BK * 2);
    const size_t hstep = (size_t)HALF * K * 2;
    const size_t tstep = 2 * hstep;
    const unsigned ldsw = (unsigned)wid * 1024u;
    const int aoff = lds_byte(wr * 64 + fr, fq * 8), boff = lds_byte(wc * 32 + fr, fq * 8);
#define PG8_SA(b, h) (((b) * 2 + (h)) * HTB)
#define PG8_SB(b, h) ((4 + (b) * 2 + (h)) * HTB)
#define PG8_STAGE(bufoff, gbase, voff) do { _Pragma("unroll") for (int _i = 0; _i < 2; ++_i) \
        __builtin_amdgcn_global_load_lds((const unsigned*)((const char*)(gbase) + (voff)[_i]), (PG8_LAS unsigned*)(lds + (bufoff) + ldsw + _i * 8192), 16, 0, 0); } while (0)
#define PG8_LDA(dst, b, h) do { _Pragma("unroll") for (int m = 0; m < 4; ++m) _Pragma("unroll") for (int k = 0; k < 2; ++k) dst[m][k] = *(const PG8_LAS bf16x8*)(lds + PG8_SA(b, h) + aoff + m * 2048 + k * 1024); } while (0)
#define PG8_LDB(dst, b, h) do { _Pragma("unroll") for (int n = 0; n < 2; ++n) _Pragma("unroll") for (int k = 0; k < 2; ++k) dst[n][k] = *(const PG8_LAS bf16x8*)(lds + PG8_SB(b, h) + boff + n * 2048 + k * 1024); } while (0)
#define PG8_MMA(ai, bj, At, Bt) do { __builtin_amdgcn_s_setprio(1); _Pragma("unroll") for (int m = 0; m < 4; ++m) _Pragma("unroll") for (int n = 0; n < 2; ++n) _Pragma("unroll") for (int k = 0; k < 2; ++k) \
        acc[ai][bj][m][n] = __builtin_amdgcn_mfma_f32_16x16x32_bf16(Bt[n][k], At[m][k], acc[ai][bj][m][n], 0, 0, 0); __builtin_amdgcn_s_setprio(0); } while (0)
#define PG8_WAIT_V(n) asm volatile("s_waitcnt vmcnt(" #n ")" ::: "memory")
#define PG8_WAIT_L(n) asm volatile("s_waitcnt lgkmcnt(" #n ")" ::: "memory")
#define PG8_BAR __builtin_amdgcn_s_barrier()
#define PG8_SCHED __builtin_amdgcn_sched_barrier(0)
    Unit cur, nxt; int ui = 0;
    if (!S.next(0, cur)) return;
    f32x4 acc[2][2][4][2];
#pragma unroll
    for (int a = 0; a < 2; ++a)
#pragma unroll
        for (int b = 0; b < 2; ++b)
#pragma unroll
            for (int m = 0; m < 4; ++m)
#pragma unroll
                for (int n = 0; n < 2; ++n) acc[a][b][m][n] = (f32x4){0.f, 0.f, 0.f, 0.f};
    bf16x8 At[4][2], B0[2][2], B1[2][2];
    const char* cA = (const char*)g.A + (size_t)cur.pm * tstep; const char* cB = (const char*)g.Bt + (size_t)cur.pn * tstep;
    S.a_ready(cur);
    if constexpr (SP2) {
        PG8_STAGE(PG8_SB(0, 0), cB, voffB); PG8_STAGE(PG8_SB(0, 1), cB + hstep, voffB); PG8_STAGE(PG8_SA(0, 0), cA, voffA); PG8_STAGE(PG8_SA(0, 1), cA + hstep, voffA);
        if (wr == 1) PG8_BAR;
        PG8_WAIT_V(2); PG8_BAR;
        PG8_STAGE(PG8_SB(1, 0), cB + kstep, voffB); PG8_STAGE(PG8_SA(1, 0), cA + kstep, voffA); PG8_STAGE(PG8_SB(1, 1), cB + hstep + kstep, voffB);
        PG8_WAIT_V(6); PG8_BAR;
    } else {
        PG8_STAGE(PG8_SB(0, 0), cB, voffB); PG8_STAGE(PG8_SA(0, 0), cA, voffA); PG8_STAGE(PG8_SB(0, 1), cB + hstep, voffB); PG8_STAGE(PG8_SA(0, 1), cA + hstep, voffA);
        if (wr == 1) PG8_BAR;
        PG8_WAIT_V(4); PG8_BAR;
        PG8_STAGE(PG8_SB(1, 0), cB + kstep, voffB); PG8_STAGE(PG8_SA(1, 0), cA + kstep, voffA); PG8_STAGE(PG8_SB(1, 1), cB + hstep + kstep, voffB);
        PG8_WAIT_V(6); PG8_BAR;
    }
    for (;;) {
        const bool has_next = S.next(ui + 1, nxt);
        const char* nA = has_next ? (const char*)g.A + (size_t)nxt.pm * tstep : cA; const char* nB = has_next ? (const char*)g.Bt + (size_t)nxt.pn * tstep : cB;
        for (int t = 0; t < nt; t += 2) {
            const bool last = (t == nt - 2);
            const char* a1 = cA + (size_t)(t + 1) * kstep;
            const char* a2 = last ? nA : cA + (size_t)(t + 2) * kstep; const char* b2 = last ? nB : cB + (size_t)(t + 2) * kstep;
            const char* a3 = a2 + kstep; const char* b3 = b2 + kstep;
            if (last && has_next) S.a_ready(nxt);
            if constexpr (SP2) {
            PG8_LDB(B0, 0, 0); PG8_LDB(B1, 0, 1); PG8_SCHED; PG8_LDA(At, 0, 0); PG8_STAGE(PG8_SA(1, 1), a1 + hstep, voffA);
            PG8_WAIT_V(8); PG8_WAIT_L(0); PG8_BAR; PG8_MMA(0, 0, At, B0); PG8_MMA(0, 1, At, B1); PG8_BAR; PG8_SCHED;
            PG8_LDA(At, 0, 1); PG8_STAGE(PG8_SB(0, 0), b2, voffB); PG8_STAGE(PG8_SB(0, 1), b2 + hstep, voffB); PG8_STAGE(PG8_SA(0, 0), a2, voffA);
            PG8_WAIT_V(8); PG8_WAIT_L(0); PG8_BAR; PG8_MMA(1, 0, At, B0); PG8_MMA(1, 1, At, B1); PG8_BAR; PG8_SCHED;
            PG8_LDB(B0, 1, 0); PG8_LDB(B1, 1, 1); PG8_SCHED; PG8_LDA(At, 1, 0); PG8_STAGE(PG8_SA(0, 1), a2 + hstep, voffA);
            PG8_WAIT_V(8); PG8_WAIT_L(0); PG8_BAR; PG8_MMA(0, 0, At, B0); PG8_MMA(0, 1, At, B1); PG8_BAR; PG8_SCHED;
            PG8_LDA(At, 1, 1); PG8_STAGE(PG8_SB(1, 0), b3, voffB); PG8_STAGE(PG8_SB(1, 1), b3 + hstep, voffB); PG8_STAGE(PG8_SA(1, 0), a3, voffA);
            PG8_WAIT_V(8); PG8_WAIT_L(0); PG8_BAR; PG8_MMA(1, 0, At, B0); PG8_MMA(1, 1, At, B1); PG8_BAR; PG8_SCHED;
            } else {
            PG8_LDB(B0, 0, 0); PG8_SCHED; PG8_LDA(At, 0, 0); PG8_STAGE(PG8_SA(1, 1), a1 + hstep, voffA);
            PG8_WAIT_L(8); PG8_BAR; PG8_WAIT_L(0); PG8_MMA(0, 0, At, B0); PG8_BAR; PG8_SCHED;
            PG8_LDB(B1, 0, 1); PG8_STAGE(PG8_SB(0, 0), b2, voffB);
            PG8_BAR; PG8_WAIT_L(0); PG8_MMA(0, 1, At, B1); PG8_BAR;
            PG8_LDA(At, 0, 1); PG8_STAGE(PG8_SA(0, 0), a2, voffA);
            PG8_BAR; PG8_WAIT_L(0); PG8_MMA(1, 0, At, B0); PG8_BAR; PG8_SCHED;
            PG8_STAGE(PG8_SB(0, 1), b2 + hstep, voffB);
            PG8_WAIT_V(6); PG8_BAR; PG8_MMA(1, 1, At, B1); PG8_BAR;
            PG8_LDB(B0, 1, 0); PG8_SCHED; PG8_LDA(At, 1, 0); PG8_STAGE(PG8_SA(0, 1), a2 + hstep, voffA);
            PG8_WAIT_L(8); PG8_BAR; PG8_WAIT_L(0); PG8_MMA(0, 0, At, B0); PG8_BAR; PG8_SCHED;
            PG8_LDB(B1, 1, 1); PG8_STAGE(PG8_SB(1, 0), b3, voffB);
            PG8_BAR; PG8_WAIT_L(0); PG8_MMA(0, 1, At, B1); PG8_BAR;
            PG8_LDA(At, 1, 1); PG8_STAGE(PG8_SA(1, 0), a3, voffA);
            PG8_BAR; PG8_WAIT_L(0); PG8_MMA(1, 0, At, B0); PG8_BAR; PG8_SCHED;
            PG8_STAGE(PG8_SB(1, 1), b3 + hstep, voffB);
            PG8_WAIT_V(6); PG8_BAR; PG8_MMA(1, 1, At, B1); PG8_BAR;
            }
        }
        if constexpr (ALIGN_EPI) { if (wr == 0) PG8_BAR; }
        if constexpr (!Epi::AFTER_DRAIN) { E(acc, cur, wr, wc, fr, fq); S.done(cur); }
        if (!has_next) break;
#pragma unroll
        for (int a = 0; a < 2; ++a)
#pragma unroll
            for (int b = 0; b < 2; ++b)
#pragma unroll
                for (int m = 0; m < 4; ++m)
#pragma unroll
                    for (int n = 0; n < 2; ++n) acc[a][b][m][n] = (f32x4){0.f, 0.f, 0.f, 0.f};
        cur = nxt; cA = nA; cB = nB; ++ui;
        if constexpr (ALIGN_EPI) { if (wr == 1) PG8_BAR; }
    }
    PG8_WAIT_V(0);
    if constexpr (!ALIGN_EPI) { if (wr == 0) PG8_BAR; }
    PG8_BAR;
    if constexpr (Epi::AFTER_DRAIN) { E.fused(acc, cur, wr, wc, fr, fq, lds, wid, lane); S.done(cur); }
#undef PG8_SA
#undef PG8_SB
#undef PG8_STAGE
#undef PG8_LDA
#undef PG8_LDB
#undef PG8_MMA
#undef PG8_WAIT_V
#undef PG8_WAIT_L
#undef PG8_BAR
#undef PG8_SCHED
}
}
#define XB_TMO      128
#define XB_XCNT(j)  (256  + 64 * (j))
#define XB_XSUB(j)  (1280 + 64 * (j))
#define XB_XGEN(j)  (2304 + 64 * (j))
#define XB_TOP      3328
#define XB_TOPGEN   3392
#define XCD_BAR_WORDS 3456
#define XB_SPIN_CAP (1u << 18)
#define LAS __attribute__((address_space(3)))

__device__ __forceinline__ unsigned xb_ld(unsigned* p)              { return __hip_atomic_load(p, __ATOMIC_RELAXED, __HIP_MEMORY_SCOPE_AGENT); }
__device__ __forceinline__ unsigned xb_add(unsigned* p, unsigned v) { return __hip_atomic_fetch_add(p, v, __ATOMIC_RELAXED, __HIP_MEMORY_SCOPE_AGENT); }
__device__ __forceinline__ unsigned xb_xcc_id() { return (unsigned)__builtin_amdgcn_s_getreg((3 << 11) | 20) & 0xFu; }
#define XB_SPIN(cond, bar) do { unsigned _sp = 0; while (cond) { __builtin_amdgcn_s_sleep(1); \
    if ((++_sp & 255u) == 0u) { if (xb_ld(&(bar)[XB_TMO])) break; if (_sp > XB_SPIN_CAP) { atomicAdd(&(bar)[XB_TMO], 1u); break; } } } } while (0)

struct XcdBarrier {
    unsigned* bar; unsigned x;
    volatile LAS unsigned* st;
};

__device__ __forceinline__ XcdBarrier xcd_barrier_post(unsigned* bar, volatile LAS unsigned* st) {
    XcdBarrier b; b.bar = bar; b.x = xb_xcc_id(); b.st = st;
    if (threadIdx.x == 0) (void)xb_add(&bar[XB_XCNT(b.x)], 1u);
    return b;
}
__device__ __forceinline__ void xcd_barrier_complete(unsigned* bar, unsigned x, unsigned& nloc, unsigned& nx) {
    const unsigned G = gridDim.x * gridDim.y * gridDim.z;
    unsigned sum, cnt, mine, sp = 0u;
    for (;;) {
        sum = 0u; cnt = 0u; mine = 0u;
#pragma unroll
        for (unsigned j = 0; j < 16; ++j) { const unsigned c = xb_ld(&bar[XB_XCNT(j)]); sum += c; cnt += (c > 0u) ? 1u : 0u; mine = (j == x) ? c : mine; }
        if (sum == G) break;
        __builtin_amdgcn_s_sleep(1);
        if ((++sp & 255u) == 0u) { if (xb_ld(&bar[XB_TMO])) break; if (sp > XB_SPIN_CAP) { atomicAdd(&bar[XB_TMO], 1u); break; } }
    }
    nloc = mine > 0u ? mine : 1u; nx = cnt > 0u ? cnt : 1u;
}

__device__ __forceinline__ void xcd_barrier(const XcdBarrier& b) {
    asm volatile("s_waitcnt vmcnt(0)" ::: "memory");
    __syncthreads();
    if (threadIdx.x == 0) {
        unsigned* bar = b.bar;
        __builtin_amdgcn_s_waitcnt(0);
        unsigned nloc = b.st[0], nx = b.st[1];
        if (nloc == 0u) { xcd_barrier_complete(bar, b.x, nloc, nx); b.st[0] = nloc; b.st[1] = nx; }
        const unsigned old = xb_add(&bar[XB_XSUB(b.x)], 1u);
        const unsigned gen = old / nloc;
        if (old + 1u == (gen + 1u) * nloc) {
            __builtin_amdgcn_fence(__ATOMIC_RELEASE, "agent");
            asm volatile("s_waitcnt vmcnt(0)" ::: "memory");
            const unsigned og = xb_add(&bar[XB_TOP], 1u);
            const unsigned tg = og / nx;
            if (og + 1u == (tg + 1u) * nx) xb_add(&bar[XB_TOPGEN], 1u);
            else XB_SPIN(xb_ld(&bar[XB_TOPGEN]) == tg, bar);
            __builtin_amdgcn_fence(__ATOMIC_ACQUIRE, "agent");
            xb_add(&bar[XB_XGEN(b.x)], 1u);
            asm volatile("s_waitcnt vmcnt(0)" ::: "memory");
        } else {
            XB_SPIN(xb_ld(&bar[XB_XGEN(b.x)]) == gen, bar);
            __builtin_amdgcn_fence(__ATOMIC_ACQUIRE, "agent");
            asm volatile("s_waitcnt vmcnt(0)" ::: "memory");
        }
    }
    __syncthreads();
}

namespace fk {
using namespace nv;
typedef unsigned short bf16;
typedef float f32x4 __attribute__((ext_vector_type(4)));
typedef short bf16x8 __attribute__((ext_vector_type(8)));
typedef unsigned u32x2 __attribute__((ext_vector_type(2)));
typedef unsigned u32x4 __attribute__((ext_vector_type(4)));
#define FLAS __attribute__((address_space(3)))
constexpr float LOG2E = 1.4426950408889634f;
constexpr int NTHR = 512, NWAVE = 8;
constexpr int LDS_BYTES = 147456;
constexpr int LDS_MISC = 131072 + 8192;

__device__ __forceinline__ unsigned f2bf(float f) { unsigned u = __builtin_bit_cast(unsigned, f); return (u + 0x7fffu + ((u >> 16) & 1u)) >> 16; }
typedef __bf16 hbf16x2 __attribute__((ext_vector_type(2)));
typedef float f32x2 __attribute__((ext_vector_type(2)));
__device__ __forceinline__ unsigned pk2(float lo, float hi) { const f32x2 v = {lo, hi}; return __builtin_bit_cast(unsigned, __builtin_convertvector(v, hbf16x2)); }
__device__ __forceinline__ float bf2f(unsigned short b) { return __builtin_bit_cast(float, (unsigned)b << 16); }
__device__ __forceinline__ float fsigm(float x) { return __builtin_amdgcn_rcpf(1.f + __expf(-x)); }
__device__ __forceinline__ float fsilu(float x) { return x * __builtin_amdgcn_rcpf(1.f + __expf(-x)); }
__device__ __forceinline__ float xmax32(float v) { const unsigned u = __builtin_bit_cast(unsigned, v); auto rr = __builtin_amdgcn_permlane32_swap(u, u, false, false); return fmaxf(__builtin_bit_cast(float, (unsigned)rr[0]), __builtin_bit_cast(float, (unsigned)rr[1])); }
__device__ __forceinline__ float xsum32(float v) { const unsigned u = __builtin_bit_cast(unsigned, v); auto rr = __builtin_amdgcn_permlane32_swap(u, u, false, false); return __builtin_bit_cast(float, (unsigned)rr[0]) + __builtin_bit_cast(float, (unsigned)rr[1]); }
__device__ __forceinline__ float wsum(float v) {
#pragma unroll
    for (int o = 1; o < 64; o <<= 1) v += __shfl_xor(v, o);
    return v; }
__device__ __forceinline__ int cidx_row(int row) { return row < MP ? (row >> 12) : 4 + ((row - MP) >> 2); }

constexpr size_t al(size_t x) { return (x + 4095) & ~(size_t)4095; }
constexpr size_t F_CTL = 0, F_MOD = 1u << 20, F_WPW1 = F_MOD + al((size_t)8 * NC * 3072 * 4), F_WPW2 = F_WPW1 + (size_t)2 * 2048 * 1024 * 2,
    F_WGU = F_WPW2 + (size_t)2 * 1024 * 1024 * 2, F_WDN = F_WGU + (size_t)4 * 5632 * 1024 * 2, F_WKV = F_WDN + (size_t)4 * 1024 * 2816 * 2,
    F_WQ = F_WKV + (size_t)1536 * 1024 * 2, F_WG = F_WQ + (size_t)2 * 1024 * 1024 * 2, F_WO = F_WG + (size_t)2 * 64 * 1024 * 2, F_WPHI1 = F_WO + (size_t)2 * 1024 * 1024 * 2,
    F_WPHI2 = F_WPHI1 + (size_t)2 * 128 * 2048 * 2, F_BPHI = F_WPHI2 + (size_t)2 * 64 * 128 * 2, F_X = F_BPHI + 32768, F_H = F_X + al((size_t)R * D * 4),
    F_HKV = F_H + al((size_t)R * D * 2), F_U = F_HKV + al((size_t)R * D * 2), F_US = F_U + al((size_t)R * D * 2), F_C = F_US + (size_t)MS * D * 4, F_ACT = F_C + al((size_t)R * D * 2),
    F_RB = F_ACT + al((size_t)R * DFF * 2), F_Q = F_RB + al((size_t)R * KVW * 2), F_GT = F_Q + al((size_t)R * D * 2), F_O = F_GT + al((size_t)R * 64 * 4),
    F_VT = F_O + al((size_t)R * D * 2), F_CMPK = F_VT + (size_t)2 * 16 * 64 * 4096 * 2, F_CMPVT = F_CMPK + (size_t)16 * 128 * 64 * 2, F_CMPS = F_CMPVT + (size_t)16 * 128 * 64 * 2,
    F_PART = F_CMPS + (size_t)2 * DB * 256 * 256 * 4, F_QPART = F_PART + (size_t)8 * MS * D * 4, F_STATS = F_QPART + (size_t)8 * MS * D * 4, F_END = F_STATS + (size_t)8 * 64 * 4 * 256 * 4;
constexpr size_t CTL_BYTES = 1u << 20;

struct Args { const void* in[34]; float* out; unsigned char* fb; int lo, hi; };

typedef const __attribute__((address_space(4))) Args CArgs;
struct Ctx {
    FLAS unsigned char* lds; int tid, lane, wave, G, wg; int gw, ngw;
};
#define IN_F(i) ((const float*)A.in[i])
__device__ __forceinline__ Ctx refreshed(const Ctx& C0) { Ctx C = C0; int t; asm volatile("v_mov_b32 %0, %1" : "=v"(t) : "v"(threadIdx.x)); C.tid = t; C.lane = t & 63;
    int wg_ = C0.wg, G_ = C0.G, wv_ = C0.wave; asm volatile("" : "+s"(wg_), "+s"(G_), "+s"(wv_)); C.wg = wg_; C.G = G_; C.wave = wv_; C.gw = wg_ * NWAVE + wv_; C.ngw = G_ * NWAVE; return C; }
enum TrMode { TR_PLAIN = 0, TR_PW1 = 1, TR_GATE = 2, TR_UP = 3, TR_QG = 4 };
__device__ __forceinline__ void tr_item(const float* __restrict__ W, int K, int N, bf16* __restrict__ WT, bf16* __restrict__ WT2, int mode, FLAS float* scr, int item, int lane) {
    const int nblk = (N + 63) / 64, kb = item / nblk, nb = item % nblk, k0 = 64 * kb, n0 = 64 * nb;
    const int c4 = lane & 15, rq = lane >> 4; const bool okc = n0 + 4 * c4 < N;
    f32x4 v[16];
#pragma unroll
    for (int i = 0; i < 16; ++i) { const int kk = 4 * i + rq; v[i] = okc ? *(const f32x4*)(W + (size_t)(k0 + kk) * N + n0 + 4 * c4) : (f32x4){0.f, 0.f, 0.f, 0.f}; }
#pragma unroll
    for (int i = 0; i < 16; ++i) { const int kk = 4 * i + rq; *(FLAS f32x4*)(scr + kk * 68 + 4 * c4) = v[i]; }
    asm volatile("s_waitcnt lgkmcnt(0)" ::: "memory");
    const int c = lane & 7;
#pragma unroll
    for (int j = 0; j < 8; ++j) { const int nl = (lane >> 3) + 8 * j; const int n = n0 + nl; const FLAS float* sp = scr + (8 * c) * 68 + nl;
        u32x4 o; o.x = pk2(sp[0 * 68], sp[1 * 68]); o.y = pk2(sp[2 * 68], sp[3 * 68]); o.z = pk2(sp[4 * 68], sp[5 * 68]); o.w = pk2(sp[6 * 68], sp[7 * 68]);
        bf16* dst = WT; int nr = n;
        if (mode == TR_PW1) { const int f = n & 1023, isg = n >> 10; nr = 256 * (f >> 7) + 128 * isg + (f & 127); }
        else if (mode == TR_GATE) nr = 256 * (n >> 7) + (n & 127);
        else if (mode == TR_UP) nr = 256 * (n >> 7) + 128 + (n & 127);
        else if (mode == TR_QG) { if (n >= 1024) { dst = WT2; nr = n - 1024; } }
        if (mode != TR_QG || n < 1088) *(u32x4*)(dst + (size_t)nr * K + k0 + 8 * c) = o; }
    asm volatile("s_waitcnt lgkmcnt(0)" ::: "memory");
}
struct TrJob { const float* W; bf16* WT; bf16* WT2; int K, N, mode, nitems; };

__device__ __forceinline__ void mod_unit(const Ctx& C, CArgs& A, int unit) {
    const int ls = unit / 24, cg = unit % 24, tid = C.tid, w = C.wave, lane = C.lane;
    FLAS float* SCs = (FLAS float*)C.lds;
    const float* W = IN_F(9) + (size_t)ls * D * 3072;
    float acc0[36], acc1[36];
#pragma unroll
    for (int c = 0; c < 36; ++c) { acc0[c] = 0.f; acc1[c] = 0.f; }
    for (int half = 0; half < 2; ++half) {
        __syncthreads();
        { const int kg = 128 * (tid >> 6) + 64 * half + (tid & 63);
#pragma unroll 4
          for (int c = 0; c < 36; ++c) { const float v = c < 4 ? IN_F(2)[c * D + kg] : IN_F(3)[(c - 4) * D + kg]; SCs[tid * 36 + c] = fsilu(v); } }
        __syncthreads();
        const float* wp = W + (size_t)(128 * w + 64 * half) * 3072 + cg * 128 + lane;
        const FLAS f32x4* sp = (const FLAS f32x4*)(SCs + (w * 64) * 36);
#pragma unroll 2
        for (int kk = 0; kk < 64; ++kk) { const float w0 = wp[(size_t)kk * 3072], w1 = wp[(size_t)kk * 3072 + 64];
#pragma unroll
            for (int q = 0; q < 9; ++q) { const f32x4 sv = sp[kk * 9 + q];
#pragma unroll
                for (int j = 0; j < 4; ++j) { acc0[4 * q + j] += sv[j] * w0; acc1[4 * q + j] += sv[j] * w1; } } }
    }
    FLAS float* part = (FLAS float*)C.lds;
#pragma unroll
    for (int ps = 0; ps < 3; ++ps) {
        __syncthreads();
#pragma unroll
        for (int cc = 0; cc < 12; ++cc) { part[(w * 128 + lane) * 13 + cc] = acc0[12 * ps + cc]; part[(w * 128 + lane + 64) * 13 + cc] = acc1[12 * ps + cc]; }
        __syncthreads();
        for (int o = tid; o < 12 * 128; o += NTHR) { const int cc = o >> 7, nn = o & 127, c = 12 * ps + cc, ng = cg * 128 + nn; float v = IN_F(10)[ls * 3072 + ng];
#pragma unroll
            for (int ww = 0; ww < 8; ++ww) v += part[(ww * 128 + nn) * 13 + cc];
            if (ng >= 1024 && ng < 2048) v = IN_F(11)[ls * D + ng - 1024] * (1.f + v);
            ((float*)(A.fb + F_MOD))[((size_t)ls * NC + c) * 3072 + ng] = v; }
    }
    __syncthreads();
}

__device__ __forceinline__ void phase_prologue(const Ctx& C, CArgs& A) {
    unsigned char* fb = A.fb;
    {
        FLAS float* scr = (FLAS float*)(C.lds + C.wave * 17408);
        int it = C.gw;
#pragma unroll 1
        for (int job = 0; job < 25; ++job) {
            const float* Wp; bf16* WTp; bf16* WT2p = nullptr; int Kv, Nv, modev;
            if (job < 12) { const int l = job / 6, t = job % 6;
                if (t == 0) { Wp = IN_F(12) + (size_t)l * D * 2048; WTp = (bf16*)(fb + F_WPW1) + (size_t)l * 2048 * 1024; Kv = 1024; Nv = 2048; modev = TR_PW1; }
                else if (t == 1) { Wp = IN_F(18) + (size_t)l * D * D; WTp = (bf16*)(fb + F_WPW2) + (size_t)l * 1024 * 1024; Kv = 1024; Nv = 1024; modev = TR_PLAIN; }
                else if (t == 2) { Wp = IN_F(27) + (size_t)l * D * QGW; WTp = (bf16*)(fb + F_WQ) + (size_t)l * 1024 * 1024; WT2p = (bf16*)(fb + F_WG) + (size_t)l * 64 * 1024; Kv = 1024; Nv = QGW; modev = TR_QG; }
                else if (t == 3) { Wp = IN_F(28) + (size_t)l * D * D; WTp = (bf16*)(fb + F_WO) + (size_t)l * 1024 * 1024; Kv = 1024; Nv = 1024; modev = TR_PLAIN; }
                else if (t == 4) { Wp = IN_F(22) + (size_t)l * 2048 * PHI; WTp = (bf16*)(fb + F_WPHI1) + (size_t)l * 128 * 2048; Kv = 2048; Nv = 128; modev = TR_PLAIN; }
                else { Wp = IN_F(24) + (size_t)l * PHI * 64; WTp = (bf16*)(fb + F_WPHI2) + (size_t)l * 64 * 128; Kv = 128; Nv = 64; modev = TR_PLAIN; }
            } else if (job < 24) { const int l = (job - 12) / 3, t = (job - 12) % 3;
                if (t == 0) { Wp = IN_F(30) + (size_t)l * D * DFF; WTp = (bf16*)(fb + F_WGU) + (size_t)l * 5632 * 1024; Kv = 1024; Nv = DFF; modev = TR_GATE; }
                else if (t == 1) { Wp = IN_F(31) + (size_t)l * D * DFF; WTp = (bf16*)(fb + F_WGU) + (size_t)l * 5632 * 1024; Kv = 1024; Nv = DFF; modev = TR_UP; }
                else { Wp = IN_F(32) + (size_t)l * DFF * D; WTp = (bf16*)(fb + F_WDN) + (size_t)l * 1024 * 2816; Kv = 2816; Nv = 1024; modev = TR_PLAIN; }
            } else { Wp = IN_F(21); WTp = (bf16*)(fb + F_WKV); Kv = 1024; Nv = KVW; modev = TR_PLAIN; }
            const int nit = (Kv / 64) * ((Nv + 63) / 64);
            while (it < nit) { tr_item(Wp, Kv, Nv, WTp, WT2p, modev, scr, it, C.lane); it += C.ngw; }
            it -= nit;
        }
    }
    {
        const size_t gt = (size_t)C.wg * NTHR + C.tid, nt = (size_t)C.G * NTHR;
        const f32x4* src = (const f32x4*)IN_F(6); f32x4* dst = (f32x4*)(A.out + O_WINS);
        for (size_t i = gt; i < (size_t)DB * 508 * 128; i += nt) { const size_t b = i / (508 * 128), r = i % (508 * 128); dst[b * 512 * 128 + r] = src[b * 512 * 128 + 4 * 128 + r]; }
        const f32x4* s2 = (const f32x4*)IN_F(7); f32x4* d2 = (f32x4*)(A.out + O_CONVS);
        for (size_t i = gt; i < (size_t)2 * DB * 26 * 256; i += nt) { const size_t lb = i / (26 * 256), r = i % (26 * 256); d2[lb * 30 * 256 + r] = s2[lb * 30 * 256 + 4 * 256 + r]; }
    }
    { const int ck = C.G - 1 - C.wg;
      if (ck < 16 && C.tid < 256) { const int e = C.tid >> 7, h = C.tid & 127; float a = ck == 0 ? IN_F(23)[e * PHI + h] : 0.f; const float* w = IN_F(22) + ((size_t)e * 2048 + ck * 128) * PHI + h; const float* pe = IN_F(26) + e * 2048 + ck * 128;
#pragma unroll 16
          for (int f = 0; f < 128; ++f) a += pe[f] * w[(size_t)f * PHI];
          ((float*)(fb + F_BPHI))[ck * 256 + e * PHI + h] = a; } }
    __syncthreads();
    for (int u = C.wg; u < 192; u += C.G) mod_unit(C, A, u);
}

__device__ __forceinline__ f32x4 bfx4(unsigned lo, unsigned hi) { f32x4 r; r[0] = __builtin_bit_cast(float, lo << 16); r[1] = __builtin_bit_cast(float, lo & 0xffff0000u); r[2] = __builtin_bit_cast(float, hi << 16); r[3] = __builtin_bit_cast(float, hi & 0xffff0000u); return r; }
__device__ __forceinline__ void phase_norm(const Ctx& C, CArgs& A, int mode, int ls, bool from_input, int pend_ls, const float* pend_bias, bool pend_in, int first, int step, int limit) {
    unsigned char* fb = A.fb; const float* modf = (const float*)(fb + F_MOD) + (size_t)ls * NC * 3072; const bf16* XB = (const bf16*)(fb + F_X);
    if (from_input && C.wg == 0 && C.tid < 256) { const float* p = (const float*)(fb + F_BPHI); float a = 0.f;
#pragma unroll
        for (int ck = 0; ck < 16; ++ck) a += p[ck * 256 + C.tid];
        ((float*)(fb + F_BPHI))[4096 + C.tid] = a; }
    constexpr int NB = 4;
    for (int row0 = first; row0 < limit; row0 += NB * step) {
        f32x4 v[NB][4];
#pragma unroll
        for (int i = 0; i < NB; ++i) { const int rq = row0 + i * step; const int rr = rq < limit ? rq : row0;
            if (from_input || (pend_in && rr >= MP)) { const float* xr = rr < MP ? IN_F(0) + (size_t)rr * D : IN_F(1) + (size_t)(rr - MP) * D;
#pragma unroll
                for (int jj = 0; jj < 2; ++jj) { v[i][2 * jj] = *(const f32x4*)(xr + 8 * (C.lane + 64 * jj)); v[i][2 * jj + 1] = *(const f32x4*)(xr + 8 * (C.lane + 64 * jj) + 4); } }
            else { const bf16* xr = XB + (size_t)rr * D;
#pragma unroll
                for (int jj = 0; jj < 2; ++jj) { const u32x4 t = *(const u32x4*)(xr + 8 * (C.lane + 64 * jj)); v[i][2 * jj] = bfx4(t.x, t.y); v[i][2 * jj + 1] = bfx4(t.z, t.w); } } }
#pragma unroll
        for (int i = 0; i < NB; ++i) { const int row = row0 + i * step; if (row >= limit) break;
            if (pend_ls >= 0 && row >= MP) { const float* pp = (const float*)(fb + F_PART) + (size_t)(row - MP) * D; const float* gm = (const float*)(fb + F_MOD) + ((size_t)pend_ls * NC + cidx_row(row)) * 3072 + 2048;
#pragma unroll
                for (int j = 0; j < 4; ++j) { const int c0 = 8 * (C.lane + 64 * (j >> 1)) + 4 * (j & 1); f32x4 y = {0.f, 0.f, 0.f, 0.f}; if (pend_bias) y = *(const f32x4*)(pend_bias + c0);
#pragma unroll
                    for (int ksl = 0; ksl < 8; ++ksl) y += *(const f32x4*)(pp + (size_t)ksl * MS * D + c0);
                    v[i][j] += *(const f32x4*)(gm + c0) * y; }
#pragma unroll
                for (int jj = 0; jj < 2; ++jj) { u32x4 o; o.x = pk2(v[i][2 * jj][0], v[i][2 * jj][1]); o.y = pk2(v[i][2 * jj][2], v[i][2 * jj][3]); o.z = pk2(v[i][2 * jj + 1][0], v[i][2 * jj + 1][1]); o.w = pk2(v[i][2 * jj + 1][2], v[i][2 * jj + 1][3]);
                    *(u32x4*)((bf16*)(fb + F_X) + (size_t)row * D + 8 * (C.lane + 64 * jj)) = o; } }
            float ss = 0.f;
#pragma unroll
            for (int j = 0; j < 4; ++j) ss += (v[i][j][0] * v[i][j][0] + v[i][j][1] * v[i][j][1]) + (v[i][j][2] * v[i][j][2] + v[i][j][3] * v[i][j][3]);
            const float rstd = rsqrtf(wsum(ss) * (1.f / D) + EPS);
            if (mode == 2) { float* yo = row < MP ? A.out + O_YP + (size_t)row * D : A.out + O_YS + (size_t)(row - MP) * D;
#pragma unroll
                for (int j = 0; j < 4; ++j) { const int c0 = 8 * (C.lane + 64 * (j >> 1)) + 4 * (j & 1); const f32x4 g = *(const f32x4*)(IN_F(33) + c0); *(f32x4*)(yo + c0) = v[i][j] * rstd * g; }
                continue; }
            const float* m = modf + (size_t)cidx_row(row) * 3072;
#pragma unroll
            for (int jj = 0; jj < 2; ++jj) { const int c0 = 8 * (C.lane + 64 * jj);
                const f32x4 h0 = v[i][2 * jj] * rstd * *(const f32x4*)(m + D + c0) + *(const f32x4*)(m + c0), h1 = v[i][2 * jj + 1] * rstd * *(const f32x4*)(m + D + c0 + 4) + *(const f32x4*)(m + c0 + 4);
                u32x4 o; o.x = pk2(h0[0], h0[1]); o.y = pk2(h0[2], h0[3]); o.z = pk2(h1[0], h1[1]); o.w = pk2(h1[2], h1[3]); *(u32x4*)((bf16*)(fb + F_H) + (size_t)row * D + c0) = o; }
            if (mode == 1) {
#pragma unroll
                for (int jj = 0; jj < 2; ++jj) { const int c0 = 8 * (C.lane + 64 * jj);
                    const f32x4 h0 = v[i][2 * jj] * rstd * *(const f32x4*)(IN_F(20) + c0), h1 = v[i][2 * jj + 1] * rstd * *(const f32x4*)(IN_F(20) + c0 + 4);
                    u32x4 o; o.x = pk2(h0[0], h0[1]); o.y = pk2(h0[2], h0[3]); o.z = pk2(h1[0], h1[1]); o.w = pk2(h1[2], h1[3]); *(u32x4*)((bf16*)(fb + F_HKV) + (size_t)row * D + c0) = o; } }
        }
    }
}

struct EpGLU { static constexpr bool PERM = true, PAIRED = true;
    bf16* U; float* US; const float* b1; float* convp; float* convs;
    __device__ __forceinline__ void st2(int row, int f, f32x4 a, f32x4 g) const {
        const f32x4 ba = *(const f32x4*)(b1 + f), bg = *(const f32x4*)(b1 + 1024 + f); f32x4 u;
#pragma unroll
        for (int j = 0; j < 4; ++j) u[j] = (a[j] + ba[j]) * fsigm(g[j] + bg[j]);
        u32x2 o; o.x = pk2(u[0], u[1]); o.y = pk2(u[2], u[3]); *(u32x2*)(U + (size_t)row * D + f) = o;
        if (row < MP) { const int t = row & 4095; if (t >= 4066) *(f32x4*)(convp + ((size_t)(row >> 12) * 30 + (t - 4066)) * D + f) = u; }
        else { const int rs = row - MP; *(f32x4*)(US + (size_t)rs * D + f) = u; *(f32x4*)(convs + ((size_t)(rs >> 2) * 30 + 26 + (rs & 3)) * D + f) = u; }
    } };
struct EpSwiGLU { static constexpr bool PERM = true, PAIRED = true;
    bf16* ACT;
    __device__ __forceinline__ void st2(int row, int f, f32x4 g, f32x4 u) const {
        f32x4 a;
#pragma unroll
        for (int j = 0; j < 4; ++j) a[j] = fsilu(g[j]) * u[j];
        u32x2 o; o.x = pk2(a[0], a[1]); o.y = pk2(a[2], a[3]); *(u32x2*)(ACT + (size_t)row * DFF + f) = o;
    } };
struct EpResid { static constexpr bool PERM = false, PAIRED = false;
    const float* xp; const float* xs; bf16* X; const float* mod; const float* bias;
    __device__ __forceinline__ void st(int row, int col, f32x4 v) const {
        const f32x4 gt = *(const f32x4*)(mod + (size_t)cidx_row(row) * 3072 + 2048 + col);
        f32x4 x;
        if (xp) x = row < MP ? *(const f32x4*)(xp + (size_t)row * D + col) : *(const f32x4*)(xs + (size_t)(row - MP) * D + col);
        else { const u32x2 t = *(const u32x2*)(X + (size_t)row * D + col); x = bfx4(t.x, t.y); }
        f32x4 b = {0.f, 0.f, 0.f, 0.f}; if (bias) b = *(const f32x4*)(bias + col);
        const f32x4 y = x + gt * (v + b); u32x2 o; o.x = pk2(y[0], y[1]); o.y = pk2(y[2], y[3]); *(u32x2*)(X + (size_t)row * D + col) = o;
    } };
struct EpKV { static constexpr bool PERM = false, PAIRED = false;
    float* out; bf16* RB;
    __device__ __forceinline__ void st(int row, int col, f32x4 v) const {
        u32x2 o; o.x = pk2(v[0], v[1]); o.y = pk2(v[2], v[3]); *(u32x2*)(RB + (size_t)row * KVW + col) = o;
        const int br = col >> 9, c = col & 511;
        if (row < MP) {
            if (br == 0) *(f32x4*)(out + O_CMPP + (size_t)row * 512 + c) = v;
            else if (br == 1) *(f32x4*)(out + O_SELP + (size_t)row * 512 + c) = v;
            else { const int t = row & 4095; if (t >= 3584) *(f32x4*)(out + O_WINP + ((size_t)(row >> 12) * 512 + (t - 3584)) * 512 + c) = v; }
        } else { const int rs = row - MP;
            if (br == 0) *(f32x4*)(out + O_CMPS + (size_t)rs * 512 + c) = v;
            else if (br == 1) *(f32x4*)(out + O_SELS + (size_t)rs * 512 + c) = v;
            else *(f32x4*)(out + O_WINS + ((size_t)(rs >> 2) * 512 + 508 + (rs & 3)) * 512 + c) = v; }
    } };
struct EpQ { static constexpr bool PERM = true, PAIRED = false;
    bf16* Q;
    __device__ __forceinline__ void st(int row, int col, f32x4 v) const {
        const float s = 0.125f * LOG2E; u32x2 o; o.x = pk2(v[0] * s, v[1] * s); o.y = pk2(v[2] * s, v[3] * s); *(u32x2*)(Q + (size_t)row * D + col) = o;
    } };
struct EpGates { static constexpr bool PERM = false, PAIRED = false;
    float* GT;
    __device__ __forceinline__ void st(int row, int col, f32x4 v) const {
        f32x4 o; o[0] = fsigm(v[0]); o[1] = fsigm(v[1]); o[2] = fsigm(v[2]); o[3] = fsigm(v[3]); *(f32x4*)(GT + (size_t)row * 64 + col) = o;
    } };
__device__ __forceinline__ void st_pair16(bf16* rowbase, int fq, u32x2 o0, u32x2 o1) {
    const auto r0 = __builtin_amdgcn_permlane16_swap(o0.x, o1.x, false, false); const auto r1 = __builtin_amdgcn_permlane16_swap(o0.y, o1.y, false, false);
    u32x4 wv; wv.x = (unsigned)r0[0]; wv.y = (unsigned)r1[0]; wv.z = (unsigned)r0[1]; wv.w = (unsigned)r1[1];
    *(u32x4*)(rowbase + ((fq & 1) ? 16 + 4 * (fq - 1) : 4 * fq)) = wv; }
struct EpResidNorm { static constexpr bool PERM = false, AFTER_DRAIN = true;
    const float* xp;
    bf16* X; const float* mod; const float* bias;
    int mode;
    const float* nmod; const float* gk; bf16* H; bf16* HKV; float* yout;
    float* stats; unsigned* cnt; unsigned* bar;
    __device__ __forceinline__ void operator()(const pg8::f32x4 (&)[2][2][4][2], const pg8::Unit&, int, int, int, int) const {}
    __device__ __forceinline__ void fused(pg8::f32x4 (&acc)[2][2][4][2], const pg8::Unit& u, int wr, int wc, int fr, int fq, PG8_LAS unsigned char* lds, int wid, int lane) const {
        const int cidx = u.pm >> 4; const float* gm = mod + (size_t)cidx * 3072 + 2048; const int tid = wid * 64 + lane;
        PG8_LAS float* sred = (PG8_LAS float*)lds; PG8_LAS float* srs = (PG8_LAS float*)(lds + 4096);
        f32x4 gv[2][2];
#pragma unroll
        for (int bj = 0; bj < 2; ++bj)
#pragma unroll
            for (int n = 0; n < 2; ++n) { const int col = u.pn * 256 + bj * 128 + wc * 32 + 16 * n + 4 * fq; gv[bj][n] = *(const f32x4*)(gm + col); }
        if (bias) {
#pragma unroll
            for (int bj = 0; bj < 2; ++bj)
#pragma unroll
                for (int n = 0; n < 2; ++n) { const f32x4 b = *(const f32x4*)(bias + (u.pn * 256 + bj * 128 + wc * 32 + 16 * n + 4 * fq));
#pragma unroll
                    for (int ai = 0; ai < 2; ++ai)
#pragma unroll
                        for (int m = 0; m < 4; ++m) acc[ai][bj][m][n] += b; } }
#pragma unroll
        for (int ai = 0; ai < 2; ++ai)
#pragma unroll
            for (int m = 0; m < 4; ++m) { const int rl = ai * 128 + wr * 64 + m * 16 + fr; const size_t row = (size_t)u.pm * 256 + rl; float ss = 0.f;
                f32x4 xv[2][2];
                if (xp) {
#pragma unroll
                    for (int bj = 0; bj < 2; ++bj)
#pragma unroll
                        for (int n = 0; n < 2; ++n) xv[bj][n] = *(const f32x4*)(xp + row * D + (u.pn * 256 + bj * 128 + wc * 32 + 16 * n + 4 * fq));
                    __builtin_amdgcn_sched_barrier(0);
                } else { u32x2 t[2][2];
#pragma unroll
                    for (int bj = 0; bj < 2; ++bj)
#pragma unroll
                        for (int n = 0; n < 2; ++n) t[bj][n] = *(const u32x2*)(X + row * D + (u.pn * 256 + bj * 128 + wc * 32 + 16 * n + 4 * fq));
                    __builtin_amdgcn_sched_barrier(0);
#pragma unroll
                    for (int bj = 0; bj < 2; ++bj)
#pragma unroll
                        for (int n = 0; n < 2; ++n) xv[bj][n] = bfx4(t[bj][n].x, t[bj][n].y); }
#pragma unroll
                for (int bj = 0; bj < 2; ++bj) { u32x2 o[2];
#pragma unroll
                    for (int n = 0; n < 2; ++n) {
                        const f32x4 y = xv[bj][n] + gv[bj][n] * acc[ai][bj][m][n]; acc[ai][bj][m][n] = y;
                        o[n].x = pk2(y[0], y[1]); o[n].y = pk2(y[2], y[3]);
                        ss += (y[0] * y[0] + y[1] * y[1]) + (y[2] * y[2] + y[3] * y[3]); }
                    st_pair16(X + row * D + (u.pn * 256 + bj * 128 + wc * 32), fq, o[0], o[1]); }
                ss += __shfl_xor(ss, 16); ss += __shfl_xor(ss, 32);
                if (fq == 0) sred[rl * 4 + wc] = ss;
                asm volatile("" ::: "memory"); }
        __syncthreads();
        if (tid < 256) __hip_atomic_store((unsigned*)stats + ((size_t)u.pm * 4 + u.pn) * 256 + tid, __builtin_bit_cast(unsigned, (sred[tid * 4] + sred[tid * 4 + 1]) + (sred[tid * 4 + 2] + sred[tid * 4 + 3])), __ATOMIC_RELAXED, __HIP_MEMORY_SCOPE_AGENT);
        if (wid < 4) { asm volatile("s_waitcnt vmcnt(0)" ::: "memory"); if (lane == 0) (void)xb_add(cnt + 64 * u.pm, 1u); }
        if (tid == 0) { XB_SPIN(xb_ld(cnt + 64 * u.pm) < 16u, bar); __builtin_amdgcn_fence(__ATOMIC_ACQUIRE, "agent"); asm volatile("s_waitcnt vmcnt(0)" ::: "memory"); }
        __syncthreads();
        if (tid < 256) { float t = 0.f;
#pragma unroll
            for (int p2 = 0; p2 < 4; ++p2) t += __builtin_bit_cast(float, __hip_atomic_load((unsigned*)stats + ((size_t)u.pm * 4 + p2) * 256 + tid, __ATOMIC_RELAXED, __HIP_MEMORY_SCOPE_AGENT));
            srs[tid] = rsqrtf(t * (1.f / D) + EPS); }
        __syncthreads();
        const float* am = nmod + (size_t)cidx * 3072;
        f32x4 sc4[2][2], sh4[2][2], gk4[2][2];
#pragma unroll
        for (int bj = 0; bj < 2; ++bj)
#pragma unroll
            for (int n = 0; n < 2; ++n) { const int col = u.pn * 256 + bj * 128 + wc * 32 + 16 * n + 4 * fq; const f32x4 z = {0.f, 0.f, 0.f, 0.f};
                sc4[bj][n] = mode == 2 ? z : *(const f32x4*)(am + D + col); sh4[bj][n] = mode == 2 ? z : *(const f32x4*)(am + col); gk4[bj][n] = mode == 0 ? z : *(const f32x4*)(gk + col); }
#pragma unroll
        for (int ai = 0; ai < 2; ++ai)
#pragma unroll
            for (int m = 0; m < 4; ++m) { const int rl = ai * 128 + wr * 64 + m * 16 + fr; const size_t row = (size_t)u.pm * 256 + rl; const float rs = srs[rl];
#pragma unroll
                for (int bj = 0; bj < 2; ++bj)
#pragma unroll
                    for (int n = 0; n < 2; ++n) { const int col = u.pn * 256 + bj * 128 + wc * 32 + 16 * n + 4 * fq; const f32x4 yn = acc[ai][bj][m][n] * rs;
                        if (mode == 2) *(f32x4*)(yout + row * D + col) = yn * gk4[bj][n];
                        else { const f32x4 h = yn * sc4[bj][n] + sh4[bj][n]; u32x2 o; o.x = pk2(h[0], h[1]); o.y = pk2(h[2], h[3]); *(u32x2*)(H + row * D + col) = o;
                            if (mode == 1) { const f32x4 k = yn * gk4[bj][n]; u32x2 o2; o2.x = pk2(k[0], k[1]); o2.y = pk2(k[2], k[3]); *(u32x2*)(HKV + row * D + col) = o2; } } }
                asm volatile("" ::: "memory"); }
    } };
template <class E> struct PgE { static constexpr bool PERM = E::PERM, AFTER_DRAIN = false; E e;
    __device__ __forceinline__ void operator()(const pg8::f32x4 (&acc)[2][2][4][2], const pg8::Unit& u, int wr, int wc, int fr, int fq) const {
#pragma unroll
        for (int ai = 0; ai < 2; ++ai)
#pragma unroll
            for (int m = 0; m < 4; ++m) { const int row = u.pm * 256 + ai * 128 + wr * 64 + m * 16 + fr;
                if constexpr (E::PAIRED) {
#pragma unroll
                    for (int n = 0; n < 2; ++n) { const int f = u.pn * 128 + wc * 32 + (E::PERM ? 8 * fq + 4 * n : 16 * n + 4 * fq); e.st2(row, f, acc[ai][0][m][n], acc[ai][1][m][n]); }
                } else {
#pragma unroll
                    for (int bj = 0; bj < 2; ++bj)
#pragma unroll
                        for (int n = 0; n < 2; ++n) { const int col = u.pn * 256 + bj * 128 + wc * 32 + (E::PERM ? 8 * fq + 4 * n : 16 * n + 4 * fq); e.st(row, col, acc[ai][bj][m][n]); }
                }
                asm volatile("" ::: "memory"); }
    } };
template <class E> __device__ __forceinline__ void gemm_prompt(const Ctx& C, const bf16* Ap, const bf16* Bt, int N, int K, const E& e) {
    pg8::Gemm g{Ap, Bt, MP, N, K}; pg8::StaticOrder S; S.init(MP, N, C.G, C.wg); PgE<E> pe{e};
    pg8::gemm_phase<PgE<E>, pg8::StaticOrder, true, true>((PG8_LAS unsigned char*)C.lds, g, S, pe);
}
__device__ __forceinline__ void gemm_prompt_fused(const Ctx& C, const bf16* Ap, const bf16* Bt, int K, const EpResidNorm& e) {
    pg8::Gemm g{Ap, Bt, MP, 1024, K}; pg8::StaticOrder S; S.init(MP, 1024, C.G, C.wg);
    pg8::gemm_phase<EpResidNorm, pg8::StaticOrder, true, true>((PG8_LAS unsigned char*)C.lds, g, S, e);
}
__device__ __forceinline__ void sample_norm_part(const Ctx& C, CArgs& A, int mode, int ls, int pend_ls, const float* pend_bias, bool pend_in, unsigned* flag) {
    if (C.wg >= C.G - 16) {
        phase_norm(C, A, mode, ls, false, pend_ls, pend_bias, pend_in, MP + 8 * (C.wg - (C.G - 16)) + C.wave, MS, R);
        asm volatile("s_waitcnt vmcnt(0)" ::: "memory"); __syncthreads();
        if (C.tid == 0) { __builtin_amdgcn_fence(__ATOMIC_RELEASE, "agent"); asm volatile("s_waitcnt vmcnt(0)" ::: "memory"); (void)xb_add(flag, 1u); }
    }
}
__device__ __forceinline__ void sample_rows_ready(const Ctx& C, unsigned* flag, unsigned* bar) {
    if (C.tid == 0) { XB_SPIN(xb_ld(flag) < 16u, bar); __builtin_amdgcn_fence(__ATOMIC_ACQUIRE, "agent"); asm volatile("s_waitcnt vmcnt(0)" ::: "memory"); }
    __syncthreads();
}
__device__ __forceinline__ void phase_conv(const Ctx& C, CArgs& A, int l) {
    unsigned char* fb = A.fb; const bf16* U = (const bf16*)(fb + F_U); bf16* Cc = (bf16*)(fb + F_C); const float* US = (const float*)(fb + F_US);
    const int c0 = 2 * C.tid;
    constexpr int TOK = 8, NR = 528;
    const unsigned voff2 = (unsigned)c0 * 2u, voff4 = (unsigned)c0 * 4u;
    float w0[31], w1[31];
    { const char* wb = (const char*)(IN_F(14) + ((size_t)l * CONVW) * D);
#pragma unroll
      for (int k = 0; k < 31; ++k) { const float2 w = *(const float2*)(wb + (size_t)k * (D * 4) + voff4); w0[k] = w.x; w1[k] = w.y; } }
    const float2 bdw = *(const float2*)(IN_F(15) + l * D + c0), lg = *(const float2*)(IN_F(16) + l * D + c0), lb = *(const float2*)(IN_F(17) + l * D + c0);
    FLAS float* red = (FLAS float*)C.lds;
    FLAS float* ybuf = (FLAS float*)(C.lds + 65536);
    const int nPU = MP / TOK, nU = nPU + DB;
    for (int u = C.wg; u < nU; u += C.G) {
        int ntok; size_t orow0;
        __syncthreads();
        if (u < nPU) {
            const int row0 = u * TOK, t0 = row0 & 4095; ntok = TOK; orow0 = row0;
            {
                const char* up = (const char*)(U + (size_t)(row0 - 30) * D); float a0[TOK], a1[TOK];
#pragma unroll
                for (int tt = 0; tt < TOK; ++tt) { a0[tt] = bdw.x; a1[tt] = bdw.y; }
                unsigned xv[TOK + 30];
#pragma unroll
                for (int i = 0; i < TOK + 30; ++i) { xv[i] = 0u; if (t0 - 30 + i >= 0) xv[i] = *(const unsigned*)(up + (size_t)i * (D * 2) + voff2); }
#pragma unroll
                for (int i = 0; i < TOK + 30; ++i) { const float x0 = __builtin_bit_cast(float, xv[i] << 16), x1 = __builtin_bit_cast(float, xv[i] & 0xffff0000u);
#pragma unroll
                    for (int tt = 0; tt < TOK; ++tt) { const int k = i - tt; if (k >= 0 && k < 31) { a0[tt] += w0[k] * x0; a1[tt] += w1[k] * x1; } } }
#pragma unroll
                for (int tt = 0; tt < TOK; ++tt) { const int t = tt; ybuf[(t * NTHR + C.tid) * 2] = a0[tt]; ybuf[(t * NTHR + C.tid) * 2 + 1] = a1[tt]; red[(2 * t) * NR + C.tid] = a0[tt] + a1[tt]; red[(2 * t + 1) * NR + C.tid] = a0[tt] * a0[tt] + a1[tt] * a1[tt]; } }
        } else {
            const int b = u - nPU; ntok = 4; orow0 = (size_t)MP + b * 4;
            const char* sp = (const char*)(IN_F(7) + (((size_t)l * DB + b) * 30) * D); const char* usp = (const char*)(US + ((size_t)b * 4) * D);
            for (int t = 0; t < TOK; ++t) { float a0 = bdw.x, a1 = bdw.y;
                if (t < 4) {
#pragma unroll
                    for (int k = 0; k < 31; ++k) { const int j = t + k; const char* p = j < 30 ? sp + (size_t)j * (D * 4) : usp + (size_t)(j - 30) * (D * 4); const float2 v = *(const float2*)(p + voff4);
                        a0 += w0[k] * v.x; a1 += w1[k] * v.y; } }
                ybuf[(t * NTHR + C.tid) * 2] = a0; ybuf[(t * NTHR + C.tid) * 2 + 1] = a1; red[(2 * t) * NR + C.tid] = a0 + a1; red[(2 * t + 1) * NR + C.tid] = a0 * a0 + a1 * a1; }
        }
        __syncthreads();
        { const int v = C.tid >> 5, part = C.tid & 31; float s = 0.f;
#pragma unroll 8
          for (int i = 0; i < 16; ++i) s += red[v * NR + i * 32 + part];
          s += __shfl_xor(s, 1); s += __shfl_xor(s, 2); s += __shfl_xor(s, 4); s += __shfl_xor(s, 8); s += __shfl_xor(s, 16);
          if (part == 0) red[2 * TOK * NR + v] = s; }
        __syncthreads();
        for (int t = 0; t < ntok; ++t) { const float mu = red[2 * TOK * NR + 2 * t] * (1.f / D); const float var = red[2 * TOK * NR + 2 * t + 1] * (1.f / D) - mu * mu; const float rstd = rsqrtf(fmaxf(var, 0.f) + EPS);
            const float yx = ybuf[(t * NTHR + C.tid) * 2], yy = ybuf[(t * NTHR + C.tid) * 2 + 1];
            const float o0 = fsilu((yx - mu) * rstd * lg.x + lb.x), o1 = fsilu((yy - mu) * rstd * lg.y + lb.y);
            *(unsigned*)(Cc + (orow0 + t) * D + c0) = pk2(o0, o1); }
    }
    __syncthreads();
}
#define FK_HAVE_ATTN 1
typedef float f32x16 __attribute__((ext_vector_type(16)));
template <class E> __device__ __forceinline__ void gemm128(const Ctx& C, const bf16* Arows  , int grow0, const bf16* Bt, int K, const E& e, int u) {
    const int fr = C.lane & 15, fq = C.lane >> 4, w = C.wave;
    int brow[2];
    if (E::PAIRED) { const int f = u * 16; brow[0] = 256 * (f >> 7) + (f & 127); brow[1] = brow[0] + 128; } else { brow[0] = u * 32; brow[1] = u * 32 + 16; }
    f32x4 acc[8][2];
#pragma unroll
    for (int rt = 0; rt < 8; ++rt) { acc[rt][0] = (f32x4){0.f, 0.f, 0.f, 0.f}; acc[rt][1] = (f32x4){0.f, 0.f, 0.f, 0.f}; }
    const int kw = K >> 3, k0 = w * kw;
    const bf16* ap = Arows + (size_t)fr * K + k0 + fq * 8; const bf16* bp0 = Bt + (size_t)(brow[0] + fr) * K + k0 + fq * 8; const bf16* bp1 = Bt + (size_t)(brow[1] + fr) * K + k0 + fq * 8;
    bf16x8 b0 = *(const bf16x8*)bp0, b1 = *(const bf16x8*)bp1, a[8];
#pragma unroll
    for (int rt = 0; rt < 8; ++rt) a[rt] = *(const bf16x8*)(ap + (size_t)rt * 16 * K);
#pragma unroll 1
    for (int k = 32; k <= kw; k += 32) { const int kn = k < kw ? k : 0;
        const bf16x8 nb0 = *(const bf16x8*)(bp0 + kn), nb1 = *(const bf16x8*)(bp1 + kn); bf16x8 na[8];
#pragma unroll
        for (int rt = 0; rt < 8; ++rt) na[rt] = *(const bf16x8*)(ap + (size_t)rt * 16 * K + kn);
#pragma unroll
        for (int rt = 0; rt < 8; ++rt) { acc[rt][0] = __builtin_amdgcn_mfma_f32_16x16x32_bf16(b0, a[rt], acc[rt][0], 0, 0, 0); acc[rt][1] = __builtin_amdgcn_mfma_f32_16x16x32_bf16(b1, a[rt], acc[rt][1], 0, 0, 0); }
        b0 = nb0; b1 = nb1;
#pragma unroll
        for (int rt = 0; rt < 8; ++rt) a[rt] = na[rt]; }
    __syncthreads();
    FLAS f32x4* slab = (FLAS f32x4*)C.lds;
#pragma unroll
    for (int rt = 0; rt < 8; ++rt) { slab[((w * 8 + rt) * 2 + 0) * 64 + C.lane] = acc[rt][0]; slab[((w * 8 + rt) * 2 + 1) * 64 + C.lane] = acc[rt][1]; }
    __syncthreads();
    f32x4 s0 = (f32x4){0.f, 0.f, 0.f, 0.f}, s1 = s0;
#pragma unroll
    for (int ww = 0; ww < 8; ++ww) { s0 += slab[((ww * 8 + w) * 2 + 0) * 64 + C.lane]; s1 += slab[((ww * 8 + w) * 2 + 1) * 64 + C.lane]; }
    const int row = grow0 + w * 16 + fr;
    if constexpr (E::PAIRED) e.st2(row, u * 16 + 4 * fq, s0, s1);
    else { e.st(row, u * 32 + 4 * fq, s0); e.st(row, u * 32 + 16 + 4 * fq, s1); }
}
template <class E> __device__ __forceinline__ void gemm_sample(const Ctx& C0, const bf16* As  , const bf16* Bt, int N, int K, const E& e) {
    const Ctx C = refreshed(C0); const int nunits = N / 32;
#ifdef FK_TIMING
    unsigned long long* tsq = (unsigned long long*)(((CArgs*)__builtin_amdgcn_kernarg_segment_ptr())->fb + F_CTL + 65536 + 1024);
    unsigned long long t0 = 0; if (C.wg == FK_TWG && C.tid == 0) t0 = __builtin_amdgcn_s_memrealtime();
#endif
    { const int rank = C.G - 1 - C.wg, half = C.G >> 1;
      if (rank < half) { if (rank < nunits) gemm128(C, As, MP, Bt, K, e, rank);
          for (int u2 = half + (rank - (half >> 1)); rank >= (half >> 1) && u2 < nunits; u2 += half) gemm128(C, As, MP, Bt, K, e, u2); } }
    __syncthreads();
#ifdef FK_TIMING
    if (C.wg == FK_TWG && C.tid == 0) tsq[N == 1024 ? 6 : 7] += __builtin_amdgcn_s_memrealtime() - t0;
#endif
}

__device__ __forceinline__ void gemm_sample_ksplit(const Ctx& C0, const bf16* As  , const bf16* Bt  , int K, float* PART) {
    const Ctx C = refreshed(C0); const int fr = C.lane & 15, fq = C.lane >> 4, w = C.wave, rh = w >> 2, kq = w & 3;
    for (int u = C.wg; u < 256; u += C.G) { const int cg = u & 31, ks = u >> 5; const int nsteps = K >> 8, k0 = ks * (K >> 3);
        f32x4 acc[4][2];
#pragma unroll
        for (int rt = 0; rt < 4; ++rt) { acc[rt][0] = (f32x4){0.f, 0.f, 0.f, 0.f}; acc[rt][1] = (f32x4){0.f, 0.f, 0.f, 0.f}; }
        const bf16* ap = As + (size_t)(64 * rh + fr) * K + k0 + fq * 8; const bf16* bp = Bt + (size_t)(32 * cg + fr) * K + k0 + fq * 8;
#pragma unroll
        for (int i = 0; i < 3; ++i) { const int st = kq + 4 * i; if (st < nsteps) { const bf16x8 b0 = *(const bf16x8*)(bp + 32 * st), b1 = *(const bf16x8*)(bp + (size_t)16 * K + 32 * st);
#pragma unroll
            for (int rt = 0; rt < 4; ++rt) { const bf16x8 a = *(const bf16x8*)(ap + (size_t)rt * 16 * K + 32 * st);
                acc[rt][0] = __builtin_amdgcn_mfma_f32_16x16x32_bf16(b0, a, acc[rt][0], 0, 0, 0); acc[rt][1] = __builtin_amdgcn_mfma_f32_16x16x32_bf16(b1, a, acc[rt][1], 0, 0, 0); } } }
        __syncthreads();
        FLAS f32x4* slab = (FLAS f32x4*)C.lds;
#pragma unroll
        for (int rt = 0; rt < 4; ++rt) { slab[(w * 8 + rt * 2 + 0) * 64 + C.lane] = acc[rt][0]; slab[(w * 8 + rt * 2 + 1) * 64 + C.lane] = acc[rt][1]; }
        __syncthreads();
#pragma unroll
        for (int h = 0; h < 2; ++h) { const int pi = kq * 2 + h, rt = pi >> 1, ct = pi & 1; f32x4 sv = slab[((rh * 4 + 0) * 8 + pi) * 64 + C.lane];
#pragma unroll
            for (int x = 1; x < 4; ++x) sv += slab[((rh * 4 + x) * 8 + pi) * 64 + C.lane];
            *(f32x4*)(PART + ((size_t)ks * MS + 64 * rh + 16 * rt + fr) * D + 32 * cg + 16 * ct + 4 * fq) = sv; }
    }
    __syncthreads();
}

__device__ __forceinline__ void phase_qkv(const Ctx& C0, CArgs& A, int l) {
    unsigned char* fb = A.fb; const bf16* HF = (const bf16*)(fb + F_H); const bf16* HKV = (const bf16*)(fb + F_HKV);
    unsigned* flag = (unsigned*)(fb + F_CTL) + 32768 + 64 * (2 * l - 1);
    { const Ctx C = refreshed(C0); sample_norm_part(C, A, l == 2 ? 1 : 0, 2 * l, 2 * l - 1, nullptr, false, flag); }
    if (l == 2) { const Ctx C = refreshed(C0); EpKV e{A.out, (bf16*)(fb + F_RB)}; gemm_prompt(C, HKV, (const bf16*)(fb + F_WKV), KVW, 1024, e); }
    { const Ctx C = refreshed(C0); EpQ e{(bf16*)(fb + F_Q)}; gemm_prompt(C, HF, (const bf16*)(fb + F_WQ) + (size_t)(l - 2) * 1024 * 1024, 1024, 1024, e); }
    { const Ctx C = refreshed(C0); sample_rows_ready(C, flag, (unsigned*)(fb + F_CTL) + 1024); }
    if (l == 2) { const Ctx C = refreshed(C0); EpKV e{A.out, (bf16*)(fb + F_RB)}; gemm_sample(C, HKV + (size_t)MP * D, (const bf16*)(fb + F_WKV), KVW, 1024, e); }
    { const Ctx C = refreshed(C0); gemm_sample_ksplit(C, HF + (size_t)MP * D, (const bf16*)(fb + F_WQ) + (size_t)(l - 2) * 1024 * 1024, 1024, (float*)(fb + F_QPART)); }
    { const Ctx C = refreshed(C0); EpGates e{(float*)(fb + F_GT)}; const bf16* W = (const bf16*)(fb + F_WG) + (size_t)(l - 2) * 64 * 1024;
      for (int it = (C.wg + 64) % C.G; it < 2 * (R / 128); it += C.G) gemm128(C, HF + (size_t)(it >> 1) * 128 * D, (it >> 1) * 128, W, 1024, e, it & 1);
      __syncthreads(); }
}

__device__ __forceinline__ void compress_prompt_wg(const Ctx& C, CArgs& A, int task) {
    unsigned char* fb = A.fb; const int fr = C.lane & 15, fq = C.lane >> 4, nl = fr >> 2, g = fr & 3, w = C.wave;
    const int e = task & 1, grp = (task >> 1) & 31, b = task >> 6;
    const bf16* W1 = (const bf16*)(fb + F_WPHI1) + (size_t)e * 128 * 2048; const bf16* W2 = (const bf16*)(fb + F_WPHI2) + (size_t)e * 64 * 128;
    f32x4 acc[8];
#pragma unroll
    for (int j = 0; j < 8; ++j) acc[j] = (f32x4){0.f, 0.f, 0.f, 0.f};
    const bf16* w1p = W1 + (size_t)fr * 2048 + fq * 8 + w * 256;
    const bf16* ap = (const bf16*)(fb + F_RB) + ((size_t)b * SEQ + (grp * 4 + nl) * 32 + 4 * w) * KVW + e * 256 + g * 64 + fq * 8;
#pragma unroll 2
    for (int s2 = 0; s2 < 8; ++s2) { const bf16x8 a = *(const bf16x8*)(ap + (size_t)(s2 >> 1) * KVW + (s2 & 1) * 32);
#pragma unroll
        for (int j = 0; j < 8; ++j) { const bf16x8 wv = *(const bf16x8*)(w1p + (size_t)j * 16 * 2048 + s2 * 32); acc[j] = __builtin_amdgcn_mfma_f32_16x16x32_bf16(wv, a, acc[j], 0, 0, 0); } }
    FLAS f32x4* slab = (FLAS f32x4*)C.lds;
    FLAS bf16* hid = (FLAS bf16*)(C.lds + 65536);
#pragma unroll
    for (int j = 0; j < 8; ++j) slab[(w * 8 + j) * 64 + C.lane] = acc[j];
    __syncthreads();
    { f32x4 h = (f32x4){0.f, 0.f, 0.f, 0.f};
#pragma unroll
      for (int ww = 0; ww < 8; ++ww) h += slab[(ww * 8 + w) * 64 + C.lane];
      const f32x4 bb = *(const f32x4*)((const float*)(fb + F_BPHI) + 4096 + e * PHI + 16 * w + 4 * fq);
      u32x2 o; o.x = pk2(fsilu(h[0] + bb[0]), fsilu(h[1] + bb[1])); o.y = pk2(fsilu(h[2] + bb[2]), fsilu(h[3] + bb[3]));
      *(FLAS u32x2*)(hid + fr * 136 + 16 * w + 4 * fq) = o; }
    __syncthreads();
    if (w < 4) { const int jj = w; f32x4 o2 = (f32x4){0.f, 0.f, 0.f, 0.f};
#pragma unroll
        for (int kq = 0; kq < 4; ++kq) { const bf16x8 a2 = *(const FLAS bf16x8*)(hid + fr * 136 + 32 * kq + 8 * fq); const bf16x8 wv = *(const bf16x8*)(W2 + (size_t)(16 * jj + fr) * 128 + 32 * kq + 8 * fq);
            o2 = __builtin_amdgcn_mfma_f32_16x16x32_bf16(wv, a2, o2, 0, 0, 0); }
        const int n = grp * 4 + nl, od = 16 * jj + 4 * fq; const f32x4 v = o2 + *(const f32x4*)(IN_F(25) + e * 64 + od);
        if (e == 0) { u32x2 o; o.x = pk2(v[0], v[1]); o.y = pk2(v[2], v[3]); *(u32x2*)((bf16*)(fb + F_CMPK) + (((size_t)b * 4 + g) * 128 + n) * 64 + od) = o; }
        else { bf16* vt = (bf16*)(fb + F_CMPVT) + (((size_t)b * 4 + g) * 64 + od) * 128 + n;
#pragma unroll
            for (int r = 0; r < 4; ++r) vt[r * 128] = (bf16)f2bf(v[r]); } }
    __syncthreads();
}
__device__ __forceinline__ void compress_sample_round(const Ctx& C, CArgs& A, int round) {
    unsigned char* fb = A.fb; const int fr = C.lane & 15, fq = C.lane >> 4, nl = fr >> 2, g = fr & 3, tid = C.tid;
    const int e = round & 1, pg = ((round >> 1) & 7) * 8 + C.wave, b = round >> 4;
    const bf16* W1 = (const bf16*)(fb + F_WPHI1) + (size_t)e * 128 * 2048; const bf16* W2 = (const bf16*)(fb + F_WPHI2) + (size_t)e * 64 * 128;
    FLAS unsigned char* L = C.lds;
    const int page = ((const int*)A.in[8])[b * NPAGES + pg];
    const float* ap = IN_F(4) + ((((size_t)page * PAGE + nl * 32) * 2 + e) * 4 + g) * 64 + fq * 8;
    f32x4 acc[8];
#pragma unroll
    for (int j = 0; j < 8; ++j) acc[j] = (f32x4){0.f, 0.f, 0.f, 0.f};
    f32x4 xa[8], xb[8];
#define CS_LOAD(dst, blk) { _Pragma("unroll") for (int q4 = 0; q4 < 4; ++q4) { const int s_ = (blk) * 4 + q4; const float* p_ = ap + (size_t)(s_ >> 1) * 512 + (s_ & 1) * 32; \
        dst[2 * q4] = __builtin_nontemporal_load((const f32x4*)p_); dst[2 * q4 + 1] = __builtin_nontemporal_load((const f32x4*)(p_ + 4)); } }
#define CS_COMP(src, blk) { _Pragma("unroll") for (int q4 = 0; q4 < 4; ++q4) { const int kl_ = ((blk) & 1) * 4 + q4; \
        u32x4 pa_; pa_.x = pk2(src[2 * q4][0], src[2 * q4][1]); pa_.y = pk2(src[2 * q4][2], src[2 * q4][3]); pa_.z = pk2(src[2 * q4 + 1][0], src[2 * q4 + 1][1]); pa_.w = pk2(src[2 * q4 + 1][2], src[2 * q4 + 1][3]); \
        const bf16x8 a_ = __builtin_bit_cast(bf16x8, pa_); \
        _Pragma("unroll") for (int j = 0; j < 8; ++j) { const bf16x8 w_ = *(const FLAS bf16x8*)(L + (16 * j + fr) * 528 + (kl_ * 32 + fq * 8) * 2); acc[j] = __builtin_amdgcn_mfma_f32_16x16x32_bf16(w_, a_, acc[j], 0, 0, 0); } } }
    CS_LOAD(xa, 0)
#pragma unroll 1
    for (int c = 0; c < 8; ++c) {
        __syncthreads();
        u32x4 wst[8];
#pragma unroll
        for (int i = 0; i < 8; ++i) { const int idx = tid + NTHR * i, nn = idx >> 5, ch = idx & 31; wst[i] = *(const u32x4*)(W1 + (size_t)nn * 2048 + c * 256 + ch * 8); }
        CS_LOAD(xb, 2 * c + 1)
#pragma unroll
        for (int i = 0; i < 8; ++i) { const int idx = tid + NTHR * i, nn = idx >> 5, ch = idx & 31; *(FLAS u32x4*)(L + nn * 528 + ch * 16) = wst[i]; }
        __syncthreads();
        CS_COMP(xa, 2 * c)
        if (c < 7) CS_LOAD(xa, 2 * c + 2)
        CS_COMP(xb, 2 * c + 1)
    }
#undef CS_LOAD
#undef CS_COMP
    const float* bph = (const float*)(fb + F_BPHI) + 4096 + e * PHI; const float* b2 = IN_F(25) + e * 64;
#pragma unroll
    for (int j = 0; j < 8; ++j) { const f32x4 bb = *(const f32x4*)(bph + 16 * j + 4 * fq);
#pragma unroll
        for (int r = 0; r < 4; ++r) acc[j][r] = fsilu(acc[j][r] + bb[r]); }
    f32x4 o2[4];
#pragma unroll
    for (int jj = 0; jj < 4; ++jj) o2[jj] = (f32x4){0.f, 0.f, 0.f, 0.f};
#pragma unroll
    for (int kq = 0; kq < 4; ++kq) {
        u32x4 pa; pa.x = pk2(acc[2 * kq][0], acc[2 * kq][1]); pa.y = pk2(acc[2 * kq][2], acc[2 * kq][3]); pa.z = pk2(acc[2 * kq + 1][0], acc[2 * kq + 1][1]); pa.w = pk2(acc[2 * kq + 1][2], acc[2 * kq + 1][3]);
        const bf16x8 a2 = __builtin_bit_cast(bf16x8, pa);
#pragma unroll
        for (int jj = 0; jj < 4; ++jj) { const bf16* wp = W2 + (size_t)(16 * jj + fr) * 128 + 32 * kq + 4 * fq; const u32x2 lo = *(const u32x2*)wp, hi = *(const u32x2*)(wp + 16);
            u32x4 pw; pw.x = lo.x; pw.y = lo.y; pw.z = hi.x; pw.w = hi.y; o2[jj] = __builtin_amdgcn_mfma_f32_16x16x32_bf16(__builtin_bit_cast(bf16x8, pw), a2, o2[jj], 0, 0, 0); } }
    const int n = pg * 4 + nl;
#pragma unroll
    for (int jj = 0; jj < 4; ++jj) { const int od = 16 * jj + 4 * fq; const f32x4 v = o2[jj] + *(const f32x4*)(b2 + od);
        if (e == 0) { u32x2 o; o.x = pk2(v[0], v[1]); o.y = pk2(v[2], v[3]); *(u32x2*)((bf16*)(fb + F_CMPS) + (((size_t)b * 4 + g) * 256 + n) * 64 + od) = o; }
        else { bf16* vt = (bf16*)(fb + F_CMPS) + (size_t)DB * 4 * 256 * 64 + (((size_t)b * 4 + g) * 64 + od) * 256 + n;
#pragma unroll
            for (int r = 0; r < 4; ++r) vt[r * 256] = (bf16)f2bf(v[r]); } }
}
__device__ __forceinline__ void phase_prep(const Ctx& C, CArgs& A) {
    unsigned char* fb = A.fb; const bf16* RB = (const bf16*)(fb + F_RB); bf16* VT = (bf16*)(fb + F_VT);
    FLAS unsigned char* scr = C.lds + C.wave * 9216;
    for (int it = C.gw; it < 2048; it += C.ngw) {
        const int tc = it & 63, g = (it >> 6) & 3, b = (it >> 8) & 3, br = it >> 10; const int t0 = tc * 64, col0 = 512 * (br + 1) + 256 + g * 64;
#pragma unroll
        for (int i = 0; i < 8; ++i) { const int tok = i * 8 + (C.lane >> 3), ch = C.lane & 7; *(FLAS u32x4*)(scr + tok * 144 + ch * 16) = *(const u32x4*)(RB + ((size_t)b * SEQ + t0 + tok) * KVW + col0 + ch * 8); }
        asm volatile("s_waitcnt lgkmcnt(0)" ::: "memory");
        bf16* dst = VT + ((((size_t)br * 4 + b) * 4 + g) * 64 + C.lane) * SEQ + t0;
#pragma unroll
        for (int i = 0; i < 8; ++i) { unsigned w[4];
#pragma unroll
            for (int j = 0; j < 4; ++j) { const unsigned lo = *(const FLAS unsigned short*)(scr + (8 * i + 2 * j) * 144 + C.lane * 2), hi = *(const FLAS unsigned short*)(scr + (8 * i + 2 * j + 1) * 144 + C.lane * 2); w[j] = lo | (hi << 16); }
            u32x4 o; o.x = w[0]; o.y = w[1]; o.z = w[2]; o.w = w[3]; *(u32x4*)(dst + 8 * i) = o; }
        asm volatile("s_waitcnt lgkmcnt(0)" ::: "memory");
    }
    __syncthreads();
    for (int task = C.wg; task < 256; task += C.G) compress_prompt_wg(C, A, task);
    for (int rd = C.wg; rd < 512; rd += C.G) compress_sample_round(C, A, rd);
    __syncthreads();
}

__device__ __forceinline__ float dpp_xor1(float v) { return __builtin_bit_cast(float, __builtin_amdgcn_update_dpp(0, __builtin_bit_cast(int, v), 0xB1, 0xF, 0xF, true)); }
__device__ __forceinline__ float dpp_xor2(float v) { return __builtin_bit_cast(float, __builtin_amdgcn_update_dpp(0, __builtin_bit_cast(int, v), 0x4E, 0xF, 0xF, true)); }
template <int N> struct IC { static constexpr int value = N; };
__device__ __forceinline__ int swz23(int m) { return (m & 0x13) | ((m & 4) << 1) | ((m & 8) >> 1); }
constexpr int AL_KB0 = 0, AL_VB0 = 9216, AL_KB1 = 18432, AL_VB1 = 27648, AL_LUT = 36864, AL_CK = 51712, AL_CV = 70144, AL_IMP = 87552, AL_SELM = 103936, AL_SCR = 104448, AL_LUTW = 110592  , AL_STASH = AL_CK;
constexpr int DMAXB = 790, LUTN = 928, LUTO = 64;
__device__ __forceinline__ bf16x8 pack8(const f32x16& p, int s) {
    u32x4 o; o.x = pk2(p[8 * s], p[8 * s + 1]); o.y = pk2(p[8 * s + 2], p[8 * s + 3]); o.z = pk2(p[8 * s + 4], p[8 * s + 5]); o.w = pk2(p[8 * s + 6], p[8 * s + 7]); return __builtin_bit_cast(bf16x8, o); }

__device__ __forceinline__ void attn_prompt_unit(const Ctx& C, CArgs& A, int b, int g, int qt, bool load_bg) {
    unsigned char* fb = A.fb; FLAS unsigned char* L = C.lds;
    const bf16* RB = (const bf16*)(fb + F_RB); const bf16* VT = (const bf16*)(fb + F_VT); const bf16* Q = (const bf16*)(fb + F_Q); const float* GT = (const float*)(fb + F_GT);
    const int tid = C.tid, lane = C.lane, w = C.wave, n = lane & 31, h = lane >> 5, ql = n >> 2, r = n & 3;
    const int q0 = qt * 64, qpos = q0 + 8 * w + ql, jq = qt; const size_t qrow = (size_t)b * SEQ + qpos;
    __syncthreads();
    {
        const bf16* ck = (const bf16*)(fb + F_CMPK) + ((size_t)b * 4 + g) * 128 * 64; const bf16* cv = (const bf16*)(fb + F_CMPVT) + ((size_t)b * 4 + g) * 64 * 128;
        for (int i = tid; i < 1024; i += NTHR) { const int key = i >> 3, ch = i & 7; *(FLAS u32x4*)(L + AL_CK + key * 144 + ch * 16) = *(const u32x4*)(ck + key * 64 + ch * 8); }
        for (int i = tid; i < 1024; i += NTHR) { const int dim = i >> 4, ch = i & 15; *(FLAS u32x4*)(L + AL_CV + dim * 272 + ch * 16) = *(const u32x4*)(cv + dim * 128 + ch * 8); }
        if (load_bg) for (int i = tid; i < LUTN * 4; i += NTHR) { const int d = (i >> 2) - LUTO, rr = i & 3; const float bv = IN_F(29)[rel_bucket(d) * 16 + g * 4 + rr] * LOG2E;
            ((FLAS float*)(L + AL_LUT))[i] = d < 0 ? -INFINITY : bv; if (i < 640 * 4) ((FLAS float*)(L + AL_LUTW))[i] = (d < 0 || d >= 512) ? -INFINITY : bv; }
    }
    bf16x8 qf[4];
#pragma unroll
    for (int s = 0; s < 4; ++s) qf[s] = *(const bf16x8*)(Q + qrow * D + (g * 4 + r) * 64 + 16 * s + 8 * h);
    const float gt0 = GT[qrow * 64 + (g * 4 + r) * 3 + 0], gt1 = GT[qrow * 64 + (g * 4 + r) * 3 + 1], gt2 = GT[qrow * 64 + (g * 4 + r) * 3 + 2];
    __syncthreads();
    const FLAS float* LUT = (const FLAS float*)(L + AL_LUT);
    FLAS u32x2* stash = (FLAS u32x2*)(L + AL_STASH) + (w * 64 + lane) * 8;
    const int krow = swz23(n);
    {
        f32x16 S[4]; float mx = -1e30f;
#pragma unroll
        for (int sub = 0; sub < 4; ++sub) { f32x16 acc;
#pragma unroll
            for (int i = 0; i < 16; ++i) acc[i] = 0.f;
#pragma unroll
            for (int ks = 0; ks < 4; ++ks) { const bf16x8 a = *(const FLAS bf16x8*)(L + AL_CK + (32 * sub + krow) * 144 + (16 * ks + 8 * h) * 2); acc = __builtin_amdgcn_mfma_f32_32x32x16_bf16(a, qf[ks], acc, 0, 0, 0); }
#pragma unroll
            for (int i = 0; i < 16; ++i) { const int nb = 32 * sub + (i & 7) + 8 * h + 16 * (i >> 3); const int d = qpos - (32 * nb + 31); const bool valid = d >= 0;
                const int dc = d > DMAXB ? DMAXB : (d < 0 ? 0 : d); const float bias = LUT[(dc + LUTO) * 4 + r]; float v = acc[i] + bias; v = valid ? v : -INFINITY; acc[i] = v; mx = fmaxf(mx, v); }
            S[sub] = acc; }
        mx = xmax32(mx);
        float sum = 0.f;
#pragma unroll
        for (int sub = 0; sub < 4; ++sub)
#pragma unroll
            for (int i = 0; i < 16; ++i) { const float p = __builtin_amdgcn_exp2f(S[sub][i] - mx); S[sub][i] = p; sum += p; }
        sum = xsum32(sum);
        const float inv = sum > 0.f ? 1.f / sum : 0.f;
        f32x16 oc[2];
#pragma unroll
        for (int d2 = 0; d2 < 2; ++d2)
#pragma unroll
            for (int i = 0; i < 16; ++i) oc[d2][i] = 0.f;
        FLAS float* IMP = (FLAS float*)(L + AL_IMP) + (w * 8 + ql) * 64;
#pragma unroll
        for (int sub = 0; sub < 4; ++sub) {
#pragma unroll
            for (int i = 0; i < 16; ++i) S[sub][i] *= inv;
#pragma unroll
            for (int i = 0; i < 16; i += 2) { float v = S[sub][i] + S[sub][i + 1]; v += dpp_xor1(v); v += dpp_xor2(v);
                const int j = 16 * sub + ((i & 7) >> 1) + 4 * h + 8 * (i >> 3); if (r == 0) IMP[j] = v; }
#pragma unroll
            for (int s = 0; s < 2; ++s) { const bf16x8 pb = pack8(S[sub], s);
#pragma unroll
                for (int d2 = 0; d2 < 2; ++d2) { const bf16x8 a = *(const FLAS bf16x8*)(L + AL_CV + (32 * d2 + n) * 272 + (32 * sub + 16 * s + 8 * h) * 2); oc[d2] = __builtin_amdgcn_mfma_f32_32x32x16_bf16(a, pb, oc[d2], 0, 0, 0); } }
        }
#pragma unroll
        for (int d2 = 0; d2 < 2; ++d2) oc[d2] *= gt0;
        __syncthreads();
#pragma unroll
        for (int d2 = 0; d2 < 2; ++d2)
#pragma unroll
            for (int c = 0; c < 4; ++c) { u32x2 o; o.x = pk2(oc[d2][4 * c], oc[d2][4 * c + 1]); o.y = pk2(oc[d2][4 * c + 2], oc[d2][4 * c + 3]); stash[d2 * 4 + c] = o; }
    }
    asm volatile("s_waitcnt lgkmcnt(0)" ::: "memory");
    {
        FLAS unsigned long long* SCR64 = (FLAS unsigned long long*)(L + AL_SCR) + w * 64; FLAS unsigned* SELM = (FLAS unsigned*)(L + AL_SELM) + w * 16;
        for (int qq = 0; qq < 8; ++qq) {
            unsigned long long mask;
            if (jq < 16) mask = (2ull << jq) - 1ull;
            else {
                const int j = lane; const float impj = ((const FLAS float*)(L + AL_IMP))[(w * 8 + qq) * 64 + j];
                const bool forced = (j == 0) || (j == jq) || (j == jq - 1); const bool okj = j <= jq; const float sj = forced ? 1e4f : impj;
                const unsigned long long keyj = okj ? (((unsigned long long)(__builtin_bit_cast(unsigned, sj) + 1u) << 32) | (unsigned)(63 - j)) : 0ull;
                SCR64[j] = keyj; asm volatile("s_waitcnt lgkmcnt(0)" ::: "memory");
                int rank = 0;
#pragma unroll
                for (int i2 = 0; i2 < 32; ++i2) { const u32x4 kv = *(const FLAS u32x4*)(SCR64 + 2 * i2);
                    const unsigned long long k0 = ((unsigned long long)kv.y << 32) | kv.x, k1 = ((unsigned long long)kv.w << 32) | kv.z;
                    rank += (k0 > keyj) ? 1 : 0; rank += (k1 > keyj) ? 1 : 0; }
                mask = __ballot(rank < 16 && okj);
                asm volatile("s_waitcnt lgkmcnt(0)" ::: "memory");
            }
            if (lane == 0) { SELM[2 * qq] = (unsigned)mask; SELM[2 * qq + 1] = (unsigned)(mask >> 32); }
        }
        asm volatile("s_waitcnt lgkmcnt(0)" ::: "memory");
    }
    const unsigned selLo = ((const FLAS unsigned*)(L + AL_SELM))[w * 16 + 2 * ql], selHi = ((const FLAS unsigned*)(L + AL_SELM))[w * 16 + 2 * ql + 1];
    const int jw0 = jq - 8 > 0 ? jq - 8 : 0; const int NTL = (jq + 1) + (jq - jw0 + 1);
    const int skey = tid >> 3, sch = tid & 7;
    const bf16* kbase = RB + ((size_t)b * SEQ + skey) * KVW + g * 64 + sch * 8;
    const bf16* vbase = VT + (((size_t)b * 4 + g) * 64 + skey) * SEQ + sch * 8;
    float m = -1e30f, lsum = 0.f; f32x16 oa[2];
#pragma unroll
    for (int d2 = 0; d2 < 2; ++d2)
#pragma unroll
        for (int i = 0; i < 16; ++i) oa[d2][i] = 0.f;
    u32x4 kreg0, vreg0, kreg1, vreg1;
    { kreg0 = *(const u32x4*)(kbase + 512); vreg0 = *(const u32x4*)vbase; }
    { const bool nw = 1 > jq; const int nj = nw ? jw0 : 1; kreg1 = *(const u32x4*)(kbase + (size_t)64 * nj * KVW + (nw ? 1024 : 512)); vreg1 = *(const u32x4*)(vbase + (nw ? (size_t)16 * 64 * SEQ : 0) + 64 * nj); }
    *(FLAS u32x4*)(L + AL_KB0 + skey * 144 + sch * 16) = kreg0; *(FLAS u32x4*)(L + AL_VB0 + skey * 144 + sch * 16) = vreg0;
    __syncthreads();
    const float b31 = LUT[(DMAXB + LUTO) * 4 + r];
    for (int ti = 0; ti < NTL; ++ti) {
        const bool isw = ti > jq; const int j = isw ? jw0 + (ti - jq - 1) : ti; const int buf = ti & 1;
        kreg0 = kreg1; vreg0 = vreg1;
        if (ti + 2 < NTL) { const bool nw = (ti + 2) > jq; const int nj = nw ? jw0 + (ti + 1 - jq) : ti + 2;
            kreg1 = *(const u32x4*)(kbase + (size_t)64 * nj * KVW + (nw ? 1024 : 512)); vreg1 = *(const u32x4*)(vbase + (nw ? (size_t)16 * 64 * SEQ : 0) + 64 * nj); }
        if (ti == jq + 1) {
            const float lt = xsum32(lsum); const float f = lt > 0.f ? gt1 / lt : 0.f;
#pragma unroll
            for (int d2 = 0; d2 < 2; ++d2) {
#pragma unroll
                for (int c = 0; c < 4; ++c) { const u32x2 o = stash[d2 * 4 + c]; u32x2 n2;
                    n2.x = pk2(__builtin_bit_cast(float, o.x << 16) + oa[d2][4 * c] * f, __builtin_bit_cast(float, o.x & 0xffff0000u) + oa[d2][4 * c + 1] * f);
                    n2.y = pk2(__builtin_bit_cast(float, o.y << 16) + oa[d2][4 * c + 2] * f, __builtin_bit_cast(float, o.y & 0xffff0000u) + oa[d2][4 * c + 3] * f); stash[d2 * 4 + c] = n2; }
#pragma unroll
                for (int i = 0; i < 16; ++i) oa[d2][i] = 0.f; }
            m = -1e30f; lsum = 0.f; }
        const bool selbit = ((j < 32 ? selLo >> j : selHi >> (j - 32)) & 1u) != 0u;
        const bool active = isw ? true : (__any(selbit) != 0);
        if (active) {
            const FLAS unsigned char* KB = L + (buf ? AL_KB1 : AL_KB0); const FLAS unsigned char* VB = L + (buf ? AL_VB1 : AL_VB0);
            f32x16 S[2];
            { bf16x8 kf[2][4];
#pragma unroll
              for (int sub = 0; sub < 2; ++sub)
#pragma unroll
                  for (int ks = 0; ks < 4; ++ks) kf[sub][ks] = *(const FLAS bf16x8*)(KB + (32 * sub + krow) * 144 + (16 * ks + 8 * h) * 2);
              __builtin_amdgcn_sched_barrier(0);
#pragma unroll
              for (int sub = 0; sub < 2; ++sub) { f32x16 acc;
#pragma unroll
                  for (int i = 0; i < 16; ++i) acc[i] = 0.f;
#pragma unroll
                  for (int ks = 0; ks < 4; ++ks) acc = __builtin_amdgcn_mfma_f32_32x32x16_bf16(kf[sub][ks], qf[ks], acc, 0, 0, 0);
                  S[sub] = acc; }
            }
            const int dbase = qpos - 64 * j;
            const bool far = !isw && ((q0 + 8 * w) - (64 * j + 63) >= DMAXB);
            auto body = [&](auto tag) { constexpr int MODE = decltype(tag)::value;
                float tmax = -INFINITY, poff;
                if constexpr (MODE == 0) {
#pragma unroll
                    for (int sub = 0; sub < 2; ++sub)
#pragma unroll
                        for (int i = 0; i < 16; ++i) tmax = fmaxf(tmax, S[sub][i]);
                    tmax = selbit ? tmax + b31 : -INFINITY;
                } else {
                    const int dl = dbase - 8 * h;
                    const int dle = (MODE == 2 || selbit) ? dl : -1;
                    const FLAS float* lpb = (MODE == 2 ? (const FLAS float*)(L + AL_LUTW) : LUT) + ((dle + LUTO - 55) * 4 + r);
                    float bv[2][16];
#pragma unroll
                    for (int sub = 0; sub < 2; ++sub)
#pragma unroll
                        for (int i = 0; i < 16; ++i) { const int koff = 32 * sub + (i & 7) + 16 * (i >> 3); bv[sub][i] = lpb[(55 - koff) * 4]; }
                    __builtin_amdgcn_sched_barrier(0);
#pragma unroll
                    for (int sub = 0; sub < 2; ++sub)
#pragma unroll
                        for (int i = 0; i < 16; ++i) { const float v = S[sub][i] + bv[sub][i]; S[sub][i] = v; tmax = fmaxf(tmax, v); }
                }
                tmax = xmax32(tmax);
                const float mnew = fmaxf(m, tmax); const float sc = __builtin_amdgcn_exp2f(m - mnew); m = mnew;
                poff = MODE == 0 ? (selbit ? b31 - mnew : -INFINITY) : -mnew;
                float ps = 0.f;
#pragma unroll
                for (int sub = 0; sub < 2; ++sub)
#pragma unroll
                    for (int i = 0; i < 16; ++i) { const float p = __builtin_amdgcn_exp2f(S[sub][i] + poff); S[sub][i] = p; ps += p; }
                lsum = lsum * sc + ps;
#pragma unroll
                for (int d2 = 0; d2 < 2; ++d2) oa[d2] *= sc;
#pragma unroll
                for (int sub = 0; sub < 2; ++sub)
#pragma unroll
                    for (int s2 = 0; s2 < 2; ++s2) { const bf16x8 pb = pack8(S[sub], s2);
#pragma unroll
                        for (int d2 = 0; d2 < 2; ++d2) { const bf16x8 av = *(const FLAS bf16x8*)(VB + (32 * d2 + n) * 144 + (32 * sub + 16 * s2 + 8 * h) * 2); oa[d2] = __builtin_amdgcn_mfma_f32_32x32x16_bf16(av, pb, oa[d2], 0, 0, 0); } }
            };
            if (isw) body(IC<2>{}); else if (far) body(IC<0>{}); else body(IC<1>{});
        }
        if (ti + 1 < NTL) { FLAS unsigned char* KBn = L + (buf ? AL_KB0 : AL_KB1); FLAS unsigned char* VBn = L + (buf ? AL_VB0 : AL_VB1);
            *(FLAS u32x4*)(KBn + skey * 144 + sch * 16) = kreg0; *(FLAS u32x4*)(VBn + skey * 144 + sch * 16) = vreg0; }
        __syncthreads();
    }
    { const float lt = xsum32(lsum); const float f = lt > 0.f ? gt2 / lt : 0.f;
#pragma unroll
      for (int d2 = 0; d2 < 2; ++d2) oa[d2] *= f; }
    bf16* op = (bf16*)(fb + F_O) + qrow * D + (g * 4 + r) * 64;
#pragma unroll
    for (int d2 = 0; d2 < 2; ++d2)
#pragma unroll
        for (int c = 0; c < 4; ++c) { const u32x2 sv = stash[d2 * 4 + c]; u32x2 o;
            o.x = pk2(__builtin_bit_cast(float, sv.x << 16) + oa[d2][4 * c], __builtin_bit_cast(float, sv.x & 0xffff0000u) + oa[d2][4 * c + 1]);
            o.y = pk2(__builtin_bit_cast(float, sv.y << 16) + oa[d2][4 * c + 2], __builtin_bit_cast(float, sv.y & 0xffff0000u) + oa[d2][4 * c + 3]); *(u32x2*)(op + 32 * d2 + 8 * c + 4 * h) = o; }
}

typedef short v4i16_t __attribute__((ext_vector_type(4)));
__device__ __forceinline__ float fexp2(float x) { return __builtin_amdgcn_exp2f(x); }
constexpr int SM_LUT = 0, SM_P = 12800, SM_ML = 29184, SM_FAC = 29696, SM_SC = 29952, SM_SELQ = 32064, SM_PUB0 = 12800  , SM_LIST = 45568, SM_NIT = 46112, SM_V = 46208, SM_PUBML = 119936;
constexpr int SDMAX = 790;
struct SAcc { float m, l; f32x4 o[4]; };
__device__ __forceinline__ void sa_init(SAcc& a) { a.m = -1e30f; a.l = 0.f;
#pragma unroll
    for (int dt = 0; dt < 4; ++dt) a.o[dt] = (f32x4){0.f, 0.f, 0.f, 0.f}; }
__device__ __forceinline__ bf16x8 pack44(const f32x4& x, const f32x4& y) { u32x4 o; o.x = pk2(x[0], x[1]); o.y = pk2(x[2], x[3]); o.z = pk2(y[0], y[1]); o.w = pk2(y[2], y[3]); return __builtin_bit_cast(bf16x8, o); }
__device__ __forceinline__ void sa_update(f32x4 (&S)[4], SAcc& a, bf16x8 (&P)[2]) {
    float tmax = fmaxf(fmaxf(S[0][0], S[0][1]), fmaxf(S[0][2], S[0][3]));
#pragma unroll
    for (int kt = 1; kt < 4; ++kt) tmax = fmaxf(tmax, fmaxf(fmaxf(S[kt][0], S[kt][1]), fmaxf(S[kt][2], S[kt][3])));
    tmax = fmaxf(tmax, __shfl_xor(tmax, 16)); tmax = xmax32(tmax);
    const float mnew = fmaxf(a.m, tmax), sc = fexp2(a.m - mnew); a.m = mnew;
    float ps = 0.f;
#pragma unroll
    for (int kt = 0; kt < 4; ++kt)
#pragma unroll
        for (int t = 0; t < 4; ++t) { const float p = fexp2(S[kt][t] - mnew); S[kt][t] = p; ps += p; }
    a.l = a.l * sc + ps;
#pragma unroll
    for (int dt = 0; dt < 4; ++dt) a.o[dt] *= sc;
    P[0] = pack44(S[0], S[1]); P[1] = pack44(S[2], S[3]);
}
__device__ __forceinline__ void sa_block_f32(FLAS unsigned char* Vt, int lane, const float* kb, const float* vb, int nk, const bf16x8 (&qf)[2], SAcc& a, const FLAS float* lut, int d0, int dmax, bool rowok) {
    const int fr = lane & 15, fq = lane >> 4, r = fr & 3;
    f32x4 kr[4][4];
#pragma unroll
    for (int kt = 0; kt < 4; ++kt) { const int kk = 32 * (kt >> 1) + 8 * (fr >> 2) + 4 * (kt & 1) + (fr & 3); const float* kp = kb + (size_t)kk * 512 + 8 * fq;
        kr[kt][0] = *(const f32x4*)kp; kr[kt][1] = *(const f32x4*)(kp + 4); kr[kt][2] = *(const f32x4*)(kp + 32); kr[kt][3] = *(const f32x4*)(kp + 36); }
    f32x4 vr[8][2]; const float* vp0 = vb + (size_t)(lane >> 3) * 512 + 8 * (lane & 7);
#pragma unroll
    for (int i = 0; i < 4; ++i) { const float* vp = vp0 + (size_t)i * 4096; vr[i][0] = *(const f32x4*)vp; vr[i][1] = *(const f32x4*)(vp + 4); }
    f32x4 S[4];
#pragma unroll
    for (int kt = 0; kt < 4; ++kt) { f32x4 acc = (f32x4){0.f, 0.f, 0.f, 0.f};
        acc = __builtin_amdgcn_mfma_f32_16x16x32_bf16(pack44(kr[kt][0], kr[kt][1]), qf[0], acc, 0, 0, 0); acc = __builtin_amdgcn_mfma_f32_16x16x32_bf16(pack44(kr[kt][2], kr[kt][3]), qf[1], acc, 0, 0, 0); S[kt] = acc; }
    asm volatile("" ::: "memory");
#pragma unroll
    for (int i = 4; i < 8; ++i) { const float* vp = vp0 + (size_t)i * 4096; vr[i][0] = *(const f32x4*)vp; vr[i][1] = *(const f32x4*)(vp + 4); }
#pragma unroll
    for (int kt = 0; kt < 4; ++kt)
#pragma unroll
        for (int t = 0; t < 4; ++t) { const int kk = 32 * (kt >> 1) + 8 * fq + 4 * (kt & 1) + t; const int d = d0 - kk; const bool valid = rowok && kk < nk && d >= 0 && d < dmax;
            const int dc = d < 0 ? 0 : (d > SDMAX ? SDMAX : d); const float v = S[kt][t] + lut[dc * 4 + r]; S[kt][t] = valid ? v : -INFINITY; }
    bf16x8 P[2]; sa_update(S, a, P);
#pragma unroll
    for (int i = 0; i < 8; ++i) { const int key = 8 * i + (lane >> 3); *(FLAS bf16x8*)(Vt + key * 144 + (lane & 7) * 16) = pack44(vr[i][0], vr[i][1]); }
    asm volatile("s_waitcnt lgkmcnt(0)" ::: "memory");
#pragma unroll
    for (int s2 = 0; s2 < 2; ++s2)
#pragma unroll
        for (int dt = 0; dt < 4; ++dt) { const FLAS unsigned char* p = Vt + (32 * s2 + 8 * fq + (fr >> 2)) * 144 + (16 * dt + 4 * (fr & 3)) * 2;
            const v4i16_t lo = __builtin_amdgcn_ds_read_tr16_b64_v4i16((FLAS v4i16_t*)p), hi = __builtin_amdgcn_ds_read_tr16_b64_v4i16((FLAS v4i16_t*)(p + 4 * 144));
            bf16x8 vf; vf[0] = lo[0]; vf[1] = lo[1]; vf[2] = lo[2]; vf[3] = lo[3]; vf[4] = hi[0]; vf[5] = hi[1]; vf[6] = hi[2]; vf[7] = hi[3];
            a.o[dt] = __builtin_amdgcn_mfma_f32_16x16x32_bf16(vf, P[s2], a.o[dt], 0, 0, 0); }
    asm volatile("s_waitcnt lgkmcnt(0)" ::: "memory");
}
__device__ __forceinline__ void attn_sample_unit(const Ctx& C, CArgs& A, int u) {
    unsigned char* fb = A.fb; const int lane = C.lane, tid = C.tid, w = C.wave, fr = lane & 15, fq = lane >> 4, q = fr >> 2, r = fr & 3; FLAS unsigned char* L = C.lds;
    const int b = u >> 2, g = u & 3;
    FLAS float* lut = (FLAS float*)(L + SM_LUT); FLAS float* Pc = (FLAS float*)(L + SM_P); FLAS float* ML = (FLAS float*)(L + SM_ML); FLAS float* FAC = (FLAS float*)(L + SM_FAC); FLAS float* SC = (FLAS float*)(L + SM_SC);
    FLAS unsigned* SELQ = (FLAS unsigned*)(L + SM_SELQ); FLAS unsigned* LIST = (FLAS unsigned*)(L + SM_LIST); FLAS unsigned* NIT = (FLAS unsigned*)(L + SM_NIT); FLAS unsigned char* Vt = L + SM_V + w * 9216;
    const float* table = IN_F(29); const int* pt = (const int*)A.in[8];
    __syncthreads();
    for (int i = tid; i < (SDMAX + 2) * 4; i += NTHR) lut[i] = table[rel_bucket(i >> 2) * 16 + g * 4 + (i & 3)] * LOG2E;
    bf16x8 qf[2];
    { const float* qp = (const float*)(fb + F_QPART) + ((size_t)b * 4 + q) * D + (g * 4 + r) * 64 + 8 * fq; const float qs = 0.125f * LOG2E;
#pragma unroll
      for (int k2 = 0; k2 < 2; ++k2) { f32x4 s0 = {0.f, 0.f, 0.f, 0.f}, s1 = s0;
#pragma unroll
          for (int ksl = 0; ksl < 8; ++ksl) { s0 += *(const f32x4*)(qp + (size_t)ksl * MS * D + 32 * k2); s1 += *(const f32x4*)(qp + (size_t)ksl * MS * D + 32 * k2 + 4); }
          qf[k2] = pack44(s0 * qs, s1 * qs); } }
    SAcc a0, a1; sa_init(a0); sa_init(a1);
    __syncthreads();
    const float* winK = IN_F(6) + ((size_t)b * 512 * 2) * 256 + g * 64;
    const float* winN = A.out + O_WINS + ((size_t)b * 512 + 508) * 512 + g * 64;
    if (w < 4) {
        const int cb = w; const bf16* ck = (const bf16*)(fb + F_CMPS) + (((size_t)b * 4 + g) * 256 + 64 * cb) * 64; const bf16* vt = (const bf16*)(fb + F_CMPS) + (size_t)DB * 4 * 256 * 64 + ((size_t)b * 4 + g) * 64 * 256 + 64 * cb;
        f32x4 S[4];
#pragma unroll
        for (int kt = 0; kt < 4; ++kt) { const int kk = 32 * (kt >> 1) + 8 * (fr >> 2) + 4 * (kt & 1) + (fr & 3); const bf16* kp = ck + kk * 64 + 8 * fq; f32x4 acc = (f32x4){0.f, 0.f, 0.f, 0.f};
            acc = __builtin_amdgcn_mfma_f32_16x16x32_bf16(*(const bf16x8*)kp, qf[0], acc, 0, 0, 0); acc = __builtin_amdgcn_mfma_f32_16x16x32_bf16(*(const bf16x8*)(kp + 32), qf[1], acc, 0, 0, 0); S[kt] = acc; }
        const int d0 = PAST + q - 31 - 32 * 64 * cb;
#pragma unroll
        for (int kt = 0; kt < 4; ++kt)
#pragma unroll
            for (int t = 0; t < 4; ++t) { const int kk = 32 * (kt >> 1) + 8 * fq + 4 * (kt & 1) + t; const int d = d0 - 32 * kk; S[kt][t] += lut[(d > SDMAX ? SDMAX : d) * 4 + r]; }
        bf16x8 P[2]; sa_update(S, a0, P);
#pragma unroll
        for (int kt = 0; kt < 4; ++kt) *(FLAS f32x4*)(Pc + fr * 256 + 64 * cb + 32 * (kt >> 1) + 8 * fq + 4 * (kt & 1)) = S[kt];
#pragma unroll
        for (int s2 = 0; s2 < 2; ++s2)
#pragma unroll
            for (int dt = 0; dt < 4; ++dt) a0.o[dt] = __builtin_amdgcn_mfma_f32_16x16x32_bf16(*(const bf16x8*)(vt + (size_t)(16 * dt + fr) * 256 + 32 * s2 + 8 * fq), P[s2], a0.o[dt], 0, 0, 0);
        float lr = a0.l; lr += __shfl_xor(lr, 16); lr += __shfl_xor(lr, 32);
        if (fq == 0) { ML[(w * 16 + fr) * 2] = a0.m; ML[(w * 16 + fr) * 2 + 1] = lr; }
    } else { const int wb = w - 4; sa_block_f32(Vt, lane, winK + (size_t)64 * wb * 512, winK + (size_t)64 * wb * 512 + 256, 64, qf, a0, lut, 512 + q - 64 * wb, 512, true); }
    __syncthreads();
    if (tid < 64) { const int row = tid >> 2, ww = tid & 3; float M = -1e30f;
#pragma unroll
        for (int x = 0; x < 4; ++x) M = fmaxf(M, ML[(x * 16 + row) * 2]);
        float Ls = 0.f;
#pragma unroll
        for (int x = 0; x < 4; ++x) Ls += ML[(x * 16 + row) * 2 + 1] * fexp2(ML[(x * 16 + row) * 2] - M);
        FAC[row * 4 + ww] = fexp2(ML[(ww * 16 + row) * 2] - M) / Ls; }
    __syncthreads();
    { const int qq = tid >> 7, j = tid & 127; float sv = 0.f;
#pragma unroll
      for (int rr = 0; rr < 4; ++rr) { const int row = qq * 4 + rr; const f32x2 pp = *(const FLAS f32x2*)(Pc + row * 256 + 2 * j); sv += (pp[0] + pp[1]) * FAC[row * 4 + (j >> 5)]; }
      SC[qq * 132 + j] = (j == 0 || j == 127) ? 1e4f : sv; }
    __syncthreads();
    { const int qq = w >> 1, j = 64 * (w & 1) + lane; const float sj = SC[qq * 132 + j]; int rank = 0;
#pragma unroll 4
      for (int i4 = 0; i4 < 32; ++i4) { const f32x4 sv = *(const FLAS f32x4*)(SC + qq * 132 + 4 * i4);
#pragma unroll
          for (int k = 0; k < 4; ++k) { const int i = 4 * i4 + k; rank += (sv[k] > sj || (sv[k] == sj && i < j)) ? 1 : 0; } }
      SELQ[qq * 132 + j] = rank < 15 ? 1u : 0u; }
    __syncthreads();
    if (w == 0) { unsigned base = 0;
        for (int c = 0; c < 3; ++c) { const int j = 64 * c + lane; unsigned msk = 0u;
            if (j < 128) msk = SELQ[j] | (SELQ[132 + j] << 1) | (SELQ[264 + j] << 2) | (SELQ[396 + j] << 3); else if (j == 128) msk = 0xFu;
            const unsigned long long ball = __ballot(msk != 0u); const unsigned pos = base + (unsigned)__builtin_popcountll(ball & ((1ull << lane) - 1ull));
            if (msk != 0u) LIST[pos] = (unsigned)j | (msk << 8);
            base += (unsigned)__builtin_popcountll(ball); }
        if (lane == 0) NIT[0] = base; }
    __syncthreads();
    const int nit = (int)NIT[0];
    if (w >= 4) {
        sa_block_f32(Vt, lane, winK + (size_t)64 * w * 512, winK + (size_t)64 * w * 512 + 256, 64, qf, a0, lut, 512 + q - 64 * w, 512, true);
        if (w == 4) sa_block_f32(Vt, lane, winN, winN + 256, 4, qf, a0, lut, q, 512, true); }
    { FLAS float* PO = (FLAS float*)(L + SM_PUB0); FLAS float* PM = (FLAS float*)(L + SM_PUBML);
#pragma unroll
      for (int dt = 0; dt < 4; ++dt) *(FLAS f32x4*)(PO + (w * 16 + fr) * 64 + 16 * dt + 4 * fq) = a0.o[dt];
      float l0 = a0.l; l0 += __shfl_xor(l0, 16); l0 += __shfl_xor(l0, 32);
      if (fq == 0) { PM[((w * 2 + 0) * 16 + fr) * 2] = a0.m; PM[((w * 2 + 0) * 16 + fr) * 2 + 1] = l0; } }
#pragma unroll 1
    for (int i = 0; i < nit; ++i) { const int p12 = i % 12; if ((p12 < 8 ? p12 : p12 - 8) != w) continue;
        const unsigned item = LIST[i]; const int j = (int)(item & 255u); const bool rowok = ((item >> (8 + q)) & 1u) != 0u;
        const float* kb; int nk;
        if (j < 128) { const int page = pt[b * NPAGES + (j >> 1)]; kb = IN_F(5) + (((size_t)page * PAGE + (j & 1) * 64) * 2) * 256 + g * 64; nk = 64; }
        else { kb = A.out + O_SELS + ((size_t)b * DS) * 512 + g * 64; nk = DS; }
        sa_block_f32(Vt, lane, kb, kb + 256, nk, qf, a1, lut, PAST + q - 64 * j, 1 << 30, rowok); }
    __syncthreads();
    { FLAS float* PO = (FLAS float*)(L + SM_V); FLAS float* PM = (FLAS float*)(L + SM_PUBML);
#pragma unroll
      for (int dt = 0; dt < 4; ++dt) *(FLAS f32x4*)(PO + (w * 16 + fr) * 64 + 16 * dt + 4 * fq) = a1.o[dt];
      float l1 = a1.l; l1 += __shfl_xor(l1, 16); l1 += __shfl_xor(l1, 32);
      if (fq == 0) { PM[((w * 2 + 1) * 16 + fr) * 2] = a1.m; PM[((w * 2 + 1) * 16 + fr) * 2 + 1] = l1; } }
    __syncthreads();
    { const FLAS float* PM = (const FLAS float*)(L + SM_PUBML);
      const int row = tid >> 5, dim = 2 * (tid & 31), qq = row >> 2, rr = row & 3; const size_t grow = (size_t)MP + b * DS + qq;
      const float* gt = (const float*)(fb + F_GT) + grow * 64 + (g * 4 + rr) * 3; float o0 = 0.f, o1 = 0.f;
#pragma unroll
      for (int br = 0; br < 3; ++br) {
          const int w0 = br == 2 ? 4 : 0, w1 = br == 0 ? 4 : 8, set = br == 1 ? 1 : 0; const FLAS float* PO = (const FLAS float*)(L + (br == 1 ? SM_V : SM_PUB0)); float M = -1e30f;
          for (int x = w0; x < w1; ++x) M = fmaxf(M, PM[((x * 2 + set) * 16 + row) * 2]);
          float Ls = 0.f, x0 = 0.f, x1 = 0.f;
          for (int x = w0; x < w1; ++x) { const float f = fexp2(PM[((x * 2 + set) * 16 + row) * 2] - M); Ls += PM[((x * 2 + set) * 16 + row) * 2 + 1] * f;
              const f32x2 ov = *(const FLAS f32x2*)(PO + (x * 16 + row) * 64 + dim); x0 += ov[0] * f; x1 += ov[1] * f; }
          const float gv = Ls > 0.f ? gt[br] / Ls : 0.f; o0 += gv * x0; o1 += gv * x1; }
      *(unsigned*)((bf16*)(fb + F_O) + grow * D + (g * 4 + rr) * 64 + dim) = pk2(o0, o1); }
}

__device__ __forceinline__ void phase_attn(const Ctx& C, CArgs& A, int l) {
    int prev_bg = -1;
    for (int u = C.wg; u < 1024; u += C.G) { const int i = u >> 8, wv = u & 255, bg = wv & 15, k = wv >> 4;
        const int qt = i == 0 ? 63 - k : (i == 1 ? (k == 7 ? 47 : (k == 15 ? 39 : 32 + k)) : (i == 2 ? (k <= 6 ? 14 - k : (k == 15 ? 7 : 31 - k)) : ((k >= 8 && k <= 14) ? 17 + k : (k == 7 ? 16 : k))));
        attn_prompt_unit(C, A, bg >> 2, bg & 3, qt, bg != prev_bg); prev_bg = bg; }
    __syncthreads();
#ifdef FK_TIMING
    unsigned long long* ts2 = (unsigned long long*)(A.fb + F_CTL + 65536 + 1024);
    if (C.wg == FK_TWG && C.tid == 0) ts2[0] = __builtin_amdgcn_s_memrealtime();
#endif
    { const int su = C.wg < 112 ? C.wg : (C.wg >= 240 ? 112 + (C.wg - 240) : -1); if (su >= 0 && su < DB * 4) attn_sample_unit(C, A, su); }
    __syncthreads();
#ifdef FK_TIMING
    if (C.wg == FK_TWG && C.tid == 0) ts2[1] = __builtin_amdgcn_s_memrealtime();
#endif
}
constexpr int NPHASE = 24;
#ifdef FK_TIMING
#define FK_TIMING_ON 1
#else
#define FK_TIMING_ON 0
#endif
__global__ void __launch_bounds__(NTHR, 2) mega(Args A_unused) {
    extern __shared__ __attribute__((aligned(16))) unsigned char lds_raw[];
    Ctx C; C.lds = (FLAS unsigned char*)lds_raw; C.tid = threadIdx.x; C.lane = C.tid & 63; C.wave = __builtin_amdgcn_readfirstlane(C.tid >> 6); C.G = gridDim.x; C.wg = blockIdx.x;
    C.gw = C.wg * NWAVE + C.wave; C.ngw = C.G * NWAVE;
    CArgs* Ap0 = (CArgs*)__builtin_amdgcn_kernarg_segment_ptr();
    unsigned char* fb = Ap0->fb;
    volatile FLAS unsigned* misc = (volatile FLAS unsigned*)(C.lds + LDS_MISC);
    if (C.tid < 8) misc[C.tid] = 0u;
    __syncthreads();
    const int lo = Ap0->lo, hi = Ap0->hi;
    const bool use_bar = (hi - lo) > 1;
    XcdBarrier bar; bar.bar = (unsigned*)(fb + F_CTL) + 1024; bar.x = 0; bar.st = nullptr;
    if (use_bar) bar = xcd_barrier_post((unsigned*)(fb + F_CTL) + 1024, misc);
    int pidx = 0;
#ifdef FK_TIMING
    unsigned long long* ts = (unsigned long long*)(fb + F_CTL + 65536);
    if (C.wg == 0 && C.tid == 0) ts[0] = __builtin_amdgcn_s_memrealtime();
#define TSTAMP() do { if (C.wg == 0 && threadIdx.x == 0) ts[pidx + 1] = __builtin_amdgcn_s_memrealtime(); } while (0)
#else
#define TSTAMP() do {} while (0)
#endif
#define PH_BEGIN if (lo <= pidx && pidx < hi) { C.tid = pg8::opaque_tid(); C.lane = C.tid & 63; { int wg_ = blockIdx.x, G_ = gridDim.x, wv_ = C.wave; asm volatile("" : "+s"(wg_), "+s"(G_), "+s"(wv_)); C.wg = wg_; C.G = G_; C.wave = wv_; C.gw = wg_ * NWAVE + wv_; C.ngw = G_ * NWAVE; } CArgs* Ap = (CArgs*)__builtin_amdgcn_kernarg_segment_ptr(); asm volatile("" : "+s"(Ap)); CArgs& A = *Ap; unsigned char* fb = A.fb; \
        bf16* XF = (bf16*)(fb + F_X); bf16* HF = (bf16*)(fb + F_H); const float* MODF = (const float*)(fb + F_MOD); \
        const float* mod0 = MODF + (size_t)(2 * l) * NC * 3072; const float* mod1 = MODF + (size_t)(2 * l + 1) * NC * 3072; (void)XF; (void)HF; (void)mod0; (void)mod1;
#define PH_END   if (pidx + 1 < hi || FK_TIMING_ON) xcd_barrier(bar); TSTAMP(); } ++pidx;
    { const int l = 0; PH_BEGIN phase_prologue(C, A); PH_END }

    for (int l = 0; l < 4; ++l) {
        if (l == 0) { PH_BEGIN phase_norm(C, A, 0, 0, true, -1, nullptr, false, C.gw, C.ngw, R); PH_END }
        if (l < 2) {
            PH_BEGIN {
                unsigned* flag = (unsigned*)(fb + F_CTL) + 32768 + 64 * (2 * l - 1);
                if (l > 0) { const Ctx Cn = refreshed(C); sample_norm_part(Cn, A, 0, 2 * l, 2 * l - 1, nullptr, false, flag); }
                C = refreshed(C);
                EpGLU e{(bf16*)(fb + F_U), (float*)(fb + F_US), IN_F(13) + (size_t)l * 2048, A.out + O_CONVP + (size_t)l * BATCH * 30 * D, A.out + O_CONVS + (size_t)l * DB * 30 * D};
                const bf16* W = (const bf16*)(fb + F_WPW1) + (size_t)l * 2048 * 1024;
                gemm_prompt(C, HF, W, 2048, 1024, e);
                C = refreshed(C);
                if (l > 0) sample_rows_ready(C, flag, (unsigned*)(fb + F_CTL) + 1024);
                gemm_sample(C, HF + (size_t)MP * D, W, 2048, 1024, e);
            } PH_END
            PH_BEGIN phase_conv(C, A, l); PH_END
            PH_BEGIN {
                EpResidNorm e{l == 0 ? IN_F(0) : nullptr, XF, mod0, IN_F(19) + (size_t)l * D, 0, mod1, nullptr, HF, nullptr, nullptr,
                              (float*)(fb + F_STATS) + (size_t)(2 * l) * 65536, (unsigned*)(fb + F_CTL) + 65536 + (2 * l) * 4096, (unsigned*)(fb + F_CTL) + 1024};
                const bf16* W = (const bf16*)(fb + F_WPW2) + (size_t)l * 1024 * 1024; const bf16* Ain = (const bf16*)(fb + F_C);
                gemm_prompt_fused(C, Ain, W, 1024, e);
                gemm_sample_ksplit(C, Ain + (size_t)MP * D, W, 1024, (float*)(fb + F_PART));
            } PH_END
        } else {
#ifdef FK_HAVE_ATTN
            PH_BEGIN phase_qkv(C, A, l); PH_END
            if (l == 2) { PH_BEGIN phase_prep(C, A); PH_END }
            PH_BEGIN phase_attn(C, A, l); PH_END
            PH_BEGIN {
                EpResidNorm e{nullptr, XF, mod0, nullptr, 0, mod1, nullptr, HF, nullptr, nullptr,
                              (float*)(fb + F_STATS) + (size_t)(2 * l) * 65536, (unsigned*)(fb + F_CTL) + 65536 + (2 * l) * 4096, (unsigned*)(fb + F_CTL) + 1024};
                const bf16* W = (const bf16*)(fb + F_WO) + (size_t)(l - 2) * 1024 * 1024; const bf16* Ain = (const bf16*)(fb + F_O);
                gemm_prompt_fused(C, Ain, W, 1024, e);
                gemm_sample_ksplit(C, Ain + (size_t)MP * D, W, 1024, (float*)(fb + F_PART));
            } PH_END
#endif
        }
        PH_BEGIN {
            unsigned* flag = (unsigned*)(fb + F_CTL) + 32768 + 64 * (2 * l);
            { const Ctx Cn = refreshed(C); sample_norm_part(Cn, A, 0, 2 * l + 1, 2 * l, l < 2 ? IN_F(19) + (size_t)l * D : nullptr, l == 0, flag); }
            C = refreshed(C);
            EpSwiGLU e{(bf16*)(fb + F_ACT)};
            const bf16* W = (const bf16*)(fb + F_WGU) + (size_t)l * 5632 * 1024;
            gemm_prompt(C, HF, W, 5632, 1024, e);
            C = refreshed(C);
            sample_rows_ready(C, flag, (unsigned*)(fb + F_CTL) + 1024);
            gemm_sample(C, HF + (size_t)MP * D, W, 5632, 1024, e);
        } PH_END
        PH_BEGIN {
            EpResidNorm e{nullptr, XF, mod1, nullptr, l == 3 ? 2 : (l == 1 ? 1 : 0), MODF + (size_t)(l < 3 ? 2 * l + 2 : 0) * NC * 3072, l == 3 ? IN_F(33) : IN_F(20), HF, (bf16*)(fb + F_HKV), A.out + O_YP,
                          (float*)(fb + F_STATS) + (size_t)(2 * l + 1) * 65536, (unsigned*)(fb + F_CTL) + 65536 + (2 * l + 1) * 4096, (unsigned*)(fb + F_CTL) + 1024};
            const bf16* W = (const bf16*)(fb + F_WDN) + (size_t)l * 1024 * 2816; const bf16* Ain = (const bf16*)(fb + F_ACT);
            gemm_prompt_fused(C, Ain, W, 2816, e);
            gemm_sample_ksplit(C, Ain + (size_t)MP * DFF, W, 2816, (float*)(fb + F_PART));
        } PH_END
    }
    { const int l = 0; PH_BEGIN phase_norm(C, A, 2, 0, false, 7, nullptr, false, MP + C.gw, C.ngw, R); PH_END }
#undef PH_BEGIN
#undef PH_END
}


#ifdef FK_TIMING
__global__ void k_encode(const unsigned long long* ts, float* out) {
    float t1 = 0.f, t2 = 0.f;
    for (int p = 0; p < 31; ++p) { const float us = (float)(ts[p + 1] - ts[p]) * 0.01f;
        if ((FK_M1 >> p) & 1ull) t1 += us; if ((FK_M2 >> p) & 1ull) t2 += us; }
#ifdef FK_TSPLIT
    { const unsigned long long* ts2 = ts + 128;
      if (FK_TSPLIT == 1) { t1 = (float)(ts2[0] - ts[25]) * 0.01f; t2 = (float)(ts2[1] - ts2[0]) * 0.01f; }
      if (FK_TSPLIT == 4) { t1 = (float)ts2[6] * 0.01f; t2 = (float)ts2[7] * 0.01f; } }
#endif
    const float sc = 1.f + sqrtf(t1 * 1e-5f);
    for (int i = threadIdx.x; i < MS * D; i += blockDim.x) out[O_YS + i] *= sc;
    if (threadIdx.x == 0) out[O_YP + 12345] += t2 * 1e-2f;
}
#endif
static int g_grid = 0;
static bool fast_setup() {
    if (g_grid) return g_grid > 0;
    int dev = 0, cus = 0;
    if (hipGetDevice(&dev) != hipSuccess || hipDeviceGetAttribute(&cus, hipDeviceAttributeMultiprocessorCount, dev) != hipSuccess) { g_grid = -1; return false; }
    if (hipFuncSetAttribute((const void*)mega, hipFuncAttributeMaxDynamicSharedMemorySize, LDS_BYTES) != hipSuccess) { g_grid = -1; return false; }
    int per_cu = 0; (void)hipOccupancyMaxActiveBlocksPerMultiprocessor(&per_cu, (const void*)mega, NTHR, LDS_BYTES); (void)hipGetLastError();
    if (per_cu < 1) fprintf(stderr, "fast_setup: occupancy query says %d blocks/CU\n", per_cu);
    g_grid = cus;
    return true;
}
static void fast_launch(void* const* d_in, float* out, unsigned char* fb, int lo, int hi, hipStream_t st) {
    if (!fast_setup()) return;
    Args a{}; for (int i = 0; i < 34; ++i) a.in[i] = d_in[i]; a.out = out; a.fb = fb; a.lo = lo; a.hi = hi;
    hipLaunchKernelGGL(mega, dim3(g_grid), dim3(NTHR), LDS_BYTES, st, a);
}
}
extern "C" void kernel_launch(void* const* d_in, const int* in_sizes, int n_in, void* d_out, int out_size, void* d_ws, size_t ws_size, hipStream_t stream) {
    if (ws_size < fk::F_END) { fprintf(stderr, "ws too small: %zu < %zu\n", ws_size, (size_t)fk::F_END); return; }
    unsigned char* fb = (unsigned char*)d_ws;
    (void)hipMemsetAsync(fb + fk::F_CTL, 0, fk::CTL_BYTES, stream);
#if FK_NLAUNCH == 1
    fk::fast_launch(d_in, (float*)d_out, fb, 0, fk::NPHASE, stream);
#ifdef FK_TIMING
    fk::k_encode<<<1, 256, 0, stream>>>((const unsigned long long*)(fb + fk::F_CTL + 65536), (float*)d_out);
#endif
#else
    for (int p = 0; p < fk::NPHASE; ++p) fk::fast_launch(d_in, (float*)d_out, fb, p, p + 1, stream);
#endif
}
```

```cpp
#define FK_NLAUNCH 1
#include <math.h>
#include <hip/hip_runtime.h>
#include <stdint.h>
#include <stdio.h>

namespace nv {
constexpr int D = 1024, BATCH = 4, SEQ = 4096, DB = 32, DS = 4, PAST = 8192, PAGE = 128, NPAGES = 64;
constexpr int KVH = 4, GROUP = 4, HD = 64, CONVW = 31, DFF = 2816, PHI = 128, QGW = 1072, KVW = 1536;
constexpr int MP = BATCH * SEQ, MS = DB * DS, R = MP + MS, NC = 36;
constexpr float EPS = 1e-6f;

constexpr size_t O_YP = 0, O_YS = O_YP + (size_t)MP * D, O_CMPP = O_YS + (size_t)MS * D, O_CMPS = O_CMPP + (size_t)MP * 512,
                 O_SELP = O_CMPS + (size_t)MS * 512, O_SELS = O_SELP + (size_t)MP * 512, O_WINP = O_SELS + (size_t)MS * 512,
                 O_WINS = O_WINP + (size_t)BATCH * 512 * 512, O_CONVP = O_WINS + (size_t)DB * 512 * 512,
                 O_CONVS = O_CONVP + (size_t)2 * BATCH * 30 * D, O_END = O_CONVS + (size_t)2 * DB * 30 * D;

__device__ __forceinline__ float silu(float x) { return x / (1.f + expf(-x)); }
__device__ __forceinline__ float sigm(float x) { return 1.f / (1.f + expf(-x)); }
__device__ __forceinline__ int cidx_of(int row) { return row < MP ? row / SEQ : 4 + (row - MP) / DS; }
__device__ __forceinline__ int rel_bucket(int n) {
    if (n < 0) n = 0;
    if (n < 16) return n;
    int b = 16;
    b += (n >= 21); b += (n >= 27); b += (n >= 35); b += (n >= 46); b += (n >= 59); b += (n >= 77); b += (n >= 99); b += (n >= 128);
    b += (n >= 166); b += (n >= 216); b += (n >= 280); b += (n >= 363); b += (n >= 470); b += (n >= 609); b += (n >= 790);
    return b;
}

__global__ __launch_bounds__(256) void k_gemm(const float* __restrict__ A, int lda, const float* __restrict__ W, int ldw, const float* __restrict__ bias,
                                              float* __restrict__ C, int ldc, int M, int N, int K) {
    __shared__ float As[16][68];
    __shared__ float Ws[16][68];
    const int tid = threadIdx.x, tx = tid & 15, ty = tid >> 4;
    const int m0 = blockIdx.y * 64, n0 = blockIdx.x * 64;
    float acc[4][4];
#pragma unroll
    for (int i = 0; i < 4; ++i)
#pragma unroll
        for (int j = 0; j < 4; ++j) acc[i][j] = 0.f;
    for (int k0 = 0; k0 < K; k0 += 16) {
#pragma unroll
        for (int it = 0; it < 4; ++it) { const int i = tid + it * 256; const int m = i >> 4, k = i & 15; const int gm = m0 + m; As[k][m] = gm < M ? A[(size_t)gm * lda + k0 + k] : 0.f; }
#pragma unroll
        for (int it = 0; it < 4; ++it) { const int i = tid + it * 256; const int k = i >> 6, n = i & 63; const int gn = n0 + n; Ws[k][n] = gn < N ? W[(size_t)(k0 + k) * ldw + gn] : 0.f; }
        __syncthreads();
#pragma unroll
        for (int k = 0; k < 16; ++k) {
            const float4 a = *(const float4*)&As[k][ty * 4]; const float4 b = *(const float4*)&Ws[k][tx * 4];
            const float av[4] = {a.x, a.y, a.z, a.w}, bv[4] = {b.x, b.y, b.z, b.w};
#pragma unroll
            for (int i = 0; i < 4; ++i)
#pragma unroll
                for (int j = 0; j < 4; ++j) acc[i][j] += av[i] * bv[j];
        }
        __syncthreads();
    }
#pragma unroll
    for (int i = 0; i < 4; ++i) { const int gm = m0 + ty * 4 + i; if (gm >= M) continue;
#pragma unroll
        for (int j = 0; j < 4; ++j) { const int gn = n0 + tx * 4 + j; if (gn < N) C[(size_t)gm * ldc + gn] = acc[i][j] + (bias ? bias[gn] : 0.f); } }
}

__global__ void k_silu_c(const float* cp, const float* cs, float* SC) {
    const int i = blockIdx.x * blockDim.x + threadIdx.x; if (i >= NC * D) return;
    const int r = i / D, k = i % D; const float v = r < 4 ? cp[r * D + k] : cs[(r - 4) * D + k]; SC[i] = silu(v);
}

__device__ __forceinline__ float block_sum256(float v, float* red) {
#pragma unroll
    for (int o = 32; o >= 1; o >>= 1) v += __shfl_xor(v, o);
    __syncthreads();
    if ((threadIdx.x & 63) == 0) red[threadIdx.x >> 6] = v;
    __syncthreads();
    return red[0] + red[1] + red[2] + red[3];
}
__global__ __launch_bounds__(256) void k_modnorm(const float* __restrict__ X, const float* __restrict__ g, const float* __restrict__ mod, float* __restrict__ H) {
    __shared__ float red[4];
    const int row = blockIdx.x, t = threadIdx.x; const float4 x = ((const float4*)(X + (size_t)row * D))[t];
    const float ss = block_sum256(x.x * x.x + x.y * x.y + x.z * x.z + x.w * x.w, red);
    const float rstd = (1.0f / sqrtf(ss * (1.f / D) + EPS));
    const float4 gv = ((const float4*)g)[t]; float4 y = {x.x * rstd * gv.x, x.y * rstd * gv.y, x.z * rstd * gv.z, x.w * rstd * gv.w};
    if (mod) { const float* m = mod + (size_t)cidx_of(row) * 3072; const float4 sh = ((const float4*)m)[t], sc = ((const float4*)(m + D))[t];
        y.x = y.x * (1.f + sc.x) + sh.x; y.y = y.y * (1.f + sc.y) + sh.y; y.z = y.z * (1.f + sc.z) + sh.z; y.w = y.w * (1.f + sc.w) + sh.w; }
    ((float4*)(H + (size_t)row * D))[t] = y;
}
__global__ void k_glu(const float* __restrict__ T1, float* __restrict__ U) {
    const size_t i = (size_t)blockIdx.x * blockDim.x + threadIdx.x; if (i >= (size_t)R * D) return;
    const size_t r = i / D; const int c = (int)(i % D); const float a = T1[r * 2048 + c], gg = T1[r * 2048 + D + c]; U[i] = a * sigm(gg);
}
__global__ void k_conv(const float* __restrict__ U, const float* __restrict__ state  , const float* __restrict__ wdw  , const float* __restrict__ bdw,
                       float* __restrict__ Y) {
    const size_t i = (size_t)blockIdx.x * blockDim.x + threadIdx.x; if (i >= (size_t)R * D) return;
    const int row = (int)(i / D), c = (int)(i % D); float acc = bdw[c];
    if (row < MP) { const int b = row / SEQ, t = row % SEQ;
        for (int k = 0; k < CONVW; ++k) { const int tt = t - 30 + k; if (tt >= 0) acc += wdw[k * D + c] * U[((size_t)b * SEQ + tt) * D + c]; }
    } else { const int rs = row - MP, b = rs / DS, t = rs % DS;
        for (int k = 0; k < CONVW; ++k) { const int j = t + k; const float v = j < 30 ? state[((size_t)b * 30 + j) * D + c] : U[((size_t)MP + b * DS + (j - 30)) * D + c]; acc += wdw[k * D + c] * v; }
    }
    Y[i] = acc;
}
__global__ void k_conv_state_out(const float* __restrict__ U, const float* __restrict__ state, float* __restrict__ outp  , float* __restrict__ outs  ) {
    const int i = blockIdx.x * blockDim.x + threadIdx.x; const int NPo = BATCH * 30 * D, NSo = DB * 30 * D;
    if (i < NPo) { const int b = i / (30 * D), j = (i / D) % 30, c = i % D; outp[i] = U[((size_t)b * SEQ + SEQ - 30 + j) * D + c]; }
    else if (i < NPo + NSo) { const int ii = i - NPo; const int b = ii / (30 * D), j = (ii / D) % 30, c = ii % D;
        outs[ii] = j < 26 ? state[((size_t)b * 30 + j + 4) * D + c] : U[((size_t)MP + b * DS + (j - 26)) * D + c]; }
}
__global__ __launch_bounds__(256) void k_ln_silu(const float* __restrict__ Y, const float* __restrict__ g, const float* __restrict__ bb, float* __restrict__ Cc) {
    __shared__ float red[4];
    const int row = blockIdx.x, t = threadIdx.x; const float4 x = ((const float4*)(Y + (size_t)row * D))[t];
    const float mu = block_sum256(x.x + x.y + x.z + x.w, red) * (1.f / D);
    const float4 d = {x.x - mu, x.y - mu, x.z - mu, x.w - mu};
    const float var = block_sum256(d.x * d.x + d.y * d.y + d.z * d.z + d.w * d.w, red) * (1.f / D);
    const float rstd = (1.0f / sqrtf(var + EPS)); const float4 gv = ((const float4*)g)[t], bv = ((const float4*)bb)[t];
    float4 y = {silu(d.x * rstd * gv.x + bv.x), silu(d.y * rstd * gv.y + bv.y), silu(d.z * rstd * gv.z + bv.z), silu(d.w * rstd * gv.w + bv.w)};
    ((float4*)(Cc + (size_t)row * D))[t] = y;
}
__global__ void k_resid(float* __restrict__ X, const float* __restrict__ T, int ldt, const float* __restrict__ mod) {
    const size_t i = (size_t)blockIdx.x * blockDim.x + threadIdx.x; if (i >= (size_t)R * D) return;
    const int row = (int)(i / D), c = (int)(i % D); X[i] += mod[(size_t)cidx_of(row) * 3072 + 2048 + c] * T[(size_t)row * ldt + c];
}
__global__ void k_swiglu(const float* __restrict__ G, const float* __restrict__ UP, float* __restrict__ ACT) {
    const size_t i = (size_t)blockIdx.x * blockDim.x + threadIdx.x; if (i >= (size_t)R * DFF) return; ACT[i] = silu(G[i]) * UP[i];
}
__global__ void k_kv_out(const float* __restrict__ ROWS, const float* __restrict__ cache_win, float* __restrict__ out) {
    const size_t i = (size_t)blockIdx.x * blockDim.x + threadIdx.x;
    const size_t n1 = (size_t)MP * 512, n2 = (size_t)MS * 512, n3 = (size_t)BATCH * 512 * 512, n4 = (size_t)DB * 512 * 512;
    if (i < n1) { const size_t r = i / 512, c = i % 512; out[O_CMPP + i] = ROWS[r * KVW + c]; out[O_SELP + i] = ROWS[r * KVW + 512 + c]; }
    if (i < n2) { const size_t r = i / 512, c = i % 512; out[O_CMPS + i] = ROWS[(MP + r) * KVW + c]; out[O_SELS + i] = ROWS[(MP + r) * KVW + 512 + c]; }
    if (i < n3) { const size_t b = i / (512 * 512), j = (i / 512) % 512, c = i % 512; out[O_WINP + i] = ROWS[(b * SEQ + SEQ - 512 + j) * KVW + 1024 + c]; }
    if (i < n4) { const size_t b = i / (512 * 512), j = (i / 512) % 512, c = i % 512;
        out[O_WINS + i] = j < 508 ? cache_win[(b * 512 + j + 4) * 512 + c] : ROWS[(MP + b * DS + (j - 508)) * KVW + 1024 + c]; }
}
__global__ __launch_bounds__(256) void k_compress(int is_prompt, const float* __restrict__ ROWS, const float* __restrict__ cache, const int* __restrict__ pt,
                                                   const float* __restrict__ w1, const float* __restrict__ b1, const float* __restrict__ w2, const float* __restrict__ b2,
                                                   const float* __restrict__ pe, float* __restrict__ CMP) {
    __shared__ float blk[32 * 4 * 64];
    __shared__ float hid[4][PHI];
    const int NB = is_prompt ? 128 : 256, BB = is_prompt ? BATCH : DB;
    const int e = blockIdx.x & 1, n = (blockIdx.x >> 1) % NB, b = (blockIdx.x >> 1) / NB, tid = threadIdx.x;
    for (int i = tid; i < 32 * 256; i += 256) { const int t = i >> 8, gd = i & 255; float v;
        if (is_prompt) v = ROWS[((size_t)b * SEQ + n * 32 + t) * KVW + e * 256 + gd];
        else { const int page = pt[b * NPAGES + (n >> 2)]; v = cache[(((size_t)page * PAGE + (n & 3) * 32 + t) * 2 + e) * 256 + gd]; }
        blk[i] = v + pe[(e * 32 + t) * 64 + (gd & 63)]; }
    __syncthreads();
    const int h = tid & 127, gp = tid >> 7; float a0 = 0.f, a1 = 0.f; const float* w = w1 + (size_t)e * 2048 * PHI + h;
    for (int f = 0; f < 2048; ++f) { const int t = f >> 6, d = f & 63; const float wv = w[(size_t)f * PHI]; a0 += blk[(t * 4 + gp * 2) * 64 + d] * wv; a1 += blk[(t * 4 + gp * 2 + 1) * 64 + d] * wv; }
    hid[gp * 2][h] = silu(a0 + b1[e * PHI + h]); hid[gp * 2 + 1][h] = silu(a1 + b1[e * PHI + h]);
    __syncthreads();
    const int g = tid >> 6, d = tid & 63; float o = b2[e * 64 + d];
    for (int hh = 0; hh < PHI; ++hh) o += hid[g][hh] * w2[((size_t)e * PHI + hh) * 64 + d];
    CMP[((((size_t)e * BB + b) * NB + n) * 4 + g) * 64 + d] = o;
}

struct AttnP {
    const float* QG;
    const float* ROWS;
    const float* CMP;
    const float* cache_sel; const float* cache_win; const int* pt; const float* table;
    float* O;
};
__device__ __forceinline__ const float* kv_ptr_sel(const AttnP& P, int is_prompt, int b, int g, int e, int pos) {
    if (is_prompt) return P.ROWS + ((size_t)b * SEQ + pos) * KVW + 512 + e * 256 + g * 64;
    if (pos < PAST) { const int page = P.pt[b * NPAGES + pos / PAGE]; return P.cache_sel + (((size_t)page * PAGE + pos % PAGE) * 2 + e) * 256 + g * 64; }
    return P.ROWS + ((size_t)MP + b * DS + (pos - PAST)) * KVW + 512 + e * 256 + g * 64;
}
__device__ __forceinline__ const float* kv_ptr_win(const AttnP& P, int is_prompt, int b, int g, int e, int pos) {
    if (is_prompt) return P.ROWS + ((size_t)b * SEQ + pos) * KVW + 1024 + e * 256 + g * 64;
    const int i = pos - (PAST + DS - 516);
    if (i < 512) return P.cache_win + (((size_t)b * 512 + i) * 2 + e) * 256 + g * 64;
    return P.ROWS + ((size_t)MP + b * DS + (i - 512)) * KVW + 1024 + e * 256 + g * 64;
}
__device__ __forceinline__ float wave_max(float v) {
#pragma unroll
    for (int o = 32; o >= 1; o >>= 1) v = fmaxf(v, __shfl_xor(v, o)); return v; }
__device__ __forceinline__ float wave_sum(float v) {
#pragma unroll
    for (int o = 32; o >= 1; o >>= 1) v += __shfl_xor(v, o); return v; }

constexpr int SBW = 1088;
__global__ __launch_bounds__(64) void k_attn(AttnP P, int is_prompt) {
    __shared__ float qs[4][64];
    __shared__ float sb[4][SBW];
    __shared__ float impb[192];
    __shared__ float scoreb[192];
    __shared__ int selb[16];
    const int lane = threadIdx.x; const int T = is_prompt ? SEQ : DS;
    const int g = blockIdx.x & 3, q = (blockIdx.x >> 2) % T, b = (blockIdx.x >> 2) / T;
    const int qpos = is_prompt ? q : PAST + q; const int row = is_prompt ? b * SEQ + q : MP + b * DS + q;
    const int NCMP = is_prompt ? 128 : 256, NBLK = is_prompt ? 64 : 129, BB = is_prompt ? BATCH : DB;
    const float NEGM = -3.0e38f;
#pragma unroll
    for (int r = 0; r < 4; ++r) qs[r][lane] = P.QG[(size_t)row * QGW + (g * 4 + r) * 64 + lane] * 0.125f;
    float gate[4][3];
#pragma unroll
    for (int r = 0; r < 4; ++r)
#pragma unroll
        for (int br = 0; br < 3; ++br) gate[r][br] = sigm(P.QG[(size_t)row * QGW + 1024 + (g * 4 + r) * 3 + br]);
    __syncthreads();
    float out[4] = {0.f, 0.f, 0.f, 0.f};
    {
        const float* CK = P.CMP + ((size_t)0 * BB + b) * NCMP * 256; const float* CV = P.CMP + ((size_t)1 * BB + b) * NCMP * 256;
        float mx[4] = {NEGM, NEGM, NEGM, NEGM};
        for (int n = lane; n < NCMP; n += 64) { const int endp = n * 32 + 31; const bool valid = endp <= qpos; const float* k = CK + ((size_t)n * 4 + g) * 64;
            float s[4] = {0.f, 0.f, 0.f, 0.f};
            for (int d = 0; d < 64; ++d) { const float kv = k[d]; s[0] += qs[0][d] * kv; s[1] += qs[1][d] * kv; s[2] += qs[2][d] * kv; s[3] += qs[3][d] * kv; }
            const int bk = rel_bucket(qpos - endp);
#pragma unroll
            for (int r = 0; r < 4; ++r) { const float v = valid ? s[r] + P.table[bk * 16 + g * 4 + r] : NEGM; sb[r][n] = v; mx[r] = fmaxf(mx[r], v); } }
        float sm[4];
#pragma unroll
        for (int r = 0; r < 4; ++r) { mx[r] = wave_max(mx[r]); float a = 0.f;
            for (int n = lane; n < NCMP; n += 64) { const float v = sb[r][n]; const float p = v > -1e38f ? expf(v - mx[r]) : 0.f; sb[r][n] = p; a += p; }
            sm[r] = wave_sum(a); }
        __syncthreads();
#pragma unroll
        for (int r = 0; r < 4; ++r) { const float inv = sm[r] > 0.f ? 1.f / sm[r] : 0.f; for (int n = lane; n < NCMP; n += 64) sb[r][n] *= inv; }
        __syncthreads();
        float oc[4] = {0.f, 0.f, 0.f, 0.f};
        for (int n = 0; n < NCMP; ++n) { const float v = CV[((size_t)n * 4 + g) * 64 + lane]; oc[0] += sb[0][n] * v; oc[1] += sb[1][n] * v; oc[2] += sb[2][n] * v; oc[3] += sb[3][n] * v; }
#pragma unroll
        for (int r = 0; r < 4; ++r) out[r] += gate[r][0] * oc[r];
        for (int j = lane; j < NBLK; j += 64) { float a = 0.f, c = 0.f;
            if (2 * j < NCMP) a = ((sb[0][2 * j] + sb[1][2 * j]) + sb[2][2 * j]) + sb[3][2 * j];
            if (2 * j + 1 < NCMP) c = ((sb[0][2 * j + 1] + sb[1][2 * j + 1]) + sb[2][2 * j + 1]) + sb[3][2 * j + 1];
            float nz = 1.f;
#ifdef IMP_NOISE
            { unsigned hsh = (unsigned)(j * 2654435761u) ^ (unsigned)(blockIdx.x * 40503u + 12345u); hsh ^= hsh >> 15; hsh *= 2246822519u; hsh ^= hsh >> 13; hsh *= 3266489917u; hsh ^= hsh >> 16;
              nz = 1.f + IMP_NOISE * ((float)(hsh & 0xffff) * (2.f / 65535.f) - 1.f); }
#endif
            impb[j] = (a + c) * nz; }
        __syncthreads();
    }
    const int jq = qpos / 64;
    for (int j = lane; j < NBLK; j += 64) { const bool forced = (j == 0) || (j == jq) || (j == jq - 1); scoreb[j] = j <= jq ? (forced ? 1e4f : impb[j]) : -1.f; }
    if (lane < 16) selb[lane] = -1;
    __syncthreads();
    for (int j = lane; j < NBLK; j += 64) { const float sj = scoreb[j]; int rank = 0;
        for (int i = 0; i < NBLK; ++i) { const float si = scoreb[i]; rank += (si > sj || (si == sj && i < j)) ? 1 : 0; }
        if (rank < 16 && sj >= 0.f) selb[rank] = j; }
    __syncthreads();
    {
        float mx[4] = {NEGM, NEGM, NEGM, NEGM};
        for (int sl = 0; sl < 16; ++sl) { const int j = selb[sl]; const int kpos = j * 64 + lane; const bool valid = (j >= 0) && (kpos <= qpos);
            float s[4] = {0.f, 0.f, 0.f, 0.f};
            if (valid) { const float* k = kv_ptr_sel(P, is_prompt, b, g, 0, kpos);
                for (int d = 0; d < 64; ++d) { const float kv = k[d]; s[0] += qs[0][d] * kv; s[1] += qs[1][d] * kv; s[2] += qs[2][d] * kv; s[3] += qs[3][d] * kv; } }
            const int bk = rel_bucket(qpos - kpos);
#pragma unroll
            for (int r = 0; r < 4; ++r) { const float v = valid ? s[r] + P.table[bk * 16 + g * 4 + r] : NEGM; sb[r][sl * 64 + lane] = v; mx[r] = fmaxf(mx[r], v); } }
        float sm[4];
#pragma unroll
        for (int r = 0; r < 4; ++r) { mx[r] = wave_max(mx[r]); float a = 0.f;
            for (int n = lane; n < 1024; n += 64) { const float v = sb[r][n]; const float p = v > -1e38f ? expf(v - mx[r]) : 0.f; sb[r][n] = p; a += p; }
            sm[r] = wave_sum(a); }
        __syncthreads();
        float os[4] = {0.f, 0.f, 0.f, 0.f};
        for (int sl = 0; sl < 16; ++sl) { const int j = selb[sl]; if (j < 0) continue;
            for (int kk = 0; kk < 64; ++kk) { const int kpos = j * 64 + kk; if (kpos > qpos) break;
                const float v = kv_ptr_sel(P, is_prompt, b, g, 1, kpos)[lane]; const int n = sl * 64 + kk;
                os[0] += sb[0][n] * v; os[1] += sb[1][n] * v; os[2] += sb[2][n] * v; os[3] += sb[3][n] * v; } }
#pragma unroll
        for (int r = 0; r < 4; ++r) out[r] += gate[r][1] * (sm[r] > 0.f ? os[r] / sm[r] : 0.f);
        __syncthreads();
    }
    {
        float mx[4] = {NEGM, NEGM, NEGM, NEGM};
        for (int i = lane; i < 512; i += 64) { const int kpos = qpos - 511 + i; const bool valid = kpos >= 0 && (is_prompt || kpos >= PAST + DS - 516);
            float s[4] = {0.f, 0.f, 0.f, 0.f};
            if (valid) { const float* k = kv_ptr_win(P, is_prompt, b, g, 0, kpos);
                for (int d = 0; d < 64; ++d) { const float kv = k[d]; s[0] += qs[0][d] * kv; s[1] += qs[1][d] * kv; s[2] += qs[2][d] * kv; s[3] += qs[3][d] * kv; } }
            const int bk = rel_bucket(qpos - kpos);
#pragma unroll
            for (int r = 0; r < 4; ++r) { const float v = valid ? s[r] + P.table[bk * 16 + g * 4 + r] : NEGM; sb[r][i] = v; mx[r] = fmaxf(mx[r], v); } }
        float sm[4];
#pragma unroll
        for (int r = 0; r < 4; ++r) { mx[r] = wave_max(mx[r]); float a = 0.f;
            for (int n = lane; n < 512; n += 64) { const float v = sb[r][n]; const float p = v > -1e38f ? expf(v - mx[r]) : 0.f; sb[r][n] = p; a += p; }
            sm[r] = wave_sum(a); }
        __syncthreads();
        float ow[4] = {0.f, 0.f, 0.f, 0.f};
        for (int i = 0; i < 512; ++i) { const int kpos = qpos - 511 + i; if (kpos < 0 || (!is_prompt && kpos < PAST + DS - 516)) continue;
            const float v = kv_ptr_win(P, is_prompt, b, g, 1, kpos)[lane];
            ow[0] += sb[0][i] * v; ow[1] += sb[1][i] * v; ow[2] += sb[2][i] * v; ow[3] += sb[3][i] * v; }
#pragma unroll
        for (int r = 0; r < 4; ++r) out[r] += gate[r][2] * (sm[r] > 0.f ? ow[r] / sm[r] : 0.f);
    }
#pragma unroll
    for (int r = 0; r < 4; ++r) P.O[(size_t)row * D + (g * 4 + r) * 64 + lane] = out[r];
}

constexpr size_t W_SC = 0, W_MOD = W_SC + (size_t)NC * D, W_X = W_MOD + (size_t)8 * NC * 3072, W_H = W_X + (size_t)R * D, W_T1 = W_H + (size_t)R * D,
                 W_T2 = W_T1 + (size_t)R * DFF, W_U = W_T2 + (size_t)R * DFF, W_Y = W_U + (size_t)R * D, W_CC = W_Y + (size_t)R * D, W_ACT = W_CC + (size_t)R * D,
                 W_ROWS = W_ACT + (size_t)R * DFF, W_QG = W_ROWS + (size_t)R * KVW, W_O = W_QG + (size_t)R * QGW, W_CMPP = W_O + (size_t)R * D,
                 W_CMPS = W_CMPP + (size_t)2 * BATCH * 128 * 256, W_END = W_CMPS + (size_t)2 * DB * 256 * 256;

static inline void gemm(hipStream_t st, const float* A, int lda, const float* W, int ldw, const float* bias, float* C, int ldc, int M, int N, int K) {
    dim3 grid((N + 63) / 64, (M + 63) / 64); k_gemm<<<grid, 256, 0, st>>>(A, lda, W, ldw, bias, C, ldc, M, N, K);
}
static inline unsigned cdiv(size_t a, size_t b) { return (unsigned)((a + b - 1) / b); }

typedef void (*Hook)(int id, void* ctx);
static void naive_forward(void* const* d_in, float* out, float* ws, hipStream_t st, Hook hook = nullptr, void* hctx = nullptr) {
#define HOOK(id) do { if (hook) hook((id), hctx); } while (0)
    const float* x_prompt = (const float*)d_in[0]; const float* x_sample = (const float*)d_in[1]; const float* c_prompt = (const float*)d_in[2]; const float* c_sample = (const float*)d_in[3];
    const float* cache_cmp = (const float*)d_in[4]; const float* cache_sel = (const float*)d_in[5]; const float* cache_win = (const float*)d_in[6]; const float* state_conv = (const float*)d_in[7];
    const int* pt = (const int*)d_in[8]; const float* w_ada = (const float*)d_in[9]; const float* b_ada = (const float*)d_in[10]; const float* norm_g = (const float*)d_in[11];
    const float* w_pw1 = (const float*)d_in[12]; const float* b_pw1 = (const float*)d_in[13]; const float* w_dw = (const float*)d_in[14]; const float* b_dw = (const float*)d_in[15];
    const float* ln_g = (const float*)d_in[16]; const float* ln_b = (const float*)d_in[17]; const float* w_pw2 = (const float*)d_in[18]; const float* b_pw2 = (const float*)d_in[19];
    const float* g_kv = (const float*)d_in[20]; const float* w_kv = (const float*)d_in[21]; const float* w_phi1 = (const float*)d_in[22]; const float* b_phi1 = (const float*)d_in[23];
    const float* w_phi2 = (const float*)d_in[24]; const float* b_phi2 = (const float*)d_in[25]; const float* pe_cmp = (const float*)d_in[26]; const float* w_qg = (const float*)d_in[27];
    const float* w_o = (const float*)d_in[28]; const float* rel_table = (const float*)d_in[29]; const float* w_gate = (const float*)d_in[30]; const float* w_up = (const float*)d_in[31];
    const float* w_down = (const float*)d_in[32]; const float* final_g = (const float*)d_in[33];
    float *SC = ws + W_SC, *MOD = ws + W_MOD, *X = ws + W_X, *H = ws + W_H, *T1 = ws + W_T1, *T2 = ws + W_T2, *U = ws + W_U, *Y = ws + W_Y, *CC = ws + W_CC, *ACT = ws + W_ACT,
          *ROWS = ws + W_ROWS, *QG = ws + W_QG, *O = ws + W_O, *CMPP = ws + W_CMPP, *CMPS = ws + W_CMPS;
    const size_t RD = (size_t)R * D;
    hipMemcpyAsync(X, x_prompt, (size_t)MP * D * 4, hipMemcpyDeviceToDevice, st);
    hipMemcpyAsync(X + (size_t)MP * D, x_sample, (size_t)MS * D * 4, hipMemcpyDeviceToDevice, st);
    k_silu_c<<<cdiv(NC * D, 256), 256, 0, st>>>(c_prompt, c_sample, SC);
    for (int ls = 0; ls < 8; ++ls) gemm(st, SC, D, w_ada + (size_t)ls * D * 3072, 3072, b_ada + (size_t)ls * 3072, MOD + (size_t)ls * NC * 3072, 3072, NC, 3072, D);
    HOOK(1);
    for (int l = 0; l < 4; ++l) {
        const float* mod0 = MOD + (size_t)(l * 2 + 0) * NC * 3072; const float* mod1 = MOD + (size_t)(l * 2 + 1) * NC * 3072;
        if (l == 2) {
            k_modnorm<<<R, 256, 0, st>>>(X, g_kv, nullptr, H);
            gemm(st, H, D, w_kv, KVW, nullptr, ROWS, KVW, R, KVW, D);
            k_kv_out<<<cdiv((size_t)MP * 512, 256), 256, 0, st>>>(ROWS, cache_win, out);
            k_compress<<<BATCH * 128 * 2, 256, 0, st>>>(1, ROWS, cache_cmp, pt, w_phi1, b_phi1, w_phi2, b_phi2, pe_cmp, CMPP);
            k_compress<<<DB * 256 * 2, 256, 0, st>>>(0, ROWS, cache_cmp, pt, w_phi1, b_phi1, w_phi2, b_phi2, pe_cmp, CMPS);
            HOOK(250);
        }
        k_modnorm<<<R, 256, 0, st>>>(X, norm_g + (size_t)(l * 2) * D, mod0, H);
        HOOK(100 * l + 1);
        if (l < 2) {
            gemm(st, H, D, w_pw1 + (size_t)l * D * 2048, 2048, b_pw1 + (size_t)l * 2048, T1, 2048, R, 2048, D);
            k_glu<<<cdiv(RD, 256), 256, 0, st>>>(T1, U);
            HOOK(100 * l + 2);
            k_conv<<<cdiv(RD, 256), 256, 0, st>>>(U, state_conv + (size_t)l * DB * 30 * D, w_dw + (size_t)l * CONVW * D, b_dw + (size_t)l * D, Y);
            k_conv_state_out<<<cdiv((size_t)(BATCH + DB) * 30 * D, 256), 256, 0, st>>>(U, state_conv + (size_t)l * DB * 30 * D, out + O_CONVP + (size_t)l * BATCH * 30 * D, out + O_CONVS + (size_t)l * DB * 30 * D);
            k_ln_silu<<<R, 256, 0, st>>>(Y, ln_g + (size_t)l * D, ln_b + (size_t)l * D, CC);
            HOOK(100 * l + 3);
            gemm(st, CC, D, w_pw2 + (size_t)l * D * D, D, b_pw2 + (size_t)l * D, T2, D, R, D, D);
        } else {
            const int lb = l - 2;
            gemm(st, H, D, w_qg + (size_t)lb * D * QGW, QGW, nullptr, QG, QGW, R, QGW, D);
            HOOK(100 * l + 2);
            AttnP P{QG, ROWS, CMPP, cache_sel, cache_win, pt, rel_table, O};
            k_attn<<<BATCH * SEQ * 4, 64, 0, st>>>(P, 1);
            P.CMP = CMPS;
            k_attn<<<DB * DS * 4, 64, 0, st>>>(P, 0);
            HOOK(100 * l + 3);
            gemm(st, O, D, w_o + (size_t)lb * D * D, D, nullptr, T2, D, R, D, D);
        }
        k_resid<<<cdiv(RD, 256), 256, 0, st>>>(X, T2, D, mod0);
        HOOK(100 * l + 4);
        k_modnorm<<<R, 256, 0, st>>>(X, norm_g + (size_t)(l * 2 + 1) * D, mod1, H);
        HOOK(100 * l + 5);
        gemm(st, H, D, w_gate + (size_t)l * D * DFF, DFF, nullptr, T1, DFF, R, DFF, D);
        gemm(st, H, D, w_up + (size_t)l * D * DFF, DFF, nullptr, T2, DFF, R, DFF, D);
        k_swiglu<<<cdiv((size_t)R * DFF, 256), 256, 0, st>>>(T1, T2, ACT);
        HOOK(100 * l + 6);
        gemm(st, ACT, DFF, w_down + (size_t)l * DFF * D, D, nullptr, T1, D, R, D, DFF);
        k_resid<<<cdiv(RD, 256), 256, 0, st>>>(X, T1, D, mod1);
        HOOK(100 * l + 7);
    }
    k_modnorm<<<R, 256, 0, st>>>(X, final_g, nullptr, H);
    hipMemcpyAsync(out + O_YP, H, (size_t)MP * D * 4, hipMemcpyDeviceToDevice, st);
    hipMemcpyAsync(out + O_YS, H + (size_t)MP * D, (size_t)MS * D * 4, hipMemcpyDeviceToDevice, st);
    HOOK(900);
#undef HOOK
}
}
namespace pg8 {
__device__ __forceinline__ int opaque_tid() { int t; asm volatile("v_mov_b32 %0, %1" : "=v"(t) : "v"(threadIdx.x)); return t; }
#define PG8_LAS __attribute__((address_space(3)))
typedef unsigned short bf16_t;
typedef short bf16x8 __attribute__((ext_vector_type(8)));
typedef float f32x4 __attribute__((ext_vector_type(4)));
typedef unsigned u32x4 __attribute__((ext_vector_type(4)));
constexpr int BM = 256, BK = 64, HALF = 128, HTB = HALF * BK * 2  , STAGE_BYTES = 8 * HTB, NXCD = 8, WGM = 8;

__host__ __device__ __forceinline__ int lds_byte(int r, int c) { const int st = (r >> 4) * 2 + (c >> 5), rr = r & 15, cc = c & 31, ob = rr * 64 + cc * 2; return st * 1024 + (ob ^ (((ob >> 9) & 1) << 5)); }
__host__ __device__ __forceinline__ void stage_rc(int b, int& R, int& C) { const int st = b / 1024, sb = b % 1024, swz = sb ^ (((sb >> 9) & 1) << 5); R = (st >> 1) * 16 + swz / 64; C = (st & 1) * 32 + (swz % 64) / 2; }
__host__ __device__ __forceinline__ int perm32(int rho) { const int n = rho >> 4, i = rho & 15; return 8 * (i >> 2) + 4 * n + (i & 3); }

struct Unit { int pm, pn; };
struct Gemm { const bf16_t* A; const bf16_t* Bt; int M, N, K; };

struct StaticOrder {
    int nM, nN, nwg, G, c;
    __host__ __device__ void init(int M, int N, int G_, int c_) { nM = M / BM; nN = N / BM; nwg = nM * nN; G = G_; c = c_; }
    __host__ __device__ bool next(int i, Unit& u) const {
        const long L = (long)i * G + c; if (L >= nwg) return false;
        int wgid = (int)L; { const int q = nwg / NXCD, r = nwg % NXCD, xcd = wgid % NXCD, off = wgid / NXCD; wgid = (xcd < r ? xcd * (q + 1) : r * (q + 1) + (xcd - r) * q) + off; }
        const int nig = WGM * nN, gid = wgid / nig, fm = gid * WGM, gsz = (nM - fm) < WGM ? (nM - fm) : WGM;
        u.pm = fm + ((wgid % nig) % gsz); u.pn = (wgid % nig) / gsz; return true;
    }
    __device__ __forceinline__ void a_ready(const Unit&) const {}
    __device__ __forceinline__ void done(const Unit&) const {}
};

template <class Epi, class Sched, bool ALIGN_EPI = false, bool SP2 = false>
__device__ __forceinline__ void gemm_phase(PG8_LAS unsigned char* lds, const Gemm g, const Sched& S, const Epi& E) {
    const int tid = opaque_tid(), wid = __builtin_amdgcn_readfirstlane(tid >> 6), lane = tid & 63, wr = wid >> 2, wc = wid & 3, fr = lane & 15, fq = lane >> 4;
    const int K = g.K, nt = K / BK;
    unsigned voffA[2], voffB[2];
#pragma unroll
    for (int i = 0; i < 2; ++i) { int R, C; stage_rc(tid * 16 + i * 8192, R, C); const int Rb = Epi::PERM ? ((R & ~31) + perm32(R & 31)) : R;
        voffA[i] = (unsigned)(R * K + C) * 2u; voffB[i] = (unsigned)(Rb * K + C) * 2u; }
    const size_t kstep = (size_t)(BK * 2);
    const size_t hstep = (size_t)HALF * K * 2;
    const size_t tstep = 2 * hstep;
    const unsigned ldsw = (unsigned)wid * 1024u;
    const int aoff = lds_byte(wr * 64 + fr, fq * 8), boff = lds_byte(wc * 32 + fr, fq * 8);
#define PG8_SA(b, h) (((b) * 2 + (h)) * HTB)
#define PG8_SB(b, h) ((4 + (b) * 2 + (h)) * HTB)
#define PG8_STAGE(bufoff, gbase, voff) do { _Pragma("unroll") for (int _i = 0; _i < 2; ++_i) \
        __builtin_amdgcn_global_load_lds((const unsigned*)((const char*)(gbase) + (voff)[_i]), (PG8_LAS unsigned*)(lds + (bufoff) + ldsw + _i * 8192), 16, 0, 0); } while (0)
#define PG8_LDA(dst, b, h) do { _Pragma("unroll") for (int m = 0; m < 4; ++m) _Pragma("unroll") for (int k = 0; k < 2; ++k) dst[m][k] = *(const PG8_LAS bf16x8*)(lds + PG8_SA(b, h) + aoff + m * 2048 + k * 1024); } while (0)
#define PG8_LDB(dst, b, h) do { _Pragma("unroll") for (int n = 0; n < 2; ++n) _Pragma("unroll") for (int k = 0; k < 2; ++k) dst[n][k] = *(const PG8_LAS bf16x8*)(lds + PG8_SB(b, h) + boff + n * 2048 + k * 1024); } while (0)
#define PG8_MMA(ai, bj, At, Bt) do { __builtin_amdgcn_s_setprio(1); _Pragma("unroll") for (int m = 0; m < 4; ++m) _Pragma("unroll") for (int n = 0; n < 2; ++n) _Pragma("unroll") for (int k = 0; k < 2; ++k) \
        acc[ai][bj][m][n] = __builtin_amdgcn_mfma_f32_16x16x32_bf16(Bt[n][k], At[m][k], acc[ai][bj][m][n], 0, 0, 0); __builtin_amdgcn_s_setprio(0); } while (0)
#define PG8_WAIT_V(n) asm volatile("s_waitcnt vmcnt(" #n ")" ::: "memory")
#define PG8_WAIT_L(n) asm volatile("s_waitcnt lgkmcnt(" #n ")" ::: "memory")
#define PG8_BAR __builtin_amdgcn_s_barrier()
#define PG8_SCHED __builtin_amdgcn_sched_barrier(0)
    Unit cur, nxt; int ui = 0;
    if (!S.next(0, cur)) return;
    f32x4 acc[2][2][4][2];
#pragma unroll
    for (int a = 0; a < 2; ++a)
#pragma unroll
        for (int b = 0; b < 2; ++b)
#pragma unroll
            for (int m = 0; m < 4; ++m)
#pragma unroll
                for (int n = 0; n < 2; ++n) acc[a][b][m][n] = (f32x4){0.f, 0.f, 0.f, 0.f};
    bf16x8 At[4][2], B0[2][2], B1[2][2];
    const char* cA = (const char*)g.A + (size_t)cur.pm * tstep; const char* cB = (const char*)g.Bt + (size_t)cur.pn * tstep;
    S.a_ready(cur);
    if constexpr (SP2) {
        PG8_STAGE(PG8_SB(0, 0), cB, voffB); PG8_STAGE(PG8_SB(0, 1), cB + hstep, voffB); PG8_STAGE(PG8_SA(0, 0), cA, voffA); PG8_STAGE(PG8_SA(0, 1), cA + hstep, voffA);
        if (wr == 1) PG8_BAR;
        PG8_WAIT_V(2); PG8_BAR;
        PG8_STAGE(PG8_SB(1, 0), cB + kstep, voffB); PG8_STAGE(PG8_SA(1, 0), cA + kstep, voffA); PG8_STAGE(PG8_SB(1, 1), cB + hstep + kstep, voffB);
        PG8_WAIT_V(6); PG8_BAR;
    } else {
        PG8_STAGE(PG8_SB(0, 0), cB, voffB); PG8_STAGE(PG8_SA(0, 0), cA, voffA); PG8_STAGE(PG8_SB(0, 1), cB + hstep, voffB); PG8_STAGE(PG8_SA(0, 1), cA + hstep, voffA);
        if (wr == 1) PG8_BAR;
        PG8_WAIT_V(4); PG8_BAR;
        PG8_STAGE(PG8_SB(1, 0), cB + kstep, voffB); PG8_STAGE(PG8_SA(1, 0), cA + kstep, voffA); PG8_STAGE(PG8_SB(1, 1), cB + hstep + kstep, voffB);
        PG8_WAIT_V(6); PG8_BAR;
    }
    for (;;) {
        const bool has_next = S.next(ui + 1, nxt);
        const char* nA = has_next ? (const char*)g.A + (size_t)nxt.pm * tstep : cA; const char* nB = has_next ? (const char*)g.Bt + (size_t)nxt.pn * tstep : cB;
        for (int t = 0; t < nt; t += 2) {
            const bool last = (t == nt - 2);
            const char* a1 = cA + (size_t)(t + 1) * kstep;
            const char* a2 = last ? nA : cA + (size_t)(t + 2) * kstep; const char* b2 = last ? nB : cB + (size_t)(t + 2) * kstep;
            const char* a3 = a2 + kstep; const char* b3 = b2 + kstep;
            if (last && has_next) S.a_ready(nxt);
            if constexpr (SP2) {
            PG8_LDB(B0, 0, 0); PG8_LDB(B1, 0, 1); PG8_SCHED; PG8_LDA(At, 0, 0); PG8_STAGE(PG8_SA(1, 1), a1 + hstep, voffA);
            PG8_WAIT_V(8); PG8_WAIT_L(0); PG8_BAR; PG8_MMA(0, 0, At, B0); PG8_MMA(0, 1, At, B1); PG8_BAR; PG8_SCHED;
            PG8_LDA(At, 0, 1); PG8_STAGE(PG8_SB(0, 0), b2, voffB); PG8_STAGE(PG8_SB(0, 1), b2 + hstep, voffB); PG8_STAGE(PG8_SA(0, 0), a2, voffA);
            PG8_WAIT_V(8); PG8_WAIT_L(0); PG8_BAR; PG8_MMA(1, 0, At, B0); PG8_MMA(1, 1, At, B1); PG8_BAR; PG8_SCHED;
            PG8_LDB(B0, 1, 0); PG8_LDB(B1, 1, 1); PG8_SCHED; PG8_LDA(At, 1, 0); PG8_STAGE(PG8_SA(0, 1), a2 + hstep, voffA);
            PG8_WAIT_V(8); PG8_WAIT_L(0); PG8_BAR; PG8_MMA(0, 0, At, B0); PG8_MMA(0, 1, At, B1); PG8_BAR; PG8_SCHED;
            PG8_LDA(At, 1, 1); PG8_STAGE(PG8_SB(1, 0), b3, voffB); PG8_STAGE(PG8_SB(1, 1), b3 + hstep, voffB); PG8_STAGE(PG8_SA(1, 0), a3, voffA);
            PG8_WAIT_V(8); PG8_WAIT_L(0); PG8_BAR; PG8_MMA(1, 0, At, B0); PG8_MMA(1, 1, At, B1); PG8_BAR; PG8_SCHED;
            } else {
            PG8_LDB(B0, 0, 0); PG8_SCHED; PG8_LDA(At, 0, 0); PG8_STAGE(PG8_SA(1, 1), a1 + hstep, voffA);
            PG8_WAIT_L(8); PG8_BAR; PG8_WAIT_L(0); PG8_MMA(0, 0, At, B0); PG8_BAR; PG8_SCHED;
            PG8_LDB(B1, 0, 1); PG8_STAGE(PG8_SB(0, 0), b2, voffB);
            PG8_BAR; PG8_WAIT_L(0); PG8_MMA(0, 1, At, B1); PG8_BAR;
            PG8_LDA(At, 0, 1); PG8_STAGE(PG8_SA(0, 0), a2, voffA);
            PG8_BAR; PG8_WAIT_L(0); PG8_MMA(1, 0, At, B0); PG8_BAR; PG8_SCHED;
            PG8_STAGE(PG8_SB(0, 1), b2 + hstep, voffB);
            PG8_WAIT_V(6); PG8_BAR; PG8_MMA(1, 1, At, B1); PG8_BAR;
            PG8_LDB(B0, 1, 0); PG8_SCHED; PG8_LDA(At, 1, 0); PG8_STAGE(PG8_SA(0, 1), a2 + hstep, voffA);
            PG8_WAIT_L(8); PG8_BAR; PG8_WAIT_L(0); PG8_MMA(0, 0, At, B0); PG8_BAR; PG8_SCHED;
            PG8_LDB(B1, 1, 1); PG8_STAGE(PG8_SB(1, 0), b3, voffB);
            PG8_BAR; PG8_WAIT_L(0); PG8_MMA(0, 1, At, B1); PG8_BAR;
            PG8_LDA(At, 1, 1); PG8_STAGE(PG8_SA(1, 0), a3, voffA);
            PG8_BAR; PG8_WAIT_L(0); PG8_MMA(1, 0, At, B0); PG8_BAR; PG8_SCHED;
            PG8_STAGE(PG8_SB(1, 1), b3 + hstep, voffB);
            PG8_WAIT_V(6); PG8_BAR; PG8_MMA(1, 1, At, B1); PG8_BAR;
            }
        }
        if constexpr (ALIGN_EPI) { if (wr == 0) PG8_BAR; }
        if constexpr (!Epi::AFTER_DRAIN) { E(acc, cur, wr, wc, fr, fq); S.done(cur); }
        if (!has_next) break;
#pragma unroll
        for (int a = 0; a < 2; ++a)
#pragma unroll
            for (int b = 0; b < 2; ++b)
#pragma unroll
                for (int m = 0; m < 4; ++m)
#pragma unroll
                    for (int n = 0; n < 2; ++n) acc[a][b][m][n] = (f32x4){0.f, 0.f, 0.f, 0.f};
        cur = nxt; cA = nA; cB = nB; ++ui;
        if constexpr (ALIGN_EPI) { if (wr == 1) PG8_BAR; }
    }
    PG8_WAIT_V(0);
    if constexpr (!ALIGN_EPI) { if (wr == 0) PG8_BAR; }
    PG8_BAR;
    if constexpr (Epi::AFTER_DRAIN) { E.fused(acc, cur, wr, wc, fr, fq, lds, wid, lane); S.done(cur); }
#undef PG8_SA
#undef PG8_SB
#undef PG8_STAGE
#undef PG8_LDA
#undef PG8_LDB
#undef PG8_MMA
#undef PG8_WAIT_V
#undef PG8_WAIT_L
#undef PG8_BAR
#undef PG8_SCHED
}
}
#define XB_TMO      128
#define XB_XCNT(j)  (256  + 64 * (j))
#define XB_XSUB(j)  (1280 + 64 * (j))
#define XB_XGEN(j)  (2304 + 64 * (j))
#define XB_TOP      3328
#define XB_TOPGEN   3392
#define XCD_BAR_WORDS 3456
#define XB_SPIN_CAP (1u << 18)
#define LAS __attribute__((address_space(3)))

__device__ __forceinline__ unsigned xb_ld(unsigned* p)              { return __hip_atomic_load(p, __ATOMIC_RELAXED, __HIP_MEMORY_SCOPE_AGENT); }
__device__ __forceinline__ unsigned xb_add(unsigned* p, unsigned v) { return __hip_atomic_fetch_add(p, v, __ATOMIC_RELAXED, __HIP_MEMORY_SCOPE_AGENT); }
__device__ __forceinline__ unsigned xb_xcc_id() { return (unsigned)__builtin_amdgcn_s_getreg((3 << 11) | 20) & 0xFu; }
#define XB_SPIN(cond, bar) do { unsigned _sp = 0; while (cond) { __builtin_amdgcn_s_sleep(1); \
    if ((++_sp & 255u) == 0u) { if (xb_ld(&(bar)[XB_TMO])) break; if (_sp > XB_SPIN_CAP) { atomicAdd(&(bar)[XB_TMO], 1u); break; } } } } while (0)

struct XcdBarrier {
    unsigned* bar; unsigned x;
    volatile LAS unsigned* st;
};

__device__ __forceinline__ XcdBarrier xcd_barrier_post(unsigned* bar, volatile LAS unsigned* st) {
    XcdBarrier b; b.bar = bar; b.x = xb_xcc_id(); b.st = st;
    if (threadIdx.x == 0) (void)xb_add(&bar[XB_XCNT(b.x)], 1u);
    return b;
}
__device__ __forceinline__ void xcd_barrier_complete(unsigned* bar, unsigned x, unsigned& nloc, unsigned& nx) {
    const unsigned G = gridDim.x * gridDim.y * gridDim.z;
    unsigned sum, cnt, mine, sp = 0u;
    for (;;) {
        sum = 0u; cnt = 0u; mine = 0u;
#pragma unroll
        for (unsigned j = 0; j < 16; ++j) { const unsigned c = xb_ld(&bar[XB_XCNT(j)]); sum += c; cnt += (c > 0u) ? 1u : 0u; mine = (j == x) ? c : mine; }
        if (sum == G) break;
        __builtin_amdgcn_s_sleep(1);
        if ((++sp & 255u) == 0u) { if (xb_ld(&bar[XB_TMO])) break; if (sp > XB_SPIN_CAP) { atomicAdd(&bar[XB_TMO], 1u); break; } }
    }
    nloc = mine > 0u ? mine : 1u; nx = cnt > 0u ? cnt : 1u;
}

__device__ __forceinline__ void xcd_barrier(const XcdBarrier& b) {
    asm volatile("s_waitcnt vmcnt(0)" ::: "memory");
    __syncthreads();
    if (threadIdx.x == 0) {
        unsigned* bar = b.bar;
        __builtin_amdgcn_s_waitcnt(0);
        unsigned nloc = b.st[0], nx = b.st[1];
        if (nloc == 0u) { xcd_barrier_complete(bar, b.x, nloc, nx); b.st[0] = nloc; b.st[1] = nx; }
        const unsigned old = xb_add(&bar[XB_XSUB(b.x)], 1u);
        const unsigned gen = old / nloc;
        if (old + 1u == (gen + 1u) * nloc) {
            __builtin_amdgcn_fence(__ATOMIC_RELEASE, "agent");
            asm volatile("s_waitcnt vmcnt(0)" ::: "memory");
            const unsigned og = xb_add(&bar[XB_TOP], 1u);
            const unsigned tg = og / nx;
            if (og + 1u == (tg + 1u) * nx) xb_add(&bar[XB_TOPGEN], 1u);
            else XB_SPIN(xb_ld(&bar[XB_TOPGEN]) == tg, bar);
            __builtin_amdgcn_fence(__ATOMIC_ACQUIRE, "agent");
            xb_add(&bar[XB_XGEN(b.x)], 1u);
            asm volatile("s_waitcnt vmcnt(0)" ::: "memory");
        } else {
            XB_SPIN(xb_ld(&bar[XB_XGEN(b.x)]) == gen, bar);
            __builtin_amdgcn_fence(__ATOMIC_ACQUIRE, "agent");
            asm volatile("s_waitcnt vmcnt(0)" ::: "memory");
        }
    }
    __syncthreads();
}

namespace fk {
using namespace nv;
typedef unsigned short bf16;
typedef float f32x4 __attribute__((ext_vector_type(4)));
typedef short bf16x8 __attribute__((ext_vector_type(8)));
typedef unsigned u32x2 __attribute__((ext_vector_type(2)));
typedef unsigned u32x4 __attribute__((ext_vector_type(4)));
#define FLAS __attribute__((address_space(3)))
constexpr float LOG2E = 1.4426950408889634f;
constexpr int NTHR = 512, NWAVE = 8;
constexpr int LDS_BYTES = 147456;
constexpr int LDS_MISC = 131072 + 8192;

__device__ __forceinline__ unsigned f2bf(float f) { unsigned u = __builtin_bit_cast(unsigned, f); return (u + 0x7fffu + ((u >> 16) & 1u)) >> 16; }
typedef __bf16 hbf16x2 __attribute__((ext_vector_type(2)));
typedef float f32x2 __attribute__((ext_vector_type(2)));
__device__ __forceinline__ unsigned pk2(float lo, float hi) { const f32x2 v = {lo, hi}; return __builtin_bit_cast(unsigned, __builtin_convertvector(v, hbf16x2)); }
__device__ __forceinline__ float bf2f(unsigned short b) { return __builtin_bit_cast(float, (unsigned)b << 16); }
__device__ __forceinline__ float fsigm(float x) { return __builtin_amdgcn_rcpf(1.f + __expf(-x)); }
__device__ __forceinline__ float fsilu(float x) { return x * __builtin_amdgcn_rcpf(1.f + __expf(-x)); }
__device__ __forceinline__ float xmax32(float v) { const unsigned u = __builtin_bit_cast(unsigned, v); auto rr = __builtin_amdgcn_permlane32_swap(u, u, false, false); return fmaxf(__builtin_bit_cast(float, (unsigned)rr[0]), __builtin_bit_cast(float, (unsigned)rr[1])); }
__device__ __forceinline__ float xsum32(float v) { const unsigned u = __builtin_bit_cast(unsigned, v); auto rr = __builtin_amdgcn_permlane32_swap(u, u, false, false); return __builtin_bit_cast(float, (unsigned)rr[0]) + __builtin_bit_cast(float, (unsigned)rr[1]); }
__device__ __forceinline__ float wsum(float v) {
#pragma unroll
    for (int o = 1; o < 64; o <<= 1) v += __shfl_xor(v, o);
    return v; }
__device__ __forceinline__ int cidx_row(int row) { return row < MP ? (row >> 12) : 4 + ((row - MP) >> 2); }

constexpr size_t al(size_t x) { return (x + 4095) & ~(size_t)4095; }
constexpr size_t F_CTL = 0, F_MOD = 1u << 20, F_WPW1 = F_MOD + al((size_t)8 * NC * 3072 * 4), F_WPW2 = F_WPW1 + (size_t)2 * 2048 * 1024 * 2,
    F_WGU = F_WPW2 + (size_t)2 * 1024 * 1024 * 2, F_WDN = F_WGU + (size_t)4 * 5632 * 1024 * 2, F_WKV = F_WDN + (size_t)4 * 1024 * 2816 * 2,
    F_WQ = F_WKV + (size_t)1536 * 1024 * 2, F_WG = F_WQ + (size_t)2 * 1024 * 1024 * 2, F_WO = F_WG + (size_t)2 * 64 * 1024 * 2, F_WPHI1 = F_WO + (size_t)2 * 1024 * 1024 * 2,
    F_WPHI2 = F_WPHI1 + (size_t)2 * 128 * 2048 * 2, F_BPHI = F_WPHI2 + (size_t)2 * 64 * 128 * 2, F_X = F_BPHI + 32768, F_H = F_X + al((size_t)R * D * 4),
    F_HKV = F_H + al((size_t)R * D * 2), F_U = F_HKV + al((size_t)R * D * 2), F_US = F_U + al((size_t)R * D * 2), F_C = F_US + (size_t)MS * D * 4, F_ACT = F_C + al((size_t)R * D * 2),
    F_RB = F_ACT + al((size_t)R * DFF * 2), F_Q = F_RB + al((size_t)R * KVW * 2), F_GT = F_Q + al((size_t)R * D * 2), F_O = F_GT + al((size_t)R * 64 * 4),
    F_VT = F_O + al((size_t)R * D * 2), F_CMPK = F_VT + (size_t)2 * 16 * 64 * 4096 * 2, F_CMPVT = F_CMPK + (size_t)16 * 128 * 64 * 2, F_CMPS = F_CMPVT + (size_t)16 * 128 * 64 * 2,
    F_PART = F_CMPS + (size_t)2 * DB * 256 * 256 * 4, F_QPART = F_PART + (size_t)8 * MS * D * 4, F_STATS = F_QPART + (size_t)8 * MS * D * 4, F_END = F_STATS + (size_t)8 * 64 * 4 * 256 * 4;
constexpr size_t CTL_BYTES = 1u << 20;

struct Args { const void* in[34]; float* out; unsigned char* fb; int lo, hi; };

typedef const __attribute__((address_space(4))) Args CArgs;
struct Ctx {
    FLAS unsigned char* lds; int tid, lane, wave, G, wg; int gw, ngw;
};
#define IN_F(i) ((const float*)A.in[i])
__device__ __forceinline__ Ctx refreshed(const Ctx& C0) { Ctx C = C0; int t; asm volatile("v_mov_b32 %0, %1" : "=v"(t) : "v"(threadIdx.x)); C.tid = t; C.lane = t & 63;
    int wg_ = C0.wg, G_ = C0.G, wv_ = C0.wave; asm volatile("" : "+s"(wg_), "+s"(G_), "+s"(wv_)); C.wg = wg_; C.G = G_; C.wave = wv_; C.gw = wg_ * NWAVE + wv_; C.ngw = G_ * NWAVE; return C; }
enum TrMode { TR_PLAIN = 0, TR_PW1 = 1, TR_GATE = 2, TR_UP = 3, TR_QG = 4 };
__device__ __forceinline__ void tr_item(const float* __restrict__ W, int K, int N, bf16* __restrict__ WT, bf16* __restrict__ WT2, int mode, FLAS float* scr, int item, int lane) {
    const int nblk = (N + 63) / 64, kb = item / nblk, nb = item % nblk, k0 = 64 * kb, n0 = 64 * nb;
    const int c4 = lane & 15, rq = lane >> 4; const bool okc = n0 + 4 * c4 < N;
    f32x4 v[16];
#pragma unroll
    for (int i = 0; i < 16; ++i) { const int kk = 4 * i + rq; v[i] = okc ? *(const f32x4*)(W + (size_t)(k0 + kk) * N + n0 + 4 * c4) : (f32x4){0.f, 0.f, 0.f, 0.f}; }
#pragma unroll
    for (int i = 0; i < 16; ++i) { const int kk = 4 * i + rq; *(FLAS f32x4*)(scr + kk * 68 + 4 * c4) = v[i]; }
    asm volatile("s_waitcnt lgkmcnt(0)" ::: "memory");
    const int c = lane & 7;
#pragma unroll
    for (int j = 0; j < 8; ++j) { const int nl = (lane >> 3) + 8 * j; const int n = n0 + nl; const FLAS float* sp = scr + (8 * c) * 68 + nl;
        u32x4 o; o.x = pk2(sp[0 * 68], sp[1 * 68]); o.y = pk2(sp[2 * 68], sp[3 * 68]); o.z = pk2(sp[4 * 68], sp[5 * 68]); o.w = pk2(sp[6 * 68], sp[7 * 68]);
        bf16* dst = WT; int nr = n;
        if (mode == TR_PW1) { const int f = n & 1023, isg = n >> 10; nr = 256 * (f >> 7) + 128 * isg + (f & 127); }
        else if (mode == TR_GATE) nr = 256 * (n >> 7) + (n & 127);
        else if (mode == TR_UP) nr = 256 * (n >> 7) + 128 + (n & 127);
        else if (mode == TR_QG) { if (n >= 1024) { dst = WT2; nr = n - 1024; } }
        if (mode != TR_QG || n < 1088) *(u32x4*)(dst + (size_t)nr * K + k0 + 8 * c) = o; }
    asm volatile("s_waitcnt lgkmcnt(0)" ::: "memory");
}
struct TrJob { const float* W; bf16* WT; bf16* WT2; int K, N, mode, nitems; };

__device__ __forceinline__ void mod_unit(const Ctx& C, CArgs& A, int unit) {
    const int ls = unit / 24, cg = unit % 24, tid = C.tid, w = C.wave, lane = C.lane;
    FLAS float* SCs = (FLAS float*)C.lds;
    const float* W = IN_F(9) + (size_t)ls * D * 3072;
    float acc0[36], acc1[36];
#pragma unroll
    for (int c = 0; c < 36; ++c) { acc0[c] = 0.f; acc1[c] = 0.f; }
    for (int half = 0; half < 2; ++half) {
        __syncthreads();
        { const int kg = 128 * (tid >> 6) + 64 * half + (tid & 63);
#pragma unroll 4
          for (int c = 0; c < 36; ++c) { const float v = c < 4 ? IN_F(2)[c * D + kg] : IN_F(3)[(c - 4) * D + kg]; SCs[tid * 36 + c] = fsilu(v); } }
        __syncthreads();
        const float* wp = W + (size_t)(128 * w + 64 * half) * 3072 + cg * 128 + lane;
        const FLAS f32x4* sp = (const FLAS f32x4*)(SCs + (w * 64) * 36);
#pragma unroll 2
        for (int kk = 0; kk < 64; ++kk) { const float w0 = wp[(size_t)kk * 3072], w1 = wp[(size_t)kk * 3072 + 64];
#pragma unroll
            for (int q = 0; q < 9; ++q) { const f32x4 sv = sp[kk * 9 + q];
#pragma unroll
                for (int j = 0; j < 4; ++j) { acc0[4 * q + j] += sv[j] * w0; acc1[4 * q + j] += sv[j] * w1; } } }
    }
    FLAS float* part = (FLAS float*)C.lds;
#pragma unroll
    for (int ps = 0; ps < 3; ++ps) {
        __syncthreads();
#pragma unroll
        for (int cc = 0; cc < 12; ++cc) { part[(w * 128 + lane) * 13 + cc] = acc0[12 * ps + cc]; part[(w * 128 + lane + 64) * 13 + cc] = acc1[12 * ps + cc]; }
        __syncthreads();
        for (int o = tid; o < 12 * 128; o += NTHR) { const int cc = o >> 7, nn = o & 127, c = 12 * ps + cc, ng = cg * 128 + nn; float v = IN_F(10)[ls * 3072 + ng];
#pragma unroll
            for (int ww = 0; ww < 8; ++ww) v += part[(ww * 128 + nn) * 13 + cc];
            if (ng >= 1024 && ng < 2048) v = IN_F(11)[ls * D + ng - 1024] * (1.f + v);
            ((float*)(A.fb + F_MOD))[((size_t)ls * NC + c) * 3072 + ng] = v; }
    }
    __syncthreads();
}

__device__ __forceinline__ void phase_prologue(const Ctx& C, CArgs& A) {
    unsigned char* fb = A.fb;
    {
        FLAS float* scr = (FLAS float*)(C.lds + C.wave * 17408);
        int it = C.gw;
#pragma unroll 1
        for (int job = 0; job < 25; ++job) {
            const float* Wp; bf16* WTp; bf16* WT2p = nullptr; int Kv, Nv, modev;
            if (job < 12) { const int l = job / 6, t = job % 6;
                if (t == 0) { Wp = IN_F(12) + (size_t)l * D * 2048; WTp = (bf16*)(fb + F_WPW1) + (size_t)l * 2048 * 1024; Kv = 1024; Nv = 2048; modev = TR_PW1; }
                else if (t == 1) { Wp = IN_F(18) + (size_t)l * D * D; WTp = (bf16*)(fb + F_WPW2) + (size_t)l * 1024 * 1024; Kv = 1024; Nv = 1024; modev = TR_PLAIN; }
                else if (t == 2) { Wp = IN_F(27) + (size_t)l * D * QGW; WTp = (bf16*)(fb + F_WQ) + (size_t)l * 1024 * 1024; WT2p = (bf16*)(fb + F_WG) + (size_t)l * 64 * 1024; Kv = 1024; Nv = QGW; modev = TR_QG; }
                else if (t == 3) { Wp = IN_F(28) + (size_t)l * D * D; WTp = (bf16*)(fb + F_WO) + (size_t)l * 1024 * 1024; Kv = 1024; Nv = 1024; modev = TR_PLAIN; }
                else if (t == 4) { Wp = IN_F(22) + (size_t)l * 2048 * PHI; WTp = (bf16*)(fb + F_WPHI1) + (size_t)l * 128 * 2048; Kv = 2048; Nv = 128; modev = TR_PLAIN; }
                else { Wp = IN_F(24) + (size_t)l * PHI * 64; WTp = (bf16*)(fb + F_WPHI2) + (size_t)l * 64 * 128; Kv = 128; Nv = 64; modev = TR_PLAIN; }
            } else if (job < 24) { const int l = (job - 12) / 3, t = (job - 12) % 3;
                if (t == 0) { Wp = IN_F(30) + (size_t)l * D * DFF; WTp = (bf16*)(fb + F_WGU) + (size_t)l * 5632 * 1024; Kv = 1024; Nv = DFF; modev = TR_GATE; }
                else if (t == 1) { Wp = IN_F(31) + (size_t)l * D * DFF; WTp = (bf16*)(fb + F_WGU) + (size_t)l * 5632 * 1024; Kv = 1024; Nv = DFF; modev = TR_UP; }
                else { Wp = IN_F(32) + (size_t)l * DFF * D; WTp = (bf16*)(fb + F_WDN) + (size_t)l * 1024 * 2816; Kv = 2816; Nv = 1024; modev = TR_PLAIN; }
            } else { Wp = IN_F(21); WTp = (bf16*)(fb + F_WKV); Kv = 1024; Nv = KVW; modev = TR_PLAIN; }
            const int nit = (Kv / 64) * ((Nv + 63) / 64);
            while (it < nit) { tr_item(Wp, Kv, Nv, WTp, WT2p, modev, scr, it, C.lane); it += C.ngw; }
            it -= nit;
        }
    }
    {
        const size_t gt = (size_t)C.wg * NTHR + C.tid, nt = (size_t)C.G * NTHR;
        const f32x4* src = (const f32x4*)IN_F(6); f32x4* dst = (f32x4*)(A.out + O_WINS);
        for (size_t i = gt; i < (size_t)DB * 508 * 128; i += nt) { const size_t b = i / (508 * 128), r = i % (508 * 128); dst[b * 512 * 128 + r] = src[b * 512 * 128 + 4 * 128 + r]; }
        const f32x4* s2 = (const f32x4*)IN_F(7); f32x4* d2 = (f32x4*)(A.out + O_CONVS);
        for (size_t i = gt; i < (size_t)2 * DB * 26 * 256; i += nt) { const size_t lb = i / (26 * 256), r = i % (26 * 256); d2[lb * 30 * 256 + r] = s2[lb * 30 * 256 + 4 * 256 + r]; }
    }
    { const int ck = C.G - 1 - C.wg;
      if (ck < 16 && C.tid < 256) { const int e = C.tid >> 7, h = C.tid & 127; float a = ck == 0 ? IN_F(23)[e * PHI + h] : 0.f; const float* w = IN_F(22) + ((size_t)e * 2048 + ck * 128) * PHI + h; const float* pe = IN_F(26) + e * 2048 + ck * 128;
#pragma unroll 16
          for (int f = 0; f < 128; ++f) a += pe[f] * w[(size_t)f * PHI];
          ((float*)(fb + F_BPHI))[ck * 256 + e * PHI + h] = a; } }
    __syncthreads();
    for (int u = C.wg; u < 192; u += C.G) mod_unit(C, A, u);
}

__device__ __forceinline__ f32x4 bfx4(unsigned lo, unsigned hi) { f32x4 r; r[0] = __builtin_bit_cast(float, lo << 16); r[1] = __builtin_bit_cast(float, lo & 0xffff0000u); r[2] = __builtin_bit_cast(float, hi << 16); r[3] = __builtin_bit_cast(float, hi & 0xffff0000u); return r; }
__device__ __forceinline__ void phase_norm(const Ctx& C, CArgs& A, int mode, int ls, bool from_input, int pend_ls, const float* pend_bias, bool pend_in, int first, int step, int limit) {
    unsigned char* fb = A.fb; const float* modf = (const float*)(fb + F_MOD) + (size_t)ls * NC * 3072; const bf16* XB = (const bf16*)(fb + F_X);
    if (from_input && C.wg == 0 && C.tid < 256) { const float* p = (const float*)(fb + F_BPHI); float a = 0.f;
#pragma unroll
        for (int ck = 0; ck < 16; ++ck) a += p[ck * 256 + C.tid];
        ((float*)(fb + F_BPHI))[4096 + C.tid] = a; }
    constexpr int NB = 4;
    for (int row0 = first; row0 < limit; row0 += NB * step) {
        f32x4 v[NB][4];
#pragma unroll
        for (int i = 0; i < NB; ++i) { const int rq = row0 + i * step; const int rr = rq < limit ? rq : row0;
            if (from_input || (pend_in && rr >= MP)) { const float* xr = rr < MP ? IN_F(0) + (size_t)rr * D : IN_F(1) + (size_t)(rr - MP) * D;
#pragma unroll
                for (int jj = 0; jj < 2; ++jj) { v[i][2 * jj] = *(const f32x4*)(xr + 8 * (C.lane + 64 * jj)); v[i][2 * jj + 1] = *(const f32x4*)(xr + 8 * (C.lane + 64 * jj) + 4); } }
            else { const bf16* xr = XB + (size_t)rr * D;
#pragma unroll
                for (int jj = 0; jj < 2; ++jj) { const u32x4 t = *(const u32x4*)(xr + 8 * (C.lane + 64 * jj)); v[i][2 * jj] = bfx4(t.x, t.y); v[i][2 * jj + 1] = bfx4(t.z, t.w); } } }
#pragma unroll
        for (int i = 0; i < NB; ++i) { const int row = row0 + i * step; if (row >= limit) break;
            if (pend_ls >= 0 && row >= MP) { const float* pp = (const float*)(fb + F_PART) + (size_t)(row - MP) * D; const float* gm = (const float*)(fb + F_MOD) + ((size_t)pend_ls * NC + cidx_row(row)) * 3072 + 2048;
#pragma unroll
                for (int j = 0; j < 4; ++j) { const int c0 = 8 * (C.lane + 64 * (j >> 1)) + 4 * (j & 1); f32x4 y = {0.f, 0.f, 0.f, 0.f}; if (pend_bias) y = *(const f32x4*)(pend_bias + c0);
#pragma unroll
                    for (int ksl = 0; ksl < 8; ++ksl) y += *(const f32x4*)(pp + (size_t)ksl * MS * D + c0);
                    v[i][j] += *(const f32x4*)(gm + c0) * y; }
#pragma unroll
                for (int jj = 0; jj < 2; ++jj) { u32x4 o; o.x = pk2(v[i][2 * jj][0], v[i][2 * jj][1]); o.y = pk2(v[i][2 * jj][2], v[i][2 * jj][3]); o.z = pk2(v[i][2 * jj + 1][0], v[i][2 * jj + 1][1]); o.w = pk2(v[i][2 * jj + 1][2], v[i][2 * jj + 1][3]);
                    *(u32x4*)((bf16*)(fb + F_X) + (size_t)row * D + 8 * (C.lane + 64 * jj)) = o; } }
            float ss = 0.f;
#pragma unroll
            for (int j = 0; j < 4; ++j) ss += (v[i][j][0] * v[i][j][0] + v[i][j][1] * v[i][j][1]) + (v[i][j][2] * v[i][j][2] + v[i][j][3] * v[i][j][3]);
            const float rstd = rsqrtf(wsum(ss) * (1.f / D) + EPS);
            if (mode == 2) { float* yo = row < MP ? A.out + O_YP + (size_t)row * D : A.out + O_YS + (size_t)(row - MP) * D;
#pragma unroll
                for (int j = 0; j < 4; ++j) { const int c0 = 8 * (C.lane + 64 * (j >> 1)) + 4 * (j & 1); const f32x4 g = *(const f32x4*)(IN_F(33) + c0); *(f32x4*)(yo + c0) = v[i][j] * rstd * g; }
                continue; }
            const float* m = modf + (size_t)cidx_row(row) * 3072;
#pragma unroll
            for (int jj = 0; jj < 2; ++jj) { const int c0 = 8 * (C.lane + 64 * jj);
                const f32x4 h0 = v[i][2 * jj] * rstd * *(const f32x4*)(m + D + c0) + *(const f32x4*)(m + c0), h1 = v[i][2 * jj + 1] * rstd * *(const f32x4*)(m + D + c0 + 4) + *(const f32x4*)(m + c0 + 4);
                u32x4 o; o.x = pk2(h0[0], h0[1]); o.y = pk2(h0[2], h0[3]); o.z = pk2(h1[0], h1[1]); o.w = pk2(h1[2], h1[3]); *(u32x4*)((bf16*)(fb + F_H) + (size_t)row * D + c0) = o; }
            if (mode == 1) {
#pragma unroll
                for (int jj = 0; jj < 2; ++jj) { const int c0 = 8 * (C.lane + 64 * jj);
                    const f32x4 h0 = v[i][2 * jj] * rstd * *(const f32x4*)(IN_F(20) + c0), h1 = v[i][2 * jj + 1] * rstd * *(const f32x4*)(IN_F(20) + c0 + 4);
                    u32x4 o; o.x = pk2(h0[0], h0[1]); o.y = pk2(h0[2], h0[3]); o.z = pk2(h1[0], h1[1]); o.w = pk2(h1[2], h1[3]); *(u32x4*)((bf16*)(fb + F_HKV) + (size_t)row * D + c0) = o; } }
        }
    }
}

struct EpGLU { static constexpr bool PERM = true, PAIRED = true;
    bf16* U; float* US; const float* b1; float* convp; float* convs;
    __device__ __forceinline__ void st2(int row, int f, f32x4 a, f32x4 g) const {
        const f32x4 ba = *(const f32x4*)(b1 + f), bg = *(const f32x4*)(b1 + 1024 + f); f32x4 u;
#pragma unroll
        for (int j = 0; j < 4; ++j) u[j] = (a[j] + ba[j]) * fsigm(g[j] + bg[j]);
        u32x2 o; o.x = pk2(u[0], u[1]); o.y = pk2(u[2], u[3]); *(u32x2*)(U + (size_t)row * D + f) = o;
        if (row < MP) { const int t = row & 4095; if (t >= 4066) *(f32x4*)(convp + ((size_t)(row >> 12) * 30 + (t - 4066)) * D + f) = u; }
        else { const int rs = row - MP; *(f32x4*)(US + (size_t)rs * D + f) = u; *(f32x4*)(convs + ((size_t)(rs >> 2) * 30 + 26 + (rs & 3)) * D + f) = u; }
    } };
struct EpSwiGLU { static constexpr bool PERM = true, PAIRED = true;
    bf16* ACT;
    __device__ __forceinline__ void st2(int row, int f, f32x4 g, f32x4 u) const {
        f32x4 a;
#pragma unroll
        for (int j = 0; j < 4; ++j) a[j] = fsilu(g[j]) * u[j];
        u32x2 o; o.x = pk2(a[0], a[1]); o.y = pk2(a[2], a[3]); *(u32x2*)(ACT + (size_t)row * DFF + f) = o;
    } };
struct EpResid { static constexpr bool PERM = false, PAIRED = false;
    const float* xp; const float* xs; bf16* X; const float* mod; const float* bias;
    __device__ __forceinline__ void st(int row, int col, f32x4 v) const {
        const f32x4 gt = *(const f32x4*)(mod + (size_t)cidx_row(row) * 3072 + 2048 + col);
        f32x4 x;
        if (xp) x = row < MP ? *(const f32x4*)(xp + (size_t)row * D + col) : *(const f32x4*)(xs + (size_t)(row - MP) * D + col);
        else { const u32x2 t = *(const u32x2*)(X + (size_t)row * D + col); x = bfx4(t.x, t.y); }
        f32x4 b = {0.f, 0.f, 0.f, 0.f}; if (bias) b = *(const f32x4*)(bias + col);
        const f32x4 y = x + gt * (v + b); u32x2 o; o.x = pk2(y[0], y[1]); o.y = pk2(y[2], y[3]); *(u32x2*)(X + (size_t)row * D + col) = o;
    } };
struct EpKV { static constexpr bool PERM = false, PAIRED = false;
    float* out; bf16* RB;
    __device__ __forceinline__ void st(int row, int col, f32x4 v) const {
        u32x2 o; o.x = pk2(v[0], v[1]); o.y = pk2(v[2], v[3]); *(u32x2*)(RB + (size_t)row * KVW + col) = o;
        const int br = col >> 9, c = col & 511;
        if (row < MP) {
            if (br == 0) *(f32x4*)(out + O_CMPP + (size_t)row * 512 + c) = v;
            else if (br == 1) *(f32x4*)(out + O_SELP + (size_t)row * 512 + c) = v;
            else { const int t = row & 4095; if (t >= 3584) *(f32x4*)(out + O_WINP + ((size_t)(row >> 12) * 512 + (t - 3584)) * 512 + c) = v; }
        } else { const int rs = row - MP;
            if (br == 0) *(f32x4*)(out + O_CMPS + (size_t)rs * 512 + c) = v;
            else if (br == 1) *(f32x4*)(out + O_SELS + (size_t)rs * 512 + c) = v;
            else *(f32x4*)(out + O_WINS + ((size_t)(rs >> 2) * 512 + 508 + (rs & 3)) * 512 + c) = v; }
    } };
struct EpQ { static constexpr bool PERM = true, PAIRED = false;
    bf16* Q;
    __device__ __forceinline__ void st(int row, int col, f32x4 v) const {
        const float s = 0.125f * LOG2E; u32x2 o; o.x = pk2(v[0] * s, v[1] * s); o.y = pk2(v[2] * s, v[3] * s); *(u32x2*)(Q + (size_t)row * D + col) = o;
    } };
struct EpGates { static constexpr bool PERM = false, PAIRED = false;
    float* GT;
    __device__ __forceinline__ void st(int row, int col, f32x4 v) const {
        f32x4 o; o[0] = fsigm(v[0]); o[1] = fsigm(v[1]); o[2] = fsigm(v[2]); o[3] = fsigm(v[3]); *(f32x4*)(GT + (size_t)row * 64 + col) = o;
    } };
__device__ __forceinline__ void st_pair16(bf16* rowbase, int fq, u32x2 o0, u32x2 o1) {
    const auto r0 = __builtin_amdgcn_permlane16_swap(o0.x, o1.x, false, false); const auto r1 = __builtin_amdgcn_permlane16_swap(o0.y, o1.y, false, false);
    u32x4 wv; wv.x = (unsigned)r0[0]; wv.y = (unsigned)r1[0]; wv.z = (unsigned)r0[1]; wv.w = (unsigned)r1[1];
    *(u32x4*)(rowbase + ((fq & 1) ? 16 + 4 * (fq - 1) : 4 * fq)) = wv; }
struct EpResidNorm { static constexpr bool PERM = false, AFTER_DRAIN = true;
    const float* xp;
    bf16* X; const float* mod; const float* bias;
    int mode;
    const float* nmod; const float* gk; bf16* H; bf16* HKV; float* yout;
    float* stats; unsigned* cnt; unsigned* bar;
    __device__ __forceinline__ void operator()(const pg8::f32x4 (&)[2][2][4][2], const pg8::Unit&, int, int, int, int) const {}
    __device__ __forceinline__ void fused(pg8::f32x4 (&acc)[2][2][4][2], const pg8::Unit& u, int wr, int wc, int fr, int fq, PG8_LAS unsigned char* lds, int wid, int lane) const {
        const int cidx = u.pm >> 4; const float* gm = mod + (size_t)cidx * 3072 + 2048; const int tid = wid * 64 + lane;
        PG8_LAS float* sred = (PG8_LAS float*)lds; PG8_LAS float* srs = (PG8_LAS float*)(lds + 4096);
        f32x4 gv[2][2];
#pragma unroll
        for (int bj = 0; bj < 2; ++bj)
#pragma unroll
            for (int n = 0; n < 2; ++n) { const int col = u.pn * 256 + bj * 128 + wc * 32 + 16 * n + 4 * fq; gv[bj][n] = *(const f32x4*)(gm + col); }
        if (bias) {
#pragma unroll
            for (int bj = 0; bj < 2; ++bj)
#pragma unroll
                for (int n = 0; n < 2; ++n) { const f32x4 b = *(const f32x4*)(bias + (u.pn * 256 + bj * 128 + wc * 32 + 16 * n + 4 * fq));
#pragma unroll
                    for (int ai = 0; ai < 2; ++ai)
#pragma unroll
                        for (int m = 0; m < 4; ++m) acc[ai][bj][m][n] += b; } }
#pragma unroll
        for (int ai = 0; ai < 2; ++ai)
#pragma unroll
            for (int m = 0; m < 4; ++m) { const int rl = ai * 128 + wr * 64 + m * 16 + fr; const size_t row = (size_t)u.pm * 256 + rl; float ss = 0.f;
                f32x4 xv[2][2];
                if (xp) {
#pragma unroll
                    for (int bj = 0; bj < 2; ++bj)
#pragma unroll
                        for (int n = 0; n < 2; ++n) xv[bj][n] = *(const f32x4*)(xp + row * D + (u.pn * 256 + bj * 128 + wc * 32 + 16 * n + 4 * fq));
                    __builtin_amdgcn_sched_barrier(0);
                } else { u32x2 t[2][2];
#pragma unroll
                    for (int bj = 0; bj < 2; ++bj)
#pragma unroll
                        for (int n = 0; n < 2; ++n) t[bj][n] = *(const u32x2*)(X + row * D + (u.pn * 256 + bj * 128 + wc * 32 + 16 * n + 4 * fq));
                    __builtin_amdgcn_sched_barrier(0);
#pragma unroll
                    for (int bj = 0; bj < 2; ++bj)
#pragma unroll
                        for (int n = 0; n < 2; ++n) xv[bj][n] = bfx4(t[bj][n].x, t[bj][n].y); }
#pragma unroll
                for (int bj = 0; bj < 2; ++bj) { u32x2 o[2];
#pragma unroll
                    for (int n = 0; n < 2; ++n) {
                        const f32x4 y = xv[bj][n] + gv[bj][n] * acc[ai][bj][m][n]; acc[ai][bj][m][n] = y;
                        o[n].x = pk2(y[0], y[1]); o[n].y = pk2(y[2], y[3]);
                        ss += (y[0] * y[0] + y[1] * y[1]) + (y[2] * y[2] + y[3] * y[3]); }
                    st_pair16(X + row * D + (u.pn * 256 + bj * 128 + wc * 32), fq, o[0], o[1]); }
                ss += __shfl_xor(ss, 16); ss += __shfl_xor(ss, 32);
                if (fq == 0) sred[rl * 4 + wc] = ss;
                asm volatile("" ::: "memory"); }
        __syncthreads();
        if (tid < 256) __hip_atomic_store((unsigned*)stats + ((size_t)u.pm * 4 + u.pn) * 256 + tid, __builtin_bit_cast(unsigned, (sred[tid * 4] + sred[tid * 4 + 1]) + (sred[tid * 4 + 2] + sred[tid * 4 + 3])), __ATOMIC_RELAXED, __HIP_MEMORY_SCOPE_AGENT);
        if (wid < 4) { asm volatile("s_waitcnt vmcnt(0)" ::: "memory"); if (lane == 0) (void)xb_add(cnt + 64 * u.pm, 1u); }
        if (tid == 0) { XB_SPIN(xb_ld(cnt + 64 * u.pm) < 16u, bar); __builtin_amdgcn_fence(__ATOMIC_ACQUIRE, "agent"); asm volatile("s_waitcnt vmcnt(0)" ::: "memory"); }
        __syncthreads();
        if (tid < 256) { float t = 0.f;
#pragma unroll
            for (int p2 = 0; p2 < 4; ++p2) t += __builtin_bit_cast(float, __hip_atomic_load((unsigned*)stats + ((size_t)u.pm * 4 + p2) * 256 + tid, __ATOMIC_RELAXED, __HIP_MEMORY_SCOPE_AGENT));
            srs[tid] = rsqrtf(t * (1.f / D) + EPS); }
        __syncthreads();
        const float* am = nmod + (size_t)cidx * 3072;
        if (mode != 2) { f32x4 sc4[2][2], sh4[2][2];
#pragma unroll
            for (int bj = 0; bj < 2; ++bj)
#pragma unroll
                for (int n = 0; n < 2; ++n) { const int col = u.pn * 256 + bj * 128 + wc * 32 + 16 * n + 4 * fq; sc4[bj][n] = *(const f32x4*)(am + D + col); sh4[bj][n] = *(const f32x4*)(am + col); }
#pragma unroll
            for (int ai = 0; ai < 2; ++ai)
#pragma unroll
                for (int m = 0; m < 4; ++m) { const int rl = ai * 128 + wr * 64 + m * 16 + fr; const size_t row = (size_t)u.pm * 256 + rl; const float rs = srs[rl];
#pragma unroll
                    for (int bj = 0; bj < 2; ++bj) { u32x2 oh[2];
#pragma unroll
                        for (int n = 0; n < 2; ++n) { const f32x4 h = (acc[ai][bj][m][n] * rs) * sc4[bj][n] + sh4[bj][n]; oh[n].x = pk2(h[0], h[1]); oh[n].y = pk2(h[2], h[3]); }
                        st_pair16(H + row * D + (u.pn * 256 + bj * 128 + wc * 32), fq, oh[0], oh[1]); }
                    asm volatile("" ::: "memory"); } }
        if (mode != 0) { f32x4 gk4[2][2];
#pragma unroll
            for (int bj = 0; bj < 2; ++bj)
#pragma unroll
                for (int n = 0; n < 2; ++n) gk4[bj][n] = *(const f32x4*)(gk + (u.pn * 256 + bj * 128 + wc * 32 + 16 * n + 4 * fq));
#pragma unroll
            for (int ai = 0; ai < 2; ++ai)
#pragma unroll
                for (int m = 0; m < 4; ++m) { const int rl = ai * 128 + wr * 64 + m * 16 + fr; const size_t row = (size_t)u.pm * 256 + rl; const float rs = srs[rl];
#pragma unroll
                    for (int bj = 0; bj < 2; ++bj) {
                        if (mode == 2) {
#pragma unroll
                            for (int n = 0; n < 2; ++n) *(f32x4*)(yout + row * D + (u.pn * 256 + bj * 128 + wc * 32 + 16 * n + 4 * fq)) = (acc[ai][bj][m][n] * rs) * gk4[bj][n];
                        } else { u32x2 ok[2];
#pragma unroll
                            for (int n = 0; n < 2; ++n) { const f32x4 k = (acc[ai][bj][m][n] * rs) * gk4[bj][n]; ok[n].x = pk2(k[0], k[1]); ok[n].y = pk2(k[2], k[3]); }
                            st_pair16(HKV + row * D + (u.pn * 256 + bj * 128 + wc * 32), fq, ok[0], ok[1]); } }
                    asm volatile("" ::: "memory"); } }
    } };
template <class E> struct PgE { static constexpr bool PERM = E::PERM, AFTER_DRAIN = false; E e;
    __device__ __forceinline__ void operator()(const pg8::f32x4 (&acc)[2][2][4][2], const pg8::Unit& u, int wr, int wc, int fr, int fq) const {
#pragma unroll
        for (int ai = 0; ai < 2; ++ai)
#pragma unroll
            for (int m = 0; m < 4; ++m) { const int row = u.pm * 256 + ai * 128 + wr * 64 + m * 16 + fr;
                if constexpr (E::PAIRED) {
#pragma unroll
                    for (int n = 0; n < 2; ++n) { const int f = u.pn * 128 + wc * 32 + (E::PERM ? 8 * fq + 4 * n : 16 * n + 4 * fq); e.st2(row, f, acc[ai][0][m][n], acc[ai][1][m][n]); }
                } else {
#pragma unroll
                    for (int bj = 0; bj < 2; ++bj)
#pragma unroll
                        for (int n = 0; n < 2; ++n) { const int col = u.pn * 256 + bj * 128 + wc * 32 + (E::PERM ? 8 * fq + 4 * n : 16 * n + 4 * fq); e.st(row, col, acc[ai][bj][m][n]); }
                }
                asm volatile("" ::: "memory"); }
    } };
template <class E> __device__ __forceinline__ void gemm_prompt(const Ctx& C, const bf16* Ap, const bf16* Bt, int N, int K, const E& e) {
    pg8::Gemm g{Ap, Bt, MP, N, K}; pg8::StaticOrder S; S.init(MP, N, C.G, C.wg); PgE<E> pe{e};
    pg8::gemm_phase<PgE<E>, pg8::StaticOrder, true, true>((PG8_LAS unsigned char*)C.lds, g, S, pe);
}
__device__ __forceinline__ void gemm_prompt_fused(const Ctx& C, const bf16* Ap, const bf16* Bt, int K, const EpResidNorm& e) {
    pg8::Gemm g{Ap, Bt, MP, 1024, K}; pg8::StaticOrder S; S.init(MP, 1024, C.G, C.wg);
    pg8::gemm_phase<EpResidNorm, pg8::StaticOrder, true, true>((PG8_LAS unsigned char*)C.lds, g, S, e);
}
__device__ __forceinline__ void sample_norm_part(const Ctx& C, CArgs& A, int mode, int ls, int pend_ls, const float* pend_bias, bool pend_in, unsigned* flag) {
    if (C.wg >= C.G - 16) {
        phase_norm(C, A, mode, ls, false, pend_ls, pend_bias, pend_in, MP + 8 * (C.wg - (C.G - 16)) + C.wave, MS, R);
        asm volatile("s_waitcnt vmcnt(0)" ::: "memory"); __syncthreads();
        if (C.tid == 0) { __builtin_amdgcn_fence(__ATOMIC_RELEASE, "agent"); asm volatile("s_waitcnt vmcnt(0)" ::: "memory"); (void)xb_add(flag, 1u); }
    }
}
__device__ __forceinline__ void sample_rows_ready(const Ctx& C, unsigned* flag, unsigned* bar) {
    if (C.tid == 0) { XB_SPIN(xb_ld(flag) < 16u, bar); __builtin_amdgcn_fence(__ATOMIC_ACQUIRE, "agent"); asm volatile("s_waitcnt vmcnt(0)" ::: "memory"); }
    __syncthreads();
}
__device__ __forceinline__ void phase_conv(const Ctx& C, CArgs& A, int l) {
    unsigned char* fb = A.fb; const bf16* U = (const bf16*)(fb + F_U); bf16* Cc = (bf16*)(fb + F_C); const float* US = (const float*)(fb + F_US);
    const int c0 = 2 * C.tid;
    constexpr int TOK = 8, NR = 528;
    const unsigned voff2 = (unsigned)c0 * 2u, voff4 = (unsigned)c0 * 4u;
    float w0[31], w1[31];
    { const char* wb = (const char*)(IN_F(14) + ((size_t)l * CONVW) * D);
#pragma unroll
      for (int k = 0; k < 31; ++k) { const float2 w = *(const float2*)(wb + (size_t)k * (D * 4) + voff4); w0[k] = w.x; w1[k] = w.y; } }
    const float2 bdw = *(const float2*)(IN_F(15) + l * D + c0), lg = *(const float2*)(IN_F(16) + l * D + c0), lb = *(const float2*)(IN_F(17) + l * D + c0);
    FLAS float* red = (FLAS float*)C.lds;
    FLAS float* ybuf = (FLAS float*)(C.lds + 65536);
    const int nPU = MP / TOK, nU = nPU + DB;
    for (int u = C.wg; u < nU; u += C.G) {
        int ntok; size_t orow0;
        __syncthreads();
        if (u < nPU) {
            const int row0 = u * TOK, t0 = row0 & 4095; ntok = TOK; orow0 = row0;
            {
                const char* up = (const char*)(U + (size_t)(row0 - 30) * D); float a0[TOK], a1[TOK];
#pragma unroll
                for (int tt = 0; tt < TOK; ++tt) { a0[tt] = bdw.x; a1[tt] = bdw.y; }
                unsigned xv[TOK + 30];
#pragma unroll
                for (int i = 0; i < TOK + 30; ++i) { xv[i] = 0u; if (t0 - 30 + i >= 0) xv[i] = *(const unsigned*)(up + (size_t)i * (D * 2) + voff2); }
#pragma unroll
                for (int i = 0; i < TOK + 30; ++i) { const float x0 = __builtin_bit_cast(float, xv[i] << 16), x1 = __builtin_bit_cast(float, xv[i] & 0xffff0000u);
#pragma unroll
                    for (int tt = 0; tt < TOK; ++tt) { const int k = i - tt; if (k >= 0 && k < 31) { a0[tt] += w0[k] * x0; a1[tt] += w1[k] * x1; } } }
#pragma unroll
                for (int tt = 0; tt < TOK; ++tt) { const int t = tt; ybuf[(t * NTHR + C.tid) * 2] = a0[tt]; ybuf[(t * NTHR + C.tid) * 2 + 1] = a1[tt]; red[(2 * t) * NR + C.tid] = a0[tt] + a1[tt]; red[(2 * t + 1) * NR + C.tid] = a0[tt] * a0[tt] + a1[tt] * a1[tt]; } }
        } else {
            const int b = u - nPU; ntok = 4; orow0 = (size_t)MP + b * 4;
            const char* sp = (const char*)(IN_F(7) + (((size_t)l * DB + b) * 30) * D); const char* usp = (const char*)(US + ((size_t)b * 4) * D);
            for (int t = 0; t < TOK; ++t) { float a0 = bdw.x, a1 = bdw.y;
                if (t < 4) {
#pragma unroll
                    for (int k = 0; k < 31; ++k) { const int j = t + k; const char* p = j < 30 ? sp + (size_t)j * (D * 4) : usp + (size_t)(j - 30) * (D * 4); const float2 v = *(const float2*)(p + voff4);
                        a0 += w0[k] * v.x; a1 += w1[k] * v.y; } }
                ybuf[(t * NTHR + C.tid) * 2] = a0; ybuf[(t * NTHR + C.tid) * 2 + 1] = a1; red[(2 * t) * NR + C.tid] = a0 + a1; red[(2 * t + 1) * NR + C.tid] = a0 * a0 + a1 * a1; }
        }
        __syncthreads();
        { const int v = C.tid >> 5, part = C.tid & 31; float s = 0.f;
#pragma unroll 8
          for (int i = 0; i < 16; ++i) s += red[v * NR + i * 32 + part];
          s += __shfl_xor(s, 1); s += __shfl_xor(s, 2); s += __shfl_xor(s, 4); s += __shfl_xor(s, 8); s += __shfl_xor(s, 16);
          if (part == 0) red[2 * TOK * NR + v] = s; }
        __syncthreads();
        for (int t = 0; t < ntok; ++t) { const float mu = red[2 * TOK * NR + 2 * t] * (1.f / D); const float var = red[2 * TOK * NR + 2 * t + 1] * (1.f / D) - mu * mu; const float rstd = rsqrtf(fmaxf(var, 0.f) + EPS);
            const float yx = ybuf[(t * NTHR + C.tid) * 2], yy = ybuf[(t * NTHR + C.tid) * 2 + 1];
            const float o0 = fsilu((yx - mu) * rstd * lg.x + lb.x), o1 = fsilu((yy - mu) * rstd * lg.y + lb.y);
            *(unsigned*)(Cc + (orow0 + t) * D + c0) = pk2(o0, o1); }
    }
    __syncthreads();
}
#define FK_HAVE_ATTN 1
typedef float f32x16 __attribute__((ext_vector_type(16)));
template <class E> __device__ __forceinline__ void gemm128(const Ctx& C, const bf16* Arows  , int grow0, const bf16* Bt, int K, const E& e, int u) {
    const int fr = C.lane & 15, fq = C.lane >> 4, w = C.wave;
    int brow[2];
    if (E::PAIRED) { const int f = u * 16; brow[0] = 256 * (f >> 7) + (f & 127); brow[1] = brow[0] + 128; } else { brow[0] = u * 32; brow[1] = u * 32 + 16; }
    f32x4 acc[8][2];
#pragma unroll
    for (int rt = 0; rt < 8; ++rt) { acc[rt][0] = (f32x4){0.f, 0.f, 0.f, 0.f}; acc[rt][1] = (f32x4){0.f, 0.f, 0.f, 0.f}; }
    const int kw = K >> 3, k0 = w * kw;
    const bf16* ap = Arows + (size_t)fr * K + k0 + fq * 8; const bf16* bp0 = Bt + (size_t)(brow[0] + fr) * K + k0 + fq * 8; const bf16* bp1 = Bt + (size_t)(brow[1] + fr) * K + k0 + fq * 8;
    bf16x8 b0 = *(const bf16x8*)bp0, b1 = *(const bf16x8*)bp1, a[8];
#pragma unroll
    for (int rt = 0; rt < 8; ++rt) a[rt] = *(const bf16x8*)(ap + (size_t)rt * 16 * K);
#pragma unroll 1
    for (int k = 32; k <= kw; k += 32) { const int kn = k < kw ? k : 0;
        const bf16x8 nb0 = *(const bf16x8*)(bp0 + kn), nb1 = *(const bf16x8*)(bp1 + kn); bf16x8 na[8];
#pragma unroll
        for (int rt = 0; rt < 8; ++rt) na[rt] = *(const bf16x8*)(ap + (size_t)rt * 16 * K + kn);
#pragma unroll
        for (int rt = 0; rt < 8; ++rt) { acc[rt][0] = __builtin_amdgcn_mfma_f32_16x16x32_bf16(b0, a[rt], acc[rt][0], 0, 0, 0); acc[rt][1] = __builtin_amdgcn_mfma_f32_16x16x32_bf16(b1, a[rt], acc[rt][1], 0, 0, 0); }
        b0 = nb0; b1 = nb1;
#pragma unroll
        for (int rt = 0; rt < 8; ++rt) a[rt] = na[rt]; }
    __syncthreads();
    FLAS f32x4* slab = (FLAS f32x4*)C.lds;
#pragma unroll
    for (int rt = 0; rt < 8; ++rt) { slab[((w * 8 + rt) * 2 + 0) * 64 + C.lane] = acc[rt][0]; slab[((w * 8 + rt) * 2 + 1) * 64 + C.lane] = acc[rt][1]; }
    __syncthreads();
    f32x4 s0 = (f32x4){0.f, 0.f, 0.f, 0.f}, s1 = s0;
#pragma unroll
    for (int ww = 0; ww < 8; ++ww) { s0 += slab[((ww * 8 + w) * 2 + 0) * 64 + C.lane]; s1 += slab[((ww * 8 + w) * 2 + 1) * 64 + C.lane]; }
    const int row = grow0 + w * 16 + fr;
    if constexpr (E::PAIRED) e.st2(row, u * 16 + 4 * fq, s0, s1);
    else { e.st(row, u * 32 + 4 * fq, s0); e.st(row, u * 32 + 16 + 4 * fq, s1); }
}
template <class E> __device__ __forceinline__ void gemm_sample(const Ctx& C0, const bf16* As  , const bf16* Bt, int N, int K, const E& e) {
    const Ctx C = refreshed(C0); const int nunits = N / 32;
#ifdef FK_TIMING
    unsigned long long* tsq = (unsigned long long*)(((CArgs*)__builtin_amdgcn_kernarg_segment_ptr())->fb + F_CTL + 65536 + 1024);
    unsigned long long t0 = 0; if (C.wg == FK_TWG && C.tid == 0) t0 = __builtin_amdgcn_s_memrealtime();
#endif
    { const int rank = C.G - 1 - C.wg, half = C.G >> 1;
      if (rank < half) { if (rank < nunits) gemm128(C, As, MP, Bt, K, e, rank);
          for (int u2 = half + (rank - (half >> 1)); rank >= (half >> 1) && u2 < nunits; u2 += half) gemm128(C, As, MP, Bt, K, e, u2); } }
    __syncthreads();
#ifdef FK_TIMING
    if (C.wg == FK_TWG && C.tid == 0) tsq[N == 1024 ? 6 : 7] += __builtin_amdgcn_s_memrealtime() - t0;
#endif
}

__device__ __forceinline__ void gemm_sample_ksplit(const Ctx& C0, const bf16* As  , const bf16* Bt  , int K, float* PART) {
    const Ctx C = refreshed(C0); const int fr = C.lane & 15, fq = C.lane >> 4, w = C.wave, rh = w >> 2, kq = w & 3;
    for (int u = C.wg; u < 256; u += C.G) { const int cg = u & 31, ks = u >> 5; const int nsteps = K >> 8, k0 = ks * (K >> 3);
        f32x4 acc[4][2];
#pragma unroll
        for (int rt = 0; rt < 4; ++rt) { acc[rt][0] = (f32x4){0.f, 0.f, 0.f, 0.f}; acc[rt][1] = (f32x4){0.f, 0.f, 0.f, 0.f}; }
        const bf16* ap = As + (size_t)(64 * rh + fr) * K + k0 + fq * 8; const bf16* bp = Bt + (size_t)(32 * cg + fr) * K + k0 + fq * 8;
#pragma unroll
        for (int i = 0; i < 3; ++i) { const int st = kq + 4 * i; if (st < nsteps) { const bf16x8 b0 = *(const bf16x8*)(bp + 32 * st), b1 = *(const bf16x8*)(bp + (size_t)16 * K + 32 * st);
#pragma unroll
            for (int rt = 0; rt < 4; ++rt) { const bf16x8 a = *(const bf16x8*)(ap + (size_t)rt * 16 * K + 32 * st);
                acc[rt][0] = __builtin_amdgcn_mfma_f32_16x16x32_bf16(b0, a, acc[rt][0], 0, 0, 0); acc[rt][1] = __builtin_amdgcn_mfma_f32_16x16x32_bf16(b1, a, acc[rt][1], 0, 0, 0); } } }
        __syncthreads();
        FLAS f32x4* slab = (FLAS f32x4*)C.lds;
#pragma unroll
        for (int rt = 0; rt < 4; ++rt) { slab[(w * 8 + rt * 2 + 0) * 64 + C.lane] = acc[rt][0]; slab[(w * 8 + rt * 2 + 1) * 64 + C.lane] = acc[rt][1]; }
        __syncthreads();
#pragma unroll
        for (int h = 0; h < 2; ++h) { const int pi = kq * 2 + h, rt = pi >> 1, ct = pi & 1; f32x4 sv = slab[((rh * 4 + 0) * 8 + pi) * 64 + C.lane];
#pragma unroll
            for (int x = 1; x < 4; ++x) sv += slab[((rh * 4 + x) * 8 + pi) * 64 + C.lane];
            *(f32x4*)(PART + ((size_t)ks * MS + 64 * rh + 16 * rt + fr) * D + 32 * cg + 16 * ct + 4 * fq) = sv; }
    }
    __syncthreads();
}

__device__ __forceinline__ void phase_qkv(const Ctx& C0, CArgs& A, int l) {
    unsigned char* fb = A.fb; const bf16* HF = (const bf16*)(fb + F_H); const bf16* HKV = (const bf16*)(fb + F_HKV);
    unsigned* flag = (unsigned*)(fb + F_CTL) + 32768 + 64 * (2 * l - 1);
    { const Ctx C = refreshed(C0); sample_norm_part(C, A, l == 2 ? 1 : 0, 2 * l, 2 * l - 1, nullptr, false, flag); }
    if (l == 2) { const Ctx C = refreshed(C0); EpKV e{A.out, (bf16*)(fb + F_RB)}; gemm_prompt(C, HKV, (const bf16*)(fb + F_WKV), KVW, 1024, e); }
    { const Ctx C = refreshed(C0); EpQ e{(bf16*)(fb + F_Q)}; gemm_prompt(C, HF, (const bf16*)(fb + F_WQ) + (size_t)(l - 2) * 1024 * 1024, 1024, 1024, e); }
    { const Ctx C = refreshed(C0); sample_rows_ready(C, flag, (unsigned*)(fb + F_CTL) + 1024); }
    if (l == 2) { const Ctx C = refreshed(C0); EpKV e{A.out, (bf16*)(fb + F_RB)}; gemm_sample(C, HKV + (size_t)MP * D, (const bf16*)(fb + F_WKV), KVW, 1024, e); }
    { const Ctx C = refreshed(C0); gemm_sample_ksplit(C, HF + (size_t)MP * D, (const bf16*)(fb + F_WQ) + (size_t)(l - 2) * 1024 * 1024, 1024, (float*)(fb + F_QPART)); }
    { const Ctx C = refreshed(C0); EpGates e{(float*)(fb + F_GT)}; const bf16* W = (const bf16*)(fb + F_WG) + (size_t)(l - 2) * 64 * 1024;
      for (int it = (C.wg + 64) % C.G; it < 2 * (R / 128); it += C.G) gemm128(C, HF + (size_t)(it >> 1) * 128 * D, (it >> 1) * 128, W, 1024, e, it & 1);
      __syncthreads(); }
}

__device__ __forceinline__ void compress_prompt_wg(const Ctx& C, CArgs& A, int task) {
    unsigned char* fb = A.fb; const int fr = C.lane & 15, fq = C.lane >> 4, nl = fr >> 2, g = fr & 3, w = C.wave;
    const int e = task & 1, grp = (task >> 1) & 31, b = task >> 6;
    const bf16* W1 = (const bf16*)(fb + F_WPHI1) + (size_t)e * 128 * 2048; const bf16* W2 = (const bf16*)(fb + F_WPHI2) + (size_t)e * 64 * 128;
    f32x4 acc[8];
#pragma unroll
    for (int j = 0; j < 8; ++j) acc[j] = (f32x4){0.f, 0.f, 0.f, 0.f};
    const bf16* w1p = W1 + (size_t)fr * 2048 + fq * 8 + w * 256;
    const bf16* ap = (const bf16*)(fb + F_RB) + ((size_t)b * SEQ + (grp * 4 + nl) * 32 + 4 * w) * KVW + e * 256 + g * 64 + fq * 8;
#pragma unroll 2
    for (int s2 = 0; s2 < 8; ++s2) { const bf16x8 a = *(const bf16x8*)(ap + (size_t)(s2 >> 1) * KVW + (s2 & 1) * 32);
#pragma unroll
        for (int j = 0; j < 8; ++j) { const bf16x8 wv = *(const bf16x8*)(w1p + (size_t)j * 16 * 2048 + s2 * 32); acc[j] = __builtin_amdgcn_mfma_f32_16x16x32_bf16(wv, a, acc[j], 0, 0, 0); } }
    FLAS f32x4* slab = (FLAS f32x4*)C.lds;
    FLAS bf16* hid = (FLAS bf16*)(C.lds + 65536);
#pragma unroll
    for (int j = 0; j < 8; ++j) slab[(w * 8 + j) * 64 + C.lane] = acc[j];
    __syncthreads();
    { f32x4 h = (f32x4){0.f, 0.f, 0.f, 0.f};
#pragma unroll
      for (int ww = 0; ww < 8; ++ww) h += slab[(ww * 8 + w) * 64 + C.lane];
      const f32x4 bb = *(const f32x4*)((const float*)(fb + F_BPHI) + 4096 + e * PHI + 16 * w + 4 * fq);
      u32x2 o; o.x = pk2(fsilu(h[0] + bb[0]), fsilu(h[1] + bb[1])); o.y = pk2(fsilu(h[2] + bb[2]), fsilu(h[3] + bb[3]));
      *(FLAS u32x2*)(hid + fr * 136 + 16 * w + 4 * fq) = o; }
    __syncthreads();
    if (w < 4) { const int jj = w; f32x4 o2 = (f32x4){0.f, 0.f, 0.f, 0.f};
#pragma unroll
        for (int kq = 0; kq < 4; ++kq) { const bf16x8 a2 = *(const FLAS bf16x8*)(hid + fr * 136 + 32 * kq + 8 * fq); const bf16x8 wv = *(const bf16x8*)(W2 + (size_t)(16 * jj + fr) * 128 + 32 * kq + 8 * fq);
            o2 = __builtin_amdgcn_mfma_f32_16x16x32_bf16(wv, a2, o2, 0, 0, 0); }
        const int n = grp * 4 + nl, od = 16 * jj + 4 * fq; const f32x4 v = o2 + *(const f32x4*)(IN_F(25) + e * 64 + od);
        if (e == 0) { u32x2 o; o.x = pk2(v[0], v[1]); o.y = pk2(v[2], v[3]); *(u32x2*)((bf16*)(fb + F_CMPK) + (((size_t)b * 4 + g) * 128 + n) * 64 + od) = o; }
        else { bf16* vt = (bf16*)(fb + F_CMPVT) + (((size_t)b * 4 + g) * 64 + od) * 128 + n;
#pragma unroll
            for (int r = 0; r < 4; ++r) vt[r * 128] = (bf16)f2bf(v[r]); } }
    __syncthreads();
}
__device__ __forceinline__ void compress_sample_round(const Ctx& C, CArgs& A, int round) {
    unsigned char* fb = A.fb; const int fr = C.lane & 15, fq = C.lane >> 4, nl = fr >> 2, g = fr & 3, tid = C.tid;
    const int e = round & 1, pg = ((round >> 1) & 7) * 8 + C.wave, b = round >> 4;
    const bf16* W1 = (const bf16*)(fb + F_WPHI1) + (size_t)e * 128 * 2048; const bf16* W2 = (const bf16*)(fb + F_WPHI2) + (size_t)e * 64 * 128;
    FLAS unsigned char* L = C.lds;
    const int page = ((const int*)A.in[8])[b * NPAGES + pg];
    const float* ap = IN_F(4) + ((((size_t)page * PAGE + nl * 32) * 2 + e) * 4 + g) * 64 + fq * 8;
    f32x4 acc[8];
#pragma unroll
    for (int j = 0; j < 8; ++j) acc[j] = (f32x4){0.f, 0.f, 0.f, 0.f};
    f32x4 xa[8], xb[8];
#define CS_LOAD(dst, blk) { _Pragma("unroll") for (int q4 = 0; q4 < 4; ++q4) { const int s_ = (blk) * 4 + q4; const float* p_ = ap + (size_t)(s_ >> 1) * 512 + (s_ & 1) * 32; \
        dst[2 * q4] = __builtin_nontemporal_load((const f32x4*)p_); dst[2 * q4 + 1] = __builtin_nontemporal_load((const f32x4*)(p_ + 4)); } }
#define CS_COMP(src, blk) { _Pragma("unroll") for (int q4 = 0; q4 < 4; ++q4) { const int kl_ = ((blk) & 1) * 4 + q4; \
        u32x4 pa_; pa_.x = pk2(src[2 * q4][0], src[2 * q4][1]); pa_.y = pk2(src[2 * q4][2], src[2 * q4][3]); pa_.z = pk2(src[2 * q4 + 1][0], src[2 * q4 + 1][1]); pa_.w = pk2(src[2 * q4 + 1][2], src[2 * q4 + 1][3]); \
        const bf16x8 a_ = __builtin_bit_cast(bf16x8, pa_); \
        _Pragma("unroll") for (int j = 0; j < 8; ++j) { const bf16x8 w_ = *(const FLAS bf16x8*)(L + (16 * j + fr) * 528 + (kl_ * 32 + fq * 8) * 2); acc[j] = __builtin_amdgcn_mfma_f32_16x16x32_bf16(w_, a_, acc[j], 0, 0, 0); } } }
    CS_LOAD(xa, 0)
#pragma unroll 1
    for (int c = 0; c < 8; ++c) {
        __syncthreads();
        u32x4 wst[8];
#pragma unroll
        for (int i = 0; i < 8; ++i) { const int idx = tid + NTHR * i, nn = idx >> 5, ch = idx & 31; wst[i] = *(const u32x4*)(W1 + (size_t)nn * 2048 + c * 256 + ch * 8); }
        CS_LOAD(xb, 2 * c + 1)
#pragma unroll
        for (int i = 0; i < 8; ++i) { const int idx = tid + NTHR * i, nn = idx >> 5, ch = idx & 31; *(FLAS u32x4*)(L + nn * 528 + ch * 16) = wst[i]; }
        __syncthreads();
        CS_COMP(xa, 2 * c)
        if (c < 7) CS_LOAD(xa, 2 * c + 2)
        CS_COMP(xb, 2 * c + 1)
    }
#undef CS_LOAD
#undef CS_COMP
    const float* bph = (const float*)(fb + F_BPHI) + 4096 + e * PHI; const float* b2 = IN_F(25) + e * 64;
#pragma unroll
    for (int j = 0; j < 8; ++j) { const f32x4 bb = *(const f32x4*)(bph + 16 * j + 4 * fq);
#pragma unroll
        for (int r = 0; r < 4; ++r) acc[j][r] = fsilu(acc[j][r] + bb[r]); }
    f32x4 o2[4];
#pragma unroll
    for (int jj = 0; jj < 4; ++jj) o2[jj] = (f32x4){0.f, 0.f, 0.f, 0.f};
#pragma unroll
    for (int kq = 0; kq < 4; ++kq) {
        u32x4 pa; pa.x = pk2(acc[2 * kq][0], acc[2 * kq][1]); pa.y = pk2(acc[2 * kq][2], acc[2 * kq][3]); pa.z = pk2(acc[2 * kq + 1][0], acc[2 * kq + 1][1]); pa.w = pk2(acc[2 * kq + 1][2], acc[2 * kq + 1][3]);
        const bf16x8 a2 = __builtin_bit_cast(bf16x8, pa);
#pragma unroll
        for (int jj = 0; jj < 4; ++jj) { const bf16* wp = W2 + (size_t)(16 * jj + fr) * 128 + 32 * kq + 4 * fq; const u32x2 lo = *(const u32x2*)wp, hi = *(const u32x2*)(wp + 16);
            u32x4 pw; pw.x = lo.x; pw.y = lo.y; pw.z = hi.x; pw.w = hi.y; o2[jj] = __builtin_amdgcn_mfma_f32_16x16x32_bf16(__builtin_bit_cast(bf16x8, pw), a2, o2[jj], 0, 0, 0); } }
    const int n = pg * 4 + nl;
#pragma unroll
    for (int jj = 0; jj < 4; ++jj) { const int od = 16 * jj + 4 * fq; const f32x4 v = o2[jj] + *(const f32x4*)(b2 + od);
        if (e == 0) { u32x2 o; o.x = pk2(v[0], v[1]); o.y = pk2(v[2], v[3]); *(u32x2*)((bf16*)(fb + F_CMPS) + (((size_t)b * 4 + g) * 256 + n) * 64 + od) = o; }
        else { bf16* vt = (bf16*)(fb + F_CMPS) + (size_t)DB * 4 * 256 * 64 + (((size_t)b * 4 + g) * 64 + od) * 256 + n;
#pragma unroll
            for (int r = 0; r < 4; ++r) vt[r * 256] = (bf16)f2bf(v[r]); } }
}
__device__ __forceinline__ void phase_prep(const Ctx& C, CArgs& A) {
    unsigned char* fb = A.fb; const bf16* RB = (const bf16*)(fb + F_RB); bf16* VT = (bf16*)(fb + F_VT);
    FLAS unsigned char* scr = C.lds + C.wave * 9216;
    for (int it = C.gw; it < 2048; it += C.ngw) {
        const int tc = it & 63, g = (it >> 6) & 3, b = (it >> 8) & 3, br = it >> 10; const int t0 = tc * 64, col0 = 512 * (br + 1) + 256 + g * 64;
#pragma unroll
        for (int i = 0; i < 8; ++i) { const int tok = i * 8 + (C.lane >> 3), ch = C.lane & 7; *(FLAS u32x4*)(scr + tok * 144 + ch * 16) = *(const u32x4*)(RB + ((size_t)b * SEQ + t0 + tok) * KVW + col0 + ch * 8); }
        asm volatile("s_waitcnt lgkmcnt(0)" ::: "memory");
        bf16* dst = VT + ((((size_t)br * 4 + b) * 4 + g) * 64 + C.lane) * SEQ + t0;
#pragma unroll
        for (int i = 0; i < 8; ++i) { unsigned w[4];
#pragma unroll
            for (int j = 0; j < 4; ++j) { const unsigned lo = *(const FLAS unsigned short*)(scr + (8 * i + 2 * j) * 144 + C.lane * 2), hi = *(const FLAS unsigned short*)(scr + (8 * i + 2 * j + 1) * 144 + C.lane * 2); w[j] = lo | (hi << 16); }
            u32x4 o; o.x = w[0]; o.y = w[1]; o.z = w[2]; o.w = w[3]; *(u32x4*)(dst + 8 * i) = o; }
        asm volatile("s_waitcnt lgkmcnt(0)" ::: "memory");
    }
    __syncthreads();
    for (int task = C.wg; task < 256; task += C.G) compress_prompt_wg(C, A, task);
    for (int rd = C.wg; rd < 512; rd += C.G) compress_sample_round(C, A, rd);
    __syncthreads();
}

__device__ __forceinline__ float dpp_xor1(float v) { return __builtin_bit_cast(float, __builtin_amdgcn_update_dpp(0, __builtin_bit_cast(int, v), 0xB1, 0xF, 0xF, true)); }
__device__ __forceinline__ float dpp_xor2(float v) { return __builtin_bit_cast(float, __builtin_amdgcn_update_dpp(0, __builtin_bit_cast(int, v), 0x4E, 0xF, 0xF, true)); }
template <int N> struct IC { static constexpr int value = N; };
__device__ __forceinline__ int swz23(int m) { return (m & 0x13) | ((m & 4) << 1) | ((m & 8) >> 1); }
constexpr int AL_KB0 = 0, AL_VB0 = 9216, AL_KB1 = 18432, AL_VB1 = 27648, AL_LUT = 36864, AL_CK = 51712, AL_CV = 70144, AL_IMP = 87552, AL_SELM = 103936, AL_SCR = 104448, AL_LUTW = 110592  , AL_STASH = AL_CK;
constexpr int DMAXB = 790, LUTN = 928, LUTO = 64;
__device__ __forceinline__ bf16x8 pack8(const f32x16& p, int s) {
    u32x4 o; o.x = pk2(p[8 * s], p[8 * s + 1]); o.y = pk2(p[8 * s + 2], p[8 * s + 3]); o.z = pk2(p[8 * s + 4], p[8 * s + 5]); o.w = pk2(p[8 * s + 6], p[8 * s + 7]); return __builtin_bit_cast(bf16x8, o); }

__device__ __forceinline__ void attn_prompt_unit(const Ctx& C, CArgs& A, int b, int g, int qt, bool load_bg) {
    unsigned char* fb = A.fb; FLAS unsigned char* L = C.lds;
    const bf16* RB = (const bf16*)(fb + F_RB); const bf16* VT = (const bf16*)(fb + F_VT); const bf16* Q = (const bf16*)(fb + F_Q); const float* GT = (const float*)(fb + F_GT);
    const int tid = C.tid, lane = C.lane, w = C.wave, n = lane & 31, h = lane >> 5, ql = n >> 2, r = n & 3;
    const int q0 = qt * 64, qpos = q0 + 8 * w + ql, jq = qt; const size_t qrow = (size_t)b * SEQ + qpos;
    __syncthreads();
    {
        const bf16* ck = (const bf16*)(fb + F_CMPK) + ((size_t)b * 4 + g) * 128 * 64; const bf16* cv = (const bf16*)(fb + F_CMPVT) + ((size_t)b * 4 + g) * 64 * 128;
        for (int i = tid; i < 1024; i += NTHR) { const int key = i >> 3, ch = i & 7; *(FLAS u32x4*)(L + AL_CK + key * 144 + ch * 16) = *(const u32x4*)(ck + key * 64 + ch * 8); }
        for (int i = tid; i < 1024; i += NTHR) { const int dim = i >> 4, ch = i & 15; *(FLAS u32x4*)(L + AL_CV + dim * 272 + ch * 16) = *(const u32x4*)(cv + dim * 128 + ch * 8); }
        if (load_bg) for (int i = tid; i < LUTN * 4; i += NTHR) { const int d = (i >> 2) - LUTO, rr = i & 3; const float bv = IN_F(29)[rel_bucket(d) * 16 + g * 4 + rr] * LOG2E;
            ((FLAS float*)(L + AL_LUT))[i] = d < 0 ? -INFINITY : bv; if (i < 640 * 4) ((FLAS float*)(L + AL_LUTW))[i] = (d < 0 || d >= 512) ? -INFINITY : bv; }
    }
    bf16x8 qf[4];
#pragma unroll
    for (int s = 0; s < 4; ++s) qf[s] = *(const bf16x8*)(Q + qrow * D + (g * 4 + r) * 64 + 16 * s + 8 * h);
    const float gt0 = GT[qrow * 64 + (g * 4 + r) * 3 + 0], gt1 = GT[qrow * 64 + (g * 4 + r) * 3 + 1], gt2 = GT[qrow * 64 + (g * 4 + r) * 3 + 2];
    __syncthreads();
    const FLAS float* LUT = (const FLAS float*)(L + AL_LUT);
    FLAS u32x2* stash = (FLAS u32x2*)(L + AL_STASH) + (w * 64 + lane) * 8;
    const int krow = swz23(n);
    {
        f32x16 S[4]; float mx = -1e30f;
#pragma unroll
        for (int sub = 0; sub < 4; ++sub) { f32x16 acc;
#pragma unroll
            for (int i = 0; i < 16; ++i) acc[i] = 0.f;
#pragma unroll
            for (int ks = 0; ks < 4; ++ks) { const bf16x8 a = *(const FLAS bf16x8*)(L + AL_CK + (32 * sub + krow) * 144 + (16 * ks + 8 * h) * 2); acc = __builtin_amdgcn_mfma_f32_32x32x16_bf16(a, qf[ks], acc, 0, 0, 0); }
#pragma unroll
            for (int i = 0; i < 16; ++i) { const int nb = 32 * sub + (i & 7) + 8 * h + 16 * (i >> 3); const int d = qpos - (32 * nb + 31); const bool valid = d >= 0;
                const int dc = d > DMAXB ? DMAXB : (d < 0 ? 0 : d); const float bias = LUT[(dc + LUTO) * 4 + r]; float v = acc[i] + bias; v = valid ? v : -INFINITY; acc[i] = v; mx = fmaxf(mx, v); }
            S[sub] = acc; }
        mx = xmax32(mx);
        float sum = 0.f;
#pragma unroll
        for (int sub = 0; sub < 4; ++sub)
#pragma unroll
            for (int i = 0; i < 16; ++i) { const float p = __builtin_amdgcn_exp2f(S[sub][i] - mx); S[sub][i] = p; sum += p; }
        sum = xsum32(sum);
        const float inv = sum > 0.f ? 1.f / sum : 0.f;
        f32x16 oc[2];
#pragma unroll
        for (int d2 = 0; d2 < 2; ++d2)
#pragma unroll
            for (int i = 0; i < 16; ++i) oc[d2][i] = 0.f;
        FLAS float* IMP = (FLAS float*)(L + AL_IMP) + (w * 8 + ql) * 64;
#pragma unroll
        for (int sub = 0; sub < 4; ++sub) {
#pragma unroll
            for (int i = 0; i < 16; ++i) S[sub][i] *= inv;
#pragma unroll
            for (int i = 0; i < 16; i += 2) { float v = S[sub][i] + S[sub][i + 1]; v += dpp_xor1(v); v += dpp_xor2(v);
                const int j = 16 * sub + ((i & 7) >> 1) + 4 * h + 8 * (i >> 3); if (r == 0) IMP[j] = v; }
#pragma unroll
            for (int s = 0; s < 2; ++s) { const bf16x8 pb = pack8(S[sub], s);
#pragma unroll
                for (int d2 = 0; d2 < 2; ++d2) { const bf16x8 a = *(const FLAS bf16x8*)(L + AL_CV + (32 * d2 + n) * 272 + (32 * sub + 16 * s + 8 * h) * 2); oc[d2] = __builtin_amdgcn_mfma_f32_32x32x16_bf16(a, pb, oc[d2], 0, 0, 0); } }
        }
#pragma unroll
        for (int d2 = 0; d2 < 2; ++d2) oc[d2] *= gt0;
        __syncthreads();
#pragma unroll
        for (int d2 = 0; d2 < 2; ++d2)
#pragma unroll
            for (int c = 0; c < 4; ++c) { u32x2 o; o.x = pk2(oc[d2][4 * c], oc[d2][4 * c + 1]); o.y = pk2(oc[d2][4 * c + 2], oc[d2][4 * c + 3]); stash[d2 * 4 + c] = o; }
    }
    asm volatile("s_waitcnt lgkmcnt(0)" ::: "memory");
    {
        FLAS unsigned long long* SCR64 = (FLAS unsigned long long*)(L + AL_SCR) + w * 64; FLAS unsigned* SELM = (FLAS unsigned*)(L + AL_SELM) + w * 16;
        for (int qq = 0; qq < 8; ++qq) {
            unsigned long long mask;
            if (jq < 16) mask = (2ull << jq) - 1ull;
            else {
                const int j = lane; const float impj = ((const FLAS float*)(L + AL_IMP))[(w * 8 + qq) * 64 + j];
                const bool forced = (j == 0) || (j == jq) || (j == jq - 1); const bool okj = j <= jq; const float sj = forced ? 1e4f : impj;
                const unsigned long long keyj = okj ? (((unsigned long long)(__builtin_bit_cast(unsigned, sj) + 1u) << 32) | (unsigned)(63 - j)) : 0ull;
                SCR64[j] = keyj; asm volatile("s_waitcnt lgkmcnt(0)" ::: "memory");
                int rank = 0;
#pragma unroll
                for (int i2 = 0; i2 < 32; ++i2) { const u32x4 kv = *(const FLAS u32x4*)(SCR64 + 2 * i2);
                    const unsigned long long k0 = ((unsigned long long)kv.y << 32) | kv.x, k1 = ((unsigned long long)kv.w << 32) | kv.z;
                    rank += (k0 > keyj) ? 1 : 0; rank += (k1 > keyj) ? 1 : 0; }
                mask = __ballot(rank < 16 && okj);
                asm volatile("s_waitcnt lgkmcnt(0)" ::: "memory");
            }
            if (lane == 0) { SELM[2 * qq] = (unsigned)mask; SELM[2 * qq + 1] = (unsigned)(mask >> 32); }
        }
        asm volatile("s_waitcnt lgkmcnt(0)" ::: "memory");
    }
    const unsigned selLo = ((const FLAS unsigned*)(L + AL_SELM))[w * 16 + 2 * ql], selHi = ((const FLAS unsigned*)(L + AL_SELM))[w * 16 + 2 * ql + 1];
    const int jw0 = jq - 8 > 0 ? jq - 8 : 0; const int NTL = (jq + 1) + (jq - jw0 + 1);
    const int skey = tid >> 3, sch = tid & 7;
    const bf16* kbase = RB + ((size_t)b * SEQ + skey) * KVW + g * 64 + sch * 8;
    const bf16* vbase = VT + (((size_t)b * 4 + g) * 64 + skey) * SEQ + sch * 8;
    float m = -1e30f, lsum = 0.f; f32x16 oa[2];
#pragma unroll
    for (int d2 = 0; d2 < 2; ++d2)
#pragma unroll
        for (int i = 0; i < 16; ++i) oa[d2][i] = 0.f;
    u32x4 kreg0, vreg0, kreg1, vreg1;
    { kreg0 = *(const u32x4*)(kbase + 512); vreg0 = *(const u32x4*)vbase; }
    { const bool nw = 1 > jq; const int nj = nw ? jw0 : 1; kreg1 = *(const u32x4*)(kbase + (size_t)64 * nj * KVW + (nw ? 1024 : 512)); vreg1 = *(const u32x4*)(vbase + (nw ? (size_t)16 * 64 * SEQ : 0) + 64 * nj); }
    *(FLAS u32x4*)(L + AL_KB0 + skey * 144 + sch * 16) = kreg0; *(FLAS u32x4*)(L + AL_VB0 + skey * 144 + sch * 16) = vreg0;
    __syncthreads();
    const float b31 = LUT[(DMAXB + LUTO) * 4 + r];
    for (int ti = 0; ti < NTL; ++ti) {
        const bool isw = ti > jq; const int j = isw ? jw0 + (ti - jq - 1) : ti; const int buf = ti & 1;
        kreg0 = kreg1; vreg0 = vreg1;
        if (ti + 2 < NTL) { const bool nw = (ti + 2) > jq; const int nj = nw ? jw0 + (ti + 1 - jq) : ti + 2;
            kreg1 = *(const u32x4*)(kbase + (size_t)64 * nj * KVW + (nw ? 1024 : 512)); vreg1 = *(const u32x4*)(vbase + (nw ? (size_t)16 * 64 * SEQ : 0) + 64 * nj); }
        if (ti == jq + 1) {
            const float lt = xsum32(lsum); const float f = lt > 0.f ? gt1 / lt : 0.f;
#pragma unroll
            for (int d2 = 0; d2 < 2; ++d2) {
#pragma unroll
                for (int c = 0; c < 4; ++c) { const u32x2 o = stash[d2 * 4 + c]; u32x2 n2;
                    n2.x = pk2(__builtin_bit_cast(float, o.x << 16) + oa[d2][4 * c] * f, __builtin_bit_cast(float, o.x & 0xffff0000u) + oa[d2][4 * c + 1] * f);
                    n2.y = pk2(__builtin_bit_cast(float, o.y << 16) + oa[d2][4 * c + 2] * f, __builtin_bit_cast(float, o.y & 0xffff0000u) + oa[d2][4 * c + 3] * f); stash[d2 * 4 + c] = n2; }
#pragma unroll
                for (int i = 0; i < 16; ++i) oa[d2][i] = 0.f; }
            m = -1e30f; lsum = 0.f; }
        const bool selbit = ((j < 32 ? selLo >> j : selHi >> (j - 32)) & 1u) != 0u;
        const bool active = isw ? true : (__any(selbit) != 0);
        if (active) {
            const FLAS unsigned char* KB = L + (buf ? AL_KB1 : AL_KB0); const FLAS unsigned char* VB = L + (buf ? AL_VB1 : AL_VB0);
            f32x16 S[2];
            { bf16x8 kf[2][4];
#pragma unroll
              for (int sub = 0; sub < 2; ++sub)
#pragma unroll
                  for (int ks = 0; ks < 4; ++ks) kf[sub][ks] = *(const FLAS bf16x8*)(KB + (32 * sub + krow) * 144 + (16 * ks + 8 * h) * 2);
              __builtin_amdgcn_sched_barrier(0);
#pragma unroll
              for (int sub = 0; sub < 2; ++sub) { f32x16 acc;
#pragma unroll
                  for (int i = 0; i < 16; ++i) acc[i] = 0.f;
#pragma unroll
                  for (int ks = 0; ks < 4; ++ks) acc = __builtin_amdgcn_mfma_f32_32x32x16_bf16(kf[sub][ks], qf[ks], acc, 0, 0, 0);
                  S[sub] = acc; }
            }
            const int dbase = qpos - 64 * j;
            const bool far = !isw && ((q0 + 8 * w) - (64 * j + 63) >= DMAXB);
            auto body = [&](auto tag) { constexpr int MODE = decltype(tag)::value;
                float tmax = -INFINITY, poff;
                if constexpr (MODE == 0) {
#pragma unroll
                    for (int sub = 0; sub < 2; ++sub)
#pragma unroll
                        for (int i = 0; i < 16; ++i) tmax = fmaxf(tmax, S[sub][i]);
                    tmax = selbit ? tmax + b31 : -INFINITY;
                } else {
                    const int dl = dbase - 8 * h;
                    const int dle = (MODE == 2 || selbit) ? dl : -1;
                    const FLAS float* lpb = (MODE == 2 ? (const FLAS float*)(L + AL_LUTW) : LUT) + ((dle + LUTO - 55) * 4 + r);
                    float bv[2][16];
#pragma unroll
                    for (int sub = 0; sub < 2; ++sub)
#pragma unroll
                        for (int i = 0; i < 16; ++i) { const int koff = 32 * sub + (i & 7) + 16 * (i >> 3); bv[sub][i] = lpb[(55 - koff) * 4]; }
                    __builtin_amdgcn_sched_barrier(0);
#pragma unroll
                    for (int sub = 0; sub < 2; ++sub)
#pragma unroll
                        for (int i = 0; i < 16; ++i) { const float v = S[sub][i] + bv[sub][i]; S[sub][i] = v; tmax = fmaxf(tmax, v); }
                }
                tmax = xmax32(tmax);
                const float mnew = fmaxf(m, tmax); const float sc = __builtin_amdgcn_exp2f(m - mnew); m = mnew;
                poff = MODE == 0 ? (selbit ? b31 - mnew : -INFINITY) : -mnew;
                float ps = 0.f;
#pragma unroll
                for (int sub = 0; sub < 2; ++sub)
#pragma unroll
                    for (int i = 0; i < 16; ++i) { const float p = __builtin_amdgcn_exp2f(S[sub][i] + poff); S[sub][i] = p; ps += p; }
                lsum = lsum * sc + ps;
#pragma unroll
                for (int d2 = 0; d2 < 2; ++d2) oa[d2] *= sc;
#pragma unroll
                for (int sub = 0; sub < 2; ++sub)
#pragma unroll
                    for (int s2 = 0; s2 < 2; ++s2) { const bf16x8 pb = pack8(S[sub], s2);
#pragma unroll
                        for (int d2 = 0; d2 < 2; ++d2) { const bf16x8 av = *(const FLAS bf16x8*)(VB + (32 * d2 + n) * 144 + (32 * sub + 16 * s2 + 8 * h) * 2); oa[d2] = __builtin_amdgcn_mfma_f32_32x32x16_bf16(av, pb, oa[d2], 0, 0, 0); } }
            };
            if (isw) body(IC<2>{}); else if (far) body(IC<0>{}); else body(IC<1>{});
        }
        if (ti + 1 < NTL) { FLAS unsigned char* KBn = L + (buf ? AL_KB0 : AL_KB1); FLAS unsigned char* VBn = L + (buf ? AL_VB0 : AL_VB1);
            *(FLAS u32x4*)(KBn + skey * 144 + sch * 16) = kreg0; *(FLAS u32x4*)(VBn + skey * 144 + sch * 16) = vreg0; }
        __syncthreads();
    }
    { const float lt = xsum32(lsum); const float f = lt > 0.f ? gt2 / lt : 0.f;
#pragma unroll
      for (int d2 = 0; d2 < 2; ++d2) oa[d2] *= f; }
    bf16* op = (bf16*)(fb + F_O) + qrow * D + (g * 4 + r) * 64;
#pragma unroll
    for (int d2 = 0; d2 < 2; ++d2)
#pragma unroll
        for (int c = 0; c < 4; ++c) { const u32x2 sv = stash[d2 * 4 + c]; u32x2 o;
            o.x = pk2(__builtin_bit_cast(float, sv.x << 16) + oa[d2][4 * c], __builtin_bit_cast(float, sv.x & 0xffff0000u) + oa[d2][4 * c + 1]);
            o.y = pk2(__builtin_bit_cast(float, sv.y << 16) + oa[d2][4 * c + 2], __builtin_bit_cast(float, sv.y & 0xffff0000u) + oa[d2][4 * c + 3]); *(u32x2*)(op + 32 * d2 + 8 * c + 4 * h) = o; }
}

typedef short v4i16_t __attribute__((ext_vector_type(4)));
__device__ __forceinline__ float fexp2(float x) { return __builtin_amdgcn_exp2f(x); }
constexpr int SM_LUT = 0, SM_P = 12800, SM_ML = 29184, SM_FAC = 29696, SM_SC = 29952, SM_SELQ = 32064, SM_PUB0 = 12800  , SM_LIST = 45568, SM_NIT = 46112, SM_V = 46208, SM_PUBML = 119936;
constexpr int SDMAX = 790;
struct SAcc { float m, l; f32x4 o[4]; };
__device__ __forceinline__ void sa_init(SAcc& a) { a.m = -1e30f; a.l = 0.f;
#pragma unroll
    for (int dt = 0; dt < 4; ++dt) a.o[dt] = (f32x4){0.f, 0.f, 0.f, 0.f}; }
__device__ __forceinline__ bf16x8 pack44(const f32x4& x, const f32x4& y) { u32x4 o; o.x = pk2(x[0], x[1]); o.y = pk2(x[2], x[3]); o.z = pk2(y[0], y[1]); o.w = pk2(y[2], y[3]); return __builtin_bit_cast(bf16x8, o); }
__device__ __forceinline__ void sa_update(f32x4 (&S)[4], SAcc& a, bf16x8 (&P)[2]) {
    float tmax = fmaxf(fmaxf(S[0][0], S[0][1]), fmaxf(S[0][2], S[0][3]));
#pragma unroll
    for (int kt = 1; kt < 4; ++kt) tmax = fmaxf(tmax, fmaxf(fmaxf(S[kt][0], S[kt][1]), fmaxf(S[kt][2], S[kt][3])));
    tmax = fmaxf(tmax, __shfl_xor(tmax, 16)); tmax = xmax32(tmax);
    const float mnew = fmaxf(a.m, tmax), sc = fexp2(a.m - mnew); a.m = mnew;
    float ps = 0.f;
#pragma unroll
    for (int kt = 0; kt < 4; ++kt)
#pragma unroll
        for (int t = 0; t < 4; ++t) { const float p = fexp2(S[kt][t] - mnew); S[kt][t] = p; ps += p; }
    a.l = a.l * sc + ps;
#pragma unroll
    for (int dt = 0; dt < 4; ++dt) a.o[dt] *= sc;
    P[0] = pack44(S[0], S[1]); P[1] = pack44(S[2], S[3]);
}
__device__ __forceinline__ void sa_block_f32(FLAS unsigned char* Vt, int lane, const float* kb, const float* vb, int nk, const bf16x8 (&qf)[2], SAcc& a, const FLAS float* lut, int d0, int dmax, bool rowok) {
    const int fr = lane & 15, fq = lane >> 4, r = fr & 3;
    f32x4 kr[4][4];
#pragma unroll
    for (int kt = 0; kt < 4; ++kt) { const int kk = 32 * (kt >> 1) + 8 * (fr >> 2) + 4 * (kt & 1) + (fr & 3); const float* kp = kb + (size_t)kk * 512 + 8 * fq;
        kr[kt][0] = *(const f32x4*)kp; kr[kt][1] = *(const f32x4*)(kp + 4); kr[kt][2] = *(const f32x4*)(kp + 32); kr[kt][3] = *(const f32x4*)(kp + 36); }
    f32x4 vr[8][2]; const float* vp0 = vb + (size_t)(lane >> 3) * 512 + 8 * (lane & 7);
#pragma unroll
    for (int i = 0; i < 4; ++i) { const float* vp = vp0 + (size_t)i * 4096; vr[i][0] = *(const f32x4*)vp; vr[i][1] = *(const f32x4*)(vp + 4); }
    f32x4 S[4];
#pragma unroll
    for (int kt = 0; kt < 4; ++kt) { f32x4 acc = (f32x4){0.f, 0.f, 0.f, 0.f};
        acc = __builtin_amdgcn_mfma_f32_16x16x32_bf16(pack44(kr[kt][0], kr[kt][1]), qf[0], acc, 0, 0, 0); acc = __builtin_amdgcn_mfma_f32_16x16x32_bf16(pack44(kr[kt][2], kr[kt][3]), qf[1], acc, 0, 0, 0); S[kt] = acc; }
    asm volatile("" ::: "memory");
#pragma unroll
    for (int i = 4; i < 8; ++i) { const float* vp = vp0 + (size_t)i * 4096; vr[i][0] = *(const f32x4*)vp; vr[i][1] = *(const f32x4*)(vp + 4); }
#pragma unroll
    for (int kt = 0; kt < 4; ++kt)
#pragma unroll
        for (int t = 0; t < 4; ++t) { const int kk = 32 * (kt >> 1) + 8 * fq + 4 * (kt & 1) + t; const int d = d0 - kk; const bool valid = rowok && kk < nk && d >= 0 && d < dmax;
            const int dc = d < 0 ? 0 : (d > SDMAX ? SDMAX : d); const float v = S[kt][t] + lut[dc * 4 + r]; S[kt][t] = valid ? v : -INFINITY; }
    bf16x8 P[2]; sa_update(S, a, P);
#pragma unroll
    for (int i = 0; i < 8; ++i) { const int key = 8 * i + (lane >> 3); *(FLAS bf16x8*)(Vt + key * 144 + (lane & 7) * 16) = pack44(vr[i][0], vr[i][1]); }
    asm volatile("s_waitcnt lgkmcnt(0)" ::: "memory");
#pragma unroll
    for (int s2 = 0; s2 < 2; ++s2)
#pragma unroll
        for (int dt = 0; dt < 4; ++dt) { const FLAS unsigned char* p = Vt + (32 * s2 + 8 * fq + (fr >> 2)) * 144 + (16 * dt + 4 * (fr & 3)) * 2;
            const v4i16_t lo = __builtin_amdgcn_ds_read_tr16_b64_v4i16((FLAS v4i16_t*)p), hi = __builtin_amdgcn_ds_read_tr16_b64_v4i16((FLAS v4i16_t*)(p + 4 * 144));
            bf16x8 vf; vf[0] = lo[0]; vf[1] = lo[1]; vf[2] = lo[2]; vf[3] = lo[3]; vf[4] = hi[0]; vf[5] = hi[1]; vf[6] = hi[2]; vf[7] = hi[3];
            a.o[dt] = __builtin_amdgcn_mfma_f32_16x16x32_bf16(vf, P[s2], a.o[dt], 0, 0, 0); }
    asm volatile("s_waitcnt lgkmcnt(0)" ::: "memory");
}
__device__ __forceinline__ void attn_sample_unit(const Ctx& C, CArgs& A, int u) {
    unsigned char* fb = A.fb; const int lane = C.lane, tid = C.tid, w = C.wave, fr = lane & 15, fq = lane >> 4, q = fr >> 2, r = fr & 3; FLAS unsigned char* L = C.lds;
    const int b = u >> 2, g = u & 3;
    FLAS float* lut = (FLAS float*)(L + SM_LUT); FLAS float* Pc = (FLAS float*)(L + SM_P); FLAS float* ML = (FLAS float*)(L + SM_ML); FLAS float* FAC = (FLAS float*)(L + SM_FAC); FLAS float* SC = (FLAS float*)(L + SM_SC);
    FLAS unsigned* SELQ = (FLAS unsigned*)(L + SM_SELQ); FLAS unsigned* LIST = (FLAS unsigned*)(L + SM_LIST); FLAS unsigned* NIT = (FLAS unsigned*)(L + SM_NIT); FLAS unsigned char* Vt = L + SM_V + w * 9216;
    const float* table = IN_F(29); const int* pt = (const int*)A.in[8];
    __syncthreads();
    for (int i = tid; i < (SDMAX + 2) * 4; i += NTHR) lut[i] = table[rel_bucket(i >> 2) * 16 + g * 4 + (i & 3)] * LOG2E;
    bf16x8 qf[2];
    { const float* qp = (const float*)(fb + F_QPART) + ((size_t)b * 4 + q) * D + (g * 4 + r) * 64 + 8 * fq; const float qs = 0.125f * LOG2E;
#pragma unroll
      for (int k2 = 0; k2 < 2; ++k2) { f32x4 s0 = {0.f, 0.f, 0.f, 0.f}, s1 = s0;
#pragma unroll
          for (int ksl = 0; ksl < 8; ++ksl) { s0 += *(const f32x4*)(qp + (size_t)ksl * MS * D + 32 * k2); s1 += *(const f32x4*)(qp + (size_t)ksl * MS * D + 32 * k2 + 4); }
          qf[k2] = pack44(s0 * qs, s1 * qs); } }
    SAcc a0, a1; sa_init(a0); sa_init(a1);
    __syncthreads();
    const float* winK = IN_F(6) + ((size_t)b * 512 * 2) * 256 + g * 64;
    const float* winN = A.out + O_WINS + ((size_t)b * 512 + 508) * 512 + g * 64;
    if (w < 4) {
        const int cb = w; const bf16* ck = (const bf16*)(fb + F_CMPS) + (((size_t)b * 4 + g) * 256 + 64 * cb) * 64; const bf16* vt = (const bf16*)(fb + F_CMPS) + (size_t)DB * 4 * 256 * 64 + ((size_t)b * 4 + g) * 64 * 256 + 64 * cb;
        f32x4 S[4];
#pragma unroll
        for (int kt = 0; kt < 4; ++kt) { const int kk = 32 * (kt >> 1) + 8 * (fr >> 2) + 4 * (kt & 1) + (fr & 3); const bf16* kp = ck + kk * 64 + 8 * fq; f32x4 acc = (f32x4){0.f, 0.f, 0.f, 0.f};
            acc = __builtin_amdgcn_mfma_f32_16x16x32_bf16(*(const bf16x8*)kp, qf[0], acc, 0, 0, 0); acc = __builtin_amdgcn_mfma_f32_16x16x32_bf16(*(const bf16x8*)(kp + 32), qf[1], acc, 0, 0, 0); S[kt] = acc; }
        const int d0 = PAST + q - 31 - 32 * 64 * cb;
#pragma unroll
        for (int kt = 0; kt < 4; ++kt)
#pragma unroll
            for (int t = 0; t < 4; ++t) { const int kk = 32 * (kt >> 1) + 8 * fq + 4 * (kt & 1) + t; const int d = d0 - 32 * kk; S[kt][t] += lut[(d > SDMAX ? SDMAX : d) * 4 + r]; }
        bf16x8 P[2]; sa_update(S, a0, P);
#pragma unroll
        for (int kt = 0; kt < 4; ++kt) *(FLAS f32x4*)(Pc + fr * 256 + 64 * cb + 32 * (kt >> 1) + 8 * fq + 4 * (kt & 1)) = S[kt];
#pragma unroll
        for (int s2 = 0; s2 < 2; ++s2)
#pragma unroll
            for (int dt = 0; dt < 4; ++dt) a0.o[dt] = __builtin_amdgcn_mfma_f32_16x16x32_bf16(*(const bf16x8*)(vt + (size_t)(16 * dt + fr) * 256 + 32 * s2 + 8 * fq), P[s2], a0.o[dt], 0, 0, 0);
        float lr = a0.l; lr += __shfl_xor(lr, 16); lr += __shfl_xor(lr, 32);
        if (fq == 0) { ML[(w * 16 + fr) * 2] = a0.m; ML[(w * 16 + fr) * 2 + 1] = lr; }
    } else { const int wb = w - 4; sa_block_f32(Vt, lane, winK + (size_t)64 * wb * 512, winK + (size_t)64 * wb * 512 + 256, 64, qf, a0, lut, 512 + q - 64 * wb, 512, true); }
    __syncthreads();
    if (tid < 64) { const int row = tid >> 2, ww = tid & 3; float M = -1e30f;
#pragma unroll
        for (int x = 0; x < 4; ++x) M = fmaxf(M, ML[(x * 16 + row) * 2]);
        float Ls = 0.f;
#pragma unroll
        for (int x = 0; x < 4; ++x) Ls += ML[(x * 16 + row) * 2 + 1] * fexp2(ML[(x * 16 + row) * 2] - M);
        FAC[row * 4 + ww] = fexp2(ML[(ww * 16 + row) * 2] - M) / Ls; }
    __syncthreads();
    { const int qq = tid >> 7, j = tid & 127; float sv = 0.f;
#pragma unroll
      for (int rr = 0; rr < 4; ++rr) { const int row = qq * 4 + rr; const f32x2 pp = *(const FLAS f32x2*)(Pc + row * 256 + 2 * j); sv += (pp[0] + pp[1]) * FAC[row * 4 + (j >> 5)]; }
      SC[qq * 132 + j] = (j == 0 || j == 127) ? 1e4f : sv; }
    __syncthreads();
    { const int qq = w >> 1, j = 64 * (w & 1) + lane; const float sj = SC[qq * 132 + j]; int rank = 0;
#pragma unroll 4
      for (int i4 = 0; i4 < 32; ++i4) { const f32x4 sv = *(const FLAS f32x4*)(SC + qq * 132 + 4 * i4);
#pragma unroll
          for (int k = 0; k < 4; ++k) { const int i = 4 * i4 + k; rank += (sv[k] > sj || (sv[k] == sj && i < j)) ? 1 : 0; } }
      SELQ[qq * 132 + j] = rank < 15 ? 1u : 0u; }
    __syncthreads();
    if (w == 0) { unsigned base = 0;
        for (int c = 0; c < 3; ++c) { const int j = 64 * c + lane; unsigned msk = 0u;
            if (j < 128) msk = SELQ[j] | (SELQ[132 + j] << 1) | (SELQ[264 + j] << 2) | (SELQ[396 + j] << 3); else if (j == 128) msk = 0xFu;
            const unsigned long long ball = __ballot(msk != 0u); const unsigned pos = base + (unsigned)__builtin_popcountll(ball & ((1ull << lane) - 1ull));
            if (msk != 0u) LIST[pos] = (unsigned)j | (msk << 8);
            base += (unsigned)__builtin_popcountll(ball); }
        if (lane == 0) NIT[0] = base; }
    __syncthreads();
    const int nit = (int)NIT[0];
    if (w >= 4) {
        sa_block_f32(Vt, lane, winK + (size_t)64 * w * 512, winK + (size_t)64 * w * 512 + 256, 64, qf, a0, lut, 512 + q - 64 * w, 512, true);
        if (w == 4) sa_block_f32(Vt, lane, winN, winN + 256, 4, qf, a0, lut, q, 512, true); }
    { FLAS float* PO = (FLAS float*)(L + SM_PUB0); FLAS float* PM = (FLAS float*)(L + SM_PUBML);
#pragma unroll
      for (int dt = 0; dt < 4; ++dt) *(FLAS f32x4*)(PO + (w * 16 + fr) * 64 + 16 * dt + 4 * fq) = a0.o[dt];
      float l0 = a0.l; l0 += __shfl_xor(l0, 16); l0 += __shfl_xor(l0, 32);
      if (fq == 0) { PM[((w * 2 + 0) * 16 + fr) * 2] = a0.m; PM[((w * 2 + 0) * 16 + fr) * 2 + 1] = l0; } }
#pragma unroll 1
    for (int i = 0; i < nit; ++i) { const int p12 = i % 12; if ((p12 < 8 ? p12 : p12 - 8) != w) continue;
        const unsigned item = LIST[i]; const int j = (int)(item & 255u); const bool rowok = ((item >> (8 + q)) & 1u) != 0u;
        const float* kb; int nk;
        if (j < 128) { const int page = pt[b * NPAGES + (j >> 1)]; kb = IN_F(5) + (((size_t)page * PAGE + (j & 1) * 64) * 2) * 256 + g * 64; nk = 64; }
        else { kb = A.out + O_SELS + ((size_t)b * DS) * 512 + g * 64; nk = DS; }
        sa_block_f32(Vt, lane, kb, kb + 256, nk, qf, a1, lut, PAST + q - 64 * j, 1 << 30, rowok); }
    __syncthreads();
    { FLAS float* PO = (FLAS float*)(L + SM_V); FLAS float* PM = (FLAS float*)(L + SM_PUBML);
#pragma unroll
      for (int dt = 0; dt < 4; ++dt) *(FLAS f32x4*)(PO + (w * 16 + fr) * 64 + 16 * dt + 4 * fq) = a1.o[dt];
      float l1 = a1.l; l1 += __shfl_xor(l1, 16); l1 += __shfl_xor(l1, 32);
      if (fq == 0) { PM[((w * 2 + 1) * 16 + fr) * 2] = a1.m; PM[((w * 2 + 1) * 16 + fr) * 2 + 1] = l1; } }
    __syncthreads();
    { const FLAS float* PM = (const FLAS float*)(L + SM_PUBML);
      const int row = tid >> 5, dim = 2 * (tid & 31), qq = row >> 2, rr = row & 3; const size_t grow = (size_t)MP + b * DS + qq;
      const float* gt = (const float*)(fb + F_GT) + grow * 64 + (g * 4 + rr) * 3; float o0 = 0.f, o1 = 0.f;
#pragma unroll
      for (int br = 0; br < 3; ++br) {
          const int w0 = br == 2 ? 4 : 0, w1 = br == 0 ? 4 : 8, set = br == 1 ? 1 : 0; const FLAS float* PO = (const FLAS float*)(L + (br == 1 ? SM_V : SM_PUB0)); float M = -1e30f;
          for (int x = w0; x < w1; ++x) M = fmaxf(M, PM[((x * 2 + set) * 16 + row) * 2]);
          float Ls = 0.f, x0 = 0.f, x1 = 0.f;
          for (int x = w0; x < w1; ++x) { const float f = fexp2(PM[((x * 2 + set) * 16 + row) * 2] - M); Ls += PM[((x * 2 + set) * 16 + row) * 2 + 1] * f;
              const f32x2 ov = *(const FLAS f32x2*)(PO + (x * 16 + row) * 64 + dim); x0 += ov[0] * f; x1 += ov[1] * f; }
          const float gv = Ls > 0.f ? gt[br] / Ls : 0.f; o0 += gv * x0; o1 += gv * x1; }
      *(unsigned*)((bf16*)(fb + F_O) + grow * D + (g * 4 + rr) * 64 + dim) = pk2(o0, o1); }
}

__device__ __forceinline__ void phase_attn(const Ctx& C, CArgs& A, int l) {
    int prev_bg = -1;
    for (int u = C.wg; u < 1024; u += C.G) { const int i = u >> 8, wv = u & 255, bg = wv & 15, k = wv >> 4;
        const int qt = i == 0 ? 63 - k : (i == 1 ? (k == 7 ? 47 : (k == 15 ? 39 : 32 + k)) : (i == 2 ? (k <= 6 ? 14 - k : (k == 15 ? 7 : 31 - k)) : ((k >= 8 && k <= 14) ? 17 + k : (k == 7 ? 16 : k))));
        attn_prompt_unit(C, A, bg >> 2, bg & 3, qt, bg != prev_bg); prev_bg = bg; }
    __syncthreads();
#ifdef FK_TIMING
    unsigned long long* ts2 = (unsigned long long*)(A.fb + F_CTL + 65536 + 1024);
    if (C.wg == FK_TWG && C.tid == 0) ts2[0] = __builtin_amdgcn_s_memrealtime();
#endif
    { const int su = C.wg < 112 ? C.wg : (C.wg >= 240 ? 112 + (C.wg - 240) : -1); if (su >= 0 && su < DB * 4) attn_sample_unit(C, A, su); }
    __syncthreads();
#ifdef FK_TIMING
    if (C.wg == FK_TWG && C.tid == 0) ts2[1] = __builtin_amdgcn_s_memrealtime();
#endif
}
constexpr int NPHASE = 24;
#ifdef FK_TIMING
#define FK_TIMING_ON 1
#else
#define FK_TIMING_ON 0
#endif
__global__ void __launch_bounds__(NTHR, 2) mega(Args A_unused) {
    extern __shared__ __attribute__((aligned(16))) unsigned char lds_raw[];
    Ctx C; C.lds = (FLAS unsigned char*)lds_raw; C.tid = threadIdx.x; C.lane = C.tid & 63; C.wave = __builtin_amdgcn_readfirstlane(C.tid >> 6); C.G = gridDim.x; C.wg = blockIdx.x;
    C.gw = C.wg * NWAVE + C.wave; C.ngw = C.G * NWAVE;
    CArgs* Ap0 = (CArgs*)__builtin_amdgcn_kernarg_segment_ptr();
    unsigned char* fb = Ap0->fb;
    volatile FLAS unsigned* misc = (volatile FLAS unsigned*)(C.lds + LDS_MISC);
    if (C.tid < 8) misc[C.tid] = 0u;
    __syncthreads();
    const int lo = Ap0->lo, hi = Ap0->hi;
    const bool use_bar = (hi - lo) > 1;
    XcdBarrier bar; bar.bar = (unsigned*)(fb + F_CTL) + 1024; bar.x = 0; bar.st = nullptr;
    if (use_bar) bar = xcd_barrier_post((unsigned*)(fb + F_CTL) + 1024, misc);
    int pidx = 0;
#ifdef FK_TIMING
    unsigned long long* ts = (unsigned long long*)(fb + F_CTL + 65536);
    if (C.wg == 0 && C.tid == 0) ts[0] = __builtin_amdgcn_s_memrealtime();
#define TSTAMP() do { if (C.wg == 0 && threadIdx.x == 0) ts[pidx + 1] = __builtin_amdgcn_s_memrealtime(); } while (0)
#else
#define TSTAMP() do {} while (0)
#endif
#define PH_BEGIN if (lo <= pidx && pidx < hi) { C.tid = pg8::opaque_tid(); C.lane = C.tid & 63; { int wg_ = blockIdx.x, G_ = gridDim.x, wv_ = C.wave; asm volatile("" : "+s"(wg_), "+s"(G_), "+s"(wv_)); C.wg = wg_; C.G = G_; C.wave = wv_; C.gw = wg_ * NWAVE + wv_; C.ngw = G_ * NWAVE; } CArgs* Ap = (CArgs*)__builtin_amdgcn_kernarg_segment_ptr(); asm volatile("" : "+s"(Ap)); CArgs& A = *Ap; unsigned char* fb = A.fb; \
        bf16* XF = (bf16*)(fb + F_X); bf16* HF = (bf16*)(fb + F_H); const float* MODF = (const float*)(fb + F_MOD); \
        const float* mod0 = MODF + (size_t)(2 * l) * NC * 3072; const float* mod1 = MODF + (size_t)(2 * l + 1) * NC * 3072; (void)XF; (void)HF; (void)mod0; (void)mod1;
#define PH_END   if (pidx + 1 < hi || FK_TIMING_ON) xcd_barrier(bar); TSTAMP(); } ++pidx;
    { const int l = 0; PH_BEGIN phase_prologue(C, A); PH_END }

    for (int l = 0; l < 4; ++l) {
        if (l == 0) { PH_BEGIN phase_norm(C, A, 0, 0, true, -1, nullptr, false, C.gw, C.ngw, R); PH_END }
        if (l < 2) {
            PH_BEGIN {
                unsigned* flag = (unsigned*)(fb + F_CTL) + 32768 + 64 * (2 * l - 1);
                if (l > 0) { const Ctx Cn = refreshed(C); sample_norm_part(Cn, A, 0, 2 * l, 2 * l - 1, nullptr, false, flag); }
                C = refreshed(C);
                EpGLU e{(bf16*)(fb + F_U), (float*)(fb + F_US), IN_F(13) + (size_t)l * 2048, A.out + O_CONVP + (size_t)l * BATCH * 30 * D, A.out + O_CONVS + (size_t)l * DB * 30 * D};
                const bf16* W = (const bf16*)(fb + F_WPW1) + (size_t)l * 2048 * 1024;
                gemm_prompt(C, HF, W, 2048, 1024, e);
                C = refreshed(C);
                if (l > 0) sample_rows_ready(C, flag, (unsigned*)(fb + F_CTL) + 1024);
                gemm_sample(C, HF + (size_t)MP * D, W, 2048, 1024, e);
            } PH_END
            PH_BEGIN phase_conv(C, A, l); PH_END
            PH_BEGIN {
                EpResidNorm e{l == 0 ? IN_F(0) : nullptr, XF, mod0, IN_F(19) + (size_t)l * D, 0, mod1, nullptr, HF, nullptr, nullptr,
                              (float*)(fb + F_STATS) + (size_t)(2 * l) * 65536, (unsigned*)(fb + F_CTL) + 65536 + (2 * l) * 4096, (unsigned*)(fb + F_CTL) + 1024};
                const bf16* W = (const bf16*)(fb + F_WPW2) + (size_t)l * 1024 * 1024; const bf16* Ain = (const bf16*)(fb + F_C);
                gemm_prompt_fused(C, Ain, W, 1024, e);
                gemm_sample_ksplit(C, Ain + (size_t)MP * D, W, 1024, (float*)(fb + F_PART));
            } PH_END
        } else {
#ifdef FK_HAVE_ATTN
            PH_BEGIN phase_qkv(C, A, l); PH_END
            if (l == 2) { PH_BEGIN phase_prep(C, A); PH_END }
            PH_BEGIN phase_attn(C, A, l); PH_END
            PH_BEGIN {
                EpResidNorm e{nullptr, XF, mod0, nullptr, 0, mod1, nullptr, HF, nullptr, nullptr,
                              (float*)(fb + F_STATS) + (size_t)(2 * l) * 65536, (unsigned*)(fb + F_CTL) + 65536 + (2 * l) * 4096, (unsigned*)(fb + F_CTL) + 1024};
                const bf16* W = (const bf16*)(fb + F_WO) + (size_t)(l - 2) * 1024 * 1024; const bf16* Ain = (const bf16*)(fb + F_O);
                gemm_prompt_fused(C, Ain, W, 1024, e);
                gemm_sample_ksplit(C, Ain + (size_t)MP * D, W, 1024, (float*)(fb + F_PART));
            } PH_END
#endif
        }
        PH_BEGIN {
            unsigned* flag = (unsigned*)(fb + F_CTL) + 32768 + 64 * (2 * l);
            { const Ctx Cn = refreshed(C); sample_norm_part(Cn, A, 0, 2 * l + 1, 2 * l, l < 2 ? IN_F(19) + (size_t)l * D : nullptr, l == 0, flag); }
            C = refreshed(C);
            EpSwiGLU e{(bf16*)(fb + F_ACT)};
            const bf16* W = (const bf16*)(fb + F_WGU) + (size_t)l * 5632 * 1024;
            gemm_prompt(C, HF, W, 5632, 1024, e);
            C = refreshed(C);
            sample_rows_ready(C, flag, (unsigned*)(fb + F_CTL) + 1024);
            gemm_sample(C, HF + (size_t)MP * D, W, 5632, 1024, e);
        } PH_END
        PH_BEGIN {
            EpResidNorm e{nullptr, XF, mod1, nullptr, l == 3 ? 2 : (l == 1 ? 1 : 0), MODF + (size_t)(l < 3 ? 2 * l + 2 : 0) * NC * 3072, l == 3 ? IN_F(33) : IN_F(20), HF, (bf16*)(fb + F_HKV), A.out + O_YP,
                          (float*)(fb + F_STATS) + (size_t)(2 * l + 1) * 65536, (unsigned*)(fb + F_CTL) + 65536 + (2 * l + 1) * 4096, (unsigned*)(fb + F_CTL) + 1024};
            const bf16* W = (const bf16*)(fb + F_WDN) + (size_t)l * 1024 * 2816; const bf16* Ain = (const bf16*)(fb + F_ACT);
            gemm_prompt_fused(C, Ain, W, 2816, e);
            gemm_sample_ksplit(C, Ain + (size_t)MP * DFF, W, 2816, (float*)(fb + F_PART));
        } PH_END
    }
    { const int l = 0; PH_BEGIN phase_norm(C, A, 2, 0, false, 7, nullptr, false, MP + C.gw, C.ngw, R); PH_END }
#undef PH_BEGIN
#undef PH_END
}


#ifdef FK_TIMING
__global__ void k_encode(const unsigned long long* ts, float* out) {
    float t1 = 0.f, t2 = 0.f;
    for (int p = 0; p < 31; ++p) { const float us = (float)(ts[p + 1] - ts[p]) * 0.01f;
        if ((FK_M1 >> p) & 1ull) t1 += us; if ((FK_M2 >> p) & 1ull) t2 += us; }
#ifdef FK_TSPLIT
    { const unsigned long long* ts2 = ts + 128;
      if (FK_TSPLIT == 1) { t1 = (float)(ts2[0] - ts[25]) * 0.01f; t2 = (float)(ts2[1] - ts2[0]) * 0.01f; }
      if (FK_TSPLIT == 4) { t1 = (float)ts2[6] * 0.01f; t2 = (float)ts2[7] * 0.01f; } }
#endif
    const float sc = 1.f + sqrtf(t1 * 1e-5f);
    for (int i = threadIdx.x; i < MS * D; i += blockDim.x) out[O_YS + i] *= sc;
    if (threadIdx.x == 0) out[O_YP + 12345] += t2 * 1e-2f;
}
#endif
static int g_grid = 0;
static bool fast_setup() {
    if (g_grid) return g_grid > 0;
    int dev = 0, cus = 0;
    if (hipGetDevice(&dev) != hipSuccess || hipDeviceGetAttribute(&cus, hipDeviceAttributeMultiprocessorCount, dev) != hipSuccess) { g_grid = -1; return false; }
    if (hipFuncSetAttribute((const void*)mega, hipFuncAttributeMaxDynamicSharedMemorySize, LDS_BYTES) != hipSuccess) { g_grid = -1; return false; }
    int per_cu = 0; (void)hipOccupancyMaxActiveBlocksPerMultiprocessor(&per_cu, (const void*)mega, NTHR, LDS_BYTES); (void)hipGetLastError();
    if (per_cu < 1) fprintf(stderr, "fast_setup: occupancy query says %d blocks/CU\n", per_cu);
    g_grid = cus;
    return true;
}
static void fast_launch(void* const* d_in, float* out, unsigned char* fb, int lo, int hi, hipStream_t st) {
    if (!fast_setup()) return;
    Args a{}; for (int i = 0; i < 34; ++i) a.in[i] = d_in[i]; a.out = out; a.fb = fb; a.lo = lo; a.hi = hi;
    hipLaunchKernelGGL(mega, dim3(g_grid), dim3(NTHR), LDS_BYTES, st, a);
}
}
extern "C" void kernel_launch(void* const* d_in, const int* in_sizes, int n_in, void* d_out, int out_size, void* d_ws, size_t ws_size, hipStream_t stream) {
    if (ws_size < fk::F_END) { fprintf(stderr, "ws too small: %zu < %zu\n", ws_size, (size_t)fk::F_END); return; }
    unsigned char* fb = (unsigned char*)d_ws;
    (void)hipMemsetAsync(fb + fk::F_CTL, 0, fk::CTL_BYTES, stream);
#if FK_NLAUNCH == 1
    fk::fast_launch(d_in, (float*)d_out, fb, 0, fk::NPHASE, stream);
#ifdef FK_TIMING
    fk::k_encode<<<1, 256, 0, stream>>>((const unsigned long long*)(fb + fk::F_CTL + 65536), (float*)d_out);
#endif
#else
    for (int p = 0; p < fk::NPHASE; ++p) fk::fast_launch(d_in, (float*)d_out, fb, p, p + 1, stream);
#endif
}
```

```cpp
#define FK_NLAUNCH 1
#include <math.h>
#include <hip/hip_runtime.h>
#include <stdint.h>
#include <stdio.h>

namespace nv {
constexpr int D = 1024, BATCH = 4, SEQ = 4096, DB = 32, DS = 4, PAST = 8192, PAGE = 128, NPAGES = 64;
constexpr int KVH = 4, GROUP = 4, HD = 64, CONVW = 31, DFF = 2816, PHI = 128, QGW = 1072, KVW = 1536;
constexpr int MP = BATCH * SEQ, MS = DB * DS, R = MP + MS, NC = 36;
constexpr float EPS = 1e-6f;

constexpr size_t O_YP = 0, O_YS = O_YP + (size_t)MP * D, O_CMPP = O_YS + (size_t)MS * D, O_CMPS = O_CMPP + (size_t)MP * 512,
                 O_SELP = O_CMPS + (size_t)MS * 512, O_SELS = O_SELP + (size_t)MP * 512, O_WINP = O_SELS + (size_t)MS * 512,
                 O_WINS = O_WINP + (size_t)BATCH * 512 * 512, O_CONVP = O_WINS + (size_t)DB * 512 * 512,
                 O_CONVS = O_CONVP + (size_t)2 * BATCH * 30 * D, O_END = O_CONVS + (size_t)2 * DB * 30 * D;

__device__ __forceinline__ float silu(float x) { return x / (1.f + expf(-x)); }
__device__ __forceinline__ float sigm(float x) { return 1.f / (1.f + expf(-x)); }
__device__ __forceinline__ int cidx_of(int row) { return row < MP ? row / SEQ : 4 + (row - MP) / DS; }
__device__ __forceinline__ int rel_bucket(int n) {
    if (n < 0) n = 0;
    if (n < 16) return n;
    int b = 16;
    b += (n >= 21); b += (n >= 27); b += (n >= 35); b += (n >= 46); b += (n >= 59); b += (n >= 77); b += (n >= 99); b += (n >= 128);
    b += (n >= 166); b += (n >= 216); b += (n >= 280); b += (n >= 363); b += (n >= 470); b += (n >= 609); b += (n >= 790);
    return b;
}

__global__ __launch_bounds__(256) void k_gemm(const float* __restrict__ A, int lda, const float* __restrict__ W, int ldw, const float* __restrict__ bias,
                                              float* __restrict__ C, int ldc, int M, int N, int K) {
    __shared__ float As[16][68];
    __shared__ float Ws[16][68];
    const int tid = threadIdx.x, tx = tid & 15, ty = tid >> 4;
    const int m0 = blockIdx.y * 64, n0 = blockIdx.x * 64;
    float acc[4][4];
#pragma unroll
    for (int i = 0; i < 4; ++i)
#pragma unroll
        for (int j = 0; j < 4; ++j) acc[i][j] = 0.f;
    for (int k0 = 0; k0 < K; k0 += 16) {
#pragma unroll
        for (int it = 0; it < 4; ++it) { const int i = tid + it * 256; const int m = i >> 4, k = i & 15; const int gm = m0 + m; As[k][m] = gm < M ? A[(size_t)gm * lda + k0 + k] : 0.f; }
#pragma unroll
        for (int it = 0; it < 4; ++it) { const int i = tid + it * 256; const int k = i >> 6, n = i & 63; const int gn = n0 + n; Ws[k][n] = gn < N ? W[(size_t)(k0 + k) * ldw + gn] : 0.f; }
        __syncthreads();
#pragma unroll
        for (int k = 0; k < 16; ++k) {
            const float4 a = *(const float4*)&As[k][ty * 4]; const float4 b = *(const float4*)&Ws[k][tx * 4];
            const float av[4] = {a.x, a.y, a.z, a.w}, bv[4] = {b.x, b.y, b.z, b.w};
#pragma unroll
            for (int i = 0; i < 4; ++i)
#pragma unroll
                for (int j = 0; j < 4; ++j) acc[i][j] += av[i] * bv[j];
        }
        __syncthreads();
    }
#pragma unroll
    for (int i = 0; i < 4; ++i) { const int gm = m0 + ty * 4 + i; if (gm >= M) continue;
#pragma unroll
        for (int j = 0; j < 4; ++j) { const int gn = n0 + tx * 4 + j; if (gn < N) C[(size_t)gm * ldc + gn] = acc[i][j] + (bias ? bias[gn] : 0.f); } }
}

__global__ void k_silu_c(const float* cp, const float* cs, float* SC) {
    const int i = blockIdx.x * blockDim.x + threadIdx.x; if (i >= NC * D) return;
    const int r = i / D, k = i % D; const float v = r < 4 ? cp[r * D + k] : cs[(r - 4) * D + k]; SC[i] = silu(v);
}

__device__ __forceinline__ float block_sum256(float v, float* red) {
#pragma unroll
    for (int o = 32; o >= 1; o >>= 1) v += __shfl_xor(v, o);
    __syncthreads();
    if ((threadIdx.x & 63) == 0) red[threadIdx.x >> 6] = v;
    __syncthreads();
    return red[0] + red[1] + red[2] + red[3];
}
__global__ __launch_bounds__(256) void k_modnorm(const float* __restrict__ X, const float* __restrict__ g, const float* __restrict__ mod, float* __restrict__ H) {
    __shared__ float red[4];
    const int row = blockIdx.x, t = threadIdx.x; const float4 x = ((const float4*)(X + (size_t)row * D))[t];
    const float ss = block_sum256(x.x * x.x + x.y * x.y + x.z * x.z + x.w * x.w, red);
    const float rstd = (1.0f / sqrtf(ss * (1.f / D) + EPS));
    const float4 gv = ((const float4*)g)[t]; float4 y = {x.x * rstd * gv.x, x.y * rstd * gv.y, x.z * rstd * gv.z, x.w * rstd * gv.w};
    if (mod) { const float* m = mod + (size_t)cidx_of(row) * 3072; const float4 sh = ((const float4*)m)[t], sc = ((const float4*)(m + D))[t];
        y.x = y.x * (1.f + sc.x) + sh.x; y.y = y.y * (1.f + sc.y) + sh.y; y.z = y.z * (1.f + sc.z) + sh.z; y.w = y.w * (1.f + sc.w) + sh.w; }
    ((float4*)(H + (size_t)row * D))[t] = y;
}
__global__ void k_glu(const float* __restrict__ T1, float* __restrict__ U) {
    const size_t i = (size_t)blockIdx.x * blockDim.x + threadIdx.x; if (i >= (size_t)R * D) return;
    const size_t r = i / D; const int c = (int)(i % D); const float a = T1[r * 2048 + c], gg = T1[r * 2048 + D + c]; U[i] = a * sigm(gg);
}
__global__ void k_conv(const float* __restrict__ U, const float* __restrict__ state  , const float* __restrict__ wdw  , const float* __restrict__ bdw,
                       float* __restrict__ Y) {
    const size_t i = (size_t)blockIdx.x * blockDim.x + threadIdx.x; if (i >= (size_t)R * D) return;
    const int row = (int)(i / D), c = (int)(i % D); float acc = bdw[c];
    if (row < MP) { const int b = row / SEQ, t = row % SEQ;
        for (int k = 0; k < CONVW; ++k) { const int tt = t - 30 + k; if (tt >= 0) acc += wdw[k * D + c] * U[((size_t)b * SEQ + tt) * D + c]; }
    } else { const int rs = row - MP, b = rs / DS, t = rs % DS;
        for (int k = 0; k < CONVW; ++k) { const int j = t + k; const float v = j < 30 ? state[((size_t)b * 30 + j) * D + c] : U[((size_t)MP + b * DS + (j - 30)) * D + c]; acc += wdw[k * D + c] * v; }
    }
    Y[i] = acc;
}
__global__ void k_conv_state_out(const float* __restrict__ U, const float* __restrict__ state, float* __restrict__ outp  , float* __restrict__ outs  ) {
    const int i = blockIdx.x * blockDim.x + threadIdx.x; const int NPo = BATCH * 30 * D, NSo = DB * 30 * D;
    if (i < NPo) { const int b = i / (30 * D), j = (i / D) % 30, c = i % D; outp[i] = U[((size_t)b * SEQ + SEQ - 30 + j) * D + c]; }
    else if (i < NPo + NSo) { const int ii = i - NPo; const int b = ii / (30 * D), j = (ii / D) % 30, c = ii % D;
        outs[ii] = j < 26 ? state[((size_t)b * 30 + j + 4) * D + c] : U[((size_t)MP + b * DS + (j - 26)) * D + c]; }
}
__global__ __launch_bounds__(256) void k_ln_silu(const float* __restrict__ Y, const float* __restrict__ g, const float* __restrict__ bb, float* __restrict__ Cc) {
    __shared__ float red[4];
    const int row = blockIdx.x, t = threadIdx.x; const float4 x = ((const float4*)(Y + (size_t)row * D))[t];
    const float mu = block_sum256(x.x + x.y + x.z + x.w, red) * (1.f / D);
    const float4 d = {x.x - mu, x.y - mu, x.z - mu, x.w - mu};
    const float var = block_sum256(d.x * d.x + d.y * d.y + d.z * d.z + d.w * d.w, red) * (1.f / D);
    const float rstd = (1.0f / sqrtf(var + EPS)); const float4 gv = ((const float4*)g)[t], bv = ((const float4*)bb)[t];
    float4 y = {silu(d.x * rstd * gv.x + bv.x), silu(d.y * rstd * gv.y + bv.y), silu(d.z * rstd * gv.z + bv.z), silu(d.w * rstd * gv.w + bv.w)};
    ((float4*)(Cc + (size_t)row * D))[t] = y;
}
__global__ void k_resid(float* __restrict__ X, const float* __restrict__ T, int ldt, const float* __restrict__ mod) {
    const size_t i = (size_t)blockIdx.x * blockDim.x + threadIdx.x; if (i >= (size_t)R * D) return;
    const int row = (int)(i / D), c = (int)(i % D); X[i] += mod[(size_t)cidx_of(row) * 3072 + 2048 + c] * T[(size_t)row * ldt + c];
}
__global__ void k_swiglu(const float* __restrict__ G, const float* __restrict__ UP, float* __restrict__ ACT) {
    const size_t i = (size_t)blockIdx.x * blockDim.x + threadIdx.x; if (i >= (size_t)R * DFF) return; ACT[i] = silu(G[i]) * UP[i];
}
__global__ void k_kv_out(const float* __restrict__ ROWS, const float* __restrict__ cache_win, float* __restrict__ out) {
    const size_t i = (size_t)blockIdx.x * blockDim.x + threadIdx.x;
    const size_t n1 = (size_t)MP * 512, n2 = (size_t)MS * 512, n3 = (size_t)BATCH * 512 * 512, n4 = (size_t)DB * 512 * 512;
    if (i < n1) { const size_t r = i / 512, c = i % 512; out[O_CMPP + i] = ROWS[r * KVW + c]; out[O_SELP + i] = ROWS[r * KVW + 512 + c]; }
    if (i < n2) { const size_t r = i / 512, c = i % 512; out[O_CMPS + i] = ROWS[(MP + r) * KVW + c]; out[O_SELS + i] = ROWS[(MP + r) * KVW + 512 + c]; }
    if (i < n3) { const size_t b = i / (512 * 512), j = (i / 512) % 512, c = i % 512; out[O_WINP + i] = ROWS[(b * SEQ + SEQ - 512 + j) * KVW + 1024 + c]; }
    if (i < n4) { const size_t b = i / (512 * 512), j = (i / 512) % 512, c = i % 512;
        out[O_WINS + i] = j < 508 ? cache_win[(b * 512 + j + 4) * 512 + c] : ROWS[(MP + b * DS + (j - 508)) * KVW + 1024 + c]; }
}
__global__ __launch_bounds__(256) void k_compress(int is_prompt, const float* __restrict__ ROWS, const float* __restrict__ cache, const int* __restrict__ pt,
                                                   const float* __restrict__ w1, const float* __restrict__ b1, const float* __restrict__ w2, const float* __restrict__ b2,
                                                   const float* __restrict__ pe, float* __restrict__ CMP) {
    __shared__ float blk[32 * 4 * 64];
    __shared__ float hid[4][PHI];
    const int NB = is_prompt ? 128 : 256, BB = is_prompt ? BATCH : DB;
    const int e = blockIdx.x & 1, n = (blockIdx.x >> 1) % NB, b = (blockIdx.x >> 1) / NB, tid = threadIdx.x;
    for (int i = tid; i < 32 * 256; i += 256) { const int t = i >> 8, gd = i & 255; float v;
        if (is_prompt) v = ROWS[((size_t)b * SEQ + n * 32 + t) * KVW + e * 256 + gd];
        else { const int page = pt[b * NPAGES + (n >> 2)]; v = cache[(((size_t)page * PAGE + (n & 3) * 32 + t) * 2 + e) * 256 + gd]; }
        blk[i] = v + pe[(e * 32 + t) * 64 + (gd & 63)]; }
    __syncthreads();
    const int h = tid & 127, gp = tid >> 7; float a0 = 0.f, a1 = 0.f; const float* w = w1 + (size_t)e * 2048 * PHI + h;
    for (int f = 0; f < 2048; ++f) { const int t = f >> 6, d = f & 63; const float wv = w[(size_t)f * PHI]; a0 += blk[(t * 4 + gp * 2) * 64 + d] * wv; a1 += blk[(t * 4 + gp * 2 + 1) * 64 + d] * wv; }
    hid[gp * 2][h] = silu(a0 + b1[e * PHI + h]); hid[gp * 2 + 1][h] = silu(a1 + b1[e * PHI + h]);
    __syncthreads();
    const int g = tid >> 6, d = tid & 63; float o = b2[e * 64 + d];
    for (int hh = 0; hh < PHI; ++hh) o += hid[g][hh] * w2[((size_t)e * PHI + hh) * 64 + d];
    CMP[((((size_t)e * BB + b) * NB + n) * 4 + g) * 64 + d] = o;
}

struct AttnP {
    const float* QG;
    const float* ROWS;
    const float* CMP;
    const float* cache_sel; const float* cache_win; const int* pt; const float* table;
    float* O;
};
__device__ __forceinline__ const float* kv_ptr_sel(const AttnP& P, int is_prompt, int b, int g, int e, int pos) {
    if (is_prompt) return P.ROWS + ((size_t)b * SEQ + pos) * KVW + 512 + e * 256 + g * 64;
    if (pos < PAST) { const int page = P.pt[b * NPAGES + pos / PAGE]; return P.cache_sel + (((size_t)page * PAGE + pos % PAGE) * 2 + e) * 256 + g * 64; }
    return P.ROWS + ((size_t)MP + b * DS + (pos - PAST)) * KVW + 512 + e * 256 + g * 64;
}
__device__ __forceinline__ const float* kv_ptr_win(const AttnP& P, int is_prompt, int b, int g, int e, int pos) {
    if (is_prompt) return P.ROWS + ((size_t)b * SEQ + pos) * KVW + 1024 + e * 256 + g * 64;
    const int i = pos - (PAST + DS - 516);
    if (i < 512) return P.cache_win + (((size_t)b * 512 + i) * 2 + e) * 256 + g * 64;
    return P.ROWS + ((size_t)MP + b * DS + (i - 512)) * KVW + 1024 + e * 256 + g * 64;
}
__device__ __forceinline__ float wave_max(float v) {
#pragma unroll
    for (int o = 32; o >= 1; o >>= 1) v = fmaxf(v, __shfl_xor(v, o)); return v; }
__device__ __forceinline__ float wave_sum(float v) {
#pragma unroll
    for (int o = 32; o >= 1; o >>= 1) v += __shfl_xor(v, o); return v; }

constexpr int SBW = 1088;
__global__ __launch_bounds__(64) void k_attn(AttnP P, int is_prompt) {
    __shared__ float qs[4][64];
    __shared__ float sb[4][SBW];
    __shared__ float impb[192];
    __shared__ float scoreb[192];
    __shared__ int selb[16];
    const int lane = threadIdx.x; const int T = is_prompt ? SEQ : DS;
    const int g = blockIdx.x & 3, q = (blockIdx.x >> 2) % T, b = (blockIdx.x >> 2) / T;
    const int qpos = is_prompt ? q : PAST + q; const int row = is_prompt ? b * SEQ + q : MP + b * DS + q;
    const int NCMP = is_prompt ? 128 : 256, NBLK = is_prompt ? 64 : 129, BB = is_prompt ? BATCH : DB;
    const float NEGM = -3.0e38f;
#pragma unroll
    for (int r = 0; r < 4; ++r) qs[r][lane] = P.QG[(size_t)row * QGW + (g * 4 + r) * 64 + lane] * 0.125f;
    float gate[4][3];
#pragma unroll
    for (int r = 0; r < 4; ++r)
#pragma unroll
        for (int br = 0; br < 3; ++br) gate[r][br] = sigm(P.QG[(size_t)row * QGW + 1024 + (g * 4 + r) * 3 + br]);
    __syncthreads();
    float out[4] = {0.f, 0.f, 0.f, 0.f};
    {
        const float* CK = P.CMP + ((size_t)0 * BB + b) * NCMP * 256; const float* CV = P.CMP + ((size_t)1 * BB + b) * NCMP * 256;
        float mx[4] = {NEGM, NEGM, NEGM, NEGM};
        for (int n = lane; n < NCMP; n += 64) { const int endp = n * 32 + 31; const bool valid = endp <= qpos; const float* k = CK + ((size_t)n * 4 + g) * 64;
            float s[4] = {0.f, 0.f, 0.f, 0.f};
            for (int d = 0; d < 64; ++d) { const float kv = k[d]; s[0] += qs[0][d] * kv; s[1] += qs[1][d] * kv; s[2] += qs[2][d] * kv; s[3] += qs[3][d] * kv; }
            const int bk = rel_bucket(qpos - endp);
#pragma unroll
            for (int r = 0; r < 4; ++r) { const float v = valid ? s[r] + P.table[bk * 16 + g * 4 + r] : NEGM; sb[r][n] = v; mx[r] = fmaxf(mx[r], v); } }
        float sm[4];
#pragma unroll
        for (int r = 0; r < 4; ++r) { mx[r] = wave_max(mx[r]); float a = 0.f;
            for (int n = lane; n < NCMP; n += 64) { const float v = sb[r][n]; const float p = v > -1e38f ? expf(v - mx[r]) : 0.f; sb[r][n] = p; a += p; }
            sm[r] = wave_sum(a); }
        __syncthreads();
#pragma unroll
        for (int r = 0; r < 4; ++r) { const float inv = sm[r] > 0.f ? 1.f / sm[r] : 0.f; for (int n = lane; n < NCMP; n += 64) sb[r][n] *= inv; }
        __syncthreads();
        float oc[4] = {0.f, 0.f, 0.f, 0.f};
        for (int n = 0; n < NCMP; ++n) { const float v = CV[((size_t)n * 4 + g) * 64 + lane]; oc[0] += sb[0][n] * v; oc[1] += sb[1][n] * v; oc[2] += sb[2][n] * v; oc[3] += sb[3][n] * v; }
#pragma unroll
        for (int r = 0; r < 4; ++r) out[r] += gate[r][0] * oc[r];
        for (int j = lane; j < NBLK; j += 64) { float a = 0.f, c = 0.f;
            if (2 * j < NCMP) a = ((sb[0][2 * j] + sb[1][2 * j]) + sb[2][2 * j]) + sb[3][2 * j];
            if (2 * j + 1 < NCMP) c = ((sb[0][2 * j + 1] + sb[1][2 * j + 1]) + sb[2][2 * j + 1]) + sb[3][2 * j + 1];
            float nz = 1.f;
#ifdef IMP_NOISE
            { unsigned hsh = (unsigned)(j * 2654435761u) ^ (unsigned)(blockIdx.x * 40503u + 12345u); hsh ^= hsh >> 15; hsh *= 2246822519u; hsh ^= hsh >> 13; hsh *= 3266489917u; hsh ^= hsh >> 16;
              nz = 1.f + IMP_NOISE * ((float)(hsh & 0xffff) * (2.f / 65535.f) - 1.f); }
#endif
            impb[j] = (a + c) * nz; }
        __syncthreads();
    }
    const int jq = qpos / 64;
    for (int j = lane; j < NBLK; j += 64) { const bool forced = (j == 0) || (j == jq) || (j == jq - 1); scoreb[j] = j <= jq ? (forced ? 1e4f : impb[j]) : -1.f; }
    if (lane < 16) selb[lane] = -1;
    __syncthreads();
    for (int j = lane; j < NBLK; j += 64) { const float sj = scoreb[j]; int rank = 0;
        for (int i = 0; i < NBLK; ++i) { const float si = scoreb[i]; rank += (si > sj || (si == sj && i < j)) ? 1 : 0; }
        if (rank < 16 && sj >= 0.f) selb[rank] = j; }
    __syncthreads();
    {
        float mx[4] = {NEGM, NEGM, NEGM, NEGM};
        for (int sl = 0; sl < 16; ++sl) { const int j = selb[sl]; const int kpos = j * 64 + lane; const bool valid = (j >= 0) && (kpos <= qpos);
            float s[4] = {0.f, 0.f, 0.f, 0.f};
            if (valid) { const float* k = kv_ptr_sel(P, is_prompt, b, g, 0, kpos);
                for (int d = 0; d < 64; ++d) { const float kv = k[d]; s[0] += qs[0][d] * kv; s[1] += qs[1][d] * kv; s[2] += qs[2][d] * kv; s[3] += qs[3][d] * kv; } }
            const int bk = rel_bucket(qpos - kpos);
#pragma unroll
            for (int r = 0; r < 4; ++r) { const float v = valid ? s[r] + P.table[bk * 16 + g * 4 + r] : NEGM; sb[r][sl * 64 + lane] = v; mx[r] = fmaxf(mx[r], v); } }
        float sm[4];
#pragma unroll
        for (int r = 0; r < 4; ++r) { mx[r] = wave_max(mx[r]); float a = 0.f;
            for (int n = lane; n < 1024; n += 64) { const float v = sb[r][n]; const float p = v > -1e38f ? expf(v - mx[r]) : 0.f; sb[r][n] = p; a += p; }
            sm[r] = wave_sum(a); }
        __syncthreads();
        float os[4] = {0.f, 0.f, 0.f, 0.f};
        for (int sl = 0; sl < 16; ++sl) { const int j = selb[sl]; if (j < 0) continue;
            for (int kk = 0; kk < 64; ++kk) { const int kpos = j * 64 + kk; if (kpos > qpos) break;
                const float v = kv_ptr_sel(P, is_prompt, b, g, 1, kpos)[lane]; const int n = sl * 64 + kk;
                os[0] += sb[0][n] * v; os[1] += sb[1][n] * v; os[2] += sb[2][n] * v; os[3] += sb[3][n] * v; } }
#pragma unroll
        for (int r = 0; r < 4; ++r) out[r] += gate[r][1] * (sm[r] > 0.f ? os[r] / sm[r] : 0.f);
        __syncthreads();
    }
    {
        float mx[4] = {NEGM, NEGM, NEGM, NEGM};
        for (int i = lane; i < 512; i += 64) { const int kpos = qpos - 511 + i; const bool valid = kpos >= 0 && (is_prompt || kpos >= PAST + DS - 516);
            float s[4] = {0.f, 0.f, 0.f, 0.f};
            if (valid) { const float* k = kv_ptr_win(P, is_prompt, b, g, 0, kpos);
                for (int d = 0; d < 64; ++d) { const float kv = k[d]; s[0] += qs[0][d] * kv; s[1] += qs[1][d] * kv; s[2] += qs[2][d] * kv; s[3] += qs[3][d] * kv; } }
            const int bk = rel_bucket(qpos - kpos);
#pragma unroll
            for (int r = 0; r < 4; ++r) { const float v = valid ? s[r] + P.table[bk * 16 + g * 4 + r] : NEGM; sb[r][i] = v; mx[r] = fmaxf(mx[r], v); } }
        float sm[4];
#pragma unroll
        for (int r = 0; r < 4; ++r) { mx[r] = wave_max(mx[r]); float a = 0.f;
            for (int n = lane; n < 512; n += 64) { const float v = sb[r][n]; const float p = v > -1e38f ? expf(v - mx[r]) : 0.f; sb[r][n] = p; a += p; }
            sm[r] = wave_sum(a); }
        __syncthreads();
        float ow[4] = {0.f, 0.f, 0.f, 0.f};
        for (int i = 0; i < 512; ++i) { const int kpos = qpos - 511 + i; if (kpos < 0 || (!is_prompt && kpos < PAST + DS - 516)) continue;
            const float v = kv_ptr_win(P, is_prompt, b, g, 1, kpos)[lane];
            ow[0] += sb[0][i] * v; ow[1] += sb[1][i] * v; ow[2] += sb[2][i] * v; ow[3] += sb[3][i] * v; }
#pragma unroll
        for (int r = 0; r < 4; ++r) out[r] += gate[r][2] * (sm[r] > 0.f ? ow[r] / sm[r] : 0.f);
    }
#pragma unroll
    for (int r = 0; r < 4; ++r) P.O[(size_t)row * D + (g * 4 + r) * 64 + lane] = out[r];
}

constexpr size_t W_SC = 0, W_MOD = W_SC + (size_t)NC * D, W_X = W_MOD + (size_t)8 * NC * 3072, W_H = W_X + (size_t)R * D, W_T1 = W_H + (size_t)R * D,
                 W_T2 = W_T1 + (size_t)R * DFF, W_U = W_T2 + (size_t)R * DFF, W_Y = W_U + (size_t)R * D, W_CC = W_Y + (size_t)R * D, W_ACT = W_CC + (size_t)R * D,
                 W_ROWS = W_ACT + (size_t)R * DFF, W_QG = W_ROWS + (size_t)R * KVW, W_O = W_QG + (size_t)R * QGW, W_CMPP = W_O + (size_t)R * D,
                 W_CMPS = W_CMPP + (size_t)2 * BATCH * 128 * 256, W_END = W_CMPS + (size_t)2 * DB * 256 * 256;

static inline void gemm(hipStream_t st, const float* A, int lda, const float* W, int ldw, const float* bias, float* C, int ldc, int M, int N, int K) {
    dim3 grid((N + 63) / 64, (M + 63) / 64); k_gemm<<<grid, 256, 0, st>>>(A, lda, W, ldw, bias, C, ldc, M, N, K);
}
static inline unsigned cdiv(size_t a, size_t b) { return (unsigned)((a + b - 1) / b); }

typedef void (*Hook)(int id, void* ctx);
static void naive_forward(void* const* d_in, float* out, float* ws, hipStream_t st, Hook hook = nullptr, void* hctx = nullptr) {
#define HOOK(id) do { if (hook) hook((id), hctx); } while (0)
    const float* x_prompt = (const float*)d_in[0]; const float* x_sample = (const float*)d_in[1]; const float* c_prompt = (const float*)d_in[2]; const float* c_sample = (const float*)d_in[3];
    const float* cache_cmp = (const float*)d_in[4]; const float* cache_sel = (const float*)d_in[5]; const float* cache_win = (const float*)d_in[6]; const float* state_conv = (const float*)d_in[7];
    const int* pt = (const int*)d_in[8]; const float* w_ada = (const float*)d_in[9]; const float* b_ada = (const float*)d_in[10]; const float* norm_g = (const float*)d_in[11];
    const float* w_pw1 = (const float*)d_in[12]; const float* b_pw1 = (const float*)d_in[13]; const float* w_dw = (const float*)d_in[14]; const float* b_dw = (const float*)d_in[15];
    const float* ln_g = (const float*)d_in[16]; const float* ln_b = (const float*)d_in[17]; const float* w_pw2 = (const float*)d_in[18]; const float* b_pw2 = (const float*)d_in[19];
    const float* g_kv = (const float*)d_in[20]; const float* w_kv = (const float*)d_in[21]; const float* w_phi1 = (const float*)d_in[22]; const float* b_phi1 = (const float*)d_in[23];
    const float* w_phi2 = (const float*)d_in[24]; const float* b_phi2 = (const float*)d_in[25]; const float* pe_cmp = (const float*)d_in[26]; const float* w_qg = (const float*)d_in[27];
    const float* w_o = (const float*)d_in[28]; const float* rel_table = (const float*)d_in[29]; const float* w_gate = (const float*)d_in[30]; const float* w_up = (const float*)d_in[31];
    const float* w_down = (const float*)d_in[32]; const float* final_g = (const float*)d_in[33];
    float *SC = ws + W_SC, *MOD = ws + W_MOD, *X = ws + W_X, *H = ws + W_H, *T1 = ws + W_T1, *T2 = ws + W_T2, *U = ws + W_U, *Y = ws + W_Y, *CC = ws + W_CC, *ACT = ws + W_ACT,
          *ROWS = ws + W_ROWS, *QG = ws + W_QG, *O = ws + W_O, *CMPP = ws + W_CMPP, *CMPS = ws + W_CMPS;
    const size_t RD = (size_t)R * D;
    hipMemcpyAsync(X, x_prompt, (size_t)MP * D * 4, hipMemcpyDeviceToDevice, st);
    hipMemcpyAsync(X + (size_t)MP * D, x_sample, (size_t)MS * D * 4, hipMemcpyDeviceToDevice, st);
    k_silu_c<<<cdiv(NC * D, 256), 256, 0, st>>>(c_prompt, c_sample, SC);
    for (int ls = 0; ls < 8; ++ls) gemm(st, SC, D, w_ada + (size_t)ls * D * 3072, 3072, b_ada + (size_t)ls * 3072, MOD + (size_t)ls * NC * 3072, 3072, NC, 3072, D);
    HOOK(1);
    for (int l = 0; l < 4; ++l) {
        const float* mod0 = MOD + (size_t)(l * 2 + 0) * NC * 3072; const float* mod1 = MOD + (size_t)(l * 2 + 1) * NC * 3072;
        if (l == 2) {
            k_modnorm<<<R, 256, 0, st>>>(X, g_kv, nullptr, H);
            gemm(st, H, D, w_kv, KVW, nullptr, ROWS, KVW, R, KVW, D);
            k_kv_out<<<cdiv((size_t)MP * 512, 256), 256, 0, st>>>(ROWS, cache_win, out);
            k_compress<<<BATCH * 128 * 2, 256, 0, st>>>(1, ROWS, cache_cmp, pt, w_phi1, b_phi1, w_phi2, b_phi2, pe_cmp, CMPP);
            k_compress<<<DB * 256 * 2, 256, 0, st>>>(0, ROWS, cache_cmp, pt, w_phi1, b_phi1, w_phi2, b_phi2, pe_cmp, CMPS);
            HOOK(250);
        }
        k_modnorm<<<R, 256, 0, st>>>(X, norm_g + (size_t)(l * 2) * D, mod0, H);
        HOOK(100 * l + 1);
        if (l < 2) {
            gemm(st, H, D, w_pw1 + (size_t)l * D * 2048, 2048, b_pw1 + (size_t)l * 2048, T1, 2048, R, 2048, D);
            k_glu<<<cdiv(RD, 256), 256, 0, st>>>(T1, U);
            HOOK(100 * l + 2);
            k_conv<<<cdiv(RD, 256), 256, 0, st>>>(U, state_conv + (size_t)l * DB * 30 * D, w_dw + (size_t)l * CONVW * D, b_dw + (size_t)l * D, Y);
            k_conv_state_out<<<cdiv((size_t)(BATCH + DB) * 30 * D, 256), 256, 0, st>>>(U, state_conv + (size_t)l * DB * 30 * D, out + O_CONVP + (size_t)l * BATCH * 30 * D, out + O_CONVS + (size_t)l * DB * 30 * D);
            k_ln_silu<<<R, 256, 0, st>>>(Y, ln_g + (size_t)l * D, ln_b + (size_t)l * D, CC);
            HOOK(100 * l + 3);
            gemm(st, CC, D, w_pw2 + (size_t)l * D * D, D, b_pw2 + (size_t)l * D, T2, D, R, D, D);
        } else {
            const int lb = l - 2;
            gemm(st, H, D, w_qg + (size_t)lb * D * QGW, QGW, nullptr, QG, QGW, R, QGW, D);
            HOOK(100 * l + 2);
            AttnP P{QG, ROWS, CMPP, cache_sel, cache_win, pt, rel_table, O};
            k_attn<<<BATCH * SEQ * 4, 64, 0, st>>>(P, 1);
            P.CMP = CMPS;
            k_attn<<<DB * DS * 4, 64, 0, st>>>(P, 0);
            HOOK(100 * l + 3);
            gemm(st, O, D, w_o + (size_t)lb * D * D, D, nullptr, T2, D, R, D, D);
        }
        k_resid<<<cdiv(RD, 256), 256, 0, st>>>(X, T2, D, mod0);
        HOOK(100 * l + 4);
        k_modnorm<<<R, 256, 0, st>>>(X, norm_g + (size_t)(l * 2 + 1) * D, mod1, H);
        HOOK(100 * l + 5);
        gemm(st, H, D, w_gate + (size_t)l * D * DFF, DFF, nullptr, T1, DFF, R, DFF, D);
        gemm(st, H, D, w_up + (size_t)l * D * DFF, DFF, nullptr, T2, DFF, R, DFF, D);
        k_swiglu<<<cdiv((size_t)R * DFF, 256), 256, 0, st>>>(T1, T2, ACT);
        HOOK(100 * l + 6);
        gemm(st, ACT, DFF, w_down + (size_t)l * DFF * D, D, nullptr, T1, D, R, D, DFF);
        k_resid<<<cdiv(RD, 256), 256, 0, st>>>(X, T1, D, mod1);
        HOOK(100 * l + 7);
    }
    k_modnorm<<<R, 256, 0, st>>>(X, final_g, nullptr, H);
    hipMemcpyAsync(out + O_YP, H, (size_t)MP * D * 4, hipMemcpyDeviceToDevice, st);
    hipMemcpyAsync(out + O_YS, H + (size_t)MP * D, (size_t)MS * D * 4, hipMemcpyDeviceToDevice, st);
    HOOK(900);
#undef HOOK
}
}
namespace pg8 {
__device__ __forceinline__ int opaque_tid() { int t; asm volatile("v_mov_b32 %0, %1" : "=v"(t) : "v"(threadIdx.x)); return t; }
#define PG8_LAS __attribute__((address_space(3)))
typedef unsigned short bf16_t;
typedef short bf16x8 __attribute__((ext_vector_type(8)));
typedef float f32x4 __attribute__((ext_vector_type(4)));
typedef unsigned u32x4 __attribute__((ext_vector_type(4)));
constexpr int BM = 256, BK = 64, HALF = 128, HTB = HALF * BK * 2  , STAGE_BYTES = 8 * HTB, NXCD = 8, WGM = 8;

__host__ __device__ __forceinline__ int lds_byte(int r, int c) { const int st = (r >> 4) * 2 + (c >> 5), rr = r & 15, cc = c & 31, ob = rr * 64 + cc * 2; return st * 1024 + (ob ^ (((ob >> 9) & 1) << 5)); }
__host__ __device__ __forceinline__ void stage_rc(int b, int& R, int& C) { const int st = b / 1024, sb = b % 1024, swz = sb ^ (((sb >> 9) & 1) << 5); R = (st >> 1) * 16 + swz / 64; C = (st & 1) * 32 + (swz % 64) / 2; }
__host__ __device__ __forceinline__ int perm32(int rho) { const int n = rho >> 4, i = rho & 15; return 8 * (i >> 2) + 4 * n + (i & 3); }

struct Unit { int pm, pn; };
struct Gemm { const bf16_t* A; const bf16_t* Bt; int M, N, K; };

struct StaticOrder {
    int nM, nN, nwg, G, c;
    __host__ __device__ void init(int M, int N, int G_, int c_) { nM = M / BM; nN = N / BM; nwg = nM * nN; G = G_; c = c_; }
    __host__ __device__ bool next(int i, Unit& u) const {
        const long L = (long)i * G + c; if (L >= nwg) return false;
        int wgid = (int)L; { const int q = nwg / NXCD, r = nwg % NXCD, xcd = wgid % NXCD, off = wgid / NXCD; wgid = (xcd < r ? xcd * (q + 1) : r * (q + 1) + (xcd - r) * q) + off; }
        const int nig = WGM * nN, gid = wgid / nig, fm = gid * WGM, gsz = (nM - fm) < WGM ? (nM - fm) : WGM;
        u.pm = fm + ((wgid % nig) % gsz); u.pn = (wgid % nig) / gsz; return true;
    }
    __device__ __forceinline__ void a_ready(const Unit&) const {}
    __device__ __forceinline__ void done(const Unit&) const {}
};

template <class Epi, class Sched, bool ALIGN_EPI = false, bool SP2 = false>
__device__ __forceinline__ void gemm_phase(PG8_LAS unsigned char* lds, const Gemm g, const Sched& S, const Epi& E) {
    const int tid = opaque_tid(), wid = __builtin_amdgcn_readfirstlane(tid >> 6), lane = tid & 63, wr = wid >> 2, wc = wid & 3, fr = lane & 15, fq = lane >> 4;
    const int K = g.K, nt = K / BK;
    unsigned voffA[2], voffB[2];
#pragma unroll
    for (int i = 0; i < 2; ++i) { int R, C; stage_rc(tid * 16 + i * 8192, R, C); const int Rb = Epi::PERM ? ((R & ~31) + perm32(R & 31)) : R;
        voffA[i] = (unsigned)(R * K + C) * 2u; voffB[i] = (unsigned)(Rb * K + C) * 2u; }
    const size_t kstep = (size_t)(BK * 2);
    const size_t hstep = (size_t)HALF * K * 2;
    const size_t tstep = 2 * hstep;
    const unsigned ldsw = (unsigned)wid * 1024u;
    const int aoff = lds_byte(wr * 64 + fr, fq * 8), boff = lds_byte(wc * 32 + fr, fq * 8);
#define PG8_SA(b, h) (((b) * 2 + (h)) * HTB)
#define PG8_SB(b, h) ((4 + (b) * 2 + (h)) * HTB)
#define PG8_STAGE(bufoff, gbase, voff) do { _Pragma("unroll") for (int _i = 0; _i < 2; ++_i) \
        __builtin_amdgcn_global_load_lds((const unsigned*)((const char*)(gbase) + (voff)[_i]), (PG8_LAS unsigned*)(lds + (bufoff) + ldsw + _i * 8192), 16, 0, 0); } while (0)
#define PG8_LDA(dst, b, h) do { _Pragma("unroll") for (int m = 0; m < 4; ++m) _Pragma("unroll") for (int k = 0; k < 2; ++k) dst[m][k] = *(const PG8_LAS bf16x8*)(lds + PG8_SA(b, h) + aoff + m * 2048 + k * 1024); } while (0)
#define PG8_LDB(dst, b, h) do { _Pragma("unroll") for (int n = 0; n < 2; ++n) _Pragma("unroll") for (int k = 0; k < 2; ++k) dst[n][k] = *(const PG8_LAS bf16x8*)(lds + PG8_SB(b, h) + boff + n * 2048 + k * 1024); } while (0)
#define PG8_MMA(ai, bj, At, Bt) do { __builtin_amdgcn_s_setprio(1); _Pragma("unroll") for (int m = 0; m < 4; ++m) _Pragma("unroll") for (int n = 0; n < 2; ++n) _Pragma("unroll") for (int k = 0; k < 2; ++k) \
        acc[ai][bj][m][n] = __builtin_amdgcn_mfma_f32_16x16x32_bf16(Bt[n][k], At[m][k], acc[ai][bj][m][n], 0, 0, 0); __builtin_amdgcn_s_setprio(0); } while (0)
#define PG8_WAIT_V(n) asm volatile("s_waitcnt vmcnt(" #n ")" ::: "memory")
#define PG8_WAIT_L(n) asm volatile("s_waitcnt lgkmcnt(" #n ")" ::: "memory")
#define PG8_BAR __builtin_amdgcn_s_barrier()
#define PG8_SCHED __builtin_amdgcn_sched_barrier(0)
    Unit cur, nxt; int ui = 0;
    if (!S.next(0, cur)) return;
    f32x4 acc[2][2][4][2];
#pragma unroll
    for (int a = 0; a < 2; ++a)
#pragma unroll
        for (int b = 0; b < 2; ++b)
#pragma unroll
            for (int m = 0; m < 4; ++m)
#pragma unroll
                for (int n = 0; n < 2; ++n) acc[a][b][m][n] = (f32x4){0.f, 0.f, 0.f, 0.f};
    bf16x8 At[4][2], B0[2][2], B1[2][2];
    const char* cA = (const char*)g.A + (size_t)cur.pm * tstep; const char* cB = (const char*)g.Bt + (size_t)cur.pn * tstep;
    S.a_ready(cur);
    if constexpr (SP2) {
        PG8_STAGE(PG8_SB(0, 0), cB, voffB); PG8_STAGE(PG8_SB(0, 1), cB + hstep, voffB); PG8_STAGE(PG8_SA(0, 0), cA, voffA); PG8_STAGE(PG8_SA(0, 1), cA + hstep, voffA);
        if (wr == 1) PG8_BAR;
        PG8_WAIT_V(2); PG8_BAR;
        PG8_STAGE(PG8_SB(1, 0), cB + kstep, voffB); PG8_STAGE(PG8_SA(1, 0), cA + kstep, voffA); PG8_STAGE(PG8_SB(1, 1), cB + hstep + kstep, voffB);
        PG8_WAIT_V(6); PG8_BAR;
    } else {
        PG8_STAGE(PG8_SB(0, 0), cB, voffB); PG8_STAGE(PG8_SA(0, 0), cA, voffA); PG8_STAGE(PG8_SB(0, 1), cB + hstep, voffB); PG8_STAGE(PG8_SA(0, 1), cA + hstep, voffA);
        if (wr == 1) PG8_BAR;
        PG8_WAIT_V(4); PG8_BAR;
        PG8_STAGE(PG8_SB(1, 0), cB + kstep, voffB); PG8_STAGE(PG8_SA(1, 0), cA + kstep, voffA); PG8_STAGE(PG8_SB(1, 1), cB + hstep + kstep, voffB);
        PG8_WAIT_V(6); PG8_BAR;
    }
    for (;;) {
        const bool has_next = S.next(ui + 1, nxt);
        const char* nA = has_next ? (const char*)g.A + (size_t)nxt.pm * tstep : cA; const char* nB = has_next ? (const char*)g.Bt + (size_t)nxt.pn * tstep : cB;
        for (int t = 0; t < nt; t += 2) {
            const bool last = (t == nt - 2);
            const char* a1 = cA + (size_t)(t + 1) * kstep;
            const char* a2 = last ? nA : cA + (size_t)(t + 2) * kstep; const char* b2 = last ? nB : cB + (size_t)(t + 2) * kstep;
            const char* a3 = a2 + kstep; const char* b3 = b2 + kstep;
            if (last && has_next) S.a_ready(nxt);
            if constexpr (SP2) {
            PG8_LDB(B0, 0, 0); PG8_LDB(B1, 0, 1); PG8_SCHED; PG8_LDA(At, 0, 0); PG8_STAGE(PG8_SA(1, 1), a1 + hstep, voffA);
            PG8_WAIT_V(8); PG8_WAIT_L(0); PG8_BAR; PG8_MMA(0, 0, At, B0); PG8_MMA(0, 1, At, B1); PG8_BAR; PG8_SCHED;
            PG8_LDA(At, 0, 1); PG8_STAGE(PG8_SB(0, 0), b2, voffB); PG8_STAGE(PG8_SB(0, 1), b2 + hstep, voffB); PG8_STAGE(PG8_SA(0, 0), a2, voffA);
            PG8_WAIT_V(8); PG8_WAIT_L(0); PG8_BAR; PG8_MMA(1, 0, At, B0); PG8_MMA(1, 1, At, B1); PG8_BAR; PG8_SCHED;
            PG8_LDB(B0, 1, 0); PG8_LDB(B1, 1, 1); PG8_SCHED; PG8_LDA(At, 1, 0); PG8_STAGE(PG8_SA(0, 1), a2 + hstep, voffA);
            PG8_WAIT_V(8); PG8_WAIT_L(0); PG8_BAR; PG8_MMA(0, 0, At, B0); PG8_MMA(0, 1, At, B1); PG8_BAR; PG8_SCHED;
            PG8_LDA(At, 1, 1); PG8_STAGE(PG8_SB(1, 0), b3, voffB); PG8_STAGE(PG8_SB(1, 1), b3 + hstep, voffB); PG8_STAGE(PG8_SA(1, 0), a3, voffA);
            PG8_WAIT_V(8); PG8_WAIT_L(0); PG8_BAR; PG8_MMA(1, 0, At, B0); PG8_MMA(1, 1, At, B1); PG8_BAR; PG8_SCHED;
            } else {
            PG8_LDB(B0, 0, 0); PG8_SCHED; PG8_LDA(At, 0, 0); PG8_STAGE(PG8_SA(1, 1), a1 + hstep, voffA);
            PG8_WAIT_L(8); PG8_BAR; PG8_WAIT_L(0); PG8_MMA(0, 0, At, B0); PG8_BAR; PG8_SCHED;
            PG8_LDB(B1, 0, 1); PG8_STAGE(PG8_SB(0, 0), b2, voffB);
            PG8_BAR; PG8_WAIT_L(0); PG8_MMA(0, 1, At, B1); PG8_BAR;
            PG8_LDA(At, 0, 1); PG8_STAGE(PG8_SA(0, 0), a2, voffA);
            PG8_BAR; PG8_WAIT_L(0); PG8_MMA(1, 0, At, B0); PG8_BAR; PG8_SCHED;
            PG8_STAGE(PG8_SB(0, 1), b2 + hstep, voffB);
            PG8_WAIT_V(6); PG8_BAR; PG8_MMA(1, 1, At, B1); PG8_BAR;
            PG8_LDB(B0, 1, 0); PG8_SCHED; PG8_LDA(At, 1, 0); PG8_STAGE(PG8_SA(0, 1), a2 + hstep, voffA);
            PG8_WAIT_L(8); PG8_BAR; PG8_WAIT_L(0); PG8_MMA(0, 0, At, B0); PG8_BAR; PG8_SCHED;
            PG8_LDB(B1, 1, 1); PG8_STAGE(PG8_SB(1, 0), b3, voffB);
            PG8_BAR; PG8_WAIT_L(0); PG8_MMA(0, 1, At, B1); PG8_BAR;
            PG8_LDA(At, 1, 1); PG8_STAGE(PG8_SA(1, 0), a3, voffA);
            PG8_BAR; PG8_WAIT_L(0); PG8_MMA(1, 0, At, B0); PG8_BAR; PG8_SCHED;
            PG8_STAGE(PG8_SB(1, 1), b3 + hstep, voffB);
            PG8_WAIT_V(6); PG8_BAR; PG8_MMA(1, 1, At, B1); PG8_BAR;
            }
        }
        if constexpr (ALIGN_EPI) { if (wr == 0) PG8_BAR; }
        if constexpr (!Epi::AFTER_DRAIN) { E(acc, cur, wr, wc, fr, fq); S.done(cur); }
        if (!has_next) break;
#pragma unroll
        for (int a = 0; a < 2; ++a)
#pragma unroll
            for (int b = 0; b < 2; ++b)
#pragma unroll
                for (int m = 0; m < 4; ++m)
#pragma unroll
                    for (int n = 0; n < 2; ++n) acc[a][b][m][n] = (f32x4){0.f, 0.f, 0.f, 0.f};
        cur = nxt; cA = nA; cB = nB; ++ui;
        if constexpr (ALIGN_EPI) { if (wr == 1) PG8_BAR; }
    }
    PG8_WAIT_V(0);
    if constexpr (!ALIGN_EPI) { if (wr == 0) PG8_BAR; }
    PG8_BAR;
    if constexpr (Epi::AFTER_DRAIN) { E.fused(acc, cur, wr, wc, fr, fq, lds, wid, lane); S.done(cur); }
#undef PG8_SA
#undef PG8_SB
#undef PG8_STAGE
#undef PG8_LDA
#undef PG8_LDB
#undef PG8_MMA
#undef PG8_WAIT_V
#undef PG8_WAIT_L
#undef PG8_BAR
#undef PG8_SCHED
}
}
#define XB_TMO      128
#define XB_XCNT(j)  (256  + 64 * (j))
#define XB_XSUB(j)  (1280 + 64 * (j))
#define XB_XGEN(j)  (2304 + 64 * (j))
#define XB_TOP      3328
#define XB_TOPGEN   3392
#define XCD_BAR_WORDS 3456
#define XB_SPIN_CAP (1u << 18)
#define LAS __attribute__((address_space(3)))

__device__ __forceinline__ unsigned xb_ld(unsigned* p)              { return __hip_atomic_load(p, __ATOMIC_RELAXED, __HIP_MEMORY_SCOPE_AGENT); }
__device__ __forceinline__ unsigned xb_add(unsigned* p, unsigned v) { return __hip_atomic_fetch_add(p, v, __ATOMIC_RELAXED, __HIP_MEMORY_SCOPE_AGENT); }
__device__ __forceinline__ unsigned xb_xcc_id() { return (unsigned)__builtin_amdgcn_s_getreg((3 << 11) | 20) & 0xFu; }
#define XB_SPIN(cond, bar) do { unsigned _sp = 0; while (cond) { __builtin_amdgcn_s_sleep(1); \
    if ((++_sp & 255u) == 0u) { if (xb_ld(&(bar)[XB_TMO])) break; if (_sp > XB_SPIN_CAP) { atomicAdd(&(bar)[XB_TMO], 1u); break; } } } } while (0)

struct XcdBarrier {
    unsigned* bar; unsigned x;
    volatile LAS unsigned* st;
};

__device__ __forceinline__ XcdBarrier xcd_barrier_post(unsigned* bar, volatile LAS unsigned* st) {
    XcdBarrier b; b.bar = bar; b.x = xb_xcc_id(); b.st = st;
    if (threadIdx.x == 0) (void)xb_add(&bar[XB_XCNT(b.x)], 1u);
    return b;
}
__device__ __forceinline__ void xcd_barrier_complete(unsigned* bar, unsigned x, unsigned& nloc, unsigned& nx) {
    const unsigned G = gridDim.x * gridDim.y * gridDim.z;
    unsigned sum, cnt, mine, sp = 0u;
    for (;;) {
        sum = 0u; cnt = 0u; mine = 0u;
#pragma unroll
        for (unsigned j = 0; j < 16; ++j) { const unsigned c = xb_ld(&bar[XB_XCNT(j)]); sum += c; cnt += (c > 0u) ? 1u : 0u; mine = (j == x) ? c : mine; }
        if (sum == G) break;
        __builtin_amdgcn_s_sleep(1);
        if ((++sp & 255u) == 0u) { if (xb_ld(&bar[XB_TMO])) break; if (sp > XB_SPIN_CAP) { atomicAdd(&bar[XB_TMO], 1u); break; } }
    }
    nloc = mine > 0u ? mine : 1u; nx = cnt > 0u ? cnt : 1u;
}

__device__ __forceinline__ void xcd_barrier(const XcdBarrier& b) {
    asm volatile("s_waitcnt vmcnt(0)" ::: "memory");
    __syncthreads();
    if (threadIdx.x == 0) {
        unsigned* bar = b.bar;
        __builtin_amdgcn_s_waitcnt(0);
        unsigned nloc = b.st[0], nx = b.st[1];
        if (nloc == 0u) { xcd_barrier_complete(bar, b.x, nloc, nx); b.st[0] = nloc; b.st[1] = nx; }
        const unsigned old = xb_add(&bar[XB_XSUB(b.x)], 1u);
        const unsigned gen = old / nloc;
        if (old + 1u == (gen + 1u) * nloc) {
            __builtin_amdgcn_fence(__ATOMIC_RELEASE, "agent");
            asm volatile("s_waitcnt vmcnt(0)" ::: "memory");
            const unsigned og = xb_add(&bar[XB_TOP], 1u);
            const unsigned tg = og / nx;
            if (og + 1u == (tg + 1u) * nx) xb_add(&bar[XB_TOPGEN], 1u);
            else XB_SPIN(xb_ld(&bar[XB_TOPGEN]) == tg, bar);
            __builtin_amdgcn_fence(__ATOMIC_ACQUIRE, "agent");
            xb_add(&bar[XB_XGEN(b.x)], 1u);
            asm volatile("s_waitcnt vmcnt(0)" ::: "memory");
        } else {
            XB_SPIN(xb_ld(&bar[XB_XGEN(b.x)]) == gen, bar);
            __builtin_amdgcn_fence(__ATOMIC_ACQUIRE, "agent");
            asm volatile("s_waitcnt vmcnt(0)" ::: "memory");
        }
    }
    __syncthreads();
}

namespace fk {
using namespace nv;
typedef unsigned short bf16;
typedef float f32x4 __attribute__((ext_vector_type(4)));
typedef short bf16x8 __attribute__((ext_vector_type(8)));
typedef unsigned u32x2 __attribute__((ext_vector_type(2)));
typedef unsigned u32x4 __attribute__((ext_vector_type(4)));
#define FLAS __attribute__((address_space(3)))
constexpr float LOG2E = 1.4426950408889634f;
constexpr int NTHR = 512, NWAVE = 8;
constexpr int LDS_BYTES = 147456;
constexpr int LDS_MISC = 131072 + 8192;

__device__ __forceinline__ unsigned f2bf(float f) { unsigned u = __builtin_bit_cast(unsigned, f); return (u + 0x7fffu + ((u >> 16) & 1u)) >> 16; }
typedef __bf16 hbf16x2 __attribute__((ext_vector_type(2)));
typedef float f32x2 __attribute__((ext_vector_type(2)));
__device__ __forceinline__ unsigned pk2(float lo, float hi) { const f32x2 v = {lo, hi}; return __builtin_bit_cast(unsigned, __builtin_convertvector(v, hbf16x2)); }
__device__ __forceinline__ float bf2f(unsigned short b) { return __builtin_bit_cast(float, (unsigned)b << 16); }
__device__ __forceinline__ float fsigm(float x) { return __builtin_amdgcn_rcpf(1.f + __expf(-x)); }
__device__ __forceinline__ float fsilu(float x) { return x * __builtin_amdgcn_rcpf(1.f + __expf(-x)); }
__device__ __forceinline__ float xmax32(float v) { const unsigned u = __builtin_bit_cast(unsigned, v); auto rr = __builtin_amdgcn_permlane32_swap(u, u, false, false); return fmaxf(__builtin_bit_cast(float, (unsigned)rr[0]), __builtin_bit_cast(float, (unsigned)rr[1])); }
__device__ __forceinline__ float xsum32(float v) { const unsigned u = __builtin_bit_cast(unsigned, v); auto rr = __builtin_amdgcn_permlane32_swap(u, u, false, false); return __builtin_bit_cast(float, (unsigned)rr[0]) + __builtin_bit_cast(float, (unsigned)rr[1]); }
__device__ __forceinline__ float wsum(float v) {
#pragma unroll
    for (int o = 1; o < 64; o <<= 1) v += __shfl_xor(v, o);
    return v; }
__device__ __forceinline__ int cidx_row(int row) { return row < MP ? (row >> 12) : 4 + ((row - MP) >> 2); }

constexpr size_t al(size_t x) { return (x + 4095) & ~(size_t)4095; }
constexpr size_t F_CTL = 0, F_MOD = 1u << 20, F_WPW1 = F_MOD + al((size_t)8 * NC * 3072 * 4), F_WPW2 = F_WPW1 + (size_t)2 * 2048 * 1024 * 2,
    F_WGU = F_WPW2 + (size_t)2 * 1024 * 1024 * 2, F_WDN = F_WGU + (size_t)4 * 5632 * 1024 * 2, F_WKV = F_WDN + (size_t)4 * 1024 * 2816 * 2,
    F_WQ = F_WKV + (size_t)1536 * 1024 * 2, F_WG = F_WQ + (size_t)2 * 1024 * 1024 * 2, F_WO = F_WG + (size_t)2 * 64 * 1024 * 2, F_WPHI1 = F_WO + (size_t)2 * 1024 * 1024 * 2,
    F_WPHI2 = F_WPHI1 + (size_t)2 * 128 * 2048 * 2, F_BPHI = F_WPHI2 + (size_t)2 * 64 * 128 * 2, F_X = F_BPHI + 32768, F_H = F_X + al((size_t)R * D * 4),
    F_HKV = F_H + al((size_t)R * D * 2), F_U = F_HKV + al((size_t)R * D * 2), F_US = F_U + al((size_t)R * D * 2), F_C = F_US + (size_t)MS * D * 4, F_ACT = F_C + al((size_t)R * D * 2),
    F_RB = F_ACT + al((size_t)R * DFF * 2), F_Q = F_RB + al((size_t)R * KVW * 2), F_GT = F_Q + al((size_t)R * D * 2), F_O = F_GT + al((size_t)R * 64 * 4),
    F_VT = F_O + al((size_t)R * D * 2), F_CMPK = F_VT + (size_t)2 * 16 * 64 * 4096 * 2, F_CMPVT = F_CMPK + (size_t)16 * 128 * 64 * 2, F_CMPS = F_CMPVT + (size_t)16 * 128 * 64 * 2,
    F_PART = F_CMPS + (size_t)2 * DB * 256 * 256 * 4, F_QPART = F_PART + (size_t)8 * MS * D * 4, F_STATS = F_QPART + (size_t)8 * MS * D * 4, F_END = F_STATS + (size_t)8 * 64 * 4 * 256 * 4;
constexpr size_t CTL_BYTES = 1u << 20;

struct Args { const void* in[34]; float* out; unsigned char* fb; int lo, hi; };

typedef const __attribute__((address_space(4))) Args CArgs;
struct Ctx {
    FLAS unsigned char* lds; int tid, lane, wave, G, wg; int gw, ngw;
};
#define IN_F(i) ((const float*)A.in[i])
__device__ __forceinline__ Ctx refreshed(const Ctx& C0) { Ctx C = C0; int t; asm volatile("v_mov_b32 %0, %1" : "=v"(t) : "v"(threadIdx.x)); C.tid = t; C.lane = t & 63;
    int wg_ = C0.wg, G_ = C0.G, wv_ = C0.wave; asm volatile("" : "+s"(wg_), "+s"(G_), "+s"(wv_)); C.wg = wg_; C.G = G_; C.wave = wv_; C.gw = wg_ * NWAVE + wv_; C.ngw = G_ * NWAVE; return C; }
enum TrMode { TR_PLAIN = 0, TR_PW1 = 1, TR_GATE = 2, TR_UP = 3, TR_QG = 4 };
__device__ __forceinline__ void tr_item(const float* __restrict__ W, int K, int N, bf16* __restrict__ WT, bf16* __restrict__ WT2, int mode, FLAS float* scr, int item, int lane) {
    const int nblk = (N + 63) / 64, kb = item / nblk, nb = item % nblk, k0 = 64 * kb, n0 = 64 * nb;
    const int c4 = lane & 15, rq = lane >> 4; const bool okc = n0 + 4 * c4 < N;
    f32x4 v[16];
#pragma unroll
    for (int i = 0; i < 16; ++i) { const int kk = 4 * i + rq; v[i] = okc ? *(const f32x4*)(W + (size_t)(k0 + kk) * N + n0 + 4 * c4) : (f32x4){0.f, 0.f, 0.f, 0.f}; }
#pragma unroll
    for (int i = 0; i < 16; ++i) { const int kk = 4 * i + rq; *(FLAS f32x4*)(scr + kk * 68 + 4 * c4) = v[i]; }
    asm volatile("s_waitcnt lgkmcnt(0)" ::: "memory");
    const int c = lane & 7;
#pragma unroll
    for (int j = 0; j < 8; ++j) { const int nl = (lane >> 3) + 8 * j; const int n = n0 + nl; const FLAS float* sp = scr + (8 * c) * 68 + nl;
        u32x4 o; o.x = pk2(sp[0 * 68], sp[1 * 68]); o.y = pk2(sp[2 * 68], sp[3 * 68]); o.z = pk2(sp[4 * 68], sp[5 * 68]); o.w = pk2(sp[6 * 68], sp[7 * 68]);
        bf16* dst = WT; int nr = n;
        if (mode == TR_PW1) { const int f = n & 1023, isg = n >> 10; nr = 256 * (f >> 7) + 128 * isg + (f & 127); }
        else if (mode == TR_GATE) nr = 256 * (n >> 7) + (n & 127);
        else if (mode == TR_UP) nr = 256 * (n >> 7) + 128 + (n & 127);
        else if (mode == TR_QG) { if (n >= 1024) { dst = WT2; nr = n - 1024; } }
        if (mode != TR_QG || n < 1088) *(u32x4*)(dst + (size_t)nr * K + k0 + 8 * c) = o; }
    asm volatile("s_waitcnt lgkmcnt(0)" ::: "memory");
}
struct TrJob { const float* W; bf16* WT; bf16* WT2; int K, N, mode, nitems; };

__device__ __forceinline__ void mod_unit(const Ctx& C, CArgs& A, int unit) {
    const int ls = unit / 24, cg = unit % 24, tid = C.tid, w = C.wave, lane = C.lane;
    FLAS float* SCs = (FLAS float*)C.lds;
    const float* W = IN_F(9) + (size_t)ls * D * 3072;
    float acc0[36], acc1[36];
#pragma unroll
    for (int c = 0; c < 36; ++c) { acc0[c] = 0.f; acc1[c] = 0.f; }
    for (int half = 0; half < 2; ++half) {
        __syncthreads();
        { const int kg = 128 * (tid >> 6) + 64 * half + (tid & 63);
#pragma unroll 4
          for (int c = 0; c < 36; ++c) { const float v = c < 4 ? IN_F(2)[c * D + kg] : IN_F(3)[(c - 4) * D + kg]; SCs[tid * 36 + c] = fsilu(v); } }
        __syncthreads();
        const float* wp = W + (size_t)(128 * w + 64 * half) * 3072 + cg * 128 + lane;
        const FLAS f32x4* sp = (const FLAS f32x4*)(SCs + (w * 64) * 36);
#pragma unroll 2
        for (int kk = 0; kk < 64; ++kk) { const float w0 = wp[(size_t)kk * 3072], w1 = wp[(size_t)kk * 3072 + 64];
#pragma unroll
            for (int q = 0; q < 9; ++q) { const f32x4 sv = sp[kk * 9 + q];
#pragma unroll
                for (int j = 0; j < 4; ++j) { acc0[4 * q + j] += sv[j] * w0; acc1[4 * q + j] += sv[j] * w1; } } }
    }
    FLAS float* part = (FLAS float*)C.lds;
#pragma unroll
    for (int ps = 0; ps < 3; ++ps) {
        __syncthreads();
#pragma unroll
        for (int cc = 0; cc < 12; ++cc) { part[(w * 128 + lane) * 13 + cc] = acc0[12 * ps + cc]; part[(w * 128 + lane + 64) * 13 + cc] = acc1[12 * ps + cc]; }
        __syncthreads();
        for (int o = tid; o < 12 * 128; o += NTHR) { const int cc = o >> 7, nn = o & 127, c = 12 * ps + cc, ng = cg * 128 + nn; float v = IN_F(10)[ls * 3072 + ng];
#pragma unroll
            for (int ww = 0; ww < 8; ++ww) v += part[(ww * 128 + nn) * 13 + cc];
            if (ng >= 1024 && ng < 2048) v = IN_F(11)[ls * D + ng - 1024] * (1.f + v);
            ((float*)(A.fb + F_MOD))[((size_t)ls * NC + c) * 3072 + ng] = v; }
    }
    __syncthreads();
}

__device__ __forceinline__ void phase_prologue(const Ctx& C, CArgs& A) {
    unsigned char* fb = A.fb;
    {
        FLAS float* scr = (FLAS float*)(C.lds + C.wave * 17408);
        int it = C.gw;
#pragma unroll 1
        for (int job = 0; job < 25; ++job) {
            const float* Wp; bf16* WTp; bf16* WT2p = nullptr; int Kv, Nv, modev;
            if (job < 12) { const int l = job / 6, t = job % 6;
                if (t == 0) { Wp = IN_F(12) + (size_t)l * D * 2048; WTp = (bf16*)(fb + F_WPW1) + (size_t)l * 2048 * 1024; Kv = 1024; Nv = 2048; modev = TR_PW1; }
                else if (t == 1) { Wp = IN_F(18) + (size_t)l * D * D; WTp = (bf16*)(fb + F_WPW2) + (size_t)l * 1024 * 1024; Kv = 1024; Nv = 1024; modev = TR_PLAIN; }
                else if (t == 2) { Wp = IN_F(27) + (size_t)l * D * QGW; WTp = (bf16*)(fb + F_WQ) + (size_t)l * 1024 * 1024; WT2p = (bf16*)(fb + F_WG) + (size_t)l * 64 * 1024; Kv = 1024; Nv = QGW; modev = TR_QG; }
                else if (t == 3) { Wp = IN_F(28) + (size_t)l * D * D; WTp = (bf16*)(fb + F_WO) + (size_t)l * 1024 * 1024; Kv = 1024; Nv = 1024; modev = TR_PLAIN; }
                else if (t == 4) { Wp = IN_F(22) + (size_t)l * 2048 * PHI; WTp = (bf16*)(fb + F_WPHI1) + (size_t)l * 128 * 2048; Kv = 2048; Nv = 128; modev = TR_PLAIN; }
                else { Wp = IN_F(24) + (size_t)l * PHI * 64; WTp = (bf16*)(fb + F_WPHI2) + (size_t)l * 64 * 128; Kv = 128; Nv = 64; modev = TR_PLAIN; }
            } else if (job < 24) { const int l = (job - 12) / 3, t = (job - 12) % 3;
                if (t == 0) { Wp = IN_F(30) + (size_t)l * D * DFF; WTp = (bf16*)(fb + F_WGU) + (size_t)l * 5632 * 1024; Kv = 1024; Nv = DFF; modev = TR_GATE; }
                else if (t == 1) { Wp = IN_F(31) + (size_t)l * D * DFF; WTp = (bf16*)(fb + F_WGU) + (size_t)l * 5632 * 1024; Kv = 1024; Nv = DFF; modev = TR_UP; }
                else { Wp = IN_F(32) + (size_t)l * DFF * D; WTp = (bf16*)(fb + F_WDN) + (size_t)l * 1024 * 2816; Kv = 2816; Nv = 1024; modev = TR_PLAIN; }
            } else { Wp = IN_F(21); WTp = (bf16*)(fb + F_WKV); Kv = 1024; Nv = KVW; modev = TR_PLAIN; }
            const int nit = (Kv / 64) * ((Nv + 63) / 64);
            while (it < nit) { tr_item(Wp, Kv, Nv, WTp, WT2p, modev, scr, it, C.lane); it += C.ngw; }
            it -= nit;
        }
    }
    {
        const size_t gt = (size_t)C.wg * NTHR + C.tid, nt = (size_t)C.G * NTHR;
        const f32x4* src = (const f32x4*)IN_F(6); f32x4* dst = (f32x4*)(A.out + O_WINS);
        for (size_t i = gt; i < (size_t)DB * 508 * 128; i += nt) { const size_t b = i / (508 * 128), r = i % (508 * 128); dst[b * 512 * 128 + r] = src[b * 512 * 128 + 4 * 128 + r]; }
        const f32x4* s2 = (const f32x4*)IN_F(7); f32x4* d2 = (f32x4*)(A.out + O_CONVS);
        for (size_t i = gt; i < (size_t)2 * DB * 26 * 256; i += nt) { const size_t lb = i / (26 * 256), r = i % (26 * 256); d2[lb * 30 * 256 + r] = s2[lb * 30 * 256 + 4 * 256 + r]; }
    }
    { const int ck = C.G - 1 - C.wg;
      if (ck < 16 && C.tid < 256) { const int e = C.tid >> 7, h = C.tid & 127; float a = ck == 0 ? IN_F(23)[e * PHI + h] : 0.f; const float* w = IN_F(22) + ((size_t)e * 2048 + ck * 128) * PHI + h; const float* pe = IN_F(26) + e * 2048 + ck * 128;
#pragma unroll 16
          for (int f = 0; f < 128; ++f) a += pe[f] * w[(size_t)f * PHI];
          ((float*)(fb + F_BPHI))[ck * 256 + e * PHI + h] = a; } }
    __syncthreads();
    for (int u = C.wg; u < 192; u += C.G) mod_unit(C, A, u);
}

__device__ __forceinline__ f32x4 bfx4(unsigned lo, unsigned hi) { f32x4 r; r[0] = __builtin_bit_cast(float, lo << 16); r[1] = __builtin_bit_cast(float, lo & 0xffff0000u); r[2] = __builtin_bit_cast(float, hi << 16); r[3] = __builtin_bit_cast(float, hi & 0xffff0000u); return r; }
__device__ __forceinline__ void phase_norm(const Ctx& C, CArgs& A, int mode, int ls, bool from_input, int pend_ls, const float* pend_bias, bool pend_in, int first, int step, int limit) {
    unsigned char* fb = A.fb; const float* modf = (const float*)(fb + F_MOD) + (size_t)ls * NC * 3072; const bf16* XB = (const bf16*)(fb + F_X);
    if (from_input && C.wg == 0 && C.tid < 256) { const float* p = (const float*)(fb + F_BPHI); float a = 0.f;
#pragma unroll
        for (int ck = 0; ck < 16; ++ck) a += p[ck * 256 + C.tid];
        ((float*)(fb + F_BPHI))[4096 + C.tid] = a; }
    constexpr int NB = 4;
    for (int row0 = first; row0 < limit; row0 += NB * step) {
        f32x4 v[NB][4];
#pragma unroll
        for (int i = 0; i < NB; ++i) { const int rq = row0 + i * step; const int rr = rq < limit ? rq : row0;
            if (from_input || (pend_in && rr >= MP)) { const float* xr = rr < MP ? IN_F(0) + (size_t)rr * D : IN_F(1) + (size_t)(rr - MP) * D;
#pragma unroll
                for (int jj = 0; jj < 2; ++jj) { v[i][2 * jj] = *(const f32x4*)(xr + 8 * (C.lane + 64 * jj)); v[i][2 * jj + 1] = *(const f32x4*)(xr + 8 * (C.lane + 64 * jj) + 4); } }
            else { const bf16* xr = XB + (size_t)rr * D;
#pragma unroll
                for (int jj = 0; jj < 2; ++jj) { const u32x4 t = *(const u32x4*)(xr + 8 * (C.lane + 64 * jj)); v[i][2 * jj] = bfx4(t.x, t.y); v[i][2 * jj + 1] = bfx4(t.z, t.w); } } }
#pragma unroll
        for (int i = 0; i < NB; ++i) { const int row = row0 + i * step; if (row >= limit) break;
            if (pend_ls >= 0 && row >= MP) { const float* pp = (const float*)(fb + F_PART) + (size_t)(row - MP) * D; const float* gm = (const float*)(fb + F_MOD) + ((size_t)pend_ls * NC + cidx_row(row)) * 3072 + 2048;
#pragma unroll
                for (int j = 0; j < 4; ++j) { const int c0 = 8 * (C.lane + 64 * (j >> 1)) + 4 * (j & 1); f32x4 y = {0.f, 0.f, 0.f, 0.f}; if (pend_bias) y = *(const f32x4*)(pend_bias + c0);
#pragma unroll
                    for (int ksl = 0; ksl < 8; ++ksl) y += *(const f32x4*)(pp + (size_t)ksl * MS * D + c0);
                    v[i][j] += *(const f32x4*)(gm + c0) * y; }
#pragma unroll
                for (int jj = 0; jj < 2; ++jj) { u32x4 o; o.x = pk2(v[i][2 * jj][0], v[i][2 * jj][1]); o.y = pk2(v[i][2 * jj][2], v[i][2 * jj][3]); o.z = pk2(v[i][2 * jj + 1][0], v[i][2 * jj + 1][1]); o.w = pk2(v[i][2 * jj + 1][2], v[i][2 * jj + 1][3]);
                    *(u32x4*)((bf16*)(fb + F_X) + (size_t)row * D + 8 * (C.lane + 64 * jj)) = o; } }
            float ss = 0.f;
#pragma unroll
            for (int j = 0; j < 4; ++j) ss += (v[i][j][0] * v[i][j][0] + v[i][j][1] * v[i][j][1]) + (v[i][j][2] * v[i][j][2] + v[i][j][3] * v[i][j][3]);
            const float rstd = rsqrtf(wsum(ss) * (1.f / D) + EPS);
            if (mode == 2) { float* yo = row < MP ? A.out + O_YP + (size_t)row * D : A.out + O_YS + (size_t)(row - MP) * D;
#pragma unroll
                for (int j = 0; j < 4; ++j) { const int c0 = 8 * (C.lane + 64 * (j >> 1)) + 4 * (j & 1); const f32x4 g = *(const f32x4*)(IN_F(33) + c0); *(f32x4*)(yo + c0) = v[i][j] * rstd * g; }
                continue; }
            const float* m = modf + (size_t)cidx_row(row) * 3072;
#pragma unroll
            for (int jj = 0; jj < 2; ++jj) { const int c0 = 8 * (C.lane + 64 * jj);
                const f32x4 h0 = v[i][2 * jj] * rstd * *(const f32x4*)(m + D + c0) + *(const f32x4*)(m + c0), h1 = v[i][2 * jj + 1] * rstd * *(const f32x4*)(m + D + c0 + 4) + *(const f32x4*)(m + c0 + 4);
                u32x4 o; o.x = pk2(h0[0], h0[1]); o.y = pk2(h0[2], h0[3]); o.z = pk2(h1[0], h1[1]); o.w = pk2(h1[2], h1[3]); *(u32x4*)((bf16*)(fb + F_H) + (size_t)row * D + c0) = o; }
            if (mode == 1) {
#pragma unroll
                for (int jj = 0; jj < 2; ++jj) { const int c0 = 8 * (C.lane + 64 * jj);
                    const f32x4 h0 = v[i][2 * jj] * rstd * *(const f32x4*)(IN_F(20) + c0), h1 = v[i][2 * jj + 1] * rstd * *(const f32x4*)(IN_F(20) + c0 + 4);
                    u32x4 o; o.x = pk2(h0[0], h0[1]); o.y = pk2(h0[2], h0[3]); o.z = pk2(h1[0], h1[1]); o.w = pk2(h1[2], h1[3]); *(u32x4*)((bf16*)(fb + F_HKV) + (size_t)row * D + c0) = o; } }
        }
    }
}

struct EpGLU { static constexpr bool PERM = true, PAIRED = true;
    bf16* U; float* US; const float* b1; float* convp; float* convs;
    __device__ __forceinline__ void st2(int row, int f, f32x4 a, f32x4 g) const {
        const f32x4 ba = *(const f32x4*)(b1 + f), bg = *(const f32x4*)(b1 + 1024 + f); f32x4 u;
#pragma unroll
        for (int j = 0; j < 4; ++j) u[j] = (a[j] + ba[j]) * fsigm(g[j] + bg[j]);
        u32x2 o; o.x = pk2(u[0], u[1]); o.y = pk2(u[2], u[3]); *(u32x2*)(U + (size_t)row * D + f) = o;
        if (row < MP) { const int t = row & 4095; if (t >= 4066) *(f32x4*)(convp + ((size_t)(row >> 12) * 30 + (t - 4066)) * D + f) = u; }
        else { const int rs = row - MP; *(f32x4*)(US + (size_t)rs * D + f) = u; *(f32x4*)(convs + ((size_t)(rs >> 2) * 30 + 26 + (rs & 3)) * D + f) = u; }
    } };
struct EpSwiGLU { static constexpr bool PERM = true, PAIRED = true;
    bf16* ACT;
    __device__ __forceinline__ void st2(int row, int f, f32x4 g, f32x4 u) const {
        f32x4 a;
#pragma unroll
        for (int j = 0; j < 4; ++j) a[j] = fsilu(g[j]) * u[j];
        u32x2 o; o.x = pk2(a[0], a[1]); o.y = pk2(a[2], a[3]); *(u32x2*)(ACT + (size_t)row * DFF + f) = o;
    } };
struct EpResid { static constexpr bool PERM = false, PAIRED = false;
    const float* xp; const float* xs; bf16* X; const float* mod; const float* bias;
    __device__ __forceinline__ void st(int row, int col, f32x4 v) const {
        const f32x4 gt = *(const f32x4*)(mod + (size_t)cidx_row(row) * 3072 + 2048 + col);
        f32x4 x;
        if (xp) x = row < MP ? *(const f32x4*)(xp + (size_t)row * D + col) : *(const f32x4*)(xs + (size_t)(row - MP) * D + col);
        else { const u32x2 t = *(const u32x2*)(X + (size_t)row * D + col); x = bfx4(t.x, t.y); }
        f32x4 b = {0.f, 0.f, 0.f, 0.f}; if (bias) b = *(const f32x4*)(bias + col);
        const f32x4 y = x + gt * (v + b); u32x2 o; o.x = pk2(y[0], y[1]); o.y = pk2(y[2], y[3]); *(u32x2*)(X + (size_t)row * D + col) = o;
    } };
struct EpKV { static constexpr bool PERM = false, PAIRED = false;
    float* out; bf16* RB;
    __device__ __forceinline__ void st(int row, int col, f32x4 v) const {
        u32x2 o; o.x = pk2(v[0], v[1]); o.y = pk2(v[2], v[3]); *(u32x2*)(RB + (size_t)row * KVW + col) = o;
        const int br = col >> 9, c = col & 511;
        if (row < MP) {
            if (br == 0) *(f32x4*)(out + O_CMPP + (size_t)row * 512 + c) = v;
            else if (br == 1) *(f32x4*)(out + O_SELP + (size_t)row * 512 + c) = v;
            else { const int t = row & 4095; if (t >= 3584) *(f32x4*)(out + O_WINP + ((size_t)(row >> 12) * 512 + (t - 3584)) * 512 + c) = v; }
        } else { const int rs = row - MP;
            if (br == 0) *(f32x4*)(out + O_CMPS + (size_t)rs * 512 + c) = v;
            else if (br == 1) *(f32x4*)(out + O_SELS + (size_t)rs * 512 + c) = v;
            else *(f32x4*)(out + O_WINS + ((size_t)(rs >> 2) * 512 + 508 + (rs & 3)) * 512 + c) = v; }
    } };
struct EpQ { static constexpr bool PERM = true, PAIRED = false;
    bf16* Q;
    __device__ __forceinline__ void st(int row, int col, f32x4 v) const {
        const float s = 0.125f * LOG2E; u32x2 o; o.x = pk2(v[0] * s, v[1] * s); o.y = pk2(v[2] * s, v[3] * s); *(u32x2*)(Q + (size_t)row * D + col) = o;
    } };
struct EpGates { static constexpr bool PERM = false, PAIRED = false;
    float* GT;
    __device__ __forceinline__ void st(int row, int col, f32x4 v) const {
        f32x4 o; o[0] = fsigm(v[0]); o[1] = fsigm(v[1]); o[2] = fsigm(v[2]); o[3] = fsigm(v[3]); *(f32x4*)(GT + (size_t)row * 64 + col) = o;
    } };
__device__ __forceinline__ void st_pair16(bf16* rowbase, int fq, u32x2 o0, u32x2 o1) {
    const auto r0 = __builtin_amdgcn_permlane16_swap(o0.x, o1.x, false, false); const auto r1 = __builtin_amdgcn_permlane16_swap(o0.y, o1.y, false, false);
    u32x4 wv; wv.x = (unsigned)r0[0]; wv.y = (unsigned)r1[0]; wv.z = (unsigned)r0[1]; wv.w = (unsigned)r1[1];
    *(u32x4*)(rowbase + ((fq & 1) ? 16 + 4 * (fq - 1) : 4 * fq)) = wv; }
struct EpResidNorm { static constexpr bool PERM = false, AFTER_DRAIN = true;
    const float* xp;
    bf16* X; const float* mod; const float* bias;
    int mode;
    const float* nmod; const float* gk; bf16* H; bf16* HKV; float* yout;
    float* stats; unsigned* cnt; unsigned* bar;
    __device__ __forceinline__ void operator()(const pg8::f32x4 (&)[2][2][4][2], const pg8::Unit&, int, int, int, int) const {}
    __device__ __forceinline__ void fused(pg8::f32x4 (&acc)[2][2][4][2], const pg8::Unit& u, int wr, int wc, int fr, int fq, PG8_LAS unsigned char* lds, int wid, int lane) const {
        const int cidx = u.pm >> 4; const float* gm = mod + (size_t)cidx * 3072 + 2048; const int tid = wid * 64 + lane;
        PG8_LAS float* sred = (PG8_LAS float*)lds; PG8_LAS float* srs = (PG8_LAS float*)(lds + 4096);
        f32x4 gv[2][2];
#pragma unroll
        for (int bj = 0; bj < 2; ++bj)
#pragma unroll
            for (int n = 0; n < 2; ++n) { const int col = u.pn * 256 + bj * 128 + wc * 32 + 16 * n + 4 * fq; gv[bj][n] = *(const f32x4*)(gm + col); }
        if (bias) {
#pragma unroll
            for (int bj = 0; bj < 2; ++bj)
#pragma unroll
                for (int n = 0; n < 2; ++n) { const f32x4 b = *(const f32x4*)(bias + (u.pn * 256 + bj * 128 + wc * 32 + 16 * n + 4 * fq));
#pragma unroll
                    for (int ai = 0; ai < 2; ++ai)
#pragma unroll
                        for (int m = 0; m < 4; ++m) acc[ai][bj][m][n] += b; } }
#pragma unroll
        for (int ai = 0; ai < 2; ++ai)
#pragma unroll
            for (int m = 0; m < 4; ++m) { const int rl = ai * 128 + wr * 64 + m * 16 + fr; const size_t row = (size_t)u.pm * 256 + rl; float ss = 0.f;
                f32x4 xv[2][2];
                if (xp) {
#pragma unroll
                    for (int bj = 0; bj < 2; ++bj)
#pragma unroll
                        for (int n = 0; n < 2; ++n) xv[bj][n] = *(const f32x4*)(xp + row * D + (u.pn * 256 + bj * 128 + wc * 32 + 16 * n + 4 * fq));
                    __builtin_amdgcn_sched_barrier(0);
                } else { u32x4 t[2];
#pragma unroll
                    for (int bj = 0; bj < 2; ++bj) t[bj] = *(const u32x4*)(X + row * D + (u.pn * 256 + bj * 128 + wc * 32) + ((fq & 1) ? 16 + 4 * (fq - 1) : 4 * fq));
                    __builtin_amdgcn_sched_barrier(0);
#pragma unroll
                    for (int bj = 0; bj < 2; ++bj) { const auto r0 = __builtin_amdgcn_permlane16_swap(t[bj].x, t[bj].z, false, false); const auto r1 = __builtin_amdgcn_permlane16_swap(t[bj].y, t[bj].w, false, false);
                        xv[bj][0] = bfx4((unsigned)r0[0], (unsigned)r1[0]); xv[bj][1] = bfx4((unsigned)r0[1], (unsigned)r1[1]); } }
#pragma unroll
                for (int bj = 0; bj < 2; ++bj) { u32x2 o[2];
#pragma unroll
                    for (int n = 0; n < 2; ++n) {
                        const f32x4 y = xv[bj][n] + gv[bj][n] * acc[ai][bj][m][n]; acc[ai][bj][m][n] = y;
                        o[n].x = pk2(y[0], y[1]); o[n].y = pk2(y[2], y[3]);
                        ss += (y[0] * y[0] + y[1] * y[1]) + (y[2] * y[2] + y[3] * y[3]); }
                    st_pair16(X + row * D + (u.pn * 256 + bj * 128 + wc * 32), fq, o[0], o[1]); }
                ss += __shfl_xor(ss, 16); ss += __shfl_xor(ss, 32);
                if (fq == 0) sred[rl * 4 + wc] = ss;
                asm volatile("" ::: "memory"); }
        __syncthreads();
        if (tid < 256) __hip_atomic_store((unsigned*)stats + ((size_t)u.pm * 4 + u.pn) * 256 + tid, __builtin_bit_cast(unsigned, (sred[tid * 4] + sred[tid * 4 + 1]) + (sred[tid * 4 + 2] + sred[tid * 4 + 3])), __ATOMIC_RELAXED, __HIP_MEMORY_SCOPE_AGENT);
        if (wid < 4) { asm volatile("s_waitcnt vmcnt(0)" ::: "memory"); if (lane == 0) (void)xb_add(cnt + 64 * u.pm, 1u); }
        if (tid == 0) { XB_SPIN(xb_ld(cnt + 64 * u.pm) < 16u, bar); __builtin_amdgcn_fence(__ATOMIC_ACQUIRE, "agent"); asm volatile("s_waitcnt vmcnt(0)" ::: "memory"); }
        __syncthreads();
        if (tid < 256) { float t = 0.f;
#pragma unroll
            for (int p2 = 0; p2 < 4; ++p2) t += __builtin_bit_cast(float, __hip_atomic_load((unsigned*)stats + ((size_t)u.pm * 4 + p2) * 256 + tid, __ATOMIC_RELAXED, __HIP_MEMORY_SCOPE_AGENT));
            srs[tid] = rsqrtf(t * (1.f / D) + EPS); }
        __syncthreads();
        const float* am = nmod + (size_t)cidx * 3072;
        if (mode != 2) { f32x4 sc4[2][2], sh4[2][2];
#pragma unroll
            for (int bj = 0; bj < 2; ++bj)
#pragma unroll
                for (int n = 0; n < 2; ++n) { const int col = u.pn * 256 + bj * 128 + wc * 32 + 16 * n + 4 * fq; sc4[bj][n] = *(const f32x4*)(am + D + col); sh4[bj][n] = *(const f32x4*)(am + col); }
#pragma unroll
            for (int ai = 0; ai < 2; ++ai)
#pragma unroll
                for (int m = 0; m < 4; ++m) { const int rl = ai * 128 + wr * 64 + m * 16 + fr; const size_t row = (size_t)u.pm * 256 + rl; const float rs = srs[rl];
#pragma unroll
                    for (int bj = 0; bj < 2; ++bj) { u32x2 oh[2];
#pragma unroll
                        for (int n = 0; n < 2; ++n) { const f32x4 h = (acc[ai][bj][m][n] * rs) * sc4[bj][n] + sh4[bj][n]; oh[n].x = pk2(h[0], h[1]); oh[n].y = pk2(h[2], h[3]); }
                        st_pair16(H + row * D + (u.pn * 256 + bj * 128 + wc * 32), fq, oh[0], oh[1]); }
                    asm volatile("" ::: "memory"); } }
        if (mode != 0) { f32x4 gk4[2][2];
#pragma unroll
            for (int bj = 0; bj < 2; ++bj)
#pragma unroll
                for (int n = 0; n < 2; ++n) gk4[bj][n] = *(const f32x4*)(gk + (u.pn * 256 + bj * 128 + wc * 32 + 16 * n + 4 * fq));
#pragma unroll
            for (int ai = 0; ai < 2; ++ai)
#pragma unroll
                for (int m = 0; m < 4; ++m) { const int rl = ai * 128 + wr * 64 + m * 16 + fr; const size_t row = (size_t)u.pm * 256 + rl; const float rs = srs[rl];
#pragma unroll
                    for (int bj = 0; bj < 2; ++bj) {
                        if (mode == 2) {
#pragma unroll
                            for (int n = 0; n < 2; ++n) *(f32x4*)(yout + row * D + (u.pn * 256 + bj * 128 + wc * 32 + 16 * n + 4 * fq)) = (acc[ai][bj][m][n] * rs) * gk4[bj][n];
                        } else { u32x2 ok[2];
#pragma unroll
                            for (int n = 0; n < 2; ++n) { const f32x4 k = (acc[ai][bj][m][n] * rs) * gk4[bj][n]; ok[n].x = pk2(k[0], k[1]); ok[n].y = pk2(k[2], k[3]); }
                            st_pair16(HKV + row * D + (u.pn * 256 + bj * 128 + wc * 32), fq, ok[0], ok[1]); } }
                    asm volatile("" ::: "memory"); } }
    } };
template <class E> struct PgE { static constexpr bool PERM = E::PERM, AFTER_DRAIN = false; E e;
    __device__ __forceinline__ void operator()(const pg8::f32x4 (&acc)[2][2][4][2], const pg8::Unit& u, int wr, int wc, int fr, int fq) const {
#pragma unroll
        for (int ai = 0; ai < 2; ++ai)
#pragma unroll
            for (int m = 0; m < 4; ++m) { const int row = u.pm * 256 + ai * 128 + wr * 64 + m * 16 + fr;
                if constexpr (E::PAIRED) {
#pragma unroll
                    for (int n = 0; n < 2; ++n) { const int f = u.pn * 128 + wc * 32 + (E::PERM ? 8 * fq + 4 * n : 16 * n + 4 * fq); e.st2(row, f, acc[ai][0][m][n], acc[ai][1][m][n]); }
                } else {
#pragma unroll
                    for (int bj = 0; bj < 2; ++bj)
#pragma unroll
                        for (int n = 0; n < 2; ++n) { const int col = u.pn * 256 + bj * 128 + wc * 32 + (E::PERM ? 8 * fq + 4 * n : 16 * n + 4 * fq); e.st(row, col, acc[ai][bj][m][n]); }
                }
                asm volatile("" ::: "memory"); }
    } };
template <class E> __device__ __forceinline__ void gemm_prompt(const Ctx& C, const bf16* Ap, const bf16* Bt, int N, int K, const E& e) {
    pg8::Gemm g{Ap, Bt, MP, N, K}; pg8::StaticOrder S; S.init(MP, N, C.G, C.wg); PgE<E> pe{e};
    pg8::gemm_phase<PgE<E>, pg8::StaticOrder, true, true>((PG8_LAS unsigned char*)C.lds, g, S, pe);
}
__device__ __forceinline__ void gemm_prompt_fused(const Ctx& C, const bf16* Ap, const bf16* Bt, int K, const EpResidNorm& e) {
    pg8::Gemm g{Ap, Bt, MP, 1024, K}; pg8::StaticOrder S; S.init(MP, 1024, C.G, C.wg);
    pg8::gemm_phase<EpResidNorm, pg8::StaticOrder, true, true>((PG8_LAS unsigned char*)C.lds, g, S, e);
}
__device__ __forceinline__ void sample_norm_part(const Ctx& C, CArgs& A, int mode, int ls, int pend_ls, const float* pend_bias, bool pend_in, unsigned* flag) {
    if (C.wg >= C.G - 16) {
        phase_norm(C, A, mode, ls, false, pend_ls, pend_bias, pend_in, MP + 8 * (C.wg - (C.G - 16)) + C.wave, MS, R);
        asm volatile("s_waitcnt vmcnt(0)" ::: "memory"); __syncthreads();
        if (C.tid == 0) { __builtin_amdgcn_fence(__ATOMIC_RELEASE, "agent"); asm volatile("s_waitcnt vmcnt(0)" ::: "memory"); (void)xb_add(flag, 1u); }
    }
}
__device__ __forceinline__ void sample_rows_ready(const Ctx& C, unsigned* flag, unsigned* bar) {
    if (C.tid == 0) { XB_SPIN(xb_ld(flag) < 16u, bar); __builtin_amdgcn_fence(__ATOMIC_ACQUIRE, "agent"); asm volatile("s_waitcnt vmcnt(0)" ::: "memory"); }
    __syncthreads();
}
__device__ __forceinline__ void phase_conv(const Ctx& C, CArgs& A, int l) {
    unsigned char* fb = A.fb; const bf16* U = (const bf16*)(fb + F_U); bf16* Cc = (bf16*)(fb + F_C); const float* US = (const float*)(fb + F_US);
    const int c0 = 2 * C.tid;
    constexpr int TOK = 8, NR = 528;
    const unsigned voff2 = (unsigned)c0 * 2u, voff4 = (unsigned)c0 * 4u;
    float w0[31], w1[31];
    { const char* wb = (const char*)(IN_F(14) + ((size_t)l * CONVW) * D);
#pragma unroll
      for (int k = 0; k < 31; ++k) { const float2 w = *(const float2*)(wb + (size_t)k * (D * 4) + voff4); w0[k] = w.x; w1[k] = w.y; } }
    const float2 bdw = *(const float2*)(IN_F(15) + l * D + c0), lg = *(const float2*)(IN_F(16) + l * D + c0), lb = *(const float2*)(IN_F(17) + l * D + c0);
    FLAS float* red = (FLAS float*)C.lds;
    FLAS float* ybuf = (FLAS float*)(C.lds + 65536);
    const int nPU = MP / TOK, nU = nPU + DB;
    for (int u = C.wg; u < nU; u += C.G) {
        int ntok; size_t orow0;
        __syncthreads();
        if (u < nPU) {
            const int row0 = u * TOK, t0 = row0 & 4095; ntok = TOK; orow0 = row0;
            {
                const char* up = (const char*)(U + (size_t)(row0 - 30) * D); float a0[TOK], a1[TOK];
#pragma unroll
                for (int tt = 0; tt < TOK; ++tt) { a0[tt] = bdw.x; a1[tt] = bdw.y; }
                unsigned xv[TOK + 30];
#pragma unroll
                for (int i = 0; i < TOK + 30; ++i) { xv[i] = 0u; if (t0 - 30 + i >= 0) xv[i] = *(const unsigned*)(up + (size_t)i * (D * 2) + voff2); }
#pragma unroll
                for (int i = 0; i < TOK + 30; ++i) { const float x0 = __builtin_bit_cast(float, xv[i] << 16), x1 = __builtin_bit_cast(float, xv[i] & 0xffff0000u);
#pragma unroll
                    for (int tt = 0; tt < TOK; ++tt) { const int k = i - tt; if (k >= 0 && k < 31) { a0[tt] += w0[k] * x0; a1[tt] += w1[k] * x1; } } }
#pragma unroll
                for (int tt = 0; tt < TOK; ++tt) { const int t = tt; ybuf[(t * NTHR + C.tid) * 2] = a0[tt]; ybuf[(t * NTHR + C.tid) * 2 + 1] = a1[tt]; red[(2 * t) * NR + C.tid] = a0[tt] + a1[tt]; red[(2 * t + 1) * NR + C.tid] = a0[tt] * a0[tt] + a1[tt] * a1[tt]; } }
        } else {
            const int b = u - nPU; ntok = 4; orow0 = (size_t)MP + b * 4;
            const char* sp = (const char*)(IN_F(7) + (((size_t)l * DB + b) * 30) * D); const char* usp = (const char*)(US + ((size_t)b * 4) * D);
            for (int t = 0; t < TOK; ++t) { float a0 = bdw.x, a1 = bdw.y;
                if (t < 4) {
#pragma unroll
                    for (int k = 0; k < 31; ++k) { const int j = t + k; const char* p = j < 30 ? sp + (size_t)j * (D * 4) : usp + (size_t)(j - 30) * (D * 4); const float2 v = *(const float2*)(p + voff4);
                        a0 += w0[k] * v.x; a1 += w1[k] * v.y; } }
                ybuf[(t * NTHR + C.tid) * 2] = a0; ybuf[(t * NTHR + C.tid) * 2 + 1] = a1; red[(2 * t) * NR + C.tid] = a0 + a1; red[(2 * t + 1) * NR + C.tid] = a0 * a0 + a1 * a1; }
        }
        __syncthreads();
        { const int v = C.tid >> 5, part = C.tid & 31; float s = 0.f;
#pragma unroll 8
          for (int i = 0; i < 16; ++i) s += red[v * NR + i * 32 + part];
          s += __shfl_xor(s, 1); s += __shfl_xor(s, 2); s += __shfl_xor(s, 4); s += __shfl_xor(s, 8); s += __shfl_xor(s, 16);
          if (part == 0) red[2 * TOK * NR + v] = s; }
        __syncthreads();
        for (int t = 0; t < ntok; ++t) { const float mu = red[2 * TOK * NR + 2 * t] * (1.f / D); const float var = red[2 * TOK * NR + 2 * t + 1] * (1.f / D) - mu * mu; const float rstd = rsqrtf(fmaxf(var, 0.f) + EPS);
            const float yx = ybuf[(t * NTHR + C.tid) * 2], yy = ybuf[(t * NTHR + C.tid) * 2 + 1];
            const float o0 = fsilu((yx - mu) * rstd * lg.x + lb.x), o1 = fsilu((yy - mu) * rstd * lg.y + lb.y);
            *(unsigned*)(Cc + (orow0 + t) * D + c0) = pk2(o0, o1); }
    }
    __syncthreads();
}
#define FK_HAVE_ATTN 1
typedef float f32x16 __attribute__((ext_vector_type(16)));
template <class E> __device__ __forceinline__ void gemm128(const Ctx& C, const bf16* Arows  , int grow0, const bf16* Bt, int K, const E& e, int u) {
    const int fr = C.lane & 15, fq = C.lane >> 4, w = C.wave;
    int brow[2];
    if (E::PAIRED) { const int f = u * 16; brow[0] = 256 * (f >> 7) + (f & 127); brow[1] = brow[0] + 128; } else { brow[0] = u * 32; brow[1] = u * 32 + 16; }
    f32x4 acc[8][2];
#pragma unroll
    for (int rt = 0; rt < 8; ++rt) { acc[rt][0] = (f32x4){0.f, 0.f, 0.f, 0.f}; acc[rt][1] = (f32x4){0.f, 0.f, 0.f, 0.f}; }
    const int kw = K >> 3, k0 = w * kw;
    const bf16* ap = Arows + (size_t)fr * K + k0 + fq * 8; const bf16* bp0 = Bt + (size_t)(brow[0] + fr) * K + k0 + fq * 8; const bf16* bp1 = Bt + (size_t)(brow[1] + fr) * K + k0 + fq * 8;
    bf16x8 b0 = *(const bf16x8*)bp0, b1 = *(const bf16x8*)bp1, a[8];
#pragma unroll
    for (int rt = 0; rt < 8; ++rt) a[rt] = *(const bf16x8*)(ap + (size_t)rt * 16 * K);
#pragma unroll 1
    for (int k = 32; k <= kw; k += 32) { const int kn = k < kw ? k : 0;
        const bf16x8 nb0 = *(const bf16x8*)(bp0 + kn), nb1 = *(const bf16x8*)(bp1 + kn); bf16x8 na[8];
#pragma unroll
        for (int rt = 0; rt < 8; ++rt) na[rt] = *(const bf16x8*)(ap + (size_t)rt * 16 * K + kn);
#pragma unroll
        for (int rt = 0; rt < 8; ++rt) { acc[rt][0] = __builtin_amdgcn_mfma_f32_16x16x32_bf16(b0, a[rt], acc[rt][0], 0, 0, 0); acc[rt][1] = __builtin_amdgcn_mfma_f32_16x16x32_bf16(b1, a[rt], acc[rt][1], 0, 0, 0); }
        b0 = nb0; b1 = nb1;
#pragma unroll
        for (int rt = 0; rt < 8; ++rt) a[rt] = na[rt]; }
    __syncthreads();
    FLAS f32x4* slab = (FLAS f32x4*)C.lds;
#pragma unroll
    for (int rt = 0; rt < 8; ++rt) { slab[((w * 8 + rt) * 2 + 0) * 64 + C.lane] = acc[rt][0]; slab[((w * 8 + rt) * 2 + 1) * 64 + C.lane] = acc[rt][1]; }
    __syncthreads();
    f32x4 s0 = (f32x4){0.f, 0.f, 0.f, 0.f}, s1 = s0;
#pragma unroll
    for (int ww = 0; ww < 8; ++ww) { s0 += slab[((ww * 8 + w) * 2 + 0) * 64 + C.lane]; s1 += slab[((ww * 8 + w) * 2 + 1) * 64 + C.lane]; }
    const int row = grow0 + w * 16 + fr;
    if constexpr (E::PAIRED) e.st2(row, u * 16 + 4 * fq, s0, s1);
    else { e.st(row, u * 32 + 4 * fq, s0); e.st(row, u * 32 + 16 + 4 * fq, s1); }
}
template <class E> __device__ __forceinline__ void gemm_sample(const Ctx& C0, const bf16* As  , const bf16* Bt, int N, int K, const E& e) {
    const Ctx C = refreshed(C0); const int nunits = N / 32;
#ifdef FK_TIMING
    unsigned long long* tsq = (unsigned long long*)(((CArgs*)__builtin_amdgcn_kernarg_segment_ptr())->fb + F_CTL + 65536 + 1024);
    unsigned long long t0 = 0; if (C.wg == FK_TWG && C.tid == 0) t0 = __builtin_amdgcn_s_memrealtime();
#endif
    { const int rank = C.G - 1 - C.wg, half = C.G >> 1;
      if (rank < half) { if (rank < nunits) gemm128(C, As, MP, Bt, K, e, rank);
          for (int u2 = half + (rank - (half >> 1)); rank >= (half >> 1) && u2 < nunits; u2 += half) gemm128(C, As, MP, Bt, K, e, u2); } }
    __syncthreads();
#ifdef FK_TIMING
    if (C.wg == FK_TWG && C.tid == 0) tsq[N == 1024 ? 6 : 7] += __builtin_amdgcn_s_memrealtime() - t0;
#endif
}

__device__ __forceinline__ void gemm_sample_ksplit(const Ctx& C0, const bf16* As  , const bf16* Bt  , int K, float* PART) {
    const Ctx C = refreshed(C0); const int fr = C.lane & 15, fq = C.lane >> 4, w = C.wave, rh = w >> 2, kq = w & 3;
    for (int u = C.wg; u < 256; u += C.G) { const int cg = u & 31, ks = u >> 5; const int nsteps = K >> 8, k0 = ks * (K >> 3);
        f32x4 acc[4][2];
#pragma unroll
        for (int rt = 0; rt < 4; ++rt) { acc[rt][0] = (f32x4){0.f, 0.f, 0.f, 0.f}; acc[rt][1] = (f32x4){0.f, 0.f, 0.f, 0.f}; }
        const bf16* ap = As + (size_t)(64 * rh + fr) * K + k0 + fq * 8; const bf16* bp = Bt + (size_t)(32 * cg + fr) * K + k0 + fq * 8;
#pragma unroll
        for (int i = 0; i < 3; ++i) { const int st = kq + 4 * i; if (st < nsteps) { const bf16x8 b0 = *(const bf16x8*)(bp + 32 * st), b1 = *(const bf16x8*)(bp + (size_t)16 * K + 32 * st);
#pragma unroll
            for (int rt = 0; rt < 4; ++rt) { const bf16x8 a = *(const bf16x8*)(ap + (size_t)rt * 16 * K + 32 * st);
                acc[rt][0] = __builtin_amdgcn_mfma_f32_16x16x32_bf16(b0, a, acc[rt][0], 0, 0, 0); acc[rt][1] = __builtin_amdgcn_mfma_f32_16x16x32_bf16(b1, a, acc[rt][1], 0, 0, 0); } } }
        __syncthreads();
        FLAS f32x4* slab = (FLAS f32x4*)C.lds;
#pragma unroll
        for (int rt = 0; rt < 4; ++rt) { slab[(w * 8 + rt * 2 + 0) * 64 + C.lane] = acc[rt][0]; slab[(w * 8 + rt * 2 + 1) * 64 + C.lane] = acc[rt][1]; }
        __syncthreads();
#pragma unroll
        for (int h = 0; h < 2; ++h) { const int pi = kq * 2 + h, rt = pi >> 1, ct = pi & 1; f32x4 sv = slab[((rh * 4 + 0) * 8 + pi) * 64 + C.lane];
#pragma unroll
            for (int x = 1; x < 4; ++x) sv += slab[((rh * 4 + x) * 8 + pi) * 64 + C.lane];
            *(f32x4*)(PART + ((size_t)ks * MS + 64 * rh + 16 * rt + fr) * D + 32 * cg + 16 * ct + 4 * fq) = sv; }
    }
    __syncthreads();
}

__device__ __forceinline__ void phase_qkv(const Ctx& C0, CArgs& A, int l) {
    unsigned char* fb = A.fb; const bf16* HF = (const bf16*)(fb + F_H); const bf16* HKV = (const bf16*)(fb + F_HKV);
    unsigned* flag = (unsigned*)(fb + F_CTL) + 32768 + 64 * (2 * l - 1);
    { const Ctx C = refreshed(C0); sample_norm_part(C, A, l == 2 ? 1 : 0, 2 * l, 2 * l - 1, nullptr, false, flag); }
    if (l == 2) { const Ctx C = refreshed(C0); EpKV e{A.out, (bf16*)(fb + F_RB)}; gemm_prompt(C, HKV, (const bf16*)(fb + F_WKV), KVW, 1024, e); }
    { const Ctx C = refreshed(C0); EpQ e{(bf16*)(fb + F_Q)}; gemm_prompt(C, HF, (const bf16*)(fb + F_WQ) + (size_t)(l - 2) * 1024 * 1024, 1024, 1024, e); }
    { const Ctx C = refreshed(C0); sample_rows_ready(C, flag, (unsigned*)(fb + F_CTL) + 1024); }
    if (l == 2) { const Ctx C = refreshed(C0); EpKV e{A.out, (bf16*)(fb + F_RB)}; gemm_sample(C, HKV + (size_t)MP * D, (const bf16*)(fb + F_WKV), KVW, 1024, e); }
    { const Ctx C = refreshed(C0); gemm_sample_ksplit(C, HF + (size_t)MP * D, (const bf16*)(fb + F_WQ) + (size_t)(l - 2) * 1024 * 1024, 1024, (float*)(fb + F_QPART)); }
    { const Ctx C = refreshed(C0); EpGates e{(float*)(fb + F_GT)}; const bf16* W = (const bf16*)(fb + F_WG) + (size_t)(l - 2) * 64 * 1024;
      for (int it = (C.wg + 64) % C.G; it < 2 * (R / 128); it += C.G) gemm128(C, HF + (size_t)(it >> 1) * 128 * D, (it >> 1) * 128, W, 1024, e, it & 1);
      __syncthreads(); }
}

__device__ __forceinline__ void compress_prompt_wg(const Ctx& C, CArgs& A, int task) {
    unsigned char* fb = A.fb; const int fr = C.lane & 15, fq = C.lane >> 4, nl = fr >> 2, g = fr & 3, w = C.wave;
    const int e = task & 1, grp = (task >> 1) & 31, b = task >> 6;
    const bf16* W1 = (const bf16*)(fb + F_WPHI1) + (size_t)e * 128 * 2048; const bf16* W2 = (const bf16*)(fb + F_WPHI2) + (size_t)e * 64 * 128;
    f32x4 acc[8];
#pragma unroll
    for (int j = 0; j < 8; ++j) acc[j] = (f32x4){0.f, 0.f, 0.f, 0.f};
    const bf16* w1p = W1 + (size_t)fr * 2048 + fq * 8 + w * 256;
    const bf16* ap = (const bf16*)(fb + F_RB) + ((size_t)b * SEQ + (grp * 4 + nl) * 32 + 4 * w) * KVW + e * 256 + g * 64 + fq * 8;
#pragma unroll 2
    for (int s2 = 0; s2 < 8; ++s2) { const bf16x8 a = *(const bf16x8*)(ap + (size_t)(s2 >> 1) * KVW + (s2 & 1) * 32);
#pragma unroll
        for (int j = 0; j < 8; ++j) { const bf16x8 wv = *(const bf16x8*)(w1p + (size_t)j * 16 * 2048 + s2 * 32); acc[j] = __builtin_amdgcn_mfma_f32_16x16x32_bf16(wv, a, acc[j], 0, 0, 0); } }
    FLAS f32x4* slab = (FLAS f32x4*)C.lds;
    FLAS bf16* hid = (FLAS bf16*)(C.lds + 65536);
#pragma unroll
    for (int j = 0; j < 8; ++j) slab[(w * 8 + j) * 64 + C.lane] = acc[j];
    __syncthreads();
    { f32x4 h = (f32x4){0.f, 0.f, 0.f, 0.f};
#pragma unroll
      for (int ww = 0; ww < 8; ++ww) h += slab[(ww * 8 + w) * 64 + C.lane];
      const f32x4 bb = *(const f32x4*)((const float*)(fb + F_BPHI) + 4096 + e * PHI + 16 * w + 4 * fq);
      u32x2 o; o.x = pk2(fsilu(h[0] + bb[0]), fsilu(h[1] + bb[1])); o.y = pk2(fsilu(h[2] + bb[2]), fsilu(h[3] + bb[3]));
      *(FLAS u32x2*)(hid + fr * 136 + 16 * w + 4 * fq) = o; }
    __syncthreads();
    if (w < 4) { const int jj = w; f32x4 o2 = (f32x4){0.f, 0.f, 0.f, 0.f};
#pragma unroll
        for (int kq = 0; kq < 4; ++kq) { const bf16x8 a2 = *(const FLAS bf16x8*)(hid + fr * 136 + 32 * kq + 8 * fq); const bf16x8 wv = *(const bf16x8*)(W2 + (size_t)(16 * jj + fr) * 128 + 32 * kq + 8 * fq);
            o2 = __builtin_amdgcn_mfma_f32_16x16x32_bf16(wv, a2, o2, 0, 0, 0); }
        const int n = grp * 4 + nl, od = 16 * jj + 4 * fq; const f32x4 v = o2 + *(const f32x4*)(IN_F(25) + e * 64 + od);
        if (e == 0) { u32x2 o; o.x = pk2(v[0], v[1]); o.y = pk2(v[2], v[3]); *(u32x2*)((bf16*)(fb + F_CMPK) + (((size_t)b * 4 + g) * 128 + n) * 64 + od) = o; }
        else { bf16* vt = (bf16*)(fb + F_CMPVT) + (((size_t)b * 4 + g) * 64 + od) * 128 + n;
#pragma unroll
            for (int r = 0; r < 4; ++r) vt[r * 128] = (bf16)f2bf(v[r]); } }
    __syncthreads();
}
__device__ __forceinline__ void compress_sample_round(const Ctx& C, CArgs& A, int round) {
    unsigned char* fb = A.fb; const int fr = C.lane & 15, fq = C.lane >> 4, nl = fr >> 2, g = fr & 3, tid = C.tid;
    const int e = round & 1, pg = ((round >> 1) & 7) * 8 + C.wave, b = round >> 4;
    const bf16* W1 = (const bf16*)(fb + F_WPHI1) + (size_t)e * 128 * 2048; const bf16* W2 = (const bf16*)(fb + F_WPHI2) + (size_t)e * 64 * 128;
    FLAS unsigned char* L = C.lds;
    const int page = ((const int*)A.in[8])[b * NPAGES + pg];
    const float* ap = IN_F(4) + ((((size_t)page * PAGE + nl * 32) * 2 + e) * 4 + g) * 64 + fq * 8;
    f32x4 acc[8];
#pragma unroll
    for (int j = 0; j < 8; ++j) acc[j] = (f32x4){0.f, 0.f, 0.f, 0.f};
    f32x4 xa[8], xb[8];
#define CS_LOAD(dst, blk) { _Pragma("unroll") for (int q4 = 0; q4 < 4; ++q4) { const int s_ = (blk) * 4 + q4; const float* p_ = ap + (size_t)(s_ >> 1) * 512 + (s_ & 1) * 32; \
        dst[2 * q4] = __builtin_nontemporal_load((const f32x4*)p_); dst[2 * q4 + 1] = __builtin_nontemporal_load((const f32x4*)(p_ + 4)); } }
#define CS_COMP(src, blk) { _Pragma("unroll") for (int q4 = 0; q4 < 4; ++q4) { const int kl_ = ((blk) & 1) * 4 + q4; \
        u32x4 pa_; pa_.x = pk2(src[2 * q4][0], src[2 * q4][1]); pa_.y = pk2(src[2 * q4][2], src[2 * q4][3]); pa_.z = pk2(src[2 * q4 + 1][0], src[2 * q4 + 1][1]); pa_.w = pk2(src[2 * q4 + 1][2], src[2 * q4 + 1][3]); \
        const bf16x8 a_ = __builtin_bit_cast(bf16x8, pa_); \
        _Pragma("unroll") for (int j = 0; j < 8; ++j) { const bf16x8 w_ = *(const FLAS bf16x8*)(L + (16 * j + fr) * 528 + (kl_ * 32 + fq * 8) * 2); acc[j] = __builtin_amdgcn_mfma_f32_16x16x32_bf16(w_, a_, acc[j], 0, 0, 0); } } }
    CS_LOAD(xa, 0)
#pragma unroll 1
    for (int c = 0; c < 8; ++c) {
        __syncthreads();
        u32x4 wst[8];
#pragma unroll
        for (int i = 0; i < 8; ++i) { const int idx = tid + NTHR * i, nn = idx >> 5, ch = idx & 31; wst[i] = *(const u32x4*)(W1 + (size_t)nn * 2048 + c * 256 + ch * 8); }
        CS_LOAD(xb, 2 * c + 1)
#pragma unroll
        for (int i = 0; i < 8; ++i) { const int idx = tid + NTHR * i, nn = idx >> 5, ch = idx & 31; *(FLAS u32x4*)(L + nn * 528 + ch * 16) = wst[i]; }
        __syncthreads();
        CS_COMP(xa, 2 * c)
        if (c < 7) CS_LOAD(xa, 2 * c + 2)
        CS_COMP(xb, 2 * c + 1)
    }
#undef CS_LOAD
#undef CS_COMP
    const float* bph = (const float*)(fb + F_BPHI) + 4096 + e * PHI; const float* b2 = IN_F(25) + e * 64;
#pragma unroll
    for (int j = 0; j < 8; ++j) { const f32x4 bb = *(const f32x4*)(bph + 16 * j + 4 * fq);
#pragma unroll
        for (int r = 0; r < 4; ++r) acc[j][r] = fsilu(acc[j][r] + bb[r]); }
    f32x4 o2[4];
#pragma unroll
    for (int jj = 0; jj < 4; ++jj) o2[jj] = (f32x4){0.f, 0.f, 0.f, 0.f};
#pragma unroll
    for (int kq = 0; kq < 4; ++kq) {
        u32x4 pa; pa.x = pk2(acc[2 * kq][0], acc[2 * kq][1]); pa.y = pk2(acc[2 * kq][2], acc[2 * kq][3]); pa.z = pk2(acc[2 * kq + 1][0], acc[2 * kq + 1][1]); pa.w = pk2(acc[2 * kq + 1][2], acc[2 * kq + 1][3]);
        const bf16x8 a2 = __builtin_bit_cast(bf16x8, pa);
#pragma unroll
        for (int jj = 0; jj < 4; ++jj) { const bf16* wp = W2 + (size_t)(16 * jj + fr) * 128 + 32 * kq + 4 * fq; const u32x2 lo = *(const u32x2*)wp, hi = *(const u32x2*)(wp + 16);
            u32x4 pw; pw.x = lo.x; pw.y = lo.y; pw.z = hi.x; pw.w = hi.y; o2[jj] = __builtin_amdgcn_mfma_f32_16x16x32_bf16(__builtin_bit_cast(bf16x8, pw), a2, o2[jj], 0, 0, 0); } }
    const int n = pg * 4 + nl;
#pragma unroll
    for (int jj = 0; jj < 4; ++jj) { const int od = 16 * jj + 4 * fq; const f32x4 v = o2[jj] + *(const f32x4*)(b2 + od);
        if (e == 0) { u32x2 o; o.x = pk2(v[0], v[1]); o.y = pk2(v[2], v[3]); *(u32x2*)((bf16*)(fb + F_CMPS) + (((size_t)b * 4 + g) * 256 + n) * 64 + od) = o; }
        else { bf16* vt = (bf16*)(fb + F_CMPS) + (size_t)DB * 4 * 256 * 64 + (((size_t)b * 4 + g) * 64 + od) * 256 + n;
#pragma unroll
            for (int r = 0; r < 4; ++r) vt[r * 256] = (bf16)f2bf(v[r]); } }
}
__device__ __forceinline__ void phase_prep(const Ctx& C, CArgs& A) {
    unsigned char* fb = A.fb; const bf16* RB = (const bf16*)(fb + F_RB); bf16* VT = (bf16*)(fb + F_VT);
    FLAS unsigned char* scr = C.lds + C.wave * 9216;
    for (int it = C.gw; it < 2048; it += C.ngw) {
        const int tc = it & 63, g = (it >> 6) & 3, b = (it >> 8) & 3, br = it >> 10; const int t0 = tc * 64, col0 = 512 * (br + 1) + 256 + g * 64;
#pragma unroll
        for (int i = 0; i < 8; ++i) { const int tok = i * 8 + (C.lane >> 3), ch = C.lane & 7; *(FLAS u32x4*)(scr + tok * 144 + ch * 16) = *(const u32x4*)(RB + ((size_t)b * SEQ + t0 + tok) * KVW + col0 + ch * 8); }
        asm volatile("s_waitcnt lgkmcnt(0)" ::: "memory");
        bf16* dst = VT + ((((size_t)br * 4 + b) * 4 + g) * 64 + C.lane) * SEQ + t0;
#pragma unroll
        for (int i = 0; i < 8; ++i) { unsigned w[4];
#pragma unroll
            for (int j = 0; j < 4; ++j) { const unsigned lo = *(const FLAS unsigned short*)(scr + (8 * i + 2 * j) * 144 + C.lane * 2), hi = *(const FLAS unsigned short*)(scr + (8 * i + 2 * j + 1) * 144 + C.lane * 2); w[j] = lo | (hi << 16); }
            u32x4 o; o.x = w[0]; o.y = w[1]; o.z = w[2]; o.w = w[3]; *(u32x4*)(dst + 8 * i) = o; }
        asm volatile("s_waitcnt lgkmcnt(0)" ::: "memory");
    }
    __syncthreads();
    for (int task = C.wg; task < 256; task += C.G) compress_prompt_wg(C, A, task);
    for (int rd = C.wg; rd < 512; rd += C.G) compress_sample_round(C, A, rd);
    __syncthreads();
}

__device__ __forceinline__ float dpp_xor1(float v) { return __builtin_bit_cast(float, __builtin_amdgcn_update_dpp(0, __builtin_bit_cast(int, v), 0xB1, 0xF, 0xF, true)); }
__device__ __forceinline__ float dpp_xor2(float v) { return __builtin_bit_cast(float, __builtin_amdgcn_update_dpp(0, __builtin_bit_cast(int, v), 0x4E, 0xF, 0xF, true)); }
template <int N> struct IC { static constexpr int value = N; };
__device__ __forceinline__ int swz23(int m) { return (m & 0x13) | ((m & 4) << 1) | ((m & 8) >> 1); }
constexpr int AL_KB0 = 0, AL_VB0 = 9216, AL_KB1 = 18432, AL_VB1 = 27648, AL_LUT = 36864, AL_CK = 51712, AL_CV = 70144, AL_IMP = 87552, AL_SELM = 103936, AL_SCR = 104448, AL_LUTW = 110592  , AL_STASH = AL_CK;
constexpr int DMAXB = 790, LUTN = 928, LUTO = 64;
__device__ __forceinline__ bf16x8 pack8(const f32x16& p, int s) {
    u32x4 o; o.x = pk2(p[8 * s], p[8 * s + 1]); o.y = pk2(p[8 * s + 2], p[8 * s + 3]); o.z = pk2(p[8 * s + 4], p[8 * s + 5]); o.w = pk2(p[8 * s + 6], p[8 * s + 7]); return __builtin_bit_cast(bf16x8, o); }

__device__ __forceinline__ void attn_prompt_unit(const Ctx& C, CArgs& A, int b, int g, int qt, bool load_bg) {
    unsigned char* fb = A.fb; FLAS unsigned char* L = C.lds;
    const bf16* RB = (const bf16*)(fb + F_RB); const bf16* VT = (const bf16*)(fb + F_VT); const bf16* Q = (const bf16*)(fb + F_Q); const float* GT = (const float*)(fb + F_GT);
    const int tid = C.tid, lane = C.lane, w = C.wave, n = lane & 31, h = lane >> 5, ql = n >> 2, r = n & 3;
    const int q0 = qt * 64, qpos = q0 + 8 * w + ql, jq = qt; const size_t qrow = (size_t)b * SEQ + qpos;
    __syncthreads();
    {
        const bf16* ck = (const bf16*)(fb + F_CMPK) + ((size_t)b * 4 + g) * 128 * 64; const bf16* cv = (const bf16*)(fb + F_CMPVT) + ((size_t)b * 4 + g) * 64 * 128;
        for (int i = tid; i < 1024; i += NTHR) { const int key = i >> 3, ch = i & 7; *(FLAS u32x4*)(L + AL_CK + key * 144 + ch * 16) = *(const u32x4*)(ck + key * 64 + ch * 8); }
        for (int i = tid; i < 1024; i += NTHR) { const int dim = i >> 4, ch = i & 15; *(FLAS u32x4*)(L + AL_CV + dim * 272 + ch * 16) = *(const u32x4*)(cv + dim * 128 + ch * 8); }
        if (load_bg) for (int i = tid; i < LUTN * 4; i += NTHR) { const int d = (i >> 2) - LUTO, rr = i & 3; const float bv = IN_F(29)[rel_bucket(d) * 16 + g * 4 + rr] * LOG2E;
            ((FLAS float*)(L + AL_LUT))[i] = d < 0 ? -INFINITY : bv; if (i < 640 * 4) ((FLAS float*)(L + AL_LUTW))[i] = (d < 0 || d >= 512) ? -INFINITY : bv; }
    }
    bf16x8 qf[4];
#pragma unroll
    for (int s = 0; s < 4; ++s) qf[s] = *(const bf16x8*)(Q + qrow * D + (g * 4 + r) * 64 + 16 * s + 8 * h);
    const float gt0 = GT[qrow * 64 + (g * 4 + r) * 3 + 0], gt1 = GT[qrow * 64 + (g * 4 + r) * 3 + 1], gt2 = GT[qrow * 64 + (g * 4 + r) * 3 + 2];
    __syncthreads();
    const FLAS float* LUT = (const FLAS float*)(L + AL_LUT);
    FLAS u32x2* stash = (FLAS u32x2*)(L + AL_STASH) + (w * 64 + lane) * 8;
    const int krow = swz23(n);
    {
        f32x16 S[4]; float mx = -1e30f;
#pragma unroll
        for (int sub = 0; sub < 4; ++sub) { f32x16 acc;
#pragma unroll
            for (int i = 0; i < 16; ++i) acc[i] = 0.f;
#pragma unroll
            for (int ks = 0; ks < 4; ++ks) { const bf16x8 a = *(const FLAS bf16x8*)(L + AL_CK + (32 * sub + krow) * 144 + (16 * ks + 8 * h) * 2); acc = __builtin_amdgcn_mfma_f32_32x32x16_bf16(a, qf[ks], acc, 0, 0, 0); }
#pragma unroll
            for (int i = 0; i < 16; ++i) { const int nb = 32 * sub + (i & 7) + 8 * h + 16 * (i >> 3); const int d = qpos - (32 * nb + 31); const bool valid = d >= 0;
                const int dc = d > DMAXB ? DMAXB : (d < 0 ? 0 : d); const float bias = LUT[(dc + LUTO) * 4 + r]; float v = acc[i] + bias; v = valid ? v : -INFINITY; acc[i] = v; mx = fmaxf(mx, v); }
            S[sub] = acc; }
        mx = xmax32(mx);
        float sum = 0.f;
#pragma unroll
        for (int sub = 0; sub < 4; ++sub)
#pragma unroll
            for (int i = 0; i < 16; ++i) { const float p = __builtin_amdgcn_exp2f(S[sub][i] - mx); S[sub][i] = p; sum += p; }
        sum = xsum32(sum);
        const float inv = sum > 0.f ? 1.f / sum : 0.f;
        f32x16 oc[2];
#pragma unroll
        for (int d2 = 0; d2 < 2; ++d2)
#pragma unroll
            for (int i = 0; i < 16; ++i) oc[d2][i] = 0.f;
        FLAS float* IMP = (FLAS float*)(L + AL_IMP) + (w * 8 + ql) * 64;
#pragma unroll
        for (int sub = 0; sub < 4; ++sub) {
#pragma unroll
            for (int i = 0; i < 16; ++i) S[sub][i] *= inv;
#pragma unroll
            for (int i = 0; i < 16; i += 2) { float v = S[sub][i] + S[sub][i + 1]; v += dpp_xor1(v); v += dpp_xor2(v);
                const int j = 16 * sub + ((i & 7) >> 1) + 4 * h + 8 * (i >> 3); if (r == 0) IMP[j] = v; }
#pragma unroll
            for (int s = 0; s < 2; ++s) { const bf16x8 pb = pack8(S[sub], s);
#pragma unroll
                for (int d2 = 0; d2 < 2; ++d2) { const bf16x8 a = *(const FLAS bf16x8*)(L + AL_CV + (32 * d2 + n) * 272 + (32 * sub + 16 * s + 8 * h) * 2); oc[d2] = __builtin_amdgcn_mfma_f32_32x32x16_bf16(a, pb, oc[d2], 0, 0, 0); } }
        }
#pragma unroll
        for (int d2 = 0; d2 < 2; ++d2) oc[d2] *= gt0;
        __syncthreads();
#pragma unroll
        for (int d2 = 0; d2 < 2; ++d2)
#pragma unroll
            for (int c = 0; c < 4; ++c) { u32x2 o; o.x = pk2(oc[d2][4 * c], oc[d2][4 * c + 1]); o.y = pk2(oc[d2][4 * c + 2], oc[d2][4 * c + 3]); stash[d2 * 4 + c] = o; }
    }
    asm volatile("s_waitcnt lgkmcnt(0)" ::: "memory");
    {
        FLAS unsigned long long* SCR64 = (FLAS unsigned long long*)(L + AL_SCR) + w * 64; FLAS unsigned* SELM = (FLAS unsigned*)(L + AL_SELM) + w * 16;
        for (int qq = 0; qq < 8; ++qq) {
            unsigned long long mask;
            if (jq < 16) mask = (2ull << jq) - 1ull;
            else {
                const int j = lane; const float impj = ((const FLAS float*)(L + AL_IMP))[(w * 8 + qq) * 64 + j];
                const bool forced = (j == 0) || (j == jq) || (j == jq - 1); const bool okj = j <= jq; const float sj = forced ? 1e4f : impj;
                const unsigned long long keyj = okj ? (((unsigned long long)(__builtin_bit_cast(unsigned, sj) + 1u) << 32) | (unsigned)(63 - j)) : 0ull;
                SCR64[j] = keyj; asm volatile("s_waitcnt lgkmcnt(0)" ::: "memory");
                int rank = 0;
#pragma unroll
                for (int i2 = 0; i2 < 32; ++i2) { const u32x4 kv = *(const FLAS u32x4*)(SCR64 + 2 * i2);
                    const unsigned long long k0 = ((unsigned long long)kv.y << 32) | kv.x, k1 = ((unsigned long long)kv.w << 32) | kv.z;
                    rank += (k0 > keyj) ? 1 : 0; rank += (k1 > keyj) ? 1 : 0; }
                mask = __ballot(rank < 16 && okj);
                asm volatile("s_waitcnt lgkmcnt(0)" ::: "memory");
            }
            if (lane == 0) { SELM[2 * qq] = (unsigned)mask; SELM[2 * qq + 1] = (unsigned)(mask >> 32); }
        }
        asm volatile("s_waitcnt lgkmcnt(0)" ::: "memory");
    }
    const unsigned selLo = ((const FLAS unsigned*)(L + AL_SELM))[w * 16 + 2 * ql], selHi = ((const FLAS unsigned*)(L + AL_SELM))[w * 16 + 2 * ql + 1];
    const int jw0 = jq - 8 > 0 ? jq - 8 : 0; const int NTL = (jq + 1) + (jq - jw0 + 1);
    const int skey = tid >> 3, sch = tid & 7;
    const bf16* kbase = RB + ((size_t)b * SEQ + skey) * KVW + g * 64 + sch * 8;
    const bf16* vbase = VT + (((size_t)b * 4 + g) * 64 + skey) * SEQ + sch * 8;
    float m = -1e30f, lsum = 0.f; f32x16 oa[2];
#pragma unroll
    for (int d2 = 0; d2 < 2; ++d2)
#pragma unroll
        for (int i = 0; i < 16; ++i) oa[d2][i] = 0.f;
    u32x4 kreg0, vreg0, kreg1, vreg1;
    { kreg0 = *(const u32x4*)(kbase + 512); vreg0 = *(const u32x4*)vbase; }
    { const bool nw = 1 > jq; const int nj = nw ? jw0 : 1; kreg1 = *(const u32x4*)(kbase + (size_t)64 * nj * KVW + (nw ? 1024 : 512)); vreg1 = *(const u32x4*)(vbase + (nw ? (size_t)16 * 64 * SEQ : 0) + 64 * nj); }
    *(FLAS u32x4*)(L + AL_KB0 + skey * 144 + sch * 16) = kreg0; *(FLAS u32x4*)(L + AL_VB0 + skey * 144 + sch * 16) = vreg0;
    __syncthreads();
    const float b31 = LUT[(DMAXB + LUTO) * 4 + r];
    for (int ti = 0; ti < NTL; ++ti) {
        const bool isw = ti > jq; const int j = isw ? jw0 + (ti - jq - 1) : ti; const int buf = ti & 1;
        kreg0 = kreg1; vreg0 = vreg1;
        if (ti + 2 < NTL) { const bool nw = (ti + 2) > jq; const int nj = nw ? jw0 + (ti + 1 - jq) : ti + 2;
            kreg1 = *(const u32x4*)(kbase + (size_t)64 * nj * KVW + (nw ? 1024 : 512)); vreg1 = *(const u32x4*)(vbase + (nw ? (size_t)16 * 64 * SEQ : 0) + 64 * nj); }
        if (ti == jq + 1) {
            const float lt = xsum32(lsum); const float f = lt > 0.f ? gt1 / lt : 0.f;
#pragma unroll
            for (int d2 = 0; d2 < 2; ++d2) {
#pragma unroll
                for (int c = 0; c < 4; ++c) { const u32x2 o = stash[d2 * 4 + c]; u32x2 n2;
                    n2.x = pk2(__builtin_bit_cast(float, o.x << 16) + oa[d2][4 * c] * f, __builtin_bit_cast(float, o.x & 0xffff0000u) + oa[d2][4 * c + 1] * f);
                    n2.y = pk2(__builtin_bit_cast(float, o.y << 16) + oa[d2][4 * c + 2] * f, __builtin_bit_cast(float, o.y & 0xffff0000u) + oa[d2][4 * c + 3] * f); stash[d2 * 4 + c] = n2; }
#pragma unroll
                for (int i = 0; i < 16; ++i) oa[d2][i] = 0.f; }
            m = -1e30f; lsum = 0.f; }
        const bool selbit = ((j < 32 ? selLo >> j : selHi >> (j - 32)) & 1u) != 0u;
        const bool active = isw ? true : (__any(selbit) != 0);
        if (active) {
            const FLAS unsigned char* KB = L + (buf ? AL_KB1 : AL_KB0); const FLAS unsigned char* VB = L + (buf ? AL_VB1 : AL_VB0);
            f32x16 S[2];
            { bf16x8 kf[2][4];
#pragma unroll
              for (int sub = 0; sub < 2; ++sub)
#pragma unroll
                  for (int ks = 0; ks < 4; ++ks) kf[sub][ks] = *(const FLAS bf16x8*)(KB + (32 * sub + krow) * 144 + (16 * ks + 8 * h) * 2);
              __builtin_amdgcn_sched_barrier(0);
#pragma unroll
              for (int sub = 0; sub < 2; ++sub) { f32x16 acc;
#pragma unroll
                  for (int i = 0; i < 16; ++i) acc[i] = 0.f;
#pragma unroll
                  for (int ks = 0; ks < 4; ++ks) acc = __builtin_amdgcn_mfma_f32_32x32x16_bf16(kf[sub][ks], qf[ks], acc, 0, 0, 0);
                  S[sub] = acc; }
            }
            const int dbase = qpos - 64 * j;
            const bool far = !isw && ((q0 + 8 * w) - (64 * j + 63) >= DMAXB);
            auto body = [&](auto tag) { constexpr int MODE = decltype(tag)::value;
                float tmax = -INFINITY, poff;
                if constexpr (MODE == 0) {
#pragma unroll
                    for (int sub = 0; sub < 2; ++sub)
#pragma unroll
                        for (int i = 0; i < 16; ++i) tmax = fmaxf(tmax, S[sub][i]);
                    tmax = selbit ? tmax + b31 : -INFINITY;
                } else {
                    const int dl = dbase - 8 * h;
                    const int dle = (MODE == 2 || selbit) ? dl : -1;
                    const FLAS float* lpb = (MODE == 2 ? (const FLAS float*)(L + AL_LUTW) : LUT) + ((dle + LUTO - 55) * 4 + r);
                    float bv[2][16];
#pragma unroll
                    for (int sub = 0; sub < 2; ++sub)
#pragma unroll
                        for (int i = 0; i < 16; ++i) { const int koff = 32 * sub + (i & 7) + 16 * (i >> 3); bv[sub][i] = lpb[(55 - koff) * 4]; }
                    __builtin_amdgcn_sched_barrier(0);
#pragma unroll
                    for (int sub = 0; sub < 2; ++sub)
#pragma unroll
                        for (int i = 0; i < 16; ++i) { const float v = S[sub][i] + bv[sub][i]; S[sub][i] = v; tmax = fmaxf(tmax, v); }
                }
                tmax = xmax32(tmax);
                const float mnew = fmaxf(m, tmax); const float sc = __builtin_amdgcn_exp2f(m - mnew); m = mnew;
                poff = MODE == 0 ? (selbit ? b31 - mnew : -INFINITY) : -mnew;
                float ps = 0.f;
#pragma unroll
                for (int sub = 0; sub < 2; ++sub)
#pragma unroll
                    for (int i = 0; i < 16; ++i) { const float p = __builtin_amdgcn_exp2f(S[sub][i] + poff); S[sub][i] = p; ps += p; }
                lsum = lsum * sc + ps;
#pragma unroll
                for (int d2 = 0; d2 < 2; ++d2) oa[d2] *= sc;
#pragma unroll
                for (int sub = 0; sub < 2; ++sub)
#pragma unroll
                    for (int s2 = 0; s2 < 2; ++s2) { const bf16x8 pb = pack8(S[sub], s2);
#pragma unroll
                        for (int d2 = 0; d2 < 2; ++d2) { const bf16x8 av = *(const FLAS bf16x8*)(VB + (32 * d2 + n) * 144 + (32 * sub + 16 * s2 + 8 * h) * 2); oa[d2] = __builtin_amdgcn_mfma_f32_32x32x16_bf16(av, pb, oa[d2], 0, 0, 0); } }
            };
            if (isw) body(IC<2>{}); else if (far) body(IC<0>{}); else body(IC<1>{});
        }
        if (ti + 1 < NTL) { FLAS unsigned char* KBn = L + (buf ? AL_KB0 : AL_KB1); FLAS unsigned char* VBn = L + (buf ? AL_VB0 : AL_VB1);
            *(FLAS u32x4*)(KBn + skey * 144 + sch * 16) = kreg0; *(FLAS u32x4*)(VBn + skey * 144 + sch * 16) = vreg0; }
        __syncthreads();
    }
    { const float lt = xsum32(lsum); const float f = lt > 0.f ? gt2 / lt : 0.f;
#pragma unroll
      for (int d2 = 0; d2 < 2; ++d2) oa[d2] *= f; }
    bf16* op = (bf16*)(fb + F_O) + qrow * D + (g * 4 + r) * 64;
#pragma unroll
    for (int d2 = 0; d2 < 2; ++d2)
#pragma unroll
        for (int c = 0; c < 4; ++c) { const u32x2 sv = stash[d2 * 4 + c]; u32x2 o;
            o.x = pk2(__builtin_bit_cast(float, sv.x << 16) + oa[d2][4 * c], __builtin_bit_cast(float, sv.x & 0xffff0000u) + oa[d2][4 * c + 1]);
            o.y = pk2(__builtin_bit_cast(float, sv.y << 16) + oa[d2][4 * c + 2], __builtin_bit_cast(float, sv.y & 0xffff0000u) + oa[d2][4 * c + 3]); *(u32x2*)(op + 32 * d2 + 8 * c + 4 * h) = o; }
}

typedef short v4i16_t __attribute__((ext_vector_type(4)));
__device__ __forceinline__ float fexp2(float x) { return __builtin_amdgcn_exp2f(x); }
constexpr int SM_LUT = 0, SM_P = 12800, SM_ML = 29184, SM_FAC = 29696, SM_SC = 29952, SM_SELQ = 32064, SM_PUB0 = 12800  , SM_LIST = 45568, SM_NIT = 46112, SM_V = 46208, SM_PUBML = 119936;
constexpr int SDMAX = 790;
struct SAcc { float m, l; f32x4 o[4]; };
__device__ __forceinline__ void sa_init(SAcc& a) { a.m = -1e30f; a.l = 0.f;
#pragma unroll
    for (int dt = 0; dt < 4; ++dt) a.o[dt] = (f32x4){0.f, 0.f, 0.f, 0.f}; }
__device__ __forceinline__ bf16x8 pack44(const f32x4& x, const f32x4& y) { u32x4 o; o.x = pk2(x[0], x[1]); o.y = pk2(x[2], x[3]); o.z = pk2(y[0], y[1]); o.w = pk2(y[2], y[3]); return __builtin_bit_cast(bf16x8, o); }
__device__ __forceinline__ void sa_update(f32x4 (&S)[4], SAcc& a, bf16x8 (&P)[2]) {
    float tmax = fmaxf(fmaxf(S[0][0], S[0][1]), fmaxf(S[0][2], S[0][3]));
#pragma unroll
    for (int kt = 1; kt < 4; ++kt) tmax = fmaxf(tmax, fmaxf(fmaxf(S[kt][0], S[kt][1]), fmaxf(S[kt][2], S[kt][3])));
    tmax = fmaxf(tmax, __shfl_xor(tmax, 16)); tmax = xmax32(tmax);
    const float mnew = fmaxf(a.m, tmax), sc = fexp2(a.m - mnew); a.m = mnew;
    float ps = 0.f;
#pragma unroll
    for (int kt = 0; kt < 4; ++kt)
#pragma unroll
        for (int t = 0; t < 4; ++t) { const float p = fexp2(S[kt][t] - mnew); S[kt][t] = p; ps += p; }
    a.l = a.l * sc + ps;
#pragma unroll
    for (int dt = 0; dt < 4; ++dt) a.o[dt] *= sc;
    P[0] = pack44(S[0], S[1]); P[1] = pack44(S[2], S[3]);
}
__device__ __forceinline__ void sa_block_f32(FLAS unsigned char* Vt, int lane, const float* kb, const float* vb, int nk, const bf16x8 (&qf)[2], SAcc& a, const FLAS float* lut, int d0, int dmax, bool rowok) {
    const int fr = lane & 15, fq = lane >> 4, r = fr & 3;
    f32x4 kr[4][4];
#pragma unroll
    for (int kt = 0; kt < 4; ++kt) { const int kk = 32 * (kt >> 1) + 8 * (fr >> 2) + 4 * (kt & 1) + (fr & 3); const float* kp = kb + (size_t)kk * 512 + 8 * fq;
        kr[kt][0] = *(const f32x4*)kp; kr[kt][1] = *(const f32x4*)(kp + 4); kr[kt][2] = *(const f32x4*)(kp + 32); kr[kt][3] = *(const f32x4*)(kp + 36); }
    f32x4 vr[8][2]; const float* vp0 = vb + (size_t)(lane >> 3) * 512 + 8 * (lane & 7);
#pragma unroll
    for (int i = 0; i < 4; ++i) { const float* vp = vp0 + (size_t)i * 4096; vr[i][0] = *(const f32x4*)vp; vr[i][1] = *(const f32x4*)(vp + 4); }
    f32x4 S[4];
#pragma unroll
    for (int kt = 0; kt < 4; ++kt) { f32x4 acc = (f32x4){0.f, 0.f, 0.f, 0.f};
        acc = __builtin_amdgcn_mfma_f32_16x16x32_bf16(pack44(kr[kt][0], kr[kt][1]), qf[0], acc, 0, 0, 0); acc = __builtin_amdgcn_mfma_f32_16x16x32_bf16(pack44(kr[kt][2], kr[kt][3]), qf[1], acc, 0, 0, 0); S[kt] = acc; }
    asm volatile("" ::: "memory");
#pragma unroll
    for (int i = 4; i < 8; ++i) { const float* vp = vp0 + (size_t)i * 4096; vr[i][0] = *(const f32x4*)vp; vr[i][1] = *(const f32x4*)(vp + 4); }
#pragma unroll
    for (int kt = 0; kt < 4; ++kt)
#pragma unroll
        for (int t = 0; t < 4; ++t) { const int kk = 32 * (kt >> 1) + 8 * fq + 4 * (kt & 1) + t; const int d = d0 - kk; const bool valid = rowok && kk < nk && d >= 0 && d < dmax;
            const int dc = d < 0 ? 0 : (d > SDMAX ? SDMAX : d); const float v = S[kt][t] + lut[dc * 4 + r]; S[kt][t] = valid ? v : -INFINITY; }
    bf16x8 P[2]; sa_update(S, a, P);
#pragma unroll
    for (int i = 0; i < 8; ++i) { const int key = 8 * i + (lane >> 3); *(FLAS bf16x8*)(Vt + key * 144 + (lane & 7) * 16) = pack44(vr[i][0], vr[i][1]); }
    asm volatile("s_waitcnt lgkmcnt(0)" ::: "memory");
#pragma unroll
    for (int s2 = 0; s2 < 2; ++s2)
#pragma unroll
        for (int dt = 0; dt < 4; ++dt) { const FLAS unsigned char* p = Vt + (32 * s2 + 8 * fq + (fr >> 2)) * 144 + (16 * dt + 4 * (fr & 3)) * 2;
            const v4i16_t lo = __builtin_amdgcn_ds_read_tr16_b64_v4i16((FLAS v4i16_t*)p), hi = __builtin_amdgcn_ds_read_tr16_b64_v4i16((FLAS v4i16_t*)(p + 4 * 144));
            bf16x8 vf; vf[0] = lo[0]; vf[1] = lo[1]; vf[2] = lo[2]; vf[3] = lo[3]; vf[4] = hi[0]; vf[5] = hi[1]; vf[6] = hi[2]; vf[7] = hi[3];
            a.o[dt] = __builtin_amdgcn_mfma_f32_16x16x32_bf16(vf, P[s2], a.o[dt], 0, 0, 0); }
    asm volatile("s_waitcnt lgkmcnt(0)" ::: "memory");
}
__device__ __forceinline__ void attn_sample_unit(const Ctx& C, CArgs& A, int u) {
    unsigned char* fb = A.fb; const int lane = C.lane, tid = C.tid, w = C.wave, fr = lane & 15, fq = lane >> 4, q = fr >> 2, r = fr & 3; FLAS unsigned char* L = C.lds;
    const int b = u >> 2, g = u & 3;
    FLAS float* lut = (FLAS float*)(L + SM_LUT); FLAS float* Pc = (FLAS float*)(L + SM_P); FLAS float* ML = (FLAS float*)(L + SM_ML); FLAS float* FAC = (FLAS float*)(L + SM_FAC); FLAS float* SC = (FLAS float*)(L + SM_SC);
    FLAS unsigned* SELQ = (FLAS unsigned*)(L + SM_SELQ); FLAS unsigned* LIST = (FLAS unsigned*)(L + SM_LIST); FLAS unsigned* NIT = (FLAS unsigned*)(L + SM_NIT); FLAS unsigned char* Vt = L + SM_V + w * 9216;
    const float* table = IN_F(29); const int* pt = (const int*)A.in[8];
    __syncthreads();
    for (int i = tid; i < (SDMAX + 2) * 4; i += NTHR) lut[i] = table[rel_bucket(i >> 2) * 16 + g * 4 + (i & 3)] * LOG2E;
    bf16x8 qf[2];
    { const float* qp = (const float*)(fb + F_QPART) + ((size_t)b * 4 + q) * D + (g * 4 + r) * 64 + 8 * fq; const float qs = 0.125f * LOG2E;
#pragma unroll
      for (int k2 = 0; k2 < 2; ++k2) { f32x4 s0 = {0.f, 0.f, 0.f, 0.f}, s1 = s0;
#pragma unroll
          for (int ksl = 0; ksl < 8; ++ksl) { s0 += *(const f32x4*)(qp + (size_t)ksl * MS * D + 32 * k2); s1 += *(const f32x4*)(qp + (size_t)ksl * MS * D + 32 * k2 + 4); }
          qf[k2] = pack44(s0 * qs, s1 * qs); } }
    SAcc a0, a1; sa_init(a0); sa_init(a1);
    __syncthreads();
    const float* winK = IN_F(6) + ((size_t)b * 512 * 2) * 256 + g * 64;
    const float* winN = A.out + O_WINS + ((size_t)b * 512 + 508) * 512 + g * 64;
    if (w < 4) {
        const int cb = w; const bf16* ck = (const bf16*)(fb + F_CMPS) + (((size_t)b * 4 + g) * 256 + 64 * cb) * 64; const bf16* vt = (const bf16*)(fb + F_CMPS) + (size_t)DB * 4 * 256 * 64 + ((size_t)b * 4 + g) * 64 * 256 + 64 * cb;
        f32x4 S[4];
#pragma unroll
        for (int kt = 0; kt < 4; ++kt) { const int kk = 32 * (kt >> 1) + 8 * (fr >> 2) + 4 * (kt & 1) + (fr & 3); const bf16* kp = ck + kk * 64 + 8 * fq; f32x4 acc = (f32x4){0.f, 0.f, 0.f, 0.f};
            acc = __builtin_amdgcn_mfma_f32_16x16x32_bf16(*(const bf16x8*)kp, qf[0], acc, 0, 0, 0); acc = __builtin_amdgcn_mfma_f32_16x16x32_bf16(*(const bf16x8*)(kp + 32), qf[1], acc, 0, 0, 0); S[kt] = acc; }
        const int d0 = PAST + q - 31 - 32 * 64 * cb;
#pragma unroll
        for (int kt = 0; kt < 4; ++kt)
#pragma unroll
            for (int t = 0; t < 4; ++t) { const int kk = 32 * (kt >> 1) + 8 * fq + 4 * (kt & 1) + t; const int d = d0 - 32 * kk; S[kt][t] += lut[(d > SDMAX ? SDMAX : d) * 4 + r]; }
        bf16x8 P[2]; sa_update(S, a0, P);
#pragma unroll
        for (int kt = 0; kt < 4; ++kt) *(FLAS f32x4*)(Pc + fr * 256 + 64 * cb + 32 * (kt >> 1) + 8 * fq + 4 * (kt & 1)) = S[kt];
#pragma unroll
        for (int s2 = 0; s2 < 2; ++s2)
#pragma unroll
            for (int dt = 0; dt < 4; ++dt) a0.o[dt] = __builtin_amdgcn_mfma_f32_16x16x32_bf16(*(const bf16x8*)(vt + (size_t)(16 * dt + fr) * 256 + 32 * s2 + 8 * fq), P[s2], a0.o[dt], 0, 0, 0);
        float lr = a0.l; lr += __shfl_xor(lr, 16); lr += __shfl_xor(lr, 32);
        if (fq == 0) { ML[(w * 16 + fr) * 2] = a0.m; ML[(w * 16 + fr) * 2 + 1] = lr; }
    } else { const int wb = w - 4; sa_block_f32(Vt, lane, winK + (size_t)64 * wb * 512, winK + (size_t)64 * wb * 512 + 256, 64, qf, a0, lut, 512 + q - 64 * wb, 512, true); }
    __syncthreads();
    if (tid < 64) { const int row = tid >> 2, ww = tid & 3; float M = -1e30f;
#pragma unroll
        for (int x = 0; x < 4; ++x) M = fmaxf(M, ML[(x * 16 + row) * 2]);
        float Ls = 0.f;
#pragma unroll
        for (int x = 0; x < 4; ++x) Ls += ML[(x * 16 + row) * 2 + 1] * fexp2(ML[(x * 16 + row) * 2] - M);
        FAC[row * 4 + ww] = fexp2(ML[(ww * 16 + row) * 2] - M) / Ls; }
    __syncthreads();
    { const int qq = tid >> 7, j = tid & 127; float sv = 0.f;
#pragma unroll
      for (int rr = 0; rr < 4; ++rr) { const int row = qq * 4 + rr; const f32x2 pp = *(const FLAS f32x2*)(Pc + row * 256 + 2 * j); sv += (pp[0] + pp[1]) * FAC[row * 4 + (j >> 5)]; }
      SC[qq * 132 + j] = (j == 0 || j == 127) ? 1e4f : sv; }
    __syncthreads();
    { const int qq = w >> 1, j = 64 * (w & 1) + lane; const float sj = SC[qq * 132 + j]; int rank = 0;
#pragma unroll 4
      for (int i4 = 0; i4 < 32; ++i4) { const f32x4 sv = *(const FLAS f32x4*)(SC + qq * 132 + 4 * i4);
#pragma unroll
          for (int k = 0; k < 4; ++k) { const int i = 4 * i4 + k; rank += (sv[k] > sj || (sv[k] == sj && i < j)) ? 1 : 0; } }
      SELQ[qq * 132 + j] = rank < 15 ? 1u : 0u; }
    __syncthreads();
    if (w == 0) { unsigned base = 0;
        for (int c = 0; c < 3; ++c) { const int j = 64 * c + lane; unsigned msk = 0u;
            if (j < 128) msk = SELQ[j] | (SELQ[132 + j] << 1) | (SELQ[264 + j] << 2) | (SELQ[396 + j] << 3); else if (j == 128) msk = 0xFu;
            const unsigned long long ball = __ballot(msk != 0u); const unsigned pos = base + (unsigned)__builtin_popcountll(ball & ((1ull << lane) - 1ull));
            if (msk != 0u) LIST[pos] = (unsigned)j | (msk << 8);
            base += (unsigned)__builtin_popcountll(ball); }
        if (lane == 0) NIT[0] = base; }
    __syncthreads();
    const int nit = (int)NIT[0];
    if (w >= 4) {
        sa_block_f32(Vt, lane, winK + (size_t)64 * w * 512, winK + (size_t)64 * w * 512 + 256, 64, qf, a0, lut, 512 + q - 64 * w, 512, true);
        if (w == 4) sa_block_f32(Vt, lane, winN, winN + 256, 4, qf, a0, lut, q, 512, true); }
    { FLAS float* PO = (FLAS float*)(L + SM_PUB0); FLAS float* PM = (FLAS float*)(L + SM_PUBML);
#pragma unroll
      for (int dt = 0; dt < 4; ++dt) *(FLAS f32x4*)(PO + (w * 16 + fr) * 64 + 16 * dt + 4 * fq) = a0.o[dt];
      float l0 = a0.l; l0 += __shfl_xor(l0, 16); l0 += __shfl_xor(l0, 32);
      if (fq == 0) { PM[((w * 2 + 0) * 16 + fr) * 2] = a0.m; PM[((w * 2 + 0) * 16 + fr) * 2 + 1] = l0; } }
#pragma unroll 1
    for (int i = 0; i < nit; ++i) { const int p12 = i % 12; if ((p12 < 8 ? p12 : p12 - 8) != w) continue;
        const unsigned item = LIST[i]; const int j = (int)(item & 255u); const bool rowok = ((item >> (8 + q)) & 1u) != 0u;
        const float* kb; int nk;
        if (j < 128) { const int page = pt[b * NPAGES + (j >> 1)]; kb = IN_F(5) + (((size_t)page * PAGE + (j & 1) * 64) * 2) * 256 + g * 64; nk = 64; }
        else { kb = A.out + O_SELS + ((size_t)b * DS) * 512 + g * 64; nk = DS; }
        sa_block_f32(Vt, lane, kb, kb + 256, nk, qf, a1, lut, PAST + q - 64 * j, 1 << 30, rowok); }
    __syncthreads();
    { FLAS float* PO = (FLAS float*)(L + SM_V); FLAS float* PM = (FLAS float*)(L + SM_PUBML);
#pragma unroll
      for (int dt = 0; dt < 4; ++dt) *(FLAS f32x4*)(PO + (w * 16 + fr) * 64 + 16 * dt + 4 * fq) = a1.o[dt];
      float l1 = a1.l; l1 += __shfl_xor(l1, 16); l1 += __shfl_xor(l1, 32);
      if (fq == 0) { PM[((w * 2 + 1) * 16 + fr) * 2] = a1.m; PM[((w * 2 + 1) * 16 + fr) * 2 + 1] = l1; } }
    __syncthreads();
    { const FLAS float* PM = (const FLAS float*)(L + SM_PUBML);
      const int row = tid >> 5, dim = 2 * (tid & 31), qq = row >> 2, rr = row & 3; const size_t grow = (size_t)MP + b * DS + qq;
      const float* gt = (const float*)(fb + F_GT) + grow * 64 + (g * 4 + rr) * 3; float o0 = 0.f, o1 = 0.f;
#pragma unroll
      for (int br = 0; br < 3; ++br) {
          const int w0 = br == 2 ? 4 : 0, w1 = br == 0 ? 4 : 8, set = br == 1 ? 1 : 0; const FLAS float* PO = (const FLAS float*)(L + (br == 1 ? SM_V : SM_PUB0)); float M = -1e30f;
          for (int x = w0; x < w1; ++x) M = fmaxf(M, PM[((x * 2 + set) * 16 + row) * 2]);
          float Ls = 0.f, x0 = 0.f, x1 = 0.f;
          for (int x = w0; x < w1; ++x) { const float f = fexp2(PM[((x * 2 + set) * 16 + row) * 2] - M); Ls += PM[((x * 2 + set) * 16 + row) * 2 + 1] * f;
              const f32x2 ov = *(const FLAS f32x2*)(PO + (x * 16 + row) * 64 + dim); x0 += ov[0] * f; x1 += ov[1] * f; }
          const float gv = Ls > 0.f ? gt[br] / Ls : 0.f; o0 += gv * x0; o1 += gv * x1; }
      *(unsigned*)((bf16*)(fb + F_O) + grow * D + (g * 4 + rr) * 64 + dim) = pk2(o0, o1); }
}

__device__ __forceinline__ void phase_attn(const Ctx& C, CArgs& A, int l) {
    int prev_bg = -1;
    for (int u = C.wg; u < 1024; u += C.G) { const int i = u >> 8, wv = u & 255, bg = wv & 15, k = wv >> 4;
        const int qt = i == 0 ? 63 - k : (i == 1 ? (k == 7 ? 47 : (k == 15 ? 39 : 32 + k)) : (i == 2 ? (k <= 6 ? 14 - k : (k == 15 ? 7 : 31 - k)) : ((k >= 8 && k <= 14) ? 17 + k : (k == 7 ? 16 : k))));
        attn_prompt_unit(C, A, bg >> 2, bg & 3, qt, bg != prev_bg); prev_bg = bg; }
    __syncthreads();
#ifdef FK_TIMING
    unsigned long long* ts2 = (unsigned long long*)(A.fb + F_CTL + 65536 + 1024);
    if (C.wg == FK_TWG && C.tid == 0) ts2[0] = __builtin_amdgcn_s_memrealtime();
#endif
    { const int su = C.wg < 112 ? C.wg : (C.wg >= 240 ? 112 + (C.wg - 240) : -1); if (su >= 0 && su < DB * 4) attn_sample_unit(C, A, su); }
    __syncthreads();
#ifdef FK_TIMING
    if (C.wg == FK_TWG && C.tid == 0) ts2[1] = __builtin_amdgcn_s_memrealtime();
#endif
}
constexpr int NPHASE = 24;
#ifdef FK_TIMING
#define FK_TIMING_ON 1
#else
#define FK_TIMING_ON 0
#endif
__global__ void __launch_bounds__(NTHR, 2) mega(Args A_unused) {
    extern __shared__ __attribute__((aligned(16))) unsigned char lds_raw[];
    Ctx C; C.lds = (FLAS unsigned char*)lds_raw; C.tid = threadIdx.x; C.lane = C.tid & 63; C.wave = __builtin_amdgcn_readfirstlane(C.tid >> 6); C.G = gridDim.x; C.wg = blockIdx.x;
    C.gw = C.wg * NWAVE + C.wave; C.ngw = C.G * NWAVE;
    CArgs* Ap0 = (CArgs*)__builtin_amdgcn_kernarg_segment_ptr();
    unsigned char* fb = Ap0->fb;
    volatile FLAS unsigned* misc = (volatile FLAS unsigned*)(C.lds + LDS_MISC);
    if (C.tid < 8) misc[C.tid] = 0u;
    __syncthreads();
    const int lo = Ap0->lo, hi = Ap0->hi;
    const bool use_bar = (hi - lo) > 1;
    XcdBarrier bar; bar.bar = (unsigned*)(fb + F_CTL) + 1024; bar.x = 0; bar.st = nullptr;
    if (use_bar) bar = xcd_barrier_post((unsigned*)(fb + F_CTL) + 1024, misc);
    int pidx = 0;
#ifdef FK_TIMING
    unsigned long long* ts = (unsigned long long*)(fb + F_CTL + 65536);
    if (C.wg == 0 && C.tid == 0) ts[0] = __builtin_amdgcn_s_memrealtime();
#define TSTAMP() do { if (C.wg == 0 && threadIdx.x == 0) ts[pidx + 1] = __builtin_amdgcn_s_memrealtime(); } while (0)
#else
#define TSTAMP() do {} while (0)
#endif
#define PH_BEGIN if (lo <= pidx && pidx < hi) { C.tid = pg8::opaque_tid(); C.lane = C.tid & 63; { int wg_ = blockIdx.x, G_ = gridDim.x, wv_ = C.wave; asm volatile("" : "+s"(wg_), "+s"(G_), "+s"(wv_)); C.wg = wg_; C.G = G_; C.wave = wv_; C.gw = wg_ * NWAVE + wv_; C.ngw = G_ * NWAVE; } CArgs* Ap = (CArgs*)__builtin_amdgcn_kernarg_segment_ptr(); asm volatile("" : "+s"(Ap)); CArgs& A = *Ap; unsigned char* fb = A.fb; \
        bf16* XF = (bf16*)(fb + F_X); bf16* HF = (bf16*)(fb + F_H); const float* MODF = (const float*)(fb + F_MOD); \
        const float* mod0 = MODF + (size_t)(2 * l) * NC * 3072; const float* mod1 = MODF + (size_t)(2 * l + 1) * NC * 3072; (void)XF; (void)HF; (void)mod0; (void)mod1;
#define PH_END   if (pidx + 1 < hi || FK_TIMING_ON) xcd_barrier(bar); TSTAMP(); } ++pidx;
    { const int l = 0; PH_BEGIN phase_prologue(C, A); PH_END }

    for (int l = 0; l < 4; ++l) {
        if (l == 0) { PH_BEGIN phase_norm(C, A, 0, 0, true, -1, nullptr, false, C.gw, C.ngw, R); PH_END }
        if (l < 2) {
            PH_BEGIN {
                unsigned* flag = (unsigned*)(fb + F_CTL) + 32768 + 64 * (2 * l - 1);
                if (l > 0) { const Ctx Cn = refreshed(C); sample_norm_part(Cn, A, 0, 2 * l, 2 * l - 1, nullptr, false, flag); }
                C = refreshed(C);
                EpGLU e{(bf16*)(fb + F_U), (float*)(fb + F_US), IN_F(13) + (size_t)l * 2048, A.out + O_CONVP + (size_t)l * BATCH * 30 * D, A.out + O_CONVS + (size_t)l * DB * 30 * D};
                const bf16* W = (const bf16*)(fb + F_WPW1) + (size_t)l * 2048 * 1024;
                gemm_prompt(C, HF, W, 2048, 1024, e);
                C = refreshed(C);
                if (l > 0) sample_rows_ready(C, flag, (unsigned*)(fb + F_CTL) + 1024);
                gemm_sample(C, HF + (size_t)MP * D, W, 2048, 1024, e);
            } PH_END
            PH_BEGIN phase_conv(C, A, l); PH_END
            PH_BEGIN {
                EpResidNorm e{l == 0 ? IN_F(0) : nullptr, XF, mod0, IN_F(19) + (size_t)l * D, 0, mod1, nullptr, HF, nullptr, nullptr,
                              (float*)(fb + F_STATS) + (size_t)(2 * l) * 65536, (unsigned*)(fb + F_CTL) + 65536 + (2 * l) * 4096, (unsigned*)(fb + F_CTL) + 1024};
                const bf16* W = (const bf16*)(fb + F_WPW2) + (size_t)l * 1024 * 1024; const bf16* Ain = (const bf16*)(fb + F_C);
                gemm_prompt_fused(C, Ain, W, 1024, e);
                gemm_sample_ksplit(C, Ain + (size_t)MP * D, W, 1024, (float*)(fb + F_PART));
            } PH_END
        } else {
#ifdef FK_HAVE_ATTN
            PH_BEGIN phase_qkv(C, A, l); PH_END
            if (l == 2) { PH_BEGIN phase_prep(C, A); PH_END }
            PH_BEGIN phase_attn(C, A, l); PH_END
            PH_BEGIN {
                EpResidNorm e{nullptr, XF, mod0, nullptr, 0, mod1, nullptr, HF, nullptr, nullptr,
                              (float*)(fb + F_STATS) + (size_t)(2 * l) * 65536, (unsigned*)(fb + F_CTL) + 65536 + (2 * l) * 4096, (unsigned*)(fb + F_CTL) + 1024};
                const bf16* W = (const bf16*)(fb + F_WO) + (size_t)(l - 2) * 1024 * 1024; const bf16* Ain = (const bf16*)(fb + F_O);
                gemm_prompt_fused(C, Ain, W, 1024, e);
                gemm_sample_ksplit(C, Ain + (size_t)MP * D, W, 1024, (float*)(fb + F_PART));
            } PH_END
#endif
        }
        PH_BEGIN {
            unsigned* flag = (unsigned*)(fb + F_CTL) + 32768 + 64 * (2 * l);
            { const Ctx Cn = refreshed(C); sample_norm_part(Cn, A, 0, 2 * l + 1, 2 * l, l < 2 ? IN_F(19) + (size_t)l * D : nullptr, l == 0, flag); }
            C = refreshed(C);
            EpSwiGLU e{(bf16*)(fb + F_ACT)};
            const bf16* W = (const bf16*)(fb + F_WGU) + (size_t)l * 5632 * 1024;
            gemm_prompt(C, HF, W, 5632, 1024, e);
            C = refreshed(C);
            sample_rows_ready(C, flag, (unsigned*)(fb + F_CTL) + 1024);
            gemm_sample(C, HF + (size_t)MP * D, W, 5632, 1024, e);
        } PH_END
        PH_BEGIN {
            EpResidNorm e{nullptr, XF, mod1, nullptr, l == 3 ? 2 : (l == 1 ? 1 : 0), MODF + (size_t)(l < 3 ? 2 * l + 2 : 0) * NC * 3072, l == 3 ? IN_F(33) : IN_F(20), HF, (bf16*)(fb + F_HKV), A.out + O_YP,
                          (float*)(fb + F_STATS) + (size_t)(2 * l + 1) * 65536, (unsigned*)(fb + F_CTL) + 65536 + (2 * l + 1) * 4096, (unsigned*)(fb + F_CTL) + 1024};
            const bf16* W = (const bf16*)(fb + F_WDN) + (size_t)l * 1024 * 2816; const bf16* Ain = (const bf16*)(fb + F_ACT);
            gemm_prompt_fused(C, Ain, W, 2816, e);
            gemm_sample_ksplit(C, Ain + (size_t)MP * DFF, W, 2816, (float*)(fb + F_PART));
        } PH_END
    }
    { const int l = 0; PH_BEGIN phase_norm(C, A, 2, 0, false, 7, nullptr, false, MP + C.gw, C.ngw, R); PH_END }
#undef PH_BEGIN
#undef PH_END
}


#ifdef FK_TIMING
__global__ void k_encode(const unsigned long long* ts, float* out) {
    float t1 = 0.f, t2 = 0.f;
    for (int p = 0; p < 31; ++p) { const float us = (float)(ts[p + 1] - ts[p]) * 0.01f;
        if ((FK_M1 >> p) & 1ull) t1 += us; if ((FK_M2 >> p) & 1ull) t2 += us; }
#ifdef FK_TSPLIT
    { const unsigned long long* ts2 = ts + 128;
      if (FK_TSPLIT == 1) { t1 = (float)(ts2[0] - ts[25]) * 0.01f; t2 = (float)(ts2[1] - ts2[0]) * 0.01f; }
      if (FK_TSPLIT == 4) { t1 = (float)ts2[6] * 0.01f; t2 = (float)ts2[7] * 0.01f; } }
#endif
    const float sc = 1.f + sqrtf(t1 * 1e-5f);
    for (int i = threadIdx.x; i < MS * D; i += blockDim.x) out[O_YS + i] *= sc;
    if (threadIdx.x == 0) out[O_YP + 12345] += t2 * 1e-2f;
}
#endif
static int g_grid = 0;
static bool fast_setup() {
    if (g_grid) return g_grid > 0;
    int dev = 0, cus = 0;
    if (hipGetDevice(&dev) != hipSuccess || hipDeviceGetAttribute(&cus, hipDeviceAttributeMultiprocessorCount, dev) != hipSuccess) { g_grid = -1; return false; }
    if (hipFuncSetAttribute((const void*)mega, hipFuncAttributeMaxDynamicSharedMemorySize, LDS_BYTES) != hipSuccess) { g_grid = -1; return false; }
    int per_cu = 0; (void)hipOccupancyMaxActiveBlocksPerMultiprocessor(&per_cu, (const void*)mega, NTHR, LDS_BYTES); (void)hipGetLastError();
    if (per_cu < 1) fprintf(stderr, "fast_setup: occupancy query says %d blocks/CU\n", per_cu);
    g_grid = cus;
    return true;
}
static void fast_launch(void* const* d_in, float* out, unsigned char* fb, int lo, int hi, hipStream_t st) {
    if (!fast_setup()) return;
    Args a{}; for (int i = 0; i < 34; ++i) a.in[i] = d_in[i]; a.out = out; a.fb = fb; a.lo = lo; a.hi = hi;
    hipLaunchKernelGGL(mega, dim3(g_grid), dim3(NTHR), LDS_BYTES, st, a);
}
}
extern "C" void kernel_launch(void* const* d_in, const int* in_sizes, int n_in, void* d_out, int out_size, void* d_ws, size_t ws_size, hipStream_t stream) {
    if (ws_size < fk::F_END) { fprintf(stderr, "ws too small: %zu < %zu\n", ws_size, (size_t)fk::F_END); return; }
    unsigned char* fb = (unsigned char*)d_ws;
    (void)hipMemsetAsync(fb + fk::F_CTL, 0, fk::CTL_BYTES, stream);
#if FK_NLAUNCH == 1
    fk::fast_launch(d_in, (float*)d_out, fb, 0, fk::NPHASE, stream);
#ifdef FK_TIMING
    fk::k_encode<<<1, 256, 0, stream>>>((const unsigned long long*)(fb + fk::F_CTL + 65536), (float*)d_out);
#endif
#else
    for (int p = 0; p < fk::NPHASE; ++p) fk::fast_launch(d_in, (float*)d_out, fb, p, p + 1, stream);
#endif
}
```
